# Optimizing an MI355X kernel written in HIP

```python
import math
import jax, jax.numpy as jnp
from jax import lax
import numpy as np

D_MODEL = 2048
BATCH = 16
SEQ = 256
DEPTH = 2
DEC_BATCH = 2
DEC_SEQ = 1024
PAST_LEN = 256

F32 = jnp.float32
GRID_W = 64
ROPE_THETA = 10000.0
NORM_EPS = 1e-6
QBLOCK = 128

HGRN_HEADS = 8
HGRN_DK = 128
HGRN_DV = 128
HGRN_W = HGRN_HEADS * HGRN_DK
HGRN_CHUNK = 16

DIFF_HEADS = 8
DIFF_DK = 64
DIFF_DV = 2 * DIFF_DK
DIFF_W = DIFF_HEADS * DIFF_DV

GQA_HEADS = 8
GQA_KV_HEADS = 2
GQA_DH = 128
GQA_REP = GQA_HEADS // GQA_KV_HEADS
GQA_W = GQA_HEADS * GQA_DH

N_BRANCH = 3
BRANCH_W = 1024

PEER_HEADS = 8
PEER_DK = 256
N_KEYS = 128
N_EXPERTS = N_KEYS * N_KEYS
PEER_TOPK = 16
PEER_BLOCK = 64

IN_SPLITS = (HGRN_W, HGRN_W, HGRN_W, HGRN_W, HGRN_W,
             DIFF_HEADS * 2 * DIFF_DK, DIFF_HEADS * 2 * DIFF_DK, DIFF_W,
             GQA_W, GQA_KV_HEADS * GQA_DH, GQA_KV_HEADS * GQA_DH,
             N_BRANCH * D_MODEL)
IN_WIDTH = 15872

kernel_name = 'hybrid_diffusion_hgrn2_diffattn_gqa_peer_step'


def rms_norm(x, gain):
    x32 = x.astype(F32)
    y = x32 * lax.rsqrt(jnp.mean(x32 * x32, axis=-1, keepdims=True) + NORM_EPS)
    return (y * gain.astype(F32)).astype(x.dtype)


def axial_rope(x):
    T, dim = x.shape[1], x.shape[-1]
    rows = T // GRID_W
    row = jnp.repeat(jnp.arange(rows, dtype=F32), GRID_W)
    col = jnp.tile(jnp.arange(GRID_W, dtype=F32), rows)
    nfreq = dim // 4
    inv_freq = ROPE_THETA ** (-jnp.arange(nfreq, dtype=F32) / nfreq)

    def rot(xh, pos):
        ang = (pos[:, None] * inv_freq)[:, None, :]
        cos, sin = jnp.cos(ang), jnp.sin(ang)
        x1, x2 = xh[..., :nfreq].astype(F32), xh[..., nfreq:].astype(F32)
        return jnp.concatenate([x1 * cos - x2 * sin, x2 * cos + x1 * sin], axis=-1)

    half = dim // 2
    return jnp.concatenate([rot(x[..., :half], row), rot(x[..., half:], col)], axis=-1).astype(x.dtype)


def sweep_query_blocks(block_fn, queries, keys_values):
    B, T = queries[0].shape[:2]
    nb = T // QBLOCK
    qb = tuple(jnp.moveaxis(q.reshape((B, nb, QBLOCK) + q.shape[2:]), 1, 0) for q in queries)
    out = lax.map(lambda blk: block_fn(*blk, *keys_values), qb)
    return jnp.moveaxis(out, 0, 1).reshape((B, T) + out.shape[3:])


def diff_attn_block(q1, q2, k1, k2, v, lam):
    scale = DIFF_DK ** -0.5
    s1 = jnp.einsum('bqhd,bshd->bhqs', q1, k1).astype(F32) * scale
    s2 = jnp.einsum('bqhd,bshd->bhqs', q2, k2).astype(F32) * scale
    p = jax.nn.softmax(s1, axis=-1) - lam * jax.nn.softmax(s2, axis=-1)
    return jnp.einsum('bhqs,bshv->bqhv', p.astype(v.dtype), v)


def gqa_block(q, k, v):
    s = jnp.einsum('bqgrd,bsgd->bgrqs', q, k).astype(F32) * (GQA_DH ** -0.5)
    p = jax.nn.softmax(s, axis=-1).astype(v.dtype)
    return jnp.einsum('bgrqs,bsgd->bqgrd', p, v)


def forget_gate(zf, lb):
    lb = lb.astype(F32)
    logf = jnp.logaddexp(jnp.log(lb), jnp.log1p(-lb) + jax.nn.log_sigmoid(zf.astype(F32)))
    return logf, -jnp.expm1(logf)


def hgrn_chunkwise(q, logf, k, v, s0):
    B, T, H, K = q.shape
    V = v.shape[-1]
    C = HGRN_CHUNK
    N = T // C

    def chunks(a):
        return a.astype(F32).reshape(B, N, C, H, a.shape[-1]).transpose(1, 0, 3, 2, 4)

    qc, fc, kc, vc = chunks(q), chunks(logf), chunks(k), chunks(v)
    b = jnp.cumsum(fc, axis=3)
    b_last = b[:, :, :, -1, :]
    tri = jnp.tril(jnp.ones((C, C), bool))[:, :, None]
    rel = b[:, :, :, :, None, :] - b[:, :, :, None, :, :]
    decay = jnp.exp(jnp.where(tri, rel, -jnp.inf))
    attn = jnp.einsum('nbhtk,nbhsk,nbhtsk->nbhts', qc, kc, decay)
    o_intra = jnp.einsum('nbhts,nbhsv->nbhtv', attn, vc)
    q_dec = qc * jnp.exp(b)
    k_dec = kc * jnp.exp(b_last[:, :, :, None, :] - b)

    def step(S, inp):
        qd, kd, vv, dl = inp
        o = jnp.einsum('bhtk,bhkv->bhtv', qd, S)
        S = jnp.exp(dl)[..., None] * S + jnp.einsum('bhsk,bhsv->bhkv', kd, vv)
        return S, o

    s_fin, o_inter = lax.scan(step, s0.astype(F32), (q_dec, k_dec, vc, b_last))
    o = (o_intra + o_inter).transpose(1, 0, 3, 2, 4).reshape(B, T, H, V)
    return o.astype(v.dtype), s_fin.astype(v.dtype)


def peer_ffn(h, wq, keys, u, v):
    B, T, D = h.shape
    P = PEER_BLOCK
    xt = h.reshape(B * T // P, P, D)

    def block(xb):
        q = (xb @ wq).reshape(P, PEER_HEADS, 2, PEER_DK // 2)
        s = jnp.einsum('phcd,ckd->phck', q, keys).astype(F32)
        sv, si = lax.top_k(s, PEER_TOPK)
        cand = sv[:, :, 0, :, None] + sv[:, :, 1, None, :]
        cv, ci = lax.top_k(cand.reshape(P, PEER_HEADS, PEER_TOPK * PEER_TOPK), PEER_TOPK)
        i1 = jnp.take_along_axis(si[:, :, 0, :], ci // PEER_TOPK, axis=-1)
        i2 = jnp.take_along_axis(si[:, :, 1, :], ci % PEER_TOPK, axis=-1)
        e = i1 * N_KEYS + i2
        g = jax.nn.softmax(cv, axis=-1)
        a = jax.nn.gelu(jnp.einsum('phkd,pd->phk', u[e], xb), approximate=False)
        w = (g * a.astype(F32)).astype(xb.dtype)
        return jnp.einsum('phk,phkd->pd', w, v[e])

    return lax.map(block, xt).reshape(B, T, D)


def token_mixer(h, p, lb, lam_init, ctx):
    B, T, _ = h.shape
    latent = ctx is not None
    z = h @ p['w_in']
    hq, hf_fwd, hf_bwd, hi, hg, dq, dk, dv, gq, gk, gv, gate_logits = jnp.split(
        z, np.cumsum(IN_SPLITS)[:-1].tolist(), axis=-1)

    q_h = hq.reshape(B, T, HGRN_HEADS, HGRN_DK)
    v_h = hi.reshape(B, T, HGRN_HEADS, HGRN_DV)
    s0 = ctx['state_hgrn'] if latent else jnp.zeros((B, 2, HGRN_HEADS, HGRN_DK, HGRN_DV), F32)
    o_sum = None
    finals = []
    for d, zf in enumerate((hf_fwd, hf_bwd)):
        logf, k_h = forget_gate(zf.reshape(B, T, HGRN_HEADS, HGRN_DK), lb[d].reshape(HGRN_HEADS, HGRN_DK))
        if d == 1:
            o_d, s_d = hgrn_chunkwise(q_h[:, ::-1], logf[:, ::-1], k_h[:, ::-1], v_h[:, ::-1], s0[:, d])
            o_d = o_d[:, ::-1]
        else:
            o_d, s_d = hgrn_chunkwise(q_h, logf, k_h, v_h, s0[:, d])
        o_sum = o_d if o_sum is None else o_sum + o_d
        finals.append(s_d)
    hgrn_out = (rms_norm(o_sum, p['hgrn_norm'])
                * jax.nn.silu(hg.reshape(B, T, HGRN_HEADS, HGRN_DV))).reshape(B, T, HGRN_W)

    dq = rms_norm(dq.reshape(B, T, DIFF_HEADS, 2, DIFF_DK), p['diff_qk_norm'][0])
    dk = rms_norm(dk.reshape(B, T, DIFF_HEADS, 2, DIFF_DK), p['diff_qk_norm'][1])
    dv = dv.reshape(B, T, DIFF_HEADS, DIFF_DV)
    q1, q2, k1, k2 = dq[..., 0, :], dq[..., 1, :], dk[..., 0, :], dk[..., 1, :]
    if latent:
        q1, q2, k1, k2 = axial_rope(q1), axial_rope(q2), axial_rope(k1), axial_rope(k2)
        ck = ctx['diff_k']
        k1 = jnp.concatenate([k1, ck[..., :DIFF_DK]], axis=1)
        k2 = jnp.concatenate([k2, ck[..., DIFF_DK:]], axis=1)
        dv_all = jnp.concatenate([dv, ctx['diff_v']], axis=1)
    else:
        dv_all = dv
        new_diff_k = jnp.concatenate([k1, k2], axis=-1)
        new_diff_v = dv
    lp = p['diff_lambda'].astype(F32)
    lam = jnp.exp(jnp.sum(lp[0] * lp[1])) - jnp.exp(jnp.sum(lp[2] * lp[3])) + lam_init
    o_d = sweep_query_blocks(lambda a, b_, k1_, k2_, v_: diff_attn_block(a, b_, k1_, k2_, v_, lam),
                             (q1, q2), (k1, k2, dv_all))
    diff_out = (rms_norm(o_d, p['diff_subln']) * (1.0 - lam_init)).reshape(B, T, DIFF_W)

    gq = rms_norm(gq.reshape(B, T, GQA_HEADS, GQA_DH), p['gqa_qk_norm'][0])
    gk = rms_norm(gk.reshape(B, T, GQA_KV_HEADS, GQA_DH), p['gqa_qk_norm'][1])
    gv = gv.reshape(B, T, GQA_KV_HEADS, GQA_DH)
    if latent:
        gq, gk = axial_rope(gq), axial_rope(gk)
        gk_all = jnp.concatenate([gk, ctx['gqa_k']], axis=1)
        gv_all = jnp.concatenate([gv, ctx['gqa_v']], axis=1)
    else:
        gk_all, gv_all = gk, gv
        new_gqa_k, new_gqa_v = gk, gv
    o_g = sweep_query_blocks(gqa_block, (gq.reshape(B, T, GQA_KV_HEADS, GQA_REP, GQA_DH),), (gk_all, gv_all))
    gqa_out = o_g.reshape(B, T, GQA_W)

    branches = jnp.stack([hgrn_out, diff_out, gqa_out], axis=2)
    proj = jnp.einsum('btci,cid->btcd', branches, p['w_branch'])
    gates = jax.nn.sigmoid(gate_logits.reshape(B, T, N_BRANCH, D_MODEL))
    out = jnp.sum(gates * proj, axis=2) @ p['w_out']
    if latent:
        return out, None
    return out, (new_diff_k, new_diff_v, new_gqa_k, new_gqa_v, jnp.stack(finals, axis=1))


def trunk_layer(x, cond, p, lb, lam_init, ctx):
    mod = jax.nn.silu(cond) @ p['mod_w'] + p['mod_b']
    sh1, sc1, g1, sh2, sc2, g2 = jnp.split(mod[:, None, :], 6, axis=-1)
    h = rms_norm(x, p['norm_mix']) * (1 + sc1) + sh1
    mix, ctx_out = token_mixer(h, p, lb, lam_init, ctx)
    x = x + g1 * mix
    h = rms_norm(x, p['norm_ffn']) * (1 + sc2) + sh2
    x = x + g2 * peer_ffn(h, p['peer_wq'], p['peer_keys'], p['peer_u'], p['peer_v'])
    return x, ctx_out


def setup_inputs(seed: int = 0) -> dict:
    key = jax.random.key(seed)
    ks = jax.random.split(key, 32)

    def nrm(k, shape, s):
        return jax.random.normal(k, shape, F32) * s

    D = D_MODEL
    return {
        'x_prompt': nrm(ks[0], (BATCH, SEQ, D), 1.0),
        'x_sample': nrm(ks[1], (DEC_BATCH, DEC_SEQ, D), 1.0),
        'c': nrm(ks[2], (DEC_BATCH, D), 1.0),
        'cache_diff_k': nrm(ks[3], (DEC_BATCH, DEPTH, PAST_LEN, DIFF_HEADS, 2 * DIFF_DK), 1.0),
        'cache_diff_v': nrm(ks[4], (DEC_BATCH, DEPTH, PAST_LEN, DIFF_HEADS, DIFF_DV), 1.0),
        'cache_gqa_k': nrm(ks[5], (DEC_BATCH, DEPTH, PAST_LEN, GQA_KV_HEADS, GQA_DH), 1.0),
        'cache_gqa_v': nrm(ks[6], (DEC_BATCH, DEPTH, PAST_LEN, GQA_KV_HEADS, GQA_DH), 1.0),
        'state_hgrn': nrm(ks[7], (DEC_BATCH, DEPTH, 2, HGRN_HEADS, HGRN_DK, HGRN_DV), 0.5),
        'c_ctx': nrm(ks[8], (D,), 1.0),
        'mod_w': nrm(ks[9], (DEPTH, D, 6 * D), 0.5 * D ** -0.5),
        'mod_b': nrm(ks[10], (DEPTH, 6 * D), 0.02),
        'norm_mix': 1.0 + nrm(ks[11], (DEPTH, D), 0.02),
        'norm_ffn': 1.0 + nrm(ks[12], (DEPTH, D), 0.02),
        'w_in': nrm(ks[13], (DEPTH, D, IN_WIDTH), D ** -0.5),
        'hgrn_lb': nrm(ks[14], (2, DEPTH, HGRN_W), 0.5),
        'hgrn_norm': 1.0 + nrm(ks[15], (DEPTH, HGRN_DV), 0.02),
        'diff_qk_norm': 1.0 + nrm(ks[16], (DEPTH, 2, DIFF_DK), 0.02),
        'diff_lambda': nrm(ks[17], (DEPTH, 4, DIFF_DK), 0.1),
        'diff_subln': 1.0 + nrm(ks[18], (DEPTH, DIFF_DV), 0.02),
        'gqa_qk_norm': 1.0 + nrm(ks[19], (DEPTH, 2, GQA_DH), 0.02),
        'w_branch': nrm(ks[20], (DEPTH, N_BRANCH, BRANCH_W, D), BRANCH_W ** -0.5),
        'w_out': nrm(ks[21], (DEPTH, D, D), D ** -0.5),
        'peer_wq': nrm(ks[22], (DEPTH, D, PEER_HEADS * PEER_DK), D ** -0.5),
        'peer_keys': nrm(ks[23], (DEPTH, 2, N_KEYS, PEER_DK // 2), (PEER_DK // 2) ** -0.5),
        'peer_u': nrm(ks[24], (DEPTH, N_EXPERTS, D), D ** -0.5),
        'peer_v': nrm(ks[25], (DEPTH, N_EXPERTS, D), 0.1),
    }


def reference(x_prompt, x_sample, c, cache_diff_k, cache_diff_v, cache_gqa_k, cache_gqa_v, state_hgrn,
              c_ctx, mod_w, mod_b, norm_mix, norm_ffn, w_in, hgrn_lb, hgrn_norm, diff_qk_norm,
              diff_lambda, diff_subln, gqa_qk_norm, w_branch, w_out, peer_wq, peer_keys, peer_u, peer_v):
    lb_all = jnp.cumsum(jax.nn.softmax(hgrn_lb.astype(F32), axis=1), axis=1)
    lb_all = lb_all - lb_all[:, :1]
    y_prompt = x_prompt
    y_sample = x_sample
    nk, nv, ngk, ngv, nst = [], [], [], [], []
    for l in range(DEPTH):
        p = {'mod_w': mod_w[l], 'mod_b': mod_b[l], 'norm_mix': norm_mix[l], 'norm_ffn': norm_ffn[l],
             'w_in': w_in[l], 'hgrn_norm': hgrn_norm[l], 'diff_qk_norm': diff_qk_norm[l],
             'diff_lambda': diff_lambda[l], 'diff_subln': diff_subln[l], 'gqa_qk_norm': gqa_qk_norm[l],
             'w_branch': w_branch[l], 'w_out': w_out[l], 'peer_wq': peer_wq[l], 'peer_keys': peer_keys[l],
             'peer_u': peer_u[l], 'peer_v': peer_v[l]}
        lam_init = 0.8 - 0.6 * math.exp(-0.3 * l)
        lb = lb_all[:, l]
        y_prompt, ctx_out = trunk_layer(y_prompt, c_ctx[None, :], p, lb, lam_init, None)
        nk.append(ctx_out[0]); nv.append(ctx_out[1]); ngk.append(ctx_out[2]); ngv.append(ctx_out[3]); nst.append(ctx_out[4])
        ctx_l = {'diff_k': cache_diff_k[:, l], 'diff_v': cache_diff_v[:, l], 'gqa_k': cache_gqa_k[:, l],
                 'gqa_v': cache_gqa_v[:, l], 'state_hgrn': state_hgrn[:, l]}
        y_sample, _ = trunk_layer(y_sample, c, p, lb, lam_init, ctx_l)
    new_cache_diff_k = jnp.stack(nk, axis=1)
    new_cache_diff_v = jnp.stack(nv, axis=1)
    new_cache_gqa_k = jnp.stack(ngk, axis=1)
    new_cache_gqa_v = jnp.stack(ngv, axis=1)
    new_state_hgrn = jnp.stack(nst, axis=1)
    return (y_prompt, y_sample, new_cache_diff_k, new_cache_diff_v, new_cache_gqa_k, new_cache_gqa_v, new_state_hgrn)
```

```cpp
#include <hip/hip_runtime.h>
#include <hip/hip_bf16.h>
#include <cstdio>
#include <cstdint>
#include <cmath>
#define PROBE_DUP 0
#define HG_PROBE 0
#define PROBE_XBAR 0
#ifndef N_LAUNCH_MODE
#define N_LAUNCH_MODE 0
#endif
__device__ __forceinline__ int fresh_tid() { int t = (int)threadIdx.x; asm volatile("" : "+v"(t)); return t; }
__device__ __forceinline__ unsigned char* fresh_ws(unsigned char* p) { asm volatile("" : "+s"(p)); return p; }
namespace pg8 {
#define PG8_LAS __attribute__((address_space(3)))
typedef unsigned short bf16_t;
typedef short bf16x8 __attribute__((ext_vector_type(8)));
typedef float f32x4 __attribute__((ext_vector_type(4)));
typedef unsigned u32x4 __attribute__((ext_vector_type(4)));
constexpr int BM = 256, BK = 64, HALF = 128, HTB = HALF * BK * 2  , STAGE_BYTES = 8 * HTB, NXCD = 8, WGM = 8;

__host__ __device__ __forceinline__ int lds_byte(int r, int c) { const int st = (r >> 4) * 2 + (c >> 5), rr = r & 15, cc = c & 31, ob = rr * 64 + cc * 2; return st * 1024 + (ob ^ (((ob >> 9) & 1) << 5)); }
__host__ __device__ __forceinline__ void stage_rc(int b, int& R, int& C) { const int st = b / 1024, sb = b % 1024, swz = sb ^ (((sb >> 9) & 1) << 5); R = (st >> 1) * 16 + swz / 64; C = (st & 1) * 32 + (swz % 64) / 2; }
__host__ __device__ __forceinline__ int perm32(int rho) { const int n = rho >> 4, i = rho & 15; return 8 * (i >> 2) + 4 * n + (i & 3); }

struct Unit { int pm, pn; };
struct Gemm { const bf16_t* A; const bf16_t* Bt; int M, N, K; };

struct StaticOrder {
    int nM, nN, nwg, G, c;
    __host__ __device__ void init(int M, int N, int G_, int c_) { nM = M / BM; nN = N / BM; nwg = nM * nN; G = G_; c = c_; }
    __host__ __device__ bool next(int i, Unit& u) const {
        const long L = (long)i * G + c; if (L >= nwg) return false;
        int wgid = (int)L; { const int q = nwg / NXCD, r = nwg % NXCD, xcd = wgid % NXCD, off = wgid / NXCD; wgid = (xcd < r ? xcd * (q + 1) : r * (q + 1) + (xcd - r) * q) + off; }
        const int nig = WGM * nN, gid = wgid / nig, fm = gid * WGM, gsz = (nM - fm) < WGM ? (nM - fm) : WGM;
        u.pm = fm + ((wgid % nig) % gsz); u.pn = (wgid % nig) / gsz; return true;
    }
    __device__ __forceinline__ void a_ready(const Unit&) const {}
    __device__ __forceinline__ void done(const Unit&) const {}
};

__device__ __forceinline__ unsigned cvt_pk_bf16(float lo, float hi) { unsigned r; asm volatile("v_cvt_pk_bf16_f32 %0, %1, %2" : "=v"(r) : "v"(lo), "v"(hi)); return r; }
typedef float f32x2 __attribute__((ext_vector_type(2)));
__device__ __forceinline__ f32x2 gelu_pk(f32x2 v) {
    const f32x2 av = __builtin_elementwise_abs(v), d = av * 0.2316418882f + 1.0f;
    f32x2 t; t.x = __builtin_amdgcn_rcpf(d.x); t.y = __builtin_amdgcn_rcpf(d.y);
    f32x2 q = t * 0.5307027145f + (-0.7265760135f); q = q * t + 0.7107068705f; q = q * t + (-0.142248368f); q = q * t + 0.127414796f; q = q * t;
    const f32x2 s = (v * v) * (-0.72134752044f);
    f32x2 e; e.x = __builtin_amdgcn_exp2f(s.x); e.y = __builtin_amdgcn_exp2f(s.y);
    const f32x2 m = v * (q * e), r = v - m;
    f32x2 o; o.x = v.x < 0.f ? m.x : r.x; o.y = v.y < 0.f ? m.y : r.y; return o;
}

template <int ACT  > struct EpiBf16 {
    static constexpr bool PERM = true, AFTER_DRAIN = false; static_assert(ACT == 0 || ACT == 1, "EpiBf16: ACT is 0 (none) or 1 (gelu_pk)");
    bf16_t* O; int ldc; const float* bias; int split_cols; size_t split_stride; float scale0;
    __device__ __forceinline__ void operator()(const f32x4 (&acc)[2][2][4][2], const Unit& u, int wr, int wc, int fr, int fq) const {
        const int row0 = u.pm * BM + wr * 64 + fr; int colt = u.pn * BM; bf16_t* base = O;
        float sc = 1.f; if (split_cols) { const int t = colt / split_cols; base += (size_t)t * split_stride; colt -= t * split_cols; if (t == 0) sc = scale0; }
        const int col0 = colt + wc * 32 + 8 * fq, bcol0 = u.pn * BM + wc * 32 + 8 * fq;
        f32x4 bv[2][2];
#pragma unroll
        for (int bj = 0; bj < 2; ++bj)
#pragma unroll
            for (int n = 0; n < 2; ++n) bv[bj][n] = bias ? *(const f32x4*)(bias + bcol0 + bj * HALF + 4 * n) : (f32x4){0.f, 0.f, 0.f, 0.f};
#pragma unroll
        for (int ai = 0; ai < 2; ++ai)
#pragma unroll
            for (int m = 0; m < 4; ++m) { bf16_t* rowp = base + (size_t)(row0 + ai * HALF + m * 16) * ldc + col0;
#pragma unroll
                for (int bj = 0; bj < 2; ++bj) { f32x4 v0 = acc[ai][bj][m][0] + bv[bj][0], v1 = acc[ai][bj][m][1] + bv[bj][1];
                    if (ACT == 1) { f32x2 a = gelu_pk((f32x2){v0[0], v0[1]}), b = gelu_pk((f32x2){v0[2], v0[3]}), c = gelu_pk((f32x2){v1[0], v1[1]}), d = gelu_pk((f32x2){v1[2], v1[3]});
                        v0 = (f32x4){a.x, a.y, b.x, b.y}; v1 = (f32x4){c.x, c.y, d.x, d.y}; }
                    v0 = v0 * sc; v1 = v1 * sc; u32x4 w; w.x = cvt_pk_bf16(v0[0], v0[1]); w.y = cvt_pk_bf16(v0[2], v0[3]); w.z = cvt_pk_bf16(v1[0], v1[1]); w.w = cvt_pk_bf16(v1[2], v1[3]);
                    *(u32x4*)(rowp + bj * HALF) = w; } }
    }
};

struct EpiF32 {
    static constexpr bool PERM = false, AFTER_DRAIN = false;
    float* C; int ldc;
    __device__ __forceinline__ void operator()(const f32x4 (&acc)[2][2][4][2], const Unit& u, int wr, int wc, int fr, int fq) const {
        const int row0 = u.pm * BM + wr * 64 + fr, col0 = u.pn * BM + wc * 32 + 4 * fq;
#pragma unroll
        for (int ai = 0; ai < 2; ++ai)
#pragma unroll
            for (int m = 0; m < 4; ++m) { float* rowp = C + (size_t)(row0 + ai * HALF + m * 16) * ldc + col0;
#pragma unroll
                for (int bj = 0; bj < 2; ++bj)
#pragma unroll
                    for (int n = 0; n < 2; ++n) *(f32x4*)(rowp + bj * HALF + n * 16) = acc[ai][bj][m][n]; }
    }
};
__device__ __forceinline__ float sigmoid_f(float x) { return __builtin_amdgcn_rcpf(1.0f + __builtin_amdgcn_exp2f(-1.4426950408889634f * x)); }
struct EpiGate {
    static constexpr bool PERM = true, AFTER_DRAIN = false;
    const bf16_t* Z; int ldz; int gcol0; bf16_t* P; bf16_t* O; int ldc; int MODE;
    __device__ __forceinline__ void operator()(const f32x4 (&acc)[2][2][4][2], const Unit& u, int wr, int wc, int fr, int fq) const {
        const int row0 = u.pm * BM + wr * 64 + fr, col0 = u.pn * BM + wc * 32 + 8 * fq;
#pragma unroll
        for (int ai = 0; ai < 2; ++ai)
#pragma unroll
            for (int m = 0; m < 4; ++m) { const int row = row0 + ai * HALF + m * 16;
#pragma unroll
                for (int bj = 0; bj < 2; ++bj) { const int col = col0 + bj * HALF;
                    const u32x4 gz = *(const u32x4*)(Z + (size_t)row * ldz + gcol0 + col);
                    f32x4 s0, s1;
                    s0[0] = sigmoid_f(__uint_as_float(gz[0] << 16)); s0[1] = sigmoid_f(__uint_as_float(gz[0] & 0xffff0000u));
                    s0[2] = sigmoid_f(__uint_as_float(gz[1] << 16)); s0[3] = sigmoid_f(__uint_as_float(gz[1] & 0xffff0000u));
                    s1[0] = sigmoid_f(__uint_as_float(gz[2] << 16)); s1[1] = sigmoid_f(__uint_as_float(gz[2] & 0xffff0000u));
                    s1[2] = sigmoid_f(__uint_as_float(gz[3] << 16)); s1[3] = sigmoid_f(__uint_as_float(gz[3] & 0xffff0000u));
                    f32x4 v0 = acc[ai][bj][m][0] * s0, v1 = acc[ai][bj][m][1] * s1;
                    bf16_t* pp = P + (size_t)row * ldc + col;
                    if (MODE >= 1) { const u32x4 pw = *(const u32x4*)pp;
                        v0[0] += __uint_as_float(pw[0] << 16); v0[1] += __uint_as_float(pw[0] & 0xffff0000u); v0[2] += __uint_as_float(pw[1] << 16); v0[3] += __uint_as_float(pw[1] & 0xffff0000u);
                        v1[0] += __uint_as_float(pw[2] << 16); v1[1] += __uint_as_float(pw[2] & 0xffff0000u); v1[2] += __uint_as_float(pw[3] << 16); v1[3] += __uint_as_float(pw[3] & 0xffff0000u); }
                    u32x4 w; w.x = cvt_pk_bf16(v0[0], v0[1]); w.y = cvt_pk_bf16(v0[2], v0[3]); w.z = cvt_pk_bf16(v1[0], v1[1]); w.w = cvt_pk_bf16(v1[2], v1[3]);
                    *(u32x4*)((MODE <= 1 ? pp : O + (size_t)row * ldc + col)) = w; } }
    }
};
struct EpiResid {
    static constexpr bool PERM = false, AFTER_DRAIN = false;
    const float* xp; const float* xs; const float* gate; float* out;
    __device__ __forceinline__ void operator()(const f32x4 (&acc)[2][2][4][2], const Unit& u, int wr, int wc, int fr, int fq) const {
        const int row0 = u.pm * BM + wr * 64 + fr, col0 = u.pn * BM + wc * 32 + 4 * fq;
        const bool samp = u.pm >= 16; const int r = samp ? 1 + ((u.pm - 16) >> 2) : 0;
        const float* xb = samp ? xs - (size_t)4096 * 2048 : xp;
        f32x4 gv[2][2];
#pragma unroll
        for (int bj = 0; bj < 2; ++bj)
#pragma unroll
            for (int n = 0; n < 2; ++n) gv[bj][n] = *(const f32x4*)(gate + (size_t)r * 12288 + col0 + bj * HALF + n * 16);
#pragma unroll
        for (int ai = 0; ai < 2; ++ai)
#pragma unroll
            for (int m = 0; m < 4; ++m) { const size_t off = (size_t)(row0 + ai * HALF + m * 16) * 2048 + col0;
#pragma unroll
                for (int bj = 0; bj < 2; ++bj)
#pragma unroll
                    for (int n = 0; n < 2; ++n) { const f32x4 x = *(const f32x4*)(xb + off + bj * HALF + n * 16);
                        *(f32x4*)(out + off + bj * HALF + n * 16) = x + gv[bj][n] * acc[ai][bj][m][n]; } }
    }
};

template <class Epi, class Sched, bool ALIGN_EPI = false, bool SP2 = false>
__device__ __forceinline__ void gemm_phase(PG8_LAS unsigned char* lds, const Gemm g, const Sched& S, const Epi& E) {
    const int tid = fresh_tid(), wid = __builtin_amdgcn_readfirstlane(tid >> 6), lane = tid & 63, wr = wid >> 2, wc = wid & 3, fr = lane & 15, fq = lane >> 4;
    const int K = g.K, nt = K / BK;
    unsigned voffA[2], voffB[2];
#pragma unroll
    for (int i = 0; i < 2; ++i) { int R, C; stage_rc(tid * 16 + i * 8192, R, C); const int Rb = Epi::PERM ? ((R & ~31) + perm32(R & 31)) : R;
        voffA[i] = (unsigned)(R * K + C) * 2u; voffB[i] = (unsigned)(Rb * K + C) * 2u; }
    const size_t kstep = (size_t)(BK * 2);
    const size_t hstep = (size_t)HALF * K * 2;
    const size_t tstep = 2 * hstep;
    const unsigned ldsw = (unsigned)wid * 1024u;
    const int aoff = lds_byte(wr * 64 + fr, fq * 8), boff = lds_byte(wc * 32 + fr, fq * 8);
#define PG8_SA(b, h) (((b) * 2 + (h)) * HTB)
#define PG8_SB(b, h) ((4 + (b) * 2 + (h)) * HTB)
#define PG8_STAGE(bufoff, gbase, voff) do { _Pragma("unroll") for (int _i = 0; _i < 2; ++_i) \
        __builtin_amdgcn_global_load_lds((const unsigned*)((const char*)(gbase) + (voff)[_i]), (PG8_LAS unsigned*)(lds + (bufoff) + ldsw + _i * 8192), 16, 0, 0); } while (0)
#define PG8_LDA(dst, b, h) do { _Pragma("unroll") for (int m = 0; m < 4; ++m) _Pragma("unroll") for (int k = 0; k < 2; ++k) dst[m][k] = *(const PG8_LAS bf16x8*)(lds + PG8_SA(b, h) + aoff + m * 2048 + k * 1024); } while (0)
#define PG8_LDB(dst, b, h) do { _Pragma("unroll") for (int n = 0; n < 2; ++n) _Pragma("unroll") for (int k = 0; k < 2; ++k) dst[n][k] = *(const PG8_LAS bf16x8*)(lds + PG8_SB(b, h) + boff + n * 2048 + k * 1024); } while (0)
#define PG8_MMA(ai, bj, At, Bt) do { __builtin_amdgcn_s_setprio(1); _Pragma("unroll") for (int m = 0; m < 4; ++m) _Pragma("unroll") for (int n = 0; n < 2; ++n) _Pragma("unroll") for (int k = 0; k < 2; ++k) \
        acc[ai][bj][m][n] = __builtin_amdgcn_mfma_f32_16x16x32_bf16(Bt[n][k], At[m][k], acc[ai][bj][m][n], 0, 0, 0); __builtin_amdgcn_s_setprio(0); } while (0)
#define PG8_WAIT_V(n) asm volatile("s_waitcnt vmcnt(" #n ")" ::: "memory")
#define PG8_WAIT_L(n) asm volatile("s_waitcnt lgkmcnt(" #n ")" ::: "memory")
#define PG8_BAR __builtin_amdgcn_s_barrier()
#define PG8_SCHED __builtin_amdgcn_sched_barrier(0)
    Unit cur, nxt; int ui = 0;
    if (!S.next(0, cur)) return;
    f32x4 acc[2][2][4][2];
#pragma unroll
    for (int a = 0; a < 2; ++a)
#pragma unroll
        for (int b = 0; b < 2; ++b)
#pragma unroll
            for (int m = 0; m < 4; ++m)
#pragma unroll
                for (int n = 0; n < 2; ++n) acc[a][b][m][n] = (f32x4){0.f, 0.f, 0.f, 0.f};
    bf16x8 At[4][2], B0[2][2], B1[2][2];
    const char* cA = (const char*)g.A + (size_t)cur.pm * tstep; const char* cB = (const char*)g.Bt + (size_t)cur.pn * tstep;
    S.a_ready(cur);
    if constexpr (SP2) {
        PG8_STAGE(PG8_SB(0, 0), cB, voffB); PG8_STAGE(PG8_SB(0, 1), cB + hstep, voffB); PG8_STAGE(PG8_SA(0, 0), cA, voffA); PG8_STAGE(PG8_SA(0, 1), cA + hstep, voffA);
        if (wr == 1) PG8_BAR;
        PG8_WAIT_V(2); PG8_BAR;
        PG8_STAGE(PG8_SB(1, 0), cB + kstep, voffB); PG8_STAGE(PG8_SA(1, 0), cA + kstep, voffA); PG8_STAGE(PG8_SB(1, 1), cB + hstep + kstep, voffB);
        PG8_WAIT_V(6); PG8_BAR;
    } else {
        PG8_STAGE(PG8_SB(0, 0), cB, voffB); PG8_STAGE(PG8_SA(0, 0), cA, voffA); PG8_STAGE(PG8_SB(0, 1), cB + hstep, voffB); PG8_STAGE(PG8_SA(0, 1), cA + hstep, voffA);
        if (wr == 1) PG8_BAR;
        PG8_WAIT_V(4); PG8_BAR;
        PG8_STAGE(PG8_SB(1, 0), cB + kstep, voffB); PG8_STAGE(PG8_SA(1, 0), cA + kstep, voffA); PG8_STAGE(PG8_SB(1, 1), cB + hstep + kstep, voffB);
        PG8_WAIT_V(6); PG8_BAR;
    }
    for (;;) {
        const bool has_next = S.next(ui + 1, nxt);
        const char* nA = has_next ? (const char*)g.A + (size_t)nxt.pm * tstep : cA; const char* nB = has_next ? (const char*)g.Bt + (size_t)nxt.pn * tstep : cB;
        for (int t = 0; t < nt; t += 2) {
            const bool last = (t == nt - 2);
            const char* a1 = cA + (size_t)(t + 1) * kstep;
            const char* a2 = last ? nA : cA + (size_t)(t + 2) * kstep; const char* b2 = last ? nB : cB + (size_t)(t + 2) * kstep;
            const char* a3 = a2 + kstep; const char* b3 = b2 + kstep;
            if (last && has_next) S.a_ready(nxt);
            if constexpr (SP2) {
            PG8_LDB(B0, 0, 0); PG8_LDB(B1, 0, 1); PG8_SCHED; PG8_LDA(At, 0, 0); PG8_STAGE(PG8_SA(1, 1), a1 + hstep, voffA);
            PG8_WAIT_V(8); PG8_WAIT_L(0); PG8_BAR; PG8_MMA(0, 0, At, B0); PG8_MMA(0, 1, At, B1); PG8_BAR; PG8_SCHED;
            PG8_LDA(At, 0, 1); PG8_STAGE(PG8_SB(0, 0), b2, voffB); PG8_STAGE(PG8_SB(0, 1), b2 + hstep, voffB); PG8_STAGE(PG8_SA(0, 0), a2, voffA);
            PG8_WAIT_V(8); PG8_WAIT_L(0); PG8_BAR; PG8_MMA(1, 0, At, B0); PG8_MMA(1, 1, At, B1); PG8_BAR; PG8_SCHED;
            PG8_LDB(B0, 1, 0); PG8_LDB(B1, 1, 1); PG8_SCHED; PG8_LDA(At, 1, 0); PG8_STAGE(PG8_SA(0, 1), a2 + hstep, voffA);
            PG8_WAIT_V(8); PG8_WAIT_L(0); PG8_BAR; PG8_MMA(0, 0, At, B0); PG8_MMA(0, 1, At, B1); PG8_BAR; PG8_SCHED;
            PG8_LDA(At, 1, 1); PG8_STAGE(PG8_SB(1, 0), b3, voffB); PG8_STAGE(PG8_SB(1, 1), b3 + hstep, voffB); PG8_STAGE(PG8_SA(1, 0), a3, voffA);
            PG8_WAIT_V(8); PG8_WAIT_L(0); PG8_BAR; PG8_MMA(1, 0, At, B0); PG8_MMA(1, 1, At, B1); PG8_BAR; PG8_SCHED;
            } else {
            PG8_LDB(B0, 0, 0); PG8_SCHED; PG8_LDA(At, 0, 0); PG8_STAGE(PG8_SA(1, 1), a1 + hstep, voffA);
            PG8_WAIT_L(8); PG8_BAR; PG8_WAIT_L(0); PG8_MMA(0, 0, At, B0); PG8_BAR; PG8_SCHED;
            PG8_LDB(B1, 0, 1); PG8_STAGE(PG8_SB(0, 0), b2, voffB);
            PG8_BAR; PG8_WAIT_L(0); PG8_MMA(0, 1, At, B1); PG8_BAR;
            PG8_LDA(At, 0, 1); PG8_STAGE(PG8_SA(0, 0), a2, voffA);
            PG8_BAR; PG8_WAIT_L(0); PG8_MMA(1, 0, At, B0); PG8_BAR; PG8_SCHED;
            PG8_STAGE(PG8_SB(0, 1), b2 + hstep, voffB);
            PG8_WAIT_V(6); PG8_BAR; PG8_MMA(1, 1, At, B1); PG8_BAR;
            PG8_LDB(B0, 1, 0); PG8_SCHED; PG8_LDA(At, 1, 0); PG8_STAGE(PG8_SA(0, 1), a2 + hstep, voffA);
            PG8_WAIT_L(8); PG8_BAR; PG8_WAIT_L(0); PG8_MMA(0, 0, At, B0); PG8_BAR; PG8_SCHED;
            PG8_LDB(B1, 1, 1); PG8_STAGE(PG8_SB(1, 0), b3, voffB);
            PG8_BAR; PG8_WAIT_L(0); PG8_MMA(0, 1, At, B1); PG8_BAR;
            PG8_LDA(At, 1, 1); PG8_STAGE(PG8_SA(1, 0), a3, voffA);
            PG8_BAR; PG8_WAIT_L(0); PG8_MMA(1, 0, At, B0); PG8_BAR; PG8_SCHED;
            PG8_STAGE(PG8_SB(1, 1), b3 + hstep, voffB);
            PG8_WAIT_V(6); PG8_BAR; PG8_MMA(1, 1, At, B1); PG8_BAR;
            }
        }
        if constexpr (ALIGN_EPI) { if (wr == 0) PG8_BAR; }
        if constexpr (!Epi::AFTER_DRAIN) { E(acc, cur, wr, wc, fr, fq); S.done(cur); }
        if (!has_next) break;
#pragma unroll
        for (int a = 0; a < 2; ++a)
#pragma unroll
            for (int b = 0; b < 2; ++b)
#pragma unroll
                for (int m = 0; m < 4; ++m)
#pragma unroll
                    for (int n = 0; n < 2; ++n) acc[a][b][m][n] = (f32x4){0.f, 0.f, 0.f, 0.f};
        cur = nxt; cA = nA; cB = nB; ++ui;
        if constexpr (ALIGN_EPI) { if (wr == 1) PG8_BAR; }
    }
    PG8_WAIT_V(0);
    if constexpr (!ALIGN_EPI) { if (wr == 0) PG8_BAR; }
    PG8_BAR;
    if constexpr (Epi::AFTER_DRAIN) { E.fused(acc, cur, wr, wc, fr, fq, lds, wid, lane); S.done(cur); }
#undef PG8_SA
#undef PG8_SB
#undef PG8_STAGE
#undef PG8_LDA
#undef PG8_LDB
#undef PG8_MMA
#undef PG8_WAIT_V
#undef PG8_WAIT_L
#undef PG8_BAR
#undef PG8_SCHED
}
}

namespace att {
using bf16 = __hip_bfloat16;
constexpr int D = 128, NW = 8, QBLK = 32, KVBLK = 64;
constexpr float SCALE = 1.0f;
constexpr float THR = 8.f;
constexpr int SDEPTH = 2;
constexpr int LDQ = 3072, LDK = 1280, LDO = 3072;
constexpr size_t SHM_V = KVBLK * D * 2, SHM_K = KVBLK * D * 2, SHM_ATTN = 2 * SHM_V + 2 * SHM_K + NW * 64 * 4;
typedef __bf16 abf16x2_t __attribute__((ext_vector_type(2))); typedef float af32x2_t __attribute__((ext_vector_type(2)));
__device__ __forceinline__ unsigned short bf1(float x) { const af32x2_t v = {x, x}; const abf16x2_t b = __builtin_convertvector(v, abf16x2_t); return (unsigned short)(__builtin_bit_cast(unsigned, b) & 0xffffu); }
using bf16x8 = __attribute__((ext_vector_type(8))) short;
using s16x4  = __attribute__((ext_vector_type(4))) short;
using f32x16 = __attribute__((ext_vector_type(16))) float;
using f32x8  = __attribute__((ext_vector_type(8))) float;
using u32x4  = __attribute__((ext_vector_type(4))) unsigned;
#define KSWZ(row, colB) ((row) * 256 + ((colB) ^ (((row) & 7) << 4)))
#define SBAR() __builtin_amdgcn_sched_barrier(0)
__device__ __forceinline__ int crow(int r, int hi) { return (r & 3) + 8 * (r >> 2) + 4 * hi; }
__device__ __forceinline__ unsigned cvtpk(float lo, float hi) {
  unsigned r; asm volatile("v_cvt_pk_bf16_f32 %0, %1, %2" : "=v"(r) : "v"(lo), "v"(hi)); return r;
}
template <typename TIn> struct Stage;
template <> struct Stage<bf16>  { using T = bf16x8;
  __device__ static __forceinline__ T ld8(const bf16* p) { return *reinterpret_cast<const bf16x8*>(p); }
  __device__ static __forceinline__ bf16x8 tobf(T x) { return x; } };
template <> struct Stage<float> { using T = f32x8;
  __device__ static __forceinline__ T ld8(const float* p) { return *reinterpret_cast<const f32x8*>(p); }
  __device__ static __forceinline__ bf16x8 tobf(T x) {
    u32x4 w = {cvtpk(x[0], x[1]), cvtpk(x[2], x[3]), cvtpk(x[4], x[5]), cvtpk(x[6], x[7])}; return *reinterpret_cast<bf16x8*>(&w); } };

__device__ __forceinline__ void partialSM(f32x16& p0, f32x16& p1, float& m_reg, float& mn, float& alpha) {
  constexpr float C = SCALE * 1.4426950408889634f;
  float pmax = p0[0]; for (int r = 1; r < 16; ++r) pmax = fmaxf(pmax, p0[r]); for (int r = 0; r < 16; ++r) pmax = fmaxf(pmax, p1[r]);
  { auto rr = __builtin_amdgcn_permlane32_swap(__float_as_uint(pmax), __float_as_uint(pmax), false, false);
    pmax = fmaxf(__uint_as_float(rr[0]), __uint_as_float(rr[1])); }
  if (__builtin_expect(__all(pmax - m_reg <= THR / SCALE), 1)) { mn = m_reg; alpha = 1.f; }
  else { mn = fmaxf(m_reg, pmax); alpha = __builtin_amdgcn_exp2f((m_reg - mn) * C); m_reg = mn; }
  float mnC = -mn * C;
  for (int r = 0; r < 16; ++r) p0[r] = fmaf(p0[r], C, mnC); for (int r = 0; r < 16; ++r) p1[r] = fmaf(p1[r], C, mnC);
  for (int r = 0; r < 16; ++r) p0[r] = __builtin_amdgcn_exp2f(p0[r]);
}
__device__ __forceinline__ void finishSM(f32x16& p0, f32x16& p1, float alpha, float& l_reg, bf16x8& pa0, bf16x8& pa1, bf16x8& pa2, bf16x8& pa3) {
  for (int r = 0; r < 16; ++r) p1[r] = __builtin_amdgcn_exp2f(p1[r]);
  float ps = 0; for (int r = 0; r < 16; ++r) ps += p0[r]; for (int r = 0; r < 16; ++r) ps += p1[r];
  { auto rr = __builtin_amdgcn_permlane32_swap(__float_as_uint(ps), __float_as_uint(ps), false, false);
    ps = __uint_as_float(rr[0]) + __uint_as_float(rr[1]); }
  l_reg = l_reg * alpha + ps;
#define PK4(P, BASE, OUT) do { unsigned a0 = cvtpk(P[BASE + 0], P[BASE + 1]), a1 = cvtpk(P[BASE + 2], P[BASE + 3]);   \
    unsigned b0 = cvtpk(P[BASE + 4], P[BASE + 5]), b1 = cvtpk(P[BASE + 6], P[BASE + 7]);                              \
    auto r0 = __builtin_amdgcn_permlane32_swap(a0, b0, false, false); auto r1 = __builtin_amdgcn_permlane32_swap(a1, b1, false, false); \
    u32x4 w = {r0[0], r1[0], r0[1], r1[1]}; OUT = *reinterpret_cast<bf16x8*>(&w); } while (0)
  PK4(p0, 0, pa0); PK4(p0, 8, pa1); PK4(p1, 0, pa2); PK4(p1, 8, pa3);
#undef PK4
}
__device__ __forceinline__ void qkt(f32x16& p0, f32x16& p1, const bf16* Ks, const bf16x8* qr, int r32, int hi) {
  p0 = f32x16{}; p1 = f32x16{};
  for (int d0 = 0; d0 < 8; ++d0) { int cb = (d0 * 16 + hi * 8) * 2;
    bf16x8 b0 = *reinterpret_cast<const bf16x8*>((const char*)Ks + KSWZ(r32, cb));
    bf16x8 b1 = *reinterpret_cast<const bf16x8*>((const char*)Ks + KSWZ(32 + r32, cb));
    p0 = __builtin_amdgcn_mfma_f32_32x32x16_bf16(b0, qr[d0], p0, 0, 0, 0);
    p1 = __builtin_amdgcn_mfma_f32_32x32x16_bf16(b1, qr[d0], p1, 0, 0, 0); }
}
__device__ __forceinline__ int v_st(int k, int c) { const int kk = (k & ~0xC) | ((k & 4) << 1) | ((k & 8) >> 1); return ((kk >> 3) * 4 + (c >> 5)) * 512 + ((kk & 7) * 32 + (c & 31)) * 2; }
__device__ __forceinline__ int v_rd_base(int lane) { return ((lane & 3) << 3) | (((lane >> 2) & 3) << 6) | (((lane >> 4) & 1) << 5) | (((lane >> 5) & 1) << 8); }
constexpr int v_rd_off(int d0, int ks, int half) { return d0 * 512 + ks * 4096 + half * 2048; }
template <int OFF> __device__ __forceinline__ s16x4 tr_read(int vb) {
  s16x4 r; asm volatile("ds_read_b64_tr_b16 %0, %1 offset:%2" : "=&v"(r) : "v"(vb), "i"(OFF) : "memory"); return r;
}
template <int D0> __device__ __forceinline__ void pv_one(f32x16& od, int vb, bf16x8 pa0, bf16x8 pa1, bf16x8 pa2, bf16x8 pa3) {
  const s16x4 l0 = tr_read<v_rd_off(D0, 0, 0)>(vb), h0 = tr_read<v_rd_off(D0, 0, 1)>(vb), l1 = tr_read<v_rd_off(D0, 1, 0)>(vb), h1 = tr_read<v_rd_off(D0, 1, 1)>(vb);
  const s16x4 l2 = tr_read<v_rd_off(D0, 2, 0)>(vb), h2 = tr_read<v_rd_off(D0, 2, 1)>(vb), l3 = tr_read<v_rd_off(D0, 3, 0)>(vb), h3 = tr_read<v_rd_off(D0, 3, 1)>(vb);
  asm volatile("s_waitcnt lgkmcnt(0)" ::: "memory"); SBAR();
#define PK(L, H) (bf16x8){L[0], L[1], L[2], L[3], H[0], H[1], H[2], H[3]}
  od = __builtin_amdgcn_mfma_f32_32x32x16_bf16(pa0, PK(l0, h0), od, 0, 0, 0);
  od = __builtin_amdgcn_mfma_f32_32x32x16_bf16(pa1, PK(l1, h1), od, 0, 0, 0);
  od = __builtin_amdgcn_mfma_f32_32x32x16_bf16(pa2, PK(l2, h2), od, 0, 0, 0);
  od = __builtin_amdgcn_mfma_f32_32x32x16_bf16(pa3, PK(l3, h3), od, 0, 0, 0);
#undef PK
}
__device__ __forceinline__ void pv_d0(f32x16* o, int vb, bf16x8 pa0, bf16x8 pa1, bf16x8 pa2, bf16x8 pa3) {
  pv_one<0>(o[0], vb, pa0, pa1, pa2, pa3); pv_one<1>(o[1], vb, pa0, pa1, pa2, pa3); pv_one<2>(o[2], vb, pa0, pa1, pa2, pa3); pv_one<3>(o[3], vb, pa0, pa1, pa2, pa3);
}

template <typename TQ>
__device__ __forceinline__ void attn_dense_body(const TQ* __restrict__ Qb, const bf16* __restrict__ Kh, const bf16* __restrict__ Vh,
                                                unsigned short* __restrict__ Ob, int seq, char* lds) {
  using St = Stage<bf16>; using SQ = Stage<TQ>;
  const int tid = fresh_tid(), wid = tid >> 6, lane = tid & 63, r32 = lane & 31, hi = lane >> 5;
  bf16* V_lds = (bf16*)lds; bf16* K_lds = (bf16*)(lds + 2 * SHM_V);
  float* ws = (float*)(lds + 2 * SHM_V + 2 * SHM_K) + wid * 64; float* li_l = ws; float* al_l = ws + 32;
  float m_reg = -1e30f, l_reg = 0; f32x16 o[4] = {}; bf16x8 qr[8];
  const TQ* Qw = Qb + (long)(wid * QBLK + r32) * LDQ + hi * 8;
#pragma unroll
  for (int d0 = 0; d0 < 8; ++d0) qr[d0] = SQ::tobf(SQ::ld8(Qw + d0 * 16));
  const int sr = tid >> 4, sc = (tid & 15) * 8, vst0 = v_st(sr, sc), vst1 = v_st(32 + sr, sc);
  const int vb0 = (int)(uintptr_t)V_lds + v_rd_base(lane);
  struct { typename St::T vs0, vs1, ks0, ks1; } sr_[SDEPTH];
#define SLOAD(i, k0) do { sr_[i].vs0 = St::ld8(&Vh[(long)((k0) + sr) * LDK + sc]); sr_[i].vs1 = St::ld8(&Vh[(long)((k0) + 32 + sr) * LDK + sc]); \
    sr_[i].ks0 = St::ld8(&Kh[(long)((k0) + sr) * LDK + sc]); sr_[i].ks1 = St::ld8(&Kh[(long)((k0) + 32 + sr) * LDK + sc]); } while (0)
#define SWRITE(b, i) do { *(bf16x8*)((char*)V_lds + (b) * SHM_V + vst0) = St::tobf(sr_[i].vs0);          \
    *(bf16x8*)((char*)V_lds + (b) * SHM_V + vst1) = St::tobf(sr_[i].vs1); int kc = sc * 2;               \
    *(bf16x8*)((char*)K_lds + (b) * SHM_K + KSWZ(sr, kc)) = St::tobf(sr_[i].ks0);                       \
    *(bf16x8*)((char*)K_lds + (b) * SHM_K + KSWZ(32 + sr, kc)) = St::tobf(sr_[i].ks1); } while (0)
#define SWAIT() do { if constexpr (SDEPTH == 2) asm volatile("s_waitcnt vmcnt(4)" ::: "memory"); else asm volatile("s_waitcnt vmcnt(0)" ::: "memory"); } while (0)
#define RESC(a) do { if (__any((a) < 1.f)) { if (hi == 0) al_l[r32] = (a); asm volatile("s_waitcnt lgkmcnt(0)" ::: "memory"); \
    for (int d = 0; d < 4; ++d) for (int r = 0; r < 16; ++r) o[d][r] *= al_l[crow(r, hi)]; } } while (0)
  f32x16 pA0, pA1, pB0, pB1; float mnA, mnB, alA, alB; bf16x8 pa0, pa1, pa2, pa3; const int NT = seq / KVBLK;
  constexpr int SE = 0, SO = SDEPTH - 1;
  SLOAD(SE, 0); asm volatile("s_waitcnt vmcnt(0)" ::: "memory"); SWRITE(0, SE); __syncthreads();
  qkt(pA0, pA1, K_lds, qr, r32, hi); partialSM(pA0, pA1, m_reg, mnA, alA);
  SLOAD(SO, KVBLK); if constexpr (SDEPTH == 2) { if (2 < NT) SLOAD(SE, 2 * KVBLK); }
  SWAIT(); SWRITE(1, SO); __syncthreads();
  for (int j = 1; j + 1 < NT; j += 2) {
    SBAR(); qkt(pB0, pB1, (bf16*)((char*)K_lds + SHM_K), qr, r32, hi);
    finishSM(pA0, pA1, alA, l_reg, pa0, pa1, pa2, pa3); SBAR();
    SLOAD(SO, (j + SDEPTH) * KVBLK); SBAR();
    pv_d0(o, vb0, pa0, pa1, pa2, pa3); partialSM(pB0, pB1, m_reg, mnB, alB);
    __syncthreads(); SWAIT(); SWRITE(0, SE);
    RESC(alB); __syncthreads();
    SBAR(); qkt(pA0, pA1, K_lds, qr, r32, hi);
    finishSM(pB0, pB1, alB, l_reg, pa0, pa1, pa2, pa3); SBAR();
    if (SDEPTH == 1 || j + 3 < NT) SLOAD(SE, (j + 1 + SDEPTH) * KVBLK); SBAR();
    pv_d0(o, vb0 + (int)SHM_V, pa0, pa1, pa2, pa3); partialSM(pA0, pA1, m_reg, mnA, alA);
    __syncthreads(); SWAIT(); SWRITE(1, SO);
    RESC(alA); __syncthreads();
  }
  SBAR(); qkt(pB0, pB1, (bf16*)((char*)K_lds + SHM_K), qr, r32, hi);
  finishSM(pA0, pA1, alA, l_reg, pa0, pa1, pa2, pa3); SBAR();
  pv_d0(o, vb0, pa0, pa1, pa2, pa3); partialSM(pB0, pB1, m_reg, mnB, alB);
  __syncthreads(); RESC(alB);
  finishSM(pB0, pB1, alB, l_reg, pa0, pa1, pa2, pa3); SBAR();
  pv_d0(o, vb0 + (int)SHM_V, pa0, pa1, pa2, pa3);
  if (hi == 0) li_l[r32] = l_reg; asm volatile("s_waitcnt lgkmcnt(0)" ::: "memory");
  float rli[16];
#pragma unroll
  for (int r = 0; r < 16; ++r) rli[r] = __builtin_amdgcn_rcpf(li_l[crow(r, hi)]);
  unsigned short* Ow = Ob + (long)(wid * QBLK) * LDO;
#pragma unroll
  for (int r = 0; r < 16; ++r) { int orow = crow(r, hi);
    for (int d0 = 0; d0 < 4; ++d0) Ow[(long)orow * LDO + d0 * 32 + r32] = bf1(o[d0][r] * rli[r]); }
#undef SLOAD
#undef SWRITE
#undef SWAIT
#undef RESC
}
}

constexpr int DM = 2048, NTOK = 6144, NPROMPT = 4096, INW = 15872;
constexpr int C_HQ = 0, C_HF = 1024, C_HI = 3072, C_HG = 4096, C_DQ = 5120, C_DK = 6144, C_DV = 7168, C_GQ = 8192, C_GK = 9216, C_GV = 9472, C_GATE = 9728;
constexpr int KROWS = 4096 + 2 * 1280;
constexpr int KVW = 1280;
constexpr float EPS = 1e-6f;
constexpr int NPH = 23;

constexpr size_t MiB = 1u << 20;
constexpr size_t WS_CTL = 0, CTL_ZERO_BYTES = 1 * MiB;
constexpr size_t WS_MOD = 1 * MiB, WS_ROPE = 2 * MiB, WS_WIN = 3 * MiB, WS_WBR = 127 * MiB, WS_WOUT = 151 * MiB, WS_WPQ = 167 * MiB, WS_PU = 183 * MiB, WS_PV = 311 * MiB;
constexpr size_t WS_H = 439 * MiB, WS_Z = 463 * MiB, WS_QA = 649 * MiB, WS_KA = 685 * MiB, WS_VA = 702 * MiB, WS_OA = 719 * MiB, WS_OH = 791 * MiB, WS_BR = 839 * MiB, WS_MG = 875 * MiB;
constexpr size_t WS_XM = 899 * MiB, WS_X1 = 947 * MiB, WS_PE = 995 * MiB, WS_PG = 998 * MiB, WS_END = 1001 * MiB;
constexpr size_t WS_UV8 = WS_PU, WS_SC = WS_PV;
constexpr size_t WS_QP = WS_OA;
constexpr size_t WS_MGP = WS_OH;
static_assert(WS_WIN + (size_t)2 * INW * DM * 2 <= WS_WBR && WS_Z + (size_t)NTOK * INW * 2 <= WS_QA && WS_KA + (size_t)KROWS * KVW * 2 <= WS_VA && WS_VA + (size_t)KROWS * KVW * 2 <= WS_OA, "d_ws map");
static_assert(WS_OA + (size_t)NTOK * 3072 * 4 <= WS_OH && WS_OH + (size_t)2 * NTOK * 1024 * 4 <= WS_BR && WS_BR + (size_t)3 * NTOK * 1024 * 2 <= WS_MG, "d_ws map 2");
constexpr int CW_BAR = 4096;

constexpr int LDS_BYTES = 163840, RING_OFF = 1024;

#define GAS __attribute__((address_space(1)))
#define LAS __attribute__((address_space(3)))
typedef unsigned short bf16;
typedef unsigned v4u __attribute__((ext_vector_type(4)));
typedef unsigned v2u __attribute__((ext_vector_type(2)));
typedef float f32x4 __attribute__((ext_vector_type(4)));
typedef float f32x2 __attribute__((ext_vector_type(2)));
typedef __bf16 bf16x2_t __attribute__((ext_vector_type(2)));
__device__ __forceinline__ unsigned pk2(float lo, float hi) { const f32x2 v = {lo, hi}; const bf16x2_t b = __builtin_convertvector(v, bf16x2_t); return __builtin_bit_cast(unsigned, b); }
__device__ __forceinline__ unsigned f2bf(float f) { return pk2(f, f) & 0xffffu; }
__device__ __forceinline__ float bflo(unsigned w) { return __uint_as_float(w << 16); }
__device__ __forceinline__ float bfhi(unsigned w) { return __uint_as_float(w & 0xffff0000u); }
__device__ __forceinline__ float wave_sum(float v) {
#pragma unroll
    for (int o = 1; o < 64; o <<= 1) v += __shfl_xor(v, o);
    return v;
}
__device__ __forceinline__ void ld16bf(const bf16* p, float (&v)[16]) {
    const v4u a = *(const v4u*)p, b = *(const v4u*)(p + 8);
    v[0] = bflo(a.x); v[1] = bfhi(a.x); v[2] = bflo(a.y); v[3] = bfhi(a.y); v[4] = bflo(a.z); v[5] = bfhi(a.z); v[6] = bflo(a.w); v[7] = bfhi(a.w);
    v[8] = bflo(b.x); v[9] = bfhi(b.x); v[10] = bflo(b.y); v[11] = bfhi(b.y); v[12] = bflo(b.z); v[13] = bfhi(b.z); v[14] = bflo(b.w); v[15] = bfhi(b.w);
}
__device__ __forceinline__ void ld16f(const float* p, float (&v)[16]) {
#pragma unroll
    for (int i = 0; i < 4; ++i) { const f32x4 x = *(const f32x4*)(p + 4 * i); v[4 * i] = x[0]; v[4 * i + 1] = x[1]; v[4 * i + 2] = x[2]; v[4 * i + 3] = x[3]; }
}
__device__ __forceinline__ void st16bf(bf16* p, const float (&v)[16]) {
    v4u a, b; a.x = pk2(v[0], v[1]); a.y = pk2(v[2], v[3]); a.z = pk2(v[4], v[5]); a.w = pk2(v[6], v[7]); b.x = pk2(v[8], v[9]); b.y = pk2(v[10], v[11]); b.z = pk2(v[12], v[13]); b.w = pk2(v[14], v[15]);
    *(v4u*)p = a; *(v4u*)(p + 8) = b;
}
__device__ __forceinline__ void st16f(float* p, const float (&v)[16]) {
#pragma unroll
    for (int i = 0; i < 4; ++i) *(f32x4*)(p + 4 * i) = (f32x4){v[4 * i], v[4 * i + 1], v[4 * i + 2], v[4 * i + 3]};
}

#define XB_TMO      128
#define XB_XCNT(j)  (256  + 64 * (j))
#define XB_XSUB(j)  (1280 + 64 * (j))
#define XB_XGEN(j)  (2304 + 64 * (j))
#define XB_TOP      3328
#define XB_TOPGEN   3392
#define XCD_BAR_WORDS 3456
#define XB_SPIN_CAP (1u << 18)

__device__ __forceinline__ unsigned xb_ld(unsigned* p)              { return __hip_atomic_load(p, __ATOMIC_RELAXED, __HIP_MEMORY_SCOPE_AGENT); }
__device__ __forceinline__ unsigned xb_add(unsigned* p, unsigned v) { return __hip_atomic_fetch_add(p, v, __ATOMIC_RELAXED, __HIP_MEMORY_SCOPE_AGENT); }
__device__ __forceinline__ unsigned xb_xcc_id() { return (unsigned)__builtin_amdgcn_s_getreg((3 << 11) | 20) & 0xFu; }
#define XB_SPIN(cond, bar) do { unsigned _sp = 0; while (cond) { __builtin_amdgcn_s_sleep(1); \
    if ((++_sp & 255u) == 0u) { if (xb_ld(&(bar)[XB_TMO])) break; if (_sp > XB_SPIN_CAP) { atomicAdd(&(bar)[XB_TMO], 1u); break; } } } } while (0)

struct XcdBarrier {
    unsigned* bar; unsigned x;
    volatile LAS unsigned* st;
};

__device__ __forceinline__ XcdBarrier xcd_barrier_post(unsigned* bar, volatile LAS unsigned* st) {
    XcdBarrier b; b.bar = bar; b.x = xb_xcc_id(); b.st = st;
    if (threadIdx.x == 0) (void)xb_add(&bar[XB_XCNT(b.x)], 1u);
    return b;
}
__device__ __forceinline__ void xcd_barrier_complete(unsigned* bar, unsigned x, unsigned& nloc, unsigned& nx) {
    const unsigned G = gridDim.x * gridDim.y * gridDim.z;
    unsigned sum, cnt, mine, sp = 0u;
    for (;;) {
        sum = 0u; cnt = 0u; mine = 0u;
#pragma unroll
        for (unsigned j = 0; j < 16; ++j) { const unsigned c = xb_ld(&bar[XB_XCNT(j)]); sum += c; cnt += (c > 0u) ? 1u : 0u; mine = (j == x) ? c : mine; }
        if (sum == G) break;
        __builtin_amdgcn_s_sleep(1);
        if ((++sp & 255u) == 0u) { if (xb_ld(&bar[XB_TMO])) break; if (sp > XB_SPIN_CAP) { atomicAdd(&bar[XB_TMO], 1u); break; } }
    }
    nloc = mine > 0u ? mine : 1u; nx = cnt > 0u ? cnt : 1u;
}

__device__ __forceinline__ void xcd_barrier(const XcdBarrier& b) {
    asm volatile("s_waitcnt vmcnt(0)" ::: "memory");
    __syncthreads();
    if (threadIdx.x == 0) {
        unsigned* bar = b.bar;
        __builtin_amdgcn_s_waitcnt(0);
        unsigned nloc = b.st[0], nx = b.st[1];
        if (nloc == 0u) { xcd_barrier_complete(bar, b.x, nloc, nx); b.st[0] = nloc; b.st[1] = nx; }
        const unsigned old = xb_add(&bar[XB_XSUB(b.x)], 1u);
        const unsigned gen = old / nloc;
        if (old + 1u == (gen + 1u) * nloc) {
            __builtin_amdgcn_fence(__ATOMIC_RELEASE, "agent");
            asm volatile("s_waitcnt vmcnt(0)" ::: "memory");
            const unsigned og = xb_add(&bar[XB_TOP], 1u);
            const unsigned tg = og / nx;
            if (og + 1u == (tg + 1u) * nx) xb_add(&bar[XB_TOPGEN], 1u);
            else XB_SPIN(xb_ld(&bar[XB_TOPGEN]) == tg, bar);
            __builtin_amdgcn_fence(__ATOMIC_ACQUIRE, "agent");
            xb_add(&bar[XB_XGEN(b.x)], 1u);
            asm volatile("s_waitcnt vmcnt(0)" ::: "memory");
        } else {
            XB_SPIN(xb_ld(&bar[XB_XGEN(b.x)]) == gen, bar);
            __builtin_amdgcn_fence(__ATOMIC_ACQUIRE, "agent");
            asm volatile("s_waitcnt vmcnt(0)" ::: "memory");
        }
    }
    __syncthreads();
}
struct Args { const float* in[26]; float* out; unsigned char* ws; int ph_lo, ph_hi; };
constexpr size_t OUT_YP = 0, OUT_DK = 12582912, OUT_DV = 20971520, OUT_GK = 29360128, OUT_GV = 31457280, OUT_ST = 33554432, OUT_TOTAL = 41943040;
#define LDS_WAIT() asm volatile("s_waitcnt lgkmcnt(0)" ::: "memory")

__device__ __forceinline__ void p0_transpose_item(const float* W, int K, int N, bf16* WT, LAS float* scr, int item, int lane) {
    const int nblk = N / 32, kb = item / nblk, nb = item % nblk, k0 = 64 * kb, n0 = 32 * nb;
#pragma unroll 8
    for (int i = 0; i < 32; ++i) { const int kk = 2 * i + (lane >> 5); scr[kk * 33 + (lane & 31)] = W[(size_t)(k0 + kk) * N + n0 + (lane & 31)]; }
    LDS_WAIT(); asm volatile("" ::: "memory");
    const int c = lane & 7;
#pragma unroll
    for (int j = 0; j < 4; ++j) { const int n = (lane >> 3) + 8 * j; const LAS float* s = scr + (8 * c) * 33 + n;
        v4u o; o.x = pk2(s[0 * 33], s[1 * 33]); o.y = pk2(s[2 * 33], s[3 * 33]); o.z = pk2(s[4 * 33], s[5 * 33]); o.w = pk2(s[6 * 33], s[7 * 33]);
        *(v4u*)(WT + (size_t)(n0 + n) * K + k0 + 8 * c) = o; }
    LDS_WAIT(); asm volatile("" ::: "memory");
}
__device__ __forceinline__ void cvt_fp8_row(const Args& a, unsigned char* ws, int t, int le, int lane) {
    unsigned char* UV8 = ws + WS_UV8; float* SC = (float*)(ws + WS_SC);
    const float* src = a.in[24 + t] + (size_t)le * 2048;
    f32x4 x[8]; float mx = 0.f;
#pragma unroll
    for (int j = 0; j < 8; ++j) { x[j] = *(const f32x4*)(src + j * 256 + lane * 4); mx = fmaxf(fmaxf(mx, fmaxf(fabsf(x[j][0]), fabsf(x[j][1]))), fmaxf(fabsf(x[j][2]), fabsf(x[j][3]))); }
#pragma unroll
    for (int o = 1; o < 64; o <<= 1) mx = fmaxf(mx, __shfl_xor(mx, o));
    const float sc = mx > 0.f ? mx * (1.0f / 448.0f) : 1.0f, inv = mx > 0.f ? 448.0f / mx : 0.f;
    unsigned w[8];
#pragma unroll
    for (int j = 0; j < 8; ++j) { int q = __builtin_amdgcn_cvt_pk_fp8_f32(x[j][0] * inv, x[j][1] * inv, 0, false); q = __builtin_amdgcn_cvt_pk_fp8_f32(x[j][2] * inv, x[j][3] * inv, q, true); w[j] = (unsigned)q; }
    unsigned char* dst = UV8 + (size_t)le * 4096 + t * 2048 + lane * 32;
    *(v4u*)dst = (v4u){w[0], w[1], w[2], w[3]}; *(v4u*)(dst + 16) = (v4u){w[4], w[5], w[6], w[7]};
    if (lane == 0) SC[le * 2 + t] = sc;
}
__device__ __forceinline__ void p0_prologue(const Args& a, unsigned char* ws, LAS unsigned char* lds, int G, bool defer_l1) {
    ws = fresh_ws(ws); const int tid = fresh_tid(), lane = tid & 63, wave = __builtin_amdgcn_readfirstlane(tid >> 6);
    const int bx = blockIdx.x;
    __syncthreads();
    {
        LAS float* sil = (LAS float*)(lds + RING_OFF); LAS float* red = sil + 3 * 2048;
        const float* c_ctx = a.in[8]; const float* cc = a.in[2];
        for (int i = tid; i < 3 * 2048; i += 512) { const int r = i >> 11, k = i & 2047; const float c = r == 0 ? c_ctx[k] : cc[(r - 1) * 2048 + k]; sil[i] = c / (1.0f + expf(-c)); }
        __syncthreads();
        const float* mod_w = a.in[9]; const float* mod_b = a.in[10]; float* MOD = (float*)(ws + WS_MOD);
        const int cg = tid % 24, kg = tid / 24;
        for (int task = bx; task < 256; task += G) {
            const int l = task >> 7, col0 = (task & 127) * 96;
            if (kg < 21) {
                float acc[3][4];
#pragma unroll
                for (int r = 0; r < 3; ++r)
#pragma unroll
                    for (int j = 0; j < 4; ++j) acc[r][j] = 0.f;
                const float* wp = mod_w + ((size_t)l * 2048) * 12288 + col0 + cg * 4;
#pragma unroll 4
                for (int k = kg; k < 2048; k += 21) { const f32x4 w = *(const f32x4*)(wp + (size_t)k * 12288); const float s0 = sil[k], s1 = sil[2048 + k], s2 = sil[4096 + k];
#pragma unroll
                    for (int j = 0; j < 4; ++j) { acc[0][j] += s0 * w[j]; acc[1][j] += s1 * w[j]; acc[2][j] += s2 * w[j]; } }
#pragma unroll
                for (int r = 0; r < 3; ++r)
#pragma unroll
                    for (int j = 0; j < 4; ++j) red[(kg * 24 + cg) * 12 + r * 4 + j] = acc[r][j];
            }
            __syncthreads();
            if (tid < 288) { const int r = tid / 96, c = tid % 96, g4 = c >> 2, j = c & 3; float s = 0.f;
                for (int q = 0; q < 21; ++q) s += red[(q * 24 + g4) * 12 + r * 4 + j];
                MOD[(size_t)(l * 3 + r) * 12288 + col0 + c] = s + mod_b[l * 12288 + col0 + c]; }
            __syncthreads();
        }
    }
    {
        f32x2* R64 = (f32x2*)(ws + WS_ROPE); f32x2* R128 = R64 + 64 * 16;
        const int gt = bx * 512 + tid;
        if (gt < 64 * 16) { const int pos = gt >> 4, i = gt & 15; const float inv = exp2f(-13.287712379549449f * (float)i / 16.0f); const float ang = (float)pos * inv; R64[gt] = (f32x2){cosf(ang), sinf(ang)}; }
        else if (gt < 64 * 16 + 64 * 32) { const int g2 = gt - 64 * 16, pos = g2 >> 5, i = g2 & 31; const float inv = exp2f(-13.287712379549449f * (float)i / 32.0f); const float ang = (float)pos * inv; R128[g2] = (f32x2){cosf(ang), sinf(ang)}; }
    }
    {
        LAS float* scr = (LAS float*)(lds + RING_OFF + wave * 16384);
        const int gw = bx * 8 + wave, NGW = G * 8;
        constexpr int I_IN = (DM / 64) * (INW / 32), I_BR = (1024 / 64) * (DM / 32), I_SQ = (DM / 64) * (DM / 32);
        constexpr int NITEMS = 2 * I_IN + 6 * I_BR + 4 * I_SQ;
        for (int it = gw; it < NITEMS; it += NGW) {
            int r = it;
            if (r < 2 * I_IN) { const int l = r / I_IN; p0_transpose_item(a.in[13] + (size_t)l * DM * INW, DM, INW, (bf16*)(ws + WS_WIN) + (size_t)l * INW * DM, scr, r % I_IN, lane); continue; } r -= 2 * I_IN;
            if (r < 6 * I_BR) { const int lc = r / I_BR; p0_transpose_item(a.in[20] + (size_t)lc * 1024 * DM, 1024, DM, (bf16*)(ws + WS_WBR) + (size_t)lc * DM * 1024, scr, r % I_BR, lane); continue; } r -= 6 * I_BR;
            if (r < 2 * I_SQ) { const int l = r / I_SQ; p0_transpose_item(a.in[21] + (size_t)l * DM * DM, DM, DM, (bf16*)(ws + WS_WOUT) + (size_t)l * DM * DM, scr, r % I_SQ, lane); continue; } r -= 2 * I_SQ;
            { const int l = r / I_SQ; p0_transpose_item(a.in[22] + (size_t)l * DM * DM, DM, DM, (bf16*)(ws + WS_WPQ) + (size_t)l * DM * DM, scr, r % I_SQ, lane); }
        }
    }
    {
        const int gw = bx * 8 + wave, NGW = G * 8;
        for (int i = gw; i < 32768; i += NGW) cvt_fp8_row(a, ws, i >> 14, i & 16383, lane);
        if (!defer_l1) for (int i = gw; i < 32768; i += NGW) cvt_fp8_row(a, ws, i >> 14, 16384 + (i & 16383), lane);
    }
}
__device__ __forceinline__ void fp8_rows_deferred(const Args& a, unsigned char* ws, int slot) {
    ws = fresh_ws(ws); const int tid = fresh_tid(), lane = tid & 63, wave = __builtin_amdgcn_readfirstlane(tid >> 6);
    const int lo_ = slot == 0 ? 0 : slot == 1 ? 6554 : slot == 2 ? 11469 : slot == 3 ? 16384 : slot == 4 ? 22938 : 27853;
    const int hi_ = slot == 0 ? 6554 : slot == 1 ? 11469 : slot == 2 ? 16384 : slot == 3 ? 22938 : slot == 4 ? 27853 : 32768;
    const int gw = ((int)blockIdx.x - 192) * 8 + wave;
    for (int i = lo_ + gw; i < hi_; i += 512) cvt_fp8_row(a, ws, i >> 14, 16384 + (i & 16383), lane);
}

__device__ __forceinline__ void norm_phase(const float* xp, const float* xs, const float* gain, const float* modl, int ch_sh, int ch_sc, bf16* H, int G) {
    const int tid = fresh_tid(), lane = tid & 63, gw = blockIdx.x * 8 + __builtin_amdgcn_readfirstlane(tid >> 6), NGW = G * 8;
    for (int row = gw; row < NTOK; row += NGW) {
        const float* xr = row < NPROMPT ? xp + (size_t)row * DM : xs + (size_t)(row - NPROMPT) * DM;
        const int r = row < NPROMPT ? 0 : 1 + ((row - NPROMPT) >> 10);
        const float* sh = modl + (size_t)r * 12288 + ch_sh * DM; const float* sc = modl + (size_t)r * 12288 + ch_sc * DM;
        f32x4 v[8]; float ss = 0.f;
#pragma unroll
        for (int j = 0; j < 8; ++j) { v[j] = *(const f32x4*)(xr + j * 256 + lane * 4); ss += (v[j][0] * v[j][0] + v[j][1] * v[j][1]) + (v[j][2] * v[j][2] + v[j][3] * v[j][3]); }
        const float rstd = 1.0f / sqrtf(wave_sum(ss) * (1.0f / DM) + EPS);
#pragma unroll
        for (int j = 0; j < 8; ++j) { const int c = j * 256 + lane * 4; const f32x4 g = *(const f32x4*)(gain + c), s1 = *(const f32x4*)(sc + c), s0 = *(const f32x4*)(sh + c);
            const f32x4 o = v[j] * rstd * g * (s1 + 1.0f) + s0; v2u w; w.x = pk2(o[0], o[1]); w.y = pk2(o[2], o[3]); *(v2u*)(H + (size_t)row * DM + c) = w; }
    }
}

__device__ __forceinline__ void rope_pair(float (&v)[16], const f32x2* tab, int fi0, bool first, int xm) {
#pragma unroll
    for (int e = 0; e < 16; ++e) { const float p = __shfl_xor(v[e], xm); const f32x2 cs = tab[fi0 + e]; v[e] = first ? v[e] * cs.x - p * cs.y : v[e] * cs.x + p * cs.y; }
}
__device__ __forceinline__ void prep_phase(const Args& a, unsigned char* ws, int l, int wg0, int nwg) {
    ws = fresh_ws(ws); const int tid = fresh_tid(), lane = tid & 63, gw = ((int)blockIdx.x - wg0) * 8 + __builtin_amdgcn_readfirstlane(tid >> 6), NGW = nwg * 8;
    const bf16* Z = (const bf16*)(ws + WS_Z); bf16* QA = (bf16*)(ws + WS_QA); bf16* KA = (bf16*)(ws + WS_KA); bf16* VA = (bf16*)(ws + WS_VA);
    const f32x2* R64 = (const f32x2*)(ws + WS_ROPE); const f32x2* R128 = R64 + 64 * 16;
    const float* dqk = a.in[16] + (size_t)l * 2 * 64; const float* gqk = a.in[19] + (size_t)l * 2 * 128;
    float* out = a.out;
    for (int task = gw; task < NTOK + 512; task += NGW) {
        if (task >= NTOK) {
            const int i = task - NTOK, b = i >> 8, p = i & 255; const size_t krow = (size_t)NPROMPT + b * 1280 + 1024 + p;
            float v[16];
            ld16f(a.in[3] + ((size_t)(b * 2 + l) * 256 + p) * 1024 + lane * 16, v); st16bf(KA + krow * KVW + lane * 16, v);
            ld16f(a.in[4] + ((size_t)(b * 2 + l) * 256 + p) * 1024 + lane * 16, v); st16bf(VA + krow * KVW + lane * 16, v);
            if (lane < 16) { ld16f(a.in[5] + ((size_t)(b * 2 + l) * 256 + p) * 256 + lane * 16, v); st16bf(KA + krow * KVW + 1024 + lane * 16, v);
                             ld16f(a.in[6] + ((size_t)(b * 2 + l) * 256 + p) * 256 + lane * 16, v); st16bf(VA + krow * KVW + 1024 + lane * 16, v); }
            continue;
        }
        const int row = task; const bool latent = row >= NPROMPT;
        int b, t; size_t krow;
        if (!latent) { b = row >> 8; t = row & 255; krow = row; } else { b = (row - NPROMPT) >> 10; t = (row - NPROMPT) & 1023; krow = (size_t)NPROMPT + b * 1280 + t; }
        const int prow = t >> 6, pcol = t & 63;
        const bf16* z = Z + (size_t)row * INW;
        const size_t co = ((size_t)(b * 2 + l) * 256 + t);
        float v[16];
        {
            ld16bf(z + C_DQ + lane * 16, v); float ss = 0.f;
#pragma unroll
            for (int e = 0; e < 16; ++e) ss += v[e] * v[e];
            ss += __shfl_xor(ss, 1); ss += __shfl_xor(ss, 2);
            const float rstd = 1.0f / sqrtf(ss * (1.0f / 64.0f) + EPS); const int sub = lane & 3; const float* gn = dqk + sub * 16;
#pragma unroll
            for (int e = 0; e < 16; ++e) v[e] = v[e] * rstd * gn[e];
            if (latent) rope_pair(v, R64 + (sub < 2 ? prow : pcol) * 16, 0, (sub & 1) == 0, 1);
#pragma unroll
            for (int e = 0; e < 16; ++e) v[e] *= 0.125f;
            const int he = lane >> 2, half = he & 1; bf16* q = QA + (size_t)row * 3072 + he * 128;
            st16bf(q + half * 64 + sub * 16, v);
            *(v4u*)(q + (1 - half) * 64 + sub * 16) = (v4u){0u, 0u, 0u, 0u}; *(v4u*)(q + (1 - half) * 64 + sub * 16 + 8) = (v4u){0u, 0u, 0u, 0u};
        }
        {
            ld16bf(z + C_DK + lane * 16, v); float ss = 0.f;
#pragma unroll
            for (int e = 0; e < 16; ++e) ss += v[e] * v[e];
            ss += __shfl_xor(ss, 1); ss += __shfl_xor(ss, 2);
            const float rstd = 1.0f / sqrtf(ss * (1.0f / 64.0f) + EPS); const int sub = lane & 3; const float* gn = dqk + 64 + sub * 16;
#pragma unroll
            for (int e = 0; e < 16; ++e) v[e] = v[e] * rstd * gn[e];
            if (latent) rope_pair(v, R64 + (sub < 2 ? prow : pcol) * 16, 0, (sub & 1) == 0, 1);
            else st16f(out + OUT_DK + co * 1024 + lane * 16, v);
            st16bf(KA + krow * KVW + lane * 16, v);
        }
        {
            ld16bf(z + C_DV + lane * 16, v);
            if (!latent) st16f(out + OUT_DV + co * 1024 + lane * 16, v);
            *(v4u*)(VA + krow * KVW + lane * 16) = *(const v4u*)(z + C_DV + lane * 16); *(v4u*)(VA + krow * KVW + lane * 16 + 8) = *(const v4u*)(z + C_DV + lane * 16 + 8);
        }
        {
            ld16bf(z + C_GQ + lane * 16, v); float ss = 0.f;
#pragma unroll
            for (int e = 0; e < 16; ++e) ss += v[e] * v[e];
            ss += __shfl_xor(ss, 1); ss += __shfl_xor(ss, 2); ss += __shfl_xor(ss, 4);
            const float rstd = 1.0f / sqrtf(ss * (1.0f / 128.0f) + EPS); const int sub = lane & 7; const float* gn = gqk + sub * 16;
#pragma unroll
            for (int e = 0; e < 16; ++e) v[e] = v[e] * rstd * gn[e];
            if (latent) rope_pair(v, R128 + (sub < 4 ? prow : pcol) * 32, (sub & 1) * 16, (sub & 2) == 0, 2);
#pragma unroll
            for (int e = 0; e < 16; ++e) v[e] *= 0.08838834764831845f;
            st16bf(QA + (size_t)row * 3072 + 2048 + lane * 16, v);
        }
        {
            const int ln = lane & 15;
            ld16bf(z + C_GK + ln * 16, v); float ss = 0.f;
#pragma unroll
            for (int e = 0; e < 16; ++e) ss += v[e] * v[e];
            ss += __shfl_xor(ss, 1); ss += __shfl_xor(ss, 2); ss += __shfl_xor(ss, 4);
            const float rstd = 1.0f / sqrtf(ss * (1.0f / 128.0f) + EPS); const int sub = lane & 7; const float* gn = gqk + 128 + sub * 16;
#pragma unroll
            for (int e = 0; e < 16; ++e) v[e] = v[e] * rstd * gn[e];
            if (latent) rope_pair(v, R128 + (sub < 4 ? prow : pcol) * 32, (sub & 1) * 16, (sub & 2) == 0, 2);
            if (lane < 16) { if (!latent) st16f(out + OUT_GK + co * 256 + lane * 16, v); st16bf(KA + krow * KVW + 1024 + lane * 16, v); }
            ld16bf(z + C_GV + ln * 16, v);
            if (lane < 16) { if (!latent) st16f(out + OUT_GV + co * 256 + lane * 16, v); st16bf(VA + krow * KVW + 1024 + lane * 16, v); }
        }
    }
}

typedef short bf16x4s __attribute__((ext_vector_type(4)));
typedef short bf16x8h __attribute__((ext_vector_type(8)));
constexpr int HG_QD = 0, HG_QR = 4352, HG_KR = 8704, HG_KDT = 13056, HG_VT = 17152, HG_DEC = 21248, HG_BUF = 22016, HG_TOTS = 2 * HG_BUF;
__device__ __forceinline__ void hgrn_item(const Args& a, unsigned char* ws, LAS unsigned char* lds, int l, int item, const XcdBarrier* barp = nullptr, int split = -1) {
    ws = fresh_ws(ws); const int tid = fresh_tid(), lane = tid & 63, wave = __builtin_amdgcn_readfirstlane(tid >> 6);
    const bf16* Z = (const bf16*)(ws + WS_Z);
    int b, h, dir, T, row0; const bool latent = item < 32;
    if (latent) { b = item >> 4; h = (item >> 1) & 7; dir = item & 1; T = 1024; row0 = NPROMPT + b * 1024; }
    else { const int it = item - 32; b = it >> 4; h = (it >> 1) & 7; dir = it & 1; T = 256; row0 = b * 256; }
    const int kp = lane, sg = wave;
    const int fr = lane & 15, g = lane >> 4, vb = wave * 16;
    float lb[2] = {0.f, 0.f};
    if (l == 1) { const float* hl = a.in[14];
#pragma unroll
        for (int ch = 0; ch < 2; ++ch) { const float a0 = hl[(dir * 2 + 0) * 1024 + h * 128 + 2 * kp + ch], a1 = hl[(dir * 2 + 1) * 1024 + h * 128 + 2 * kp + ch]; lb[ch] = 1.0f / (1.0f + expf(a0 - a1)); } }
    const size_t sidx = ((((size_t)(b * 2 + l) * 2 + dir) * 8 + h) * 128) * 128;
    f32x4 S[8];
    if (latent) { const float* st = a.in[7] + sidx;
#pragma unroll
        for (int kt = 0; kt < 8; ++kt)
#pragma unroll
            for (int r = 0; r < 4; ++r) S[kt][r] = st[(size_t)(16 * kt + 4 * g + r) * 128 + vb + fr]; }
    else {
#pragma unroll
        for (int kt = 0; kt < 8; ++kt) S[kt] = (f32x4){0.f, 0.f, 0.f, 0.f}; }
    LAS unsigned char* base = lds + RING_OFF;
    LAS float* tots = (LAS float*)(base + HG_TOTS);
    bf16* OH = (bf16*)(ws + WS_OH) + (size_t)dir * NTOK * 1024;
    const long ost = dir ? -1024 : 1024, zst = dir ? -(long)INW : (long)INW;
    bf16* const ob0 = OH + (size_t)(row0 + (dir ? T - 1 : 0)) * 1024 + h * 128 + vb + fr + ost * (4 * g);
    const bf16* const zb0 = Z + (size_t)(row0 + (dir ? T - 1 : 0)) * INW + h * 128 + 2 * kp + zst * (2 * sg);
    const int nchunk = T >> 4;
    unsigned rq0[2], rz0[2], rv0[2], rq1[2], rz1[2], rv1[2], rq2[2], rz2[2], rv2[2], rq3[2], rz3[2], rv3[2];
#define HG_LOAD(rq, rz, rv, c) do { if ((c) < nchunk) { _Pragma("unroll") for (int i = 0; i < 2; ++i) { const bf16* zr = zb0 + zst * ((c) * 16 + i); \
        rq[i] = *(const unsigned*)(zr + C_HQ); rz[i] = *(const unsigned*)(zr + C_HF + dir * 1024); rv[i] = *(const unsigned*)(zr + C_HI); } } } while (0)
#define HG_EXP(x) __builtin_amdgcn_exp2f(1.4426950408889634f * (x))
#ifndef HG_PROBE
#define HG_PROBE 0
#endif
#define HG_STAGE(rq, rz, rv, pbuf) do { \
        float lf[2][2], kk[2][2]; \
        _Pragma("unroll") for (int i = 0; i < 2; ++i) _Pragma("unroll") for (int ch = 0; ch < 2; ++ch) { const float zf = ch ? bfhi(rz[i]) : bflo(rz[i]); const float e = HG_EXP(-fabsf(zf)), inv = __builtin_amdgcn_rcpf(1.0f + e); \
            const float sp = zf >= 0.f ? inv : e * inv, sn = zf >= 0.f ? e * inv : inv; kk[ch][i] = (1.0f - lb[ch]) * sn; lf[ch][i] = 0.6931471805599453f * __builtin_amdgcn_logf(lb[ch] + (1.0f - lb[ch]) * sp); } \
        const float c00 = lf[0][0], c01 = c00 + lf[0][1], c10 = lf[1][0], c11 = c10 + lf[1][1]; \
        *(LAS f32x2*)(tots + sg * 128 + 2 * kp) = (f32x2){c01, c11}; \
        __syncthreads(); \
        f32x2 pre = {0.f, 0.f}, bm = {0.f, 0.f}, b15 = {0.f, 0.f}; \
        _Pragma("unroll") for (int q = 0; q < 8; ++q) { const f32x2 tq = *(const LAS f32x2*)(tots + q * 128 + 2 * kp); if (q < sg) pre += tq; if (q < 4) bm += tq; b15 += tq; } \
        LAS unsigned char* pb_ = base + (pbuf) * HG_BUF; float kd[2][2]; \
        _Pragma("unroll") for (int i = 0; i < 2; ++i) { const int s = 2 * sg + i; float qd[2], qr[2], kr[2]; \
            _Pragma("unroll") for (int ch = 0; ch < 2; ++ch) { const float q = ch ? bfhi(rq[i]) : bflo(rq[i]); const float bb = (ch ? pre.y : pre.x) + (i ? (ch ? c11 : c01) : (ch ? c10 : c00)); \
                const float bmc = ch ? bm.y : bm.x, b15c = ch ? b15.y : b15.x; const float er = HG_EXP(fminf(fmaxf(bb - bmc, -80.f), 80.f)); \
                qd[ch] = q * HG_EXP(bb); qr[ch] = q * er; kr[ch] = kk[ch][i] * __builtin_amdgcn_rcpf(er); kd[ch][i] = kk[ch][i] * HG_EXP(b15c - bb); } \
            *(LAS unsigned*)(pb_ + HG_QD + s * 272 + kp * 4) = pk2(qd[0], qd[1]); \
            *(LAS unsigned*)(pb_ + HG_QR + s * 272 + kp * 4) = pk2(qr[0], qr[1]); \
            *(LAS unsigned*)(pb_ + HG_KR + s * 272 + kp * 4) = pk2(kr[0], kr[1]); } \
        *(LAS unsigned*)(pb_ + HG_KDT + (2 * kp) * 32 + sg * 4) = pk2(kd[0][0], kd[0][1]); *(LAS unsigned*)(pb_ + HG_KDT + (2 * kp + 1) * 32 + sg * 4) = pk2(kd[1][0], kd[1][1]); \
        *(LAS unsigned*)(pb_ + HG_VT + (2 * kp) * 32 + sg * 4) = (rv[0] & 0xffffu) | (rv[1] << 16); *(LAS unsigned*)(pb_ + HG_VT + (2 * kp + 1) * 32 + sg * 4) = (rv[0] >> 16) | (rv[1] & 0xffff0000u); \
        if (sg == 0) *(LAS f32x2*)(pb_ + HG_DEC + kp * 8) = (f32x2){HG_EXP(b15.x), HG_EXP(b15.y)}; \
    } while (0)
#define HG_MFMA(c) do { \
            const LAS unsigned char* pb_ = base + ((c) & 1) * HG_BUF; bf16x8h bv; \
            f32x4 at = {0.f, 0.f, 0.f, 0.f}; \
            _Pragma("unroll") for (int ks = 0; ks < 4; ++ks) { const bf16x8h ka = *(const LAS bf16x8h*)(pb_ + HG_KR + fr * 272 + (32 * ks + 8 * g) * 2), qb = *(const LAS bf16x8h*)(pb_ + HG_QR + fr * 272 + (32 * ks + 8 * g) * 2); \
                at = __builtin_amdgcn_mfma_f32_16x16x32_bf16(ka, qb, at, 0, 0, 0); }            \
            _Pragma("unroll") for (int r = 0; r < 4; ++r) if (4 * g + r > fr) at[r] = 0.f; \
            const v4u pa4 = {pk2(at[0], at[1]), pk2(at[2], at[3]), 0u, 0u}; const bf16x8h pa = __builtin_bit_cast(bf16x8h, pa4);     \
            f32x4 o = {0.f, 0.f, 0.f, 0.f}; \
            _Pragma("unroll") for (int ks = 0; ks < 4; ++ks) { \
                const v4u bs4 = {pk2(S[2 * ks][0], S[2 * ks][1]), pk2(S[2 * ks][2], S[2 * ks][3]), pk2(S[2 * ks + 1][0], S[2 * ks + 1][1]), pk2(S[2 * ks + 1][2], S[2 * ks + 1][3])}; \
                const v2u alo = *(const LAS v2u*)(pb_ + HG_QD + fr * 272 + (32 * ks + 4 * g) * 2), ahi = *(const LAS v2u*)(pb_ + HG_QD + fr * 272 + (32 * ks + 16 + 4 * g) * 2); \
                const v4u a4 = {alo.x, alo.y, ahi.x, ahi.y}; \
                o = __builtin_amdgcn_mfma_f32_16x16x32_bf16(__builtin_bit_cast(bf16x8h, a4), __builtin_bit_cast(bf16x8h, bs4), o, 0, 0, 0); } \
            const v2u bv2 = *(const LAS v2u*)(pb_ + HG_VT + (vb + fr) * 32 + g * 8); const v4u bv4 = {bv2.x, bv2.y, 0u, 0u}; bv = __builtin_bit_cast(bf16x8h, bv4); \
            o = __builtin_amdgcn_mfma_f32_16x16x32_bf16(pa, bv, o, 0, 0, 0); \
            _Pragma("unroll") for (int r = 0; r < 4; ++r) ob0[ost * ((c) * 16 + r)] = (bf16)f2bf(o[r]); \
            _Pragma("unroll") for (int kt = 0; kt < 8; ++kt) { const f32x4 d4 = *(const LAS f32x4*)(pb_ + HG_DEC + (16 * kt + 4 * g) * 4); const v2u ak2 = *(const LAS v2u*)(pb_ + HG_KDT + (16 * kt + fr) * 32 + g * 8); const v4u ak4 = {ak2.x, ak2.y, 0u, 0u}; \
                S[kt] = __builtin_amdgcn_mfma_f32_16x16x32_bf16(__builtin_bit_cast(bf16x8h, ak4), bv, S[kt] * d4, 0, 0, 0); } \
    } while (0)
    HG_LOAD(rq0, rz0, rv0, 0); HG_LOAD(rq1, rz1, rv1, 1); HG_LOAD(rq2, rz2, rv2, 2); HG_LOAD(rq3, rz3, rv3, 3);
    HG_STAGE(rq0, rz0, rv0, 0);
    HG_LOAD(rq0, rz0, rv0, 4);
    __syncthreads();
    for (int c = 0; c < nchunk; c += 4) {
        if (c == split) xcd_barrier(*barp);
        HG_STAGE(rq1, rz1, rv1, 1); HG_LOAD(rq1, rz1, rv1, c + 5); HG_MFMA(c);     __syncthreads();
        HG_STAGE(rq2, rz2, rv2, 0); HG_LOAD(rq2, rz2, rv2, c + 6); HG_MFMA(c + 1); __syncthreads();
        HG_STAGE(rq3, rz3, rv3, 1); HG_LOAD(rq3, rz3, rv3, c + 7); HG_MFMA(c + 2); __syncthreads();
        if (c + 4 < nchunk) { HG_STAGE(rq0, rz0, rv0, 0); HG_LOAD(rq0, rz0, rv0, c + 8); }
        HG_MFMA(c + 3); __syncthreads();
    }
#undef HG_MFMA
#undef HG_EXP
#undef HG_LOAD
#undef HG_STAGE
    if (!latent) { float* st = a.out + OUT_ST + sidx;
#pragma unroll
        for (int kt = 0; kt < 8; ++kt)
#pragma unroll
            for (int r = 0; r < 4; ++r) st[(size_t)(16 * kt + 4 * g + r) * 128 + vb + fr] = S[kt][r]; }
    __syncthreads();
}

__device__ __forceinline__ void attn_unit(unsigned char* ws, char* lds_generic, int u) {
    ws = fresh_ws(ws);
    int b, he, row0, key0, seq;
    if (u < 192) { b = u / 96; const int r = u % 96; he = r >> 2; const int qb = r & 3; row0 = NPROMPT + b * 1024 + qb * 256; key0 = NPROMPT + b * 1280; seq = 1280; }
    else { const int uu = u - 192; b = uu / 24; he = uu % 24; row0 = b * 256; key0 = b * 256; seq = 256; }
    const int kvh = he < 16 ? (he >> 1) : 8 + ((he - 16) >> 2);
    const att::bf16* Q = (const att::bf16*)(ws + WS_QA) + (size_t)row0 * 3072 + he * 128;
    const att::bf16* K = (const att::bf16*)(ws + WS_KA) + (size_t)key0 * KVW + kvh * 128;
    const att::bf16* V = (const att::bf16*)(ws + WS_VA) + (size_t)key0 * KVW + kvh * 128;
    unsigned short* O = (unsigned short*)(ws + WS_OA) + (size_t)row0 * 3072 + he * 128;
    att::attn_dense_body<att::bf16>(Q, K, V, O, seq, lds_generic + RING_OFF);
    __syncthreads();
}

__device__ __forceinline__ void post_phase(const Args& a, unsigned char* ws, int l, int G) {
    ws = fresh_ws(ws); const int tid = fresh_tid(), lane = tid & 63, gw = blockIdx.x * 8 + __builtin_amdgcn_readfirstlane(tid >> 6), NGW = G * 8;
    const bf16* Z = (const bf16*)(ws + WS_Z); const bf16* OA = (const bf16*)(ws + WS_OA); const bf16* OHf = (const bf16*)(ws + WS_OH); const bf16* OHb = OHf + (size_t)NTOK * 1024;
    bf16* BR = (bf16*)(ws + WS_BR);
    const float lam_init = 0.8f - 0.6f * expf(-0.3f * (float)l);
    const float* lp = a.in[17] + (size_t)l * 4 * 64;
    const float s01 = wave_sum(lp[lane] * lp[64 + lane]), s23 = wave_sum(lp[128 + lane] * lp[192 + lane]);
    const float lam = expf(s01) - expf(s23) + lam_init;
    const float* hn = a.in[15] + (size_t)l * 128; const float* sl = a.in[18] + (size_t)l * 128;
    const int sub = lane & 7;
    for (int row = gw; row < NTOK; row += NGW) {
        float v[16], w[16];
        {
            ld16bf(OHf + (size_t)row * 1024 + lane * 16, v); ld16bf(OHb + (size_t)row * 1024 + lane * 16, w); float ss = 0.f;
#pragma unroll
            for (int e = 0; e < 16; ++e) { v[e] += w[e]; ss += v[e] * v[e]; }
            ss += __shfl_xor(ss, 1); ss += __shfl_xor(ss, 2); ss += __shfl_xor(ss, 4);
            const float rstd = 1.0f / sqrtf(ss * (1.0f / 128.0f) + EPS);
            ld16bf(Z + (size_t)row * INW + C_HG + lane * 16, w);
#pragma unroll
            for (int e = 0; e < 16; ++e) { const float g = w[e]; v[e] = v[e] * rstd * hn[sub * 16 + e] * (g / (1.0f + expf(-g))); }
            st16bf(BR + (size_t)row * 1024 + lane * 16, v);
        }
        {
            const int h = lane >> 3; const bf16* o1 = OA + (size_t)row * 3072 + (2 * h) * 128 + sub * 16;
            ld16bf(o1, v); ld16bf(o1 + 128, w); float ss = 0.f;
#pragma unroll
            for (int e = 0; e < 16; ++e) { v[e] -= lam * w[e]; ss += v[e] * v[e]; }
            ss += __shfl_xor(ss, 1); ss += __shfl_xor(ss, 2); ss += __shfl_xor(ss, 4);
            const float rstd = 1.0f / sqrtf(ss * (1.0f / 128.0f) + EPS);
#pragma unroll
            for (int e = 0; e < 16; ++e) v[e] = v[e] * rstd * sl[sub * 16 + e] * (1.0f - lam_init);
            st16bf(BR + (size_t)NTOK * 1024 + (size_t)row * 1024 + lane * 16, v);
        }
        {
            *(v4u*)(BR + (size_t)2 * NTOK * 1024 + (size_t)row * 1024 + lane * 16) = *(const v4u*)(OA + (size_t)row * 3072 + 2048 + lane * 16); *(v4u*)(BR + (size_t)2 * NTOK * 1024 + (size_t)row * 1024 + lane * 16 + 8) = *(const v4u*)(OA + (size_t)row * 3072 + 2048 + lane * 16 + 8);
        }
    }
}

typedef short bf16x8s __attribute__((ext_vector_type(8)));
typedef float f32x16 __attribute__((ext_vector_type(16)));
__device__ __forceinline__ unsigned ford(float f) { const unsigned u = __float_as_uint(f); return u ^ ((u >> 31) ? 0xffffffffu : 0x80000000u); }
__device__ __forceinline__ float funord(unsigned k) { const unsigned u = (k & 0x80000000u) ? (k ^ 0x80000000u) : ~k; return __uint_as_float(u); }
__device__ __forceinline__ void ins16(unsigned (&L)[16], unsigned x) {
#pragma unroll
    for (int i = 0; i < 16; ++i) { const unsigned hi = L[i] > x ? L[i] : x; x = L[i] > x ? x : L[i]; L[i] = hi; }
}
__device__ __forceinline__ void ce_desc(unsigned& a_, unsigned& b_) { const unsigned hi = a_ > b_ ? a_ : b_, lo = a_ > b_ ? b_ : a_; a_ = hi; b_ = lo; }
__device__ __forceinline__ void sort16_desc(unsigned (&x)[16]) {
#pragma unroll
    for (int k = 2; k <= 16; k <<= 1)
#pragma unroll
        for (int j = k >> 1; j > 0; j >>= 1)
#pragma unroll
            for (int i = 0; i < 16; ++i) { const int l = i ^ j; if (l > i) { if ((i & k) == 0) ce_desc(x[i], x[l]); else ce_desc(x[l], x[i]); } }
}
__device__ __forceinline__ void merge16_desc(unsigned (&a_)[16], const unsigned (&b_)[16]) {
#pragma unroll
    for (int i = 0; i < 16; ++i) a_[i] = a_[i] > b_[15 - i] ? a_[i] : b_[15 - i];
#pragma unroll
    for (int j = 8; j > 0; j >>= 1)
#pragma unroll
        for (int i = 0; i < 16; ++i) { const int l = i ^ j; if (l > i) ce_desc(a_[i], a_[l]); }
}
__device__ __forceinline__ void peer_top16(unsigned (&L)[16], const LAS unsigned char* keysL, const bf16* qp, int c, int qrow, int hf) {
    f32x16 acc[4];
#pragma unroll
    for (int tl = 0; tl < 4; ++tl)
#pragma unroll
        for (int r = 0; r < 16; ++r) acc[tl][r] = 0.f;
    bf16x8s bq[8];
#pragma unroll
    for (int ks = 0; ks < 8; ++ks) bq[ks] = *(const bf16x8s*)(qp + c * 128 + ks * 16 + hf * 8);
#pragma unroll
    for (int ks = 0; ks < 8; ++ks)
#pragma unroll
        for (int tl = 0; tl < 4; ++tl) { const bf16x8s ka = *(const LAS bf16x8s*)(keysL + (c * 128 + tl * 32 + qrow) * 256 + (((ks * 2 + hf) ^ (qrow & 15)) << 4));
            acc[tl] = __builtin_amdgcn_mfma_f32_32x32x16_bf16(ka, bq[ks], acc[tl], 0, 0, 0); }
    unsigned K1[16], K2[16], K3[16];
#pragma unroll
    for (int r = 0; r < 16; ++r) { const unsigned kc = 127u - (unsigned)((r & 3) + 8 * (r >> 2)) - 4u * (unsigned)hf;
        L[r] = (ford(acc[0][r]) & 0xffffff80u) | kc; K1[r] = (ford(acc[1][r]) & 0xffffff80u) | (kc - 32u); K2[r] = (ford(acc[2][r]) & 0xffffff80u) | (kc - 64u); K3[r] = (ford(acc[3][r]) & 0xffffff80u) | (kc - 96u); }
    sort16_desc(L); sort16_desc(K1); sort16_desc(K2); sort16_desc(K3);
    merge16_desc(L, K1); merge16_desc(K2, K3); merge16_desc(L, K2);
    unsigned P[16];
#pragma unroll
    for (int i = 0; i < 16; ++i) P[i] = (unsigned)__shfl_xor((int)L[i], 32);
    merge16_desc(L, P);
}
__device__ __forceinline__ float gelu_erf(float x) { return 0.5f * x * (1.0f + erff(x * 0.70710678118654752f)); }
__device__ __forceinline__ void peer_topk_phase(const Args& a, unsigned char* ws, LAS unsigned char* lds, int l, int G) {
    ws = fresh_ws(ws); const int tid = fresh_tid(), lane = tid & 63, wave = __builtin_amdgcn_readfirstlane(tid >> 6);
    LAS unsigned char* keysL = lds + RING_OFF;
    LAS unsigned char* wtab = keysL + 65536 + wave * 2048;
    const float* pk = a.in[23] + (size_t)l * 2 * 128 * 128;
    for (int i = tid; i < 2 * 128 * 16; i += 512) { const int q = i & 15, rk = i >> 4, k = rk & 127;
        const f32x4 x0 = *(const f32x4*)(pk + (size_t)rk * 128 + q * 8), x1 = *(const f32x4*)(pk + (size_t)rk * 128 + q * 8 + 4);
        v4u o; o.x = pk2(x0[0], x0[1]); o.y = pk2(x0[2], x0[3]); o.z = pk2(x1[0], x1[1]); o.w = pk2(x1[2], x1[3]);
        *(LAS v4u*)(keysL + rk * 256 + ((q ^ (k & 15)) << 4)) = o; }
    __syncthreads();
    const bf16* QPb = (const bf16*)(ws + WS_QP); unsigned* PE = (unsigned*)(ws + WS_PE); unsigned* PG = (unsigned*)(ws + WS_PG);
    const int gw = blockIdx.x * 8 + wave, NGW = G * 8;
    const int hf = lane >> 5, qrow = lane & 31, tq = qrow >> 3, hq = qrow & 7;
    for (int tile = gw; tile < NTOK / 3; tile += NGW) {
        const int tok0 = tile * 3;
        const bf16* qp = QPb + (size_t)(tok0 + (tq < 3 ? tq : 2)) * DM + hq * 256;
        unsigned L0[16], L1[16];
        peer_top16(L0, keysL, qp, 0, qrow, hf);
        peer_top16(L1, keysL, qp, 1, qrow, hf);
        unsigned tw[8];
#pragma unroll
        for (int i = 0; i < 4; ++i) { tw[i] = (127u - (L0[4 * i] & 127u)) | ((127u - (L0[4 * i + 1] & 127u)) << 8) | ((127u - (L0[4 * i + 2] & 127u)) << 16) | ((127u - (L0[4 * i + 3] & 127u)) << 24);
                                      tw[4 + i] = (127u - (L1[4 * i] & 127u)) | ((127u - (L1[4 * i + 1] & 127u)) << 8) | ((127u - (L1[4 * i + 2] & 127u)) << 16) | ((127u - (L1[4 * i + 3] & 127u)) << 24); }
        *(LAS v4u*)(wtab + lane * 32) = (v4u){tw[0], tw[1], tw[2], tw[3]}; *(LAS v4u*)(wtab + lane * 32 + 16) = (v4u){tw[4], tw[5], tw[6], tw[7]};
        float v0[16], v1[16];
#pragma unroll
        for (int i = 0; i < 16; ++i) { v0[i] = funord(L0[i] & 0xffffff80u); v1[i] = funord(L1[i] & 0xffffff80u); }
        unsigned C[16], C1[16], C2[16], C3[16];
#pragma unroll
        for (int i = 0; i < 16; ++i) { C[i] = 0u; C1[i] = 0u; C2[i] = 0u; C3[i] = 0u; }
#pragma unroll
        for (int i = 0; i < 16; ++i)
#pragma unroll
            for (int j = 0; j < 16; ++j) if ((i + 1) * (j + 1) <= 16) {
                constexpr int PRE[16] = {0, 16, 24, 29, 33, 36, 38, 40, 42, 43, 44, 45, 46, 47, 48, 49};
                const int s = PRE[i] + j; const unsigned key = (ford(v0[i] + v1[j]) & 0xffffff00u) | (255u - (unsigned)(i * 16 + j));
                if (s < 16) C[s & 15] = key; else if (s < 32) C1[s & 15] = key; else if (s < 48) C2[s & 15] = key; else C3[s & 15] = key; }
        sort16_desc(C); sort16_desc(C1); sort16_desc(C2); sort16_desc(C3);
        merge16_desc(C, C1); merge16_desc(C2, C3); merge16_desc(C, C2);
        LDS_WAIT(); asm volatile("" ::: "memory");
        float ex[16]; float sum = 0.f; const float c0 = funord(C[0] & 0xffffff00u);
#pragma unroll
        for (int r = 0; r < 16; ++r) { ex[r] = expf(funord(C[r] & 0xffffff00u) - c0); sum += ex[r]; }
        const float rs = 1.0f / sum;
        if (tq < 3) { const size_t ob = (size_t)(tok0 + tq) * 128 + hq * 16;
            if (hf == 0) { unsigned ev[16];
#pragma unroll
                for (int r = 0; r < 16; ++r) { const unsigned ci = 255u - (C[r] & 255u); const unsigned k0 = wtab[lane * 32 + (ci >> 4)], k1 = wtab[lane * 32 + 16 + (ci & 15u)]; ev[r] = k0 * 128u + k1; }
#pragma unroll
                for (int r = 0; r < 16; r += 4) *(v4u*)(PE + ob + r) = (v4u){ev[r], ev[r + 1], ev[r + 2], ev[r + 3]}; }
            else {
#pragma unroll
                for (int r = 0; r < 16; r += 4) *(v4u*)(PG + ob + r) = (v4u){__float_as_uint(ex[r] * rs), __float_as_uint(ex[r + 1] * rs), __float_as_uint(ex[r + 2] * rs), __float_as_uint(ex[r + 3] * rs)}; }
        }
        LDS_WAIT(); asm volatile("" ::: "memory");
    }
    __syncthreads();
}
#define PEER_ACC(OUT) do { _Pragma("unroll") for (int j = 0; j < 8; ++j) { const int q = (int)w[t][j >> 2][j & 3]; \
        OUT[2 * j] = __builtin_elementwise_fma(__builtin_amdgcn_cvt_pk_f32_fp8(q, false), wg2, OUT[2 * j]); OUT[2 * j + 1] = __builtin_elementwise_fma(__builtin_amdgcn_cvt_pk_f32_fp8(q, true), wg2, OUT[2 * j + 1]); } } while (0)
__device__ __forceinline__ void fma_ip(float& o, float x, float w) { asm("v_fma_f32 %0, %1, %2, %0" : "+v"(o) : "v"(x), "v"(w)); }
__device__ __forceinline__ void peer_gather_phase(const Args& a, unsigned char* ws, LAS unsigned char* lds, int l, float* xout, int G, unsigned emask = 0xffffu, int skip = 0, bool n1fuse = false) {
    ws = fresh_ws(ws); const int tid = fresh_tid(), lane = tid & 63, wave = __builtin_amdgcn_readfirstlane(tid >> 6);
    LAS unsigned char* wb = lds + RING_OFF + wave * 16384;
    LAS v2u* list = (LAS v2u*)(wb + 12288); LAS unsigned* hist = (LAS unsigned*)(wb + 15360);
    const bf16* H = (const bf16*)(ws + WS_H); const unsigned* PE = (const unsigned*)(ws + WS_PE); const unsigned* PG = (const unsigned*)(ws + WS_PG);
    const unsigned char* UV8 = ws + WS_UV8 + (size_t)l * 16384 * 4096; const float* SC = (const float*)(ws + WS_SC) + (size_t)l * 16384 * 2;
    const float* XM = (const float*)(ws + WS_XM); const float* MOD = (const float*)(ws + WS_MOD) + (size_t)l * 3 * 12288;
    const int gw = blockIdx.x * 8 + wave, NGW = G * 8;
    for (int tile = gw; tile < NTOK / 3; tile += NGW) {
        const int tok0 = tile * 3;
        {
            unsigned e[6], gb[6], pos[6];
            hist[lane] = 0u; hist[64 + lane] = 0u; hist[128 + lane] = 0u;
#pragma unroll
            for (int m = 0; m < 6; ++m) { const size_t ix = (size_t)(tok0 + (m >> 1)) * 128 + ((lane + 64 * m) & 127); e[m] = PE[ix] & emask; gb[m] = PG[ix]; }
            LDS_WAIT(); asm volatile("" ::: "memory");
#pragma unroll
            for (int m = 0; m < 6; ++m) pos[m] = __hip_atomic_fetch_add(hist + (m >> 1) * 64 + (e[m] >> 8), 1u, __ATOMIC_RELAXED, __HIP_MEMORY_SCOPE_WORKGROUP);
            LDS_WAIT(); asm volatile("" ::: "memory");
            const unsigned cnt0 = hist[lane], cnt1 = hist[64 + lane], cnt2 = hist[128 + lane]; unsigned inc0 = cnt0, inc1 = cnt1, inc2 = cnt2;
#pragma unroll
            for (int o = 1; o < 64; o <<= 1) { const unsigned t0 = (unsigned)__shfl_up((int)inc0, o), t1 = (unsigned)__shfl_up((int)inc1, o), t2 = (unsigned)__shfl_up((int)inc2, o); if (lane >= o) { inc0 += t0; inc1 += t1; inc2 += t2; } }
            LDS_WAIT(); asm volatile("" ::: "memory");
            hist[lane] = inc0 - cnt0; hist[64 + lane] = 128u + inc1 - cnt1; hist[128 + lane] = 256u + inc2 - cnt2;
            LDS_WAIT(); asm volatile("" ::: "memory");
#pragma unroll
            for (int m = 0; m < 6; ++m) { const unsigned p_ = hist[(m >> 1) * 64 + (e[m] >> 8)] + pos[m]; list[p_] = (v2u){e[m], gb[m]}; }
            LDS_WAIT(); asm volatile("" ::: "memory");
        }
        if (!(skip & 1)) {
            f32x2 h0[16], h1[16], h2r[16];
#pragma unroll
            for (int j = 0; j < 8; ++j) { const v2u a0 = *(const v2u*)(H + (size_t)(tok0 + 0) * DM + j * 256 + lane * 4), a1 = *(const v2u*)(H + (size_t)(tok0 + 1) * DM + j * 256 + lane * 4), a2 = *(const v2u*)(H + (size_t)(tok0 + 2) * DM + j * 256 + lane * 4);
                h0[2 * j] = (f32x2){bflo(a0.x), bfhi(a0.x)}; h0[2 * j + 1] = (f32x2){bflo(a0.y), bfhi(a0.y)};
                h1[2 * j] = (f32x2){bflo(a1.x), bfhi(a1.x)}; h1[2 * j + 1] = (f32x2){bflo(a1.y), bfhi(a1.y)};
                h2r[2 * j] = (f32x2){bflo(a2.x), bfhi(a2.x)}; h2r[2 * j + 1] = (f32x2){bflo(a2.y), bfhi(a2.y)}; }
#define PU_LOAD(W, SCL, G_, kb_) do { _Pragma("unroll") for (int t = 0; t < 3; ++t) { const v2u r = list[t * 128 + (kb_)]; const int ee = __builtin_amdgcn_readfirstlane((int)r.x); G_[t] = __uint_as_float((unsigned)__builtin_amdgcn_readfirstlane((int)r.y)); \
            const unsigned char* base = UV8 + (size_t)ee * 4096 + lane * 32; W[t][0] = *(const v4u*)base; W[t][1] = *(const v4u*)(base + 16); SCL[t] = *(const f32x2*)(SC + (size_t)ee * 2); } } while (0)
#define PU_DOT(HV, Wt) ({ f32x2 s_ = {0.f, 0.f}; _Pragma("unroll") for (int j = 0; j < 8; ++j) { const int q = (int)Wt[j >> 2][j & 3]; \
            s_ = __builtin_elementwise_fma(__builtin_amdgcn_cvt_pk_f32_fp8(q, false), HV[2 * j], s_); s_ = __builtin_elementwise_fma(__builtin_amdgcn_cvt_pk_f32_fp8(q, true), HV[2 * j + 1], s_); } s_.x + s_.y; })
#define PU_RED(x_) do { x_ += __uint_as_float((unsigned)__builtin_amdgcn_update_dpp(0, (int)__float_as_uint(x_), 0xB1, 0xF, 0xF, false)); x_ += __uint_as_float((unsigned)__builtin_amdgcn_update_dpp(0, (int)__float_as_uint(x_), 0x4E, 0xF, 0xF, false)); \
            x_ += __uint_as_float((unsigned)__builtin_amdgcn_update_dpp(0, (int)__float_as_uint(x_), 0x141, 0xF, 0xF, false)); x_ += __uint_as_float((unsigned)__builtin_amdgcn_update_dpp(0, (int)__float_as_uint(x_), 0x140, 0xF, 0xF, false)); \
            x_ += __uint_as_float((unsigned)__builtin_amdgcn_update_dpp(0, (int)__float_as_uint(x_), 0x142, 0xA, 0xF, false)); x_ += __uint_as_float((unsigned)__builtin_amdgcn_update_dpp(0, (int)__float_as_uint(x_), 0x143, 0xC, 0xF, false)); } while (0)
#define PU_COMP(W, kb_) do { float d0 = PU_DOT(h0, W[0]), d1 = PU_DOT(h1, W[1]), d2 = PU_DOT(h2r, W[2]); PU_RED(d0); PU_RED(d1); PU_RED(d2); \
            if (lane == 63) { dl[(kb_)] = d0; dl[128 + (kb_)] = d1; dl[256 + (kb_)] = d2; } } while (0)
            LAS float* dl = (LAS float*)wb;
            v4u wA[3][2], wB[3][2];
#define PU_LOAD2(W, kb_) do { _Pragma("unroll") for (int t = 0; t < 3; ++t) { const int ee = __builtin_amdgcn_readfirstlane((int)list[t * 128 + (kb_)].x); \
            const unsigned char* base = UV8 + (size_t)ee * 4096 + lane * 32; W[t][0] = *(const v4u*)base; W[t][1] = *(const v4u*)(base + 16); } } while (0)
            PU_LOAD2(wA, 0);
#pragma unroll 1
            for (int kb = 0; kb < 128; kb += 2) {
                PU_LOAD2(wB, kb + 1); PU_COMP(wA, kb);
                if (kb + 2 < 128) PU_LOAD2(wA, kb + 2);
                PU_COMP(wB, kb + 1);
            }
            LDS_WAIT(); asm volatile("" ::: "memory");
#pragma unroll
            for (int m = 0; m < 6; ++m) { const int li = lane + 64 * m; const v2u ent = list[li]; const f32x2 sc2 = *(const f32x2*)(SC + (size_t)ent.x * 2);
                ((LAS float*)list)[2 * li + 1] = __uint_as_float(ent.y) * gelu_erf(dl[li] * sc2.x) * sc2.y; }
#undef PU_LOAD2
#undef PU_RED
#undef PU_LOAD
#undef PU_DOT
#undef PU_COMP
        }
        LDS_WAIT(); asm volatile("" ::: "memory");
        f32x2 out0[16], out1[16], out2[16];
#pragma unroll
        for (int i = 0; i < 16; ++i) { out0[i] = (f32x2){0.f, 0.f}; out1[i] = (f32x2){0.f, 0.f}; out2[i] = (f32x2){0.f, 0.f}; }
#define PV_LOAD(W, G_, kb_) do { _Pragma("unroll") for (int t = 0; t < 3; ++t) { const v2u r = list[t * 128 + (kb_)]; const int ee = __builtin_amdgcn_readfirstlane((int)r.x); G_[t] = __uint_as_float((unsigned)__builtin_amdgcn_readfirstlane((int)r.y)); \
            const unsigned char* base = UV8 + (size_t)ee * 4096 + 2048 + lane * 32; W[t][0] = *(const v4u*)base; W[t][1] = *(const v4u*)(base + 16); } } while (0)
#define PV_FMA(O, X, Wg) do { O.x = __builtin_fmaf(X.x, Wg, O.x); O.y = __builtin_fmaf(X.y, Wg, O.y); } while (0)
#define PV_COMP(W, G_) do { _Pragma("unroll") for (int t = 0; t < 3; ++t) { const float wg = G_[t]; \
            _Pragma("unroll") for (int j = 0; j < 8; ++j) { const int q = (int)W[t][j >> 2][j & 3]; const f32x2 lo = __builtin_amdgcn_cvt_pk_f32_fp8(q, false), hi = __builtin_amdgcn_cvt_pk_f32_fp8(q, true); \
                if (t == 0) { PV_FMA(out0[2 * j], lo, wg); PV_FMA(out0[2 * j + 1], hi, wg); } \
                else if (t == 1) { PV_FMA(out1[2 * j], lo, wg); PV_FMA(out1[2 * j + 1], hi, wg); } \
                else { PV_FMA(out2[2 * j], lo, wg); PV_FMA(out2[2 * j + 1], hi, wg); } } } } while (0)
        if (!(skip & 2)) {
            v4u wA[3][2], wB[3][2]; float gA[3], gB[3];
            PV_LOAD(wA, gA, 0);
#pragma unroll 1
            for (int kb = 0; kb < 128; kb += 2) {
                PV_LOAD(wB, gB, kb + 1); PV_COMP(wA, gA);
                if (kb + 2 < 128) PV_LOAD(wA, gA, kb + 2);
                PV_COMP(wB, gB);
            }
        }
#undef PV_LOAD
#undef PV_COMP
#pragma unroll
        for (int tt = 0; tt < 3; ++tt) {
            const int row = tok0 + tt; const int r = row < NPROMPT ? 0 : 1 + ((row - NPROMPT) >> 10);
            const float* g2 = MOD + (size_t)r * 12288 + 5 * DM;
            float ss = 0.f;
#pragma unroll
            for (int j = 0; j < 8; ++j) { const int c = j * 256 + lane * 4; const size_t off = (size_t)row * DM + c;
                const f32x4 x0 = *(const f32x4*)(XM + off), ga = *(const f32x4*)(g2 + c);
                const f32x2 oa = tt == 0 ? out0[2 * j] : (tt == 1 ? out1[2 * j] : out2[2 * j]), ob = tt == 0 ? out0[2 * j + 1] : (tt == 1 ? out1[2 * j + 1] : out2[2 * j + 1]);
                const f32x4 xo = x0 + ga * (f32x4){oa.x, oa.y, ob.x, ob.y}; *(f32x4*)(xout + off) = xo;
                ss += (xo[0] * xo[0] + xo[1] * xo[1]) + (xo[2] * xo[2] + xo[3] * xo[3]); }
            if (n1fuse) { const float* n1gain = a.in[11] + DM; const float* n1mod = (const float*)(ws + WS_MOD) + (size_t)3 * 12288;
                const float rstd = 1.0f / sqrtf(wave_sum(ss) * (1.0f / DM) + EPS); const float* sh = n1mod + (size_t)r * 12288; const float* sc = sh + DM; bf16* Hw = (bf16*)(ws + WS_H);
#pragma unroll
                for (int j = 0; j < 8; ++j) { const int c = j * 256 + lane * 4; const size_t off = (size_t)row * DM + c;
                    const f32x4 x0 = *(const f32x4*)(XM + off), ga = *(const f32x4*)(g2 + c);
                    const f32x2 oa = tt == 0 ? out0[2 * j] : (tt == 1 ? out1[2 * j] : out2[2 * j]), ob = tt == 0 ? out0[2 * j + 1] : (tt == 1 ? out1[2 * j + 1] : out2[2 * j + 1]);
                    const f32x4 xo = x0 + ga * (f32x4){oa.x, oa.y, ob.x, ob.y};
                    const f32x4 gn = *(const f32x4*)(n1gain + c), s1 = *(const f32x4*)(sc + c), s0 = *(const f32x4*)(sh + c);
                    const f32x4 o = xo * rstd * gn * (s1 + 1.0f) + s0; *(v2u*)(Hw + (size_t)row * DM + c) = (v2u){pk2(o[0], o[1]), pk2(o[2], o[3])}; }
            }
        }
        asm volatile("" ::: "memory");
    }
    __syncthreads();
}
#undef PEER_ACC

__device__ __forceinline__ unsigned dg_hash(unsigned x) { x ^= x >> 16; x *= 0x7feb352du; x ^= x >> 15; x *= 0x846ca68bu; x ^= x >> 16; return x; }
__device__ __forceinline__ void dummy_gather(unsigned char* ws, int mode, int G) {
    ws = fresh_ws(ws); const int tid = fresh_tid(), lane = tid & 63, wave = __builtin_amdgcn_readfirstlane(tid >> 6);
    const unsigned char* UV8 = ws + WS_UV8; const int gw = blockIdx.x * 8 + wave;
    f32x2 hv[16], out[16];
#pragma unroll
    for (int i = 0; i < 16; ++i) { hv[i] = (f32x2){(float)(lane + i) * 0.001f, (float)(lane - i) * 0.002f}; out[i] = (f32x2){0.f, 0.f}; }
    for (int jb = 0; jb < 384; jb += 4) {
        int e[4];
#pragma unroll
        for (int t = 0; t < 4; ++t) { const unsigned hsh = dg_hash((unsigned)(gw * 384 + jb + t) * 2654435761u + 12345u); e[t] = mode == 0 ? (int)(hsh & 16383u) : (int)((((unsigned)(jb + t) / 12u) << 9) | (hsh & 511u)); }
        v4u w[4][4];
#pragma unroll
        for (int t = 0; t < 4; ++t) { const unsigned char* base = UV8 + (size_t)e[t] * 4096 + lane * 32;
            w[t][0] = *(const v4u*)base; w[t][1] = *(const v4u*)(base + 16); w[t][2] = *(const v4u*)(base + 2048); w[t][3] = *(const v4u*)(base + 2048 + 16); }
        float d[4];
#pragma unroll
        for (int t = 0; t < 4; ++t) { f32x2 s = {0.f, 0.f};
#pragma unroll
            for (int j = 0; j < 8; ++j) { const int q = (int)w[t][j >> 2][j & 3];
                s = __builtin_elementwise_fma(__builtin_amdgcn_cvt_pk_f32_fp8(q, false), hv[2 * j], s); s = __builtin_elementwise_fma(__builtin_amdgcn_cvt_pk_f32_fp8(q, true), hv[2 * j + 1], s); }
            d[t] = s.x + s.y; }
#pragma unroll
        for (int o = 1; o < 64; o <<= 1) {
#pragma unroll
            for (int t = 0; t < 4; ++t) d[t] += __shfl_xor(d[t], o); }
#pragma unroll
        for (int t = 0; t < 4; ++t) { const float wg = d[t] * 1e-3f; const f32x2 wg2 = {wg, wg};
#pragma unroll
            for (int j = 0; j < 8; ++j) { const int q = (int)w[t][2 + (j >> 2)][j & 3];
                out[2 * j] = __builtin_elementwise_fma(__builtin_amdgcn_cvt_pk_f32_fp8(q, false), wg2, out[2 * j]); out[2 * j + 1] = __builtin_elementwise_fma(__builtin_amdgcn_cvt_pk_f32_fp8(q, true), wg2, out[2 * j + 1]); } }
    }
    float* scratch = (float*)(ws + WS_PE);
    float acc = 0.f;
#pragma unroll
    for (int i = 0; i < 16; ++i) acc += out[i].x + out[i].y;
    scratch[(size_t)gw * 64 + lane] = acc;
}
__global__ void __launch_bounds__(512, 2) mk_fwd(Args args) {
    extern __shared__ __attribute__((aligned(16))) unsigned char lds_raw[];
    LAS unsigned char* lds = (LAS unsigned char*)lds_raw;
    const int G = gridDim.x;
    unsigned char* ws = args.ws;
    unsigned* ctl = (unsigned*)(ws + WS_CTL);
    for (int u = threadIdx.x; u < RING_OFF / 4; u += 512) ((LAS unsigned*)lds)[u] = 0u;
    __syncthreads();
    const int lo = args.ph_lo, hi = args.ph_hi;
    XcdBarrier bar; bar.bar = ctl + CW_BAR; bar.x = 0; bar.st = (volatile LAS unsigned*)(lds + 32);
    if (hi - lo > 1) bar = xcd_barrier_post(ctl + CW_BAR, (volatile LAS unsigned*)(lds + 32));
#ifndef PH_EN
#define PH_EN 0xfff
#endif
#define PHEN(k) (((PH_EN) >> (k)) & 1)
#ifndef PROBE_DUP
#define PROBE_DUP 0
#endif
#define NREP(k) ((((PROBE_DUP) >> (k)) & 1) ? 2 : 1)
#define IN(k) (lo <= (k) && (k) < hi)
#define SEAM(k) do { if (IN(k) && IN((k) + 1)) xcd_barrier(bar); } while (0)

#ifndef PROBE_XBAR
#define PROBE_XBAR 0
#endif
    if (PHEN(0) && IN(0)) { for (int rep = 0; rep < NREP(0); ++rep) p0_prologue(args, ws, lds, G, lo == 0 && hi == NPH && G == 256); }
    SEAM(0);

    for (int l = 0; l < 2; ++l) {
        ws = fresh_ws(ws);
        const int pb = 1 + 11 * l;
#define MODall ((const float*)(ws + WS_MOD))
#define Hb ((bf16*)(ws + WS_H))
#define Zb ((bf16*)(ws + WS_Z))
        const float* xin_p = l == 0 ? args.in[0] : (const float*)(ws + WS_X1);
        const float* xin_s = l == 0 ? args.in[1] : (const float*)(ws + WS_X1) + (size_t)NPROMPT * DM;
        const float* modl = MODall + (size_t)l * 3 * 12288;
        for (int xb = 0; xb < PROBE_XBAR; ++xb) xcd_barrier(bar);
        const bool n1fused = lo == 0 && hi == NPH;
        const bool defer = lo == 0 && hi == NPH && G == 256 && (int)blockIdx.x >= 192;
        if (!(l == 1 && n1fused)) {
            if (PHEN(1) && IN(pb + 0)) for (int rep = 0; rep < NREP(1); ++rep) norm_phase(xin_p, xin_s, args.in[11] + (size_t)l * DM, modl, 0, 1, Hb, G);
            SEAM(pb + 0);
        }
        if (PHEN(2) && IN(pb + 1)) for (int rep = 0; rep < NREP(2); ++rep) { ws = fresh_ws(ws);
            pg8::Gemm g{Hb, (const bf16*)(ws + WS_WIN) + (size_t)l * INW * DM, NTOK, INW, DM}; pg8::StaticOrder S; S.init(NTOK, INW, G, (int)blockIdx.x);
            pg8::EpiBf16<0> E{Zb, INW, nullptr, 0, 0, 1.f};
            pg8::gemm_phase<pg8::EpiBf16<0>, pg8::StaticOrder, true, true>(lds + RING_OFF, g, S, E);
        }
        SEAM(pb + 1);
        const bool early = IN(pb + 2) && IN(pb + 3) && G > 64;
        if (early && (int)blockIdx.x < 32) { hgrn_item(args, ws, lds, l, (int)blockIdx.x, &bar, 16); }
        else {
            if (PHEN(3) && IN(pb + 2)) for (int rep = 0; rep < NREP(3); ++rep) prep_phase(args, ws, l, early ? 32 : 0, early ? G - 32 : G);
            SEAM(pb + 2);
            if (PHEN(4) && IN(pb + 3)) for (int rep = 0; rep < NREP(4); ++rep) {
                const int bx = blockIdx.x;
                if (G > 64 && bx < 32) { for (int rp = 0; rp < NREP(12); ++rp) hgrn_item(args, ws, lds, l, bx); }
                else {
                    const int u0 = G > 64 ? bx - 32 : bx, us = G > 64 ? G - 32 : G;
                    if (G <= 64) for (int u = bx; u < 32; u += G) hgrn_item(args, ws, lds, l, u);
                    for (int rp = 0; rp < NREP(12); ++rp)
                    for (int u = u0; u < 832; u += us) if (u >= 192 && u < 448) hgrn_item(args, ws, lds, l, 32 + (u - 192));
                    for (int rp = 0; rp < NREP(13); ++rp)
                    for (int u = u0; u < 832; u += us) if (u < 192 || u >= 448) attn_unit(ws, (char*)lds_raw, u < 192 ? u : 192 + (u - 448));
                }
            }
        }
        SEAM(pb + 3);
        if (PHEN(5) && IN(pb + 4)) for (int rep = 0; rep < NREP(5); ++rep) post_phase(args, ws, l, G);
        SEAM(pb + 4);
        if (PHEN(6) && IN(pb + 5)) for (int rep = 0; rep < NREP(6); ++rep) { ws = fresh_ws(ws);
            pg8::StaticOrder S; S.init(NTOK, DM, G, (int)blockIdx.x);
            for (int c = 0; c < 3; ++c) {
                pg8::Gemm g{(const bf16*)(ws + WS_BR) + (size_t)c * NTOK * 1024, (const bf16*)(ws + WS_WBR) + (size_t)(l * 3 + c) * DM * 1024, NTOK, DM, 1024};
                pg8::EpiGate E{Zb, INW, C_GATE + c * DM, (bf16*)(ws + WS_MGP), (bf16*)(ws + WS_MG), DM, c};
                pg8::gemm_phase<pg8::EpiGate, pg8::StaticOrder, true, true>(lds + RING_OFF, g, S, E);
            }
            if (defer) fp8_rows_deferred(args, ws, 3 * l + 0);
        }
        SEAM(pb + 5);
        if (PHEN(7) && IN(pb + 6)) for (int rep = 0; rep < NREP(7); ++rep) { ws = fresh_ws(ws);
            pg8::Gemm g{(const bf16*)(ws + WS_MG), (const bf16*)(ws + WS_WOUT) + (size_t)l * DM * DM, NTOK, DM, DM}; pg8::StaticOrder S; S.init(NTOK, DM, G, (int)blockIdx.x);
            pg8::EpiResid E{xin_p, xin_s, modl + 2 * DM, (float*)(ws + WS_XM)};
            pg8::gemm_phase<pg8::EpiResid, pg8::StaticOrder, true, true>(lds + RING_OFF, g, S, E);
            if (defer) fp8_rows_deferred(args, ws, 3 * l + 1);
        }
        SEAM(pb + 6);
        if (PHEN(8) && IN(pb + 7)) for (int rep = 0; rep < NREP(8); ++rep) norm_phase((const float*)(ws + WS_XM), (const float*)(ws + WS_XM) + (size_t)NPROMPT * DM, args.in[12] + (size_t)l * DM, modl, 3, 4, Hb, G);
        SEAM(pb + 7);
        if (PHEN(9) && IN(pb + 8)) for (int rep = 0; rep < NREP(9); ++rep) { ws = fresh_ws(ws);
            pg8::Gemm g{Hb, (const bf16*)(ws + WS_WPQ) + (size_t)l * DM * DM, NTOK, DM, DM}; pg8::StaticOrder S; S.init(NTOK, DM, G, (int)blockIdx.x);
            pg8::EpiBf16<0> E{(bf16*)(ws + WS_QP), DM, nullptr, 0, 0, 1.f};
            pg8::gemm_phase<pg8::EpiBf16<0>, pg8::StaticOrder, true, true>(lds + RING_OFF, g, S, E);
            if (defer) fp8_rows_deferred(args, ws, 3 * l + 2);
        }
        SEAM(pb + 8);
#ifdef PROBE_DG
        dummy_gather(ws, PROBE_DG, G);
#endif
        if (PHEN(10) && IN(pb + 9)) for (int rep = 0; rep < NREP(10); ++rep) peer_topk_phase(args, ws, lds, l, G);
        SEAM(pb + 9);
        if (PHEN(11) && IN(pb + 10)) for (int rep = 0; rep < NREP(11); ++rep) peer_gather_phase(args, ws, lds, l, l == 0 ? (float*)(ws + WS_X1) : args.out, G, 0xffffu, 0, l == 0 && n1fused);
#ifdef PROBE_GM
        peer_gather_phase(args, ws, lds, l, (float*)(ws + WS_QA), G, PROBE_GM, 0);
#endif
        if (l == 0) SEAM(pb + 10);
    }
#undef MODall
#undef Hb
#undef Zb
#undef IN
#undef SEAM
}

extern "C" void kernel_launch(void* const* d_in, const int* in_sizes, int n_in, void* d_out, int out_size, void* d_ws, size_t ws_size, hipStream_t stream) {
    static int grid = 0;
    if (grid == 0) {
        if (n_in != 26 || (size_t)out_size != OUT_TOTAL || ws_size < WS_END) { fprintf(stderr, "kernel_launch: shape mismatch: n_in %d out %d ws %zu (need %zu)\n", n_in, out_size, ws_size, (size_t)WS_END); grid = -1; return; }
        int dev = 0, cus = 0, per_cu = 0;
        if (hipGetDevice(&dev) != hipSuccess || hipDeviceGetAttribute(&cus, hipDeviceAttributeMultiprocessorCount, dev) != hipSuccess) { grid = -1; return; }
        if (hipFuncSetAttribute((const void*)mk_fwd, hipFuncAttributeMaxDynamicSharedMemorySize, LDS_BYTES) != hipSuccess) { fprintf(stderr, "kernel_launch: hipFuncSetAttribute failed\n"); grid = -1; return; }
        if (hipOccupancyMaxActiveBlocksPerMultiprocessor(&per_cu, (const void*)mk_fwd, 512, LDS_BYTES) != hipSuccess || per_cu < 1) { fprintf(stderr, "kernel_launch: occupancy query says %d\n", per_cu); per_cu = 1; }
        (void)hipGetLastError();
        grid = cus;
    }
    if (grid < 0) return;
    (void)hipMemsetAsync((char*)d_ws + WS_CTL, 0, CTL_ZERO_BYTES, stream);
    Args a{};
    for (int i = 0; i < 26; ++i) a.in[i] = (const float*)d_in[i];
    a.out = (float*)d_out; a.ws = (unsigned char*)d_ws;
#if N_LAUNCH_MODE == 0
    a.ph_lo = 0; a.ph_hi = NPH;
    hipLaunchKernelGGL(mk_fwd, dim3(grid), dim3(512), LDS_BYTES, stream, a);
#else
    for (int p = 0; p < NPH; ++p) { a.ph_lo = p; a.ph_hi = p + 1; hipLaunchKernelGGL(mk_fwd, dim3(grid), dim3(512), LDS_BYTES, stream, a); }
#endif
    const hipError_t le = hipPeekAtLastError();
    if (le != hipSuccess) fprintf(stderr, "kernel_launch: launch failed: %s\n", hipGetErrorName(le));
}
```

```cpp
#include <hip/hip_runtime.h>
#include <hip/hip_bf16.h>
#include <cstdio>
#include <cstdint>
#include <cmath>
#define PROBE_DUP 0
#define HG_PROBE 0
#define PROBE_XBAR 0
#ifndef N_LAUNCH_MODE
#define N_LAUNCH_MODE 0
#endif
__device__ __forceinline__ int fresh_tid() { int t = (int)threadIdx.x; asm volatile("" : "+v"(t)); return t; }
__device__ __forceinline__ unsigned char* fresh_ws(unsigned char* p) { asm volatile("" : "+s"(p)); return p; }
namespace pg8 {
#define PG8_LAS __attribute__((address_space(3)))
typedef unsigned short bf16_t;
typedef short bf16x8 __attribute__((ext_vector_type(8)));
typedef float f32x4 __attribute__((ext_vector_type(4)));
typedef unsigned u32x4 __attribute__((ext_vector_type(4)));
constexpr int BM = 256, BK = 64, HALF = 128, HTB = HALF * BK * 2  , STAGE_BYTES = 8 * HTB, NXCD = 8, WGM = 8;

__host__ __device__ __forceinline__ int lds_byte(int r, int c) { const int st = (r >> 4) * 2 + (c >> 5), rr = r & 15, cc = c & 31, ob = rr * 64 + cc * 2; return st * 1024 + (ob ^ (((ob >> 9) & 1) << 5)); }
__host__ __device__ __forceinline__ void stage_rc(int b, int& R, int& C) { const int st = b / 1024, sb = b % 1024, swz = sb ^ (((sb >> 9) & 1) << 5); R = (st >> 1) * 16 + swz / 64; C = (st & 1) * 32 + (swz % 64) / 2; }
__host__ __device__ __forceinline__ int perm32(int rho) { const int n = rho >> 4, i = rho & 15; return 8 * (i >> 2) + 4 * n + (i & 3); }

struct Unit { int pm, pn; };
struct Gemm { const bf16_t* A; const bf16_t* Bt; int M, N, K; };

struct StaticOrder {
    int nM, nN, nwg, G, c;
    __host__ __device__ void init(int M, int N, int G_, int c_) { nM = M / BM; nN = N / BM; nwg = nM * nN; G = G_; c = c_; }
    __host__ __device__ bool next(int i, Unit& u) const {
        const long L = (long)i * G + c; if (L >= nwg) return false;
        int wgid = (int)L; { const int q = nwg / NXCD, r = nwg % NXCD, xcd = wgid % NXCD, off = wgid / NXCD; wgid = (xcd < r ? xcd * (q + 1) : r * (q + 1) + (xcd - r) * q) + off; }
        const int nig = WGM * nN, gid = wgid / nig, fm = gid * WGM, gsz = (nM - fm) < WGM ? (nM - fm) : WGM;
        u.pm = fm + ((wgid % nig) % gsz); u.pn = (wgid % nig) / gsz; return true;
    }
    __device__ __forceinline__ void a_ready(const Unit&) const {}
    __device__ __forceinline__ void done(const Unit&) const {}
};

__device__ __forceinline__ unsigned cvt_pk_bf16(float lo, float hi) { unsigned r; asm volatile("v_cvt_pk_bf16_f32 %0, %1, %2" : "=v"(r) : "v"(lo), "v"(hi)); return r; }
typedef float f32x2 __attribute__((ext_vector_type(2)));
__device__ __forceinline__ f32x2 gelu_pk(f32x2 v) {
    const f32x2 av = __builtin_elementwise_abs(v), d = av * 0.2316418882f + 1.0f;
    f32x2 t; t.x = __builtin_amdgcn_rcpf(d.x); t.y = __builtin_amdgcn_rcpf(d.y);
    f32x2 q = t * 0.5307027145f + (-0.7265760135f); q = q * t + 0.7107068705f; q = q * t + (-0.142248368f); q = q * t + 0.127414796f; q = q * t;
    const f32x2 s = (v * v) * (-0.72134752044f);
    f32x2 e; e.x = __builtin_amdgcn_exp2f(s.x); e.y = __builtin_amdgcn_exp2f(s.y);
    const f32x2 m = v * (q * e), r = v - m;
    f32x2 o; o.x = v.x < 0.f ? m.x : r.x; o.y = v.y < 0.f ? m.y : r.y; return o;
}

template <int ACT  > struct EpiBf16 {
    static constexpr bool PERM = true, AFTER_DRAIN = false; static_assert(ACT == 0 || ACT == 1, "EpiBf16: ACT is 0 (none) or 1 (gelu_pk)");
    bf16_t* O; int ldc; const float* bias; int split_cols; size_t split_stride; float scale0;
    __device__ __forceinline__ void operator()(const f32x4 (&acc)[2][2][4][2], const Unit& u, int wr, int wc, int fr, int fq) const {
        const int row0 = u.pm * BM + wr * 64 + fr; int colt = u.pn * BM; bf16_t* base = O;
        float sc = 1.f; if (split_cols) { const int t = colt / split_cols; base += (size_t)t * split_stride; colt -= t * split_cols; if (t == 0) sc = scale0; }
        const int col0 = colt + wc * 32 + 8 * fq, bcol0 = u.pn * BM + wc * 32 + 8 * fq;
        f32x4 bv[2][2];
#pragma unroll
        for (int bj = 0; bj < 2; ++bj)
#pragma unroll
            for (int n = 0; n < 2; ++n) bv[bj][n] = bias ? *(const f32x4*)(bias + bcol0 + bj * HALF + 4 * n) : (f32x4){0.f, 0.f, 0.f, 0.f};
#pragma unroll
        for (int ai = 0; ai < 2; ++ai)
#pragma unroll
            for (int m = 0; m < 4; ++m) { bf16_t* rowp = base + (size_t)(row0 + ai * HALF + m * 16) * ldc + col0;
#pragma unroll
                for (int bj = 0; bj < 2; ++bj) { f32x4 v0 = acc[ai][bj][m][0] + bv[bj][0], v1 = acc[ai][bj][m][1] + bv[bj][1];
                    if (ACT == 1) { f32x2 a = gelu_pk((f32x2){v0[0], v0[1]}), b = gelu_pk((f32x2){v0[2], v0[3]}), c = gelu_pk((f32x2){v1[0], v1[1]}), d = gelu_pk((f32x2){v1[2], v1[3]});
                        v0 = (f32x4){a.x, a.y, b.x, b.y}; v1 = (f32x4){c.x, c.y, d.x, d.y}; }
                    v0 = v0 * sc; v1 = v1 * sc; u32x4 w; w.x = cvt_pk_bf16(v0[0], v0[1]); w.y = cvt_pk_bf16(v0[2], v0[3]); w.z = cvt_pk_bf16(v1[0], v1[1]); w.w = cvt_pk_bf16(v1[2], v1[3]);
                    *(u32x4*)(rowp + bj * HALF) = w; } }
    }
};

struct EpiF32 {
    static constexpr bool PERM = false, AFTER_DRAIN = false;
    float* C; int ldc;
    __device__ __forceinline__ void operator()(const f32x4 (&acc)[2][2][4][2], const Unit& u, int wr, int wc, int fr, int fq) const {
        const int row0 = u.pm * BM + wr * 64 + fr, col0 = u.pn * BM + wc * 32 + 4 * fq;
#pragma unroll
        for (int ai = 0; ai < 2; ++ai)
#pragma unroll
            for (int m = 0; m < 4; ++m) { float* rowp = C + (size_t)(row0 + ai * HALF + m * 16) * ldc + col0;
#pragma unroll
                for (int bj = 0; bj < 2; ++bj)
#pragma unroll
                    for (int n = 0; n < 2; ++n) *(f32x4*)(rowp + bj * HALF + n * 16) = acc[ai][bj][m][n]; }
    }
};
__device__ __forceinline__ float sigmoid_f(float x) { return __builtin_amdgcn_rcpf(1.0f + __builtin_amdgcn_exp2f(-1.4426950408889634f * x)); }
struct EpiGate {
    static constexpr bool PERM = true, AFTER_DRAIN = false;
    const bf16_t* Z; int ldz; int gcol0; bf16_t* P; bf16_t* O; int ldc; int MODE;
    __device__ __forceinline__ void operator()(const f32x4 (&acc)[2][2][4][2], const Unit& u, int wr, int wc, int fr, int fq) const {
        const int row0 = u.pm * BM + wr * 64 + fr, col0 = u.pn * BM + wc * 32 + 8 * fq;
#pragma unroll
        for (int ai = 0; ai < 2; ++ai)
#pragma unroll
            for (int m = 0; m < 4; ++m) { const int row = row0 + ai * HALF + m * 16;
#pragma unroll
                for (int bj = 0; bj < 2; ++bj) { const int col = col0 + bj * HALF;
                    const u32x4 gz = *(const u32x4*)(Z + (size_t)row * ldz + gcol0 + col);
                    f32x4 s0, s1;
                    s0[0] = sigmoid_f(__uint_as_float(gz[0] << 16)); s0[1] = sigmoid_f(__uint_as_float(gz[0] & 0xffff0000u));
                    s0[2] = sigmoid_f(__uint_as_float(gz[1] << 16)); s0[3] = sigmoid_f(__uint_as_float(gz[1] & 0xffff0000u));
                    s1[0] = sigmoid_f(__uint_as_float(gz[2] << 16)); s1[1] = sigmoid_f(__uint_as_float(gz[2] & 0xffff0000u));
                    s1[2] = sigmoid_f(__uint_as_float(gz[3] << 16)); s1[3] = sigmoid_f(__uint_as_float(gz[3] & 0xffff0000u));
                    f32x4 v0 = acc[ai][bj][m][0] * s0, v1 = acc[ai][bj][m][1] * s1;
                    bf16_t* pp = P + (size_t)row * ldc + col;
                    if (MODE >= 1) { const u32x4 pw = *(const u32x4*)pp;
                        v0[0] += __uint_as_float(pw[0] << 16); v0[1] += __uint_as_float(pw[0] & 0xffff0000u); v0[2] += __uint_as_float(pw[1] << 16); v0[3] += __uint_as_float(pw[1] & 0xffff0000u);
                        v1[0] += __uint_as_float(pw[2] << 16); v1[1] += __uint_as_float(pw[2] & 0xffff0000u); v1[2] += __uint_as_float(pw[3] << 16); v1[3] += __uint_as_float(pw[3] & 0xffff0000u); }
                    u32x4 w; w.x = cvt_pk_bf16(v0[0], v0[1]); w.y = cvt_pk_bf16(v0[2], v0[3]); w.z = cvt_pk_bf16(v1[0], v1[1]); w.w = cvt_pk_bf16(v1[2], v1[3]);
                    *(u32x4*)((MODE <= 1 ? pp : O + (size_t)row * ldc + col)) = w; } }
    }
};
struct EpiResid {
    static constexpr bool PERM = false, AFTER_DRAIN = false;
    const float* xp; const float* xs; const float* gate; float* out;
    __device__ __forceinline__ void operator()(const f32x4 (&acc)[2][2][4][2], const Unit& u, int wr, int wc, int fr, int fq) const {
        const int row0 = u.pm * BM + wr * 64 + fr, col0 = u.pn * BM + wc * 32 + 4 * fq;
        const bool samp = u.pm >= 16; const int r = samp ? 1 + ((u.pm - 16) >> 2) : 0;
        const float* xb = samp ? xs - (size_t)4096 * 2048 : xp;
        f32x4 gv[2][2];
#pragma unroll
        for (int bj = 0; bj < 2; ++bj)
#pragma unroll
            for (int n = 0; n < 2; ++n) gv[bj][n] = *(const f32x4*)(gate + (size_t)r * 12288 + col0 + bj * HALF + n * 16);
#pragma unroll
        for (int ai = 0; ai < 2; ++ai)
#pragma unroll
            for (int m = 0; m < 4; ++m) { const size_t off = (size_t)(row0 + ai * HALF + m * 16) * 2048 + col0;
#pragma unroll
                for (int bj = 0; bj < 2; ++bj)
#pragma unroll
                    for (int n = 0; n < 2; ++n) { const f32x4 x = *(const f32x4*)(xb + off + bj * HALF + n * 16);
                        *(f32x4*)(out + off + bj * HALF + n * 16) = x + gv[bj][n] * acc[ai][bj][m][n]; } }
    }
};

template <class Epi, class Sched, bool ALIGN_EPI = false, bool SP2 = false>
__device__ __forceinline__ void gemm_phase(PG8_LAS unsigned char* lds, const Gemm g, const Sched& S, const Epi& E) {
    const int tid = fresh_tid(), wid = __builtin_amdgcn_readfirstlane(tid >> 6), lane = tid & 63, wr = wid >> 2, wc = wid & 3, fr = lane & 15, fq = lane >> 4;
    const int K = g.K, nt = K / BK;
    unsigned voffA[2], voffB[2];
#pragma unroll
    for (int i = 0; i < 2; ++i) { int R, C; stage_rc(tid * 16 + i * 8192, R, C); const int Rb = Epi::PERM ? ((R & ~31) + perm32(R & 31)) : R;
        voffA[i] = (unsigned)(R * K + C) * 2u; voffB[i] = (unsigned)(Rb * K + C) * 2u; }
    const size_t kstep = (size_t)(BK * 2);
    const size_t hstep = (size_t)HALF * K * 2;
    const size_t tstep = 2 * hstep;
    const unsigned ldsw = (unsigned)wid * 1024u;
    const int aoff = lds_byte(wr * 64 + fr, fq * 8), boff = lds_byte(wc * 32 + fr, fq * 8);
#define PG8_SA(b, h) (((b) * 2 + (h)) * HTB)
#define PG8_SB(b, h) ((4 + (b) * 2 + (h)) * HTB)
#define PG8_STAGE(bufoff, gbase, voff) do { _Pragma("unroll") for (int _i = 0; _i < 2; ++_i) \
        __builtin_amdgcn_global_load_lds((const unsigned*)((const char*)(gbase) + (voff)[_i]), (PG8_LAS unsigned*)(lds + (bufoff) + ldsw + _i * 8192), 16, 0, 0); } while (0)
#define PG8_LDA(dst, b, h) do { _Pragma("unroll") for (int m = 0; m < 4; ++m) _Pragma("unroll") for (int k = 0; k < 2; ++k) dst[m][k] = *(const PG8_LAS bf16x8*)(lds + PG8_SA(b, h) + aoff + m * 2048 + k * 1024); } while (0)
#define PG8_LDB(dst, b, h) do { _Pragma("unroll") for (int n = 0; n < 2; ++n) _Pragma("unroll") for (int k = 0; k < 2; ++k) dst[n][k] = *(const PG8_LAS bf16x8*)(lds + PG8_SB(b, h) + boff + n * 2048 + k * 1024); } while (0)
#define PG8_MMA(ai, bj, At, Bt) do { __builtin_amdgcn_s_setprio(1); _Pragma("unroll") for (int m = 0; m < 4; ++m) _Pragma("unroll") for (int n = 0; n < 2; ++n) _Pragma("unroll") for (int k = 0; k < 2; ++k) \
        acc[ai][bj][m][n] = __builtin_amdgcn_mfma_f32_16x16x32_bf16(Bt[n][k], At[m][k], acc[ai][bj][m][n], 0, 0, 0); __builtin_amdgcn_s_setprio(0); } while (0)
#define PG8_WAIT_V(n) asm volatile("s_waitcnt vmcnt(" #n ")" ::: "memory")
#define PG8_WAIT_L(n) asm volatile("s_waitcnt lgkmcnt(" #n ")" ::: "memory")
#define PG8_BAR __builtin_amdgcn_s_barrier()
#define PG8_SCHED __builtin_amdgcn_sched_barrier(0)
    Unit cur, nxt; int ui = 0;
    if (!S.next(0, cur)) return;
    f32x4 acc[2][2][4][2];
#pragma unroll
    for (int a = 0; a < 2; ++a)
#pragma unroll
        for (int b = 0; b < 2; ++b)
#pragma unroll
            for (int m = 0; m < 4; ++m)
#pragma unroll
                for (int n = 0; n < 2; ++n) acc[a][b][m][n] = (f32x4){0.f, 0.f, 0.f, 0.f};
    bf16x8 At[4][2], B0[2][2], B1[2][2];
    const char* cA = (const char*)g.A + (size_t)cur.pm * tstep; const char* cB = (const char*)g.Bt + (size_t)cur.pn * tstep;
    S.a_ready(cur);
    if constexpr (SP2) {
        PG8_STAGE(PG8_SB(0, 0), cB, voffB); PG8_STAGE(PG8_SB(0, 1), cB + hstep, voffB); PG8_STAGE(PG8_SA(0, 0), cA, voffA); PG8_STAGE(PG8_SA(0, 1), cA + hstep, voffA);
        if (wr == 1) PG8_BAR;
        PG8_WAIT_V(2); PG8_BAR;
        PG8_STAGE(PG8_SB(1, 0), cB + kstep, voffB); PG8_STAGE(PG8_SA(1, 0), cA + kstep, voffA); PG8_STAGE(PG8_SB(1, 1), cB + hstep + kstep, voffB);
        PG8_WAIT_V(6); PG8_BAR;
    } else {
        PG8_STAGE(PG8_SB(0, 0), cB, voffB); PG8_STAGE(PG8_SA(0, 0), cA, voffA); PG8_STAGE(PG8_SB(0, 1), cB + hstep, voffB); PG8_STAGE(PG8_SA(0, 1), cA + hstep, voffA);
        if (wr == 1) PG8_BAR;
        PG8_WAIT_V(4); PG8_BAR;
        PG8_STAGE(PG8_SB(1, 0), cB + kstep, voffB); PG8_STAGE(PG8_SA(1, 0), cA + kstep, voffA); PG8_STAGE(PG8_SB(1, 1), cB + hstep + kstep, voffB);
        PG8_WAIT_V(6); PG8_BAR;
    }
    for (;;) {
        const bool has_next = S.next(ui + 1, nxt);
        const char* nA = has_next ? (const char*)g.A + (size_t)nxt.pm * tstep : cA; const char* nB = has_next ? (const char*)g.Bt + (size_t)nxt.pn * tstep : cB;
        for (int t = 0; t < nt; t += 2) {
            const bool last = (t == nt - 2);
            const char* a1 = cA + (size_t)(t + 1) * kstep;
            const char* a2 = last ? nA : cA + (size_t)(t + 2) * kstep; const char* b2 = last ? nB : cB + (size_t)(t + 2) * kstep;
            const char* a3 = a2 + kstep; const char* b3 = b2 + kstep;
            if (last && has_next) S.a_ready(nxt);
            if constexpr (SP2) {
            PG8_LDB(B0, 0, 0); PG8_LDB(B1, 0, 1); PG8_SCHED; PG8_LDA(At, 0, 0); PG8_STAGE(PG8_SA(1, 1), a1 + hstep, voffA);
            PG8_WAIT_V(8); PG8_WAIT_L(0); PG8_BAR; PG8_MMA(0, 0, At, B0); PG8_MMA(0, 1, At, B1); PG8_BAR; PG8_SCHED;
            PG8_LDA(At, 0, 1); PG8_STAGE(PG8_SB(0, 0), b2, voffB); PG8_STAGE(PG8_SB(0, 1), b2 + hstep, voffB); PG8_STAGE(PG8_SA(0, 0), a2, voffA);
            PG8_WAIT_V(8); PG8_WAIT_L(0); PG8_BAR; PG8_MMA(1, 0, At, B0); PG8_MMA(1, 1, At, B1); PG8_BAR; PG8_SCHED;
            PG8_LDB(B0, 1, 0); PG8_LDB(B1, 1, 1); PG8_SCHED; PG8_LDA(At, 1, 0); PG8_STAGE(PG8_SA(0, 1), a2 + hstep, voffA);
            PG8_WAIT_V(8); PG8_WAIT_L(0); PG8_BAR; PG8_MMA(0, 0, At, B0); PG8_MMA(0, 1, At, B1); PG8_BAR; PG8_SCHED;
            PG8_LDA(At, 1, 1); PG8_STAGE(PG8_SB(1, 0), b3, voffB); PG8_STAGE(PG8_SB(1, 1), b3 + hstep, voffB); PG8_STAGE(PG8_SA(1, 0), a3, voffA);
            PG8_WAIT_V(8); PG8_WAIT_L(0); PG8_BAR; PG8_MMA(1, 0, At, B0); PG8_MMA(1, 1, At, B1); PG8_BAR; PG8_SCHED;
            } else {
            PG8_LDB(B0, 0, 0); PG8_SCHED; PG8_LDA(At, 0, 0); PG8_STAGE(PG8_SA(1, 1), a1 + hstep, voffA);
            PG8_WAIT_L(8); PG8_BAR; PG8_WAIT_L(0); PG8_MMA(0, 0, At, B0); PG8_BAR; PG8_SCHED;
            PG8_LDB(B1, 0, 1); PG8_STAGE(PG8_SB(0, 0), b2, voffB);
            PG8_BAR; PG8_WAIT_L(0); PG8_MMA(0, 1, At, B1); PG8_BAR;
            PG8_LDA(At, 0, 1); PG8_STAGE(PG8_SA(0, 0), a2, voffA);
            PG8_BAR; PG8_WAIT_L(0); PG8_MMA(1, 0, At, B0); PG8_BAR; PG8_SCHED;
            PG8_STAGE(PG8_SB(0, 1), b2 + hstep, voffB);
            PG8_WAIT_V(6); PG8_BAR; PG8_MMA(1, 1, At, B1); PG8_BAR;
            PG8_LDB(B0, 1, 0); PG8_SCHED; PG8_LDA(At, 1, 0); PG8_STAGE(PG8_SA(0, 1), a2 + hstep, voffA);
            PG8_WAIT_L(8); PG8_BAR; PG8_WAIT_L(0); PG8_MMA(0, 0, At, B0); PG8_BAR; PG8_SCHED;
            PG8_LDB(B1, 1, 1); PG8_STAGE(PG8_SB(1, 0), b3, voffB);
            PG8_BAR; PG8_WAIT_L(0); PG8_MMA(0, 1, At, B1); PG8_BAR;
            PG8_LDA(At, 1, 1); PG8_STAGE(PG8_SA(1, 0), a3, voffA);
            PG8_BAR; PG8_WAIT_L(0); PG8_MMA(1, 0, At, B0); PG8_BAR; PG8_SCHED;
            PG8_STAGE(PG8_SB(1, 1), b3 + hstep, voffB);
            PG8_WAIT_V(6); PG8_BAR; PG8_MMA(1, 1, At, B1); PG8_BAR;
            }
        }
        if constexpr (ALIGN_EPI) { if (wr == 0) PG8_BAR; }
        if constexpr (!Epi::AFTER_DRAIN) { E(acc, cur, wr, wc, fr, fq); S.done(cur); }
        if (!has_next) break;
#pragma unroll
        for (int a = 0; a < 2; ++a)
#pragma unroll
            for (int b = 0; b < 2; ++b)
#pragma unroll
                for (int m = 0; m < 4; ++m)
#pragma unroll
                    for (int n = 0; n < 2; ++n) acc[a][b][m][n] = (f32x4){0.f, 0.f, 0.f, 0.f};
        cur = nxt; cA = nA; cB = nB; ++ui;
        if constexpr (ALIGN_EPI) { if (wr == 1) PG8_BAR; }
    }
    PG8_WAIT_V(0);
    if constexpr (!ALIGN_EPI) { if (wr == 0) PG8_BAR; }
    PG8_BAR;
    if constexpr (Epi::AFTER_DRAIN) { E.fused(acc, cur, wr, wc, fr, fq, lds, wid, lane); S.done(cur); }
#undef PG8_SA
#undef PG8_SB
#undef PG8_STAGE
#undef PG8_LDA
#undef PG8_LDB
#undef PG8_MMA
#undef PG8_WAIT_V
#undef PG8_WAIT_L
#undef PG8_BAR
#undef PG8_SCHED
}
}

namespace att {
using bf16 = __hip_bfloat16;
constexpr int D = 128, NW = 8, QBLK = 32, KVBLK = 64;
constexpr float SCALE = 1.0f;
constexpr float THR = 8.f;
constexpr int SDEPTH = 2;
constexpr int LDQ = 3072, LDK = 1280, LDO = 3072;
constexpr size_t SHM_V = KVBLK * D * 2, SHM_K = KVBLK * D * 2, SHM_ATTN = 2 * SHM_V + 2 * SHM_K + NW * 64 * 4;
typedef __bf16 abf16x2_t __attribute__((ext_vector_type(2))); typedef float af32x2_t __attribute__((ext_vector_type(2)));
__device__ __forceinline__ unsigned short bf1(float x) { const af32x2_t v = {x, x}; const abf16x2_t b = __builtin_convertvector(v, abf16x2_t); return (unsigned short)(__builtin_bit_cast(unsigned, b) & 0xffffu); }
using bf16x8 = __attribute__((ext_vector_type(8))) short;
using s16x4  = __attribute__((ext_vector_type(4))) short;
using f32x16 = __attribute__((ext_vector_type(16))) float;
using f32x8  = __attribute__((ext_vector_type(8))) float;
using u32x4  = __attribute__((ext_vector_type(4))) unsigned;
#define KSWZ(row, colB) ((row) * 256 + ((colB) ^ (((row) & 7) << 4)))
#define SBAR() __builtin_amdgcn_sched_barrier(0)
__device__ __forceinline__ int crow(int r, int hi) { return (r & 3) + 8 * (r >> 2) + 4 * hi; }
__device__ __forceinline__ unsigned cvtpk(float lo, float hi) {
  unsigned r; asm volatile("v_cvt_pk_bf16_f32 %0, %1, %2" : "=v"(r) : "v"(lo), "v"(hi)); return r;
}
template <typename TIn> struct Stage;
template <> struct Stage<bf16>  { using T = bf16x8;
  __device__ static __forceinline__ T ld8(const bf16* p) { return *reinterpret_cast<const bf16x8*>(p); }
  __device__ static __forceinline__ bf16x8 tobf(T x) { return x; } };
template <> struct Stage<float> { using T = f32x8;
  __device__ static __forceinline__ T ld8(const float* p) { return *reinterpret_cast<const f32x8*>(p); }
  __device__ static __forceinline__ bf16x8 tobf(T x) {
    u32x4 w = {cvtpk(x[0], x[1]), cvtpk(x[2], x[3]), cvtpk(x[4], x[5]), cvtpk(x[6], x[7])}; return *reinterpret_cast<bf16x8*>(&w); } };

__device__ __forceinline__ void partialSM(f32x16& p0, f32x16& p1, float& m_reg, float& mn, float& alpha) {
  constexpr float C = SCALE * 1.4426950408889634f;
  float pmax = p0[0]; for (int r = 1; r < 16; ++r) pmax = fmaxf(pmax, p0[r]); for (int r = 0; r < 16; ++r) pmax = fmaxf(pmax, p1[r]);
  { auto rr = __builtin_amdgcn_permlane32_swap(__float_as_uint(pmax), __float_as_uint(pmax), false, false);
    pmax = fmaxf(__uint_as_float(rr[0]), __uint_as_float(rr[1])); }
  if (__builtin_expect(__all(pmax - m_reg <= THR / SCALE), 1)) { mn = m_reg; alpha = 1.f; }
  else { mn = fmaxf(m_reg, pmax); alpha = __builtin_amdgcn_exp2f((m_reg - mn) * C); m_reg = mn; }
  float mnC = -mn * C;
  for (int r = 0; r < 16; ++r) p0[r] = fmaf(p0[r], C, mnC); for (int r = 0; r < 16; ++r) p1[r] = fmaf(p1[r], C, mnC);
  for (int r = 0; r < 16; ++r) p0[r] = __builtin_amdgcn_exp2f(p0[r]);
}
__device__ __forceinline__ void finishSM(f32x16& p0, f32x16& p1, float alpha, float& l_reg, bf16x8& pa0, bf16x8& pa1, bf16x8& pa2, bf16x8& pa3) {
  for (int r = 0; r < 16; ++r) p1[r] = __builtin_amdgcn_exp2f(p1[r]);
  float ps = 0; for (int r = 0; r < 16; ++r) ps += p0[r]; for (int r = 0; r < 16; ++r) ps += p1[r];
  { auto rr = __builtin_amdgcn_permlane32_swap(__float_as_uint(ps), __float_as_uint(ps), false, false);
    ps = __uint_as_float(rr[0]) + __uint_as_float(rr[1]); }
  l_reg = l_reg * alpha + ps;
#define PK4(P, BASE, OUT) do { unsigned a0 = cvtpk(P[BASE + 0], P[BASE + 1]), a1 = cvtpk(P[BASE + 2], P[BASE + 3]);   \
    unsigned b0 = cvtpk(P[BASE + 4], P[BASE + 5]), b1 = cvtpk(P[BASE + 6], P[BASE + 7]);                              \
    auto r0 = __builtin_amdgcn_permlane32_swap(a0, b0, false, false); auto r1 = __builtin_amdgcn_permlane32_swap(a1, b1, false, false); \
    u32x4 w = {r0[0], r1[0], r0[1], r1[1]}; OUT = *reinterpret_cast<bf16x8*>(&w); } while (0)
  PK4(p0, 0, pa0); PK4(p0, 8, pa1); PK4(p1, 0, pa2); PK4(p1, 8, pa3);
#undef PK4
}
__device__ __forceinline__ void qkt(f32x16& p0, f32x16& p1, const bf16* Ks, const bf16x8* qr, int r32, int hi) {
  p0 = f32x16{}; p1 = f32x16{};
  for (int d0 = 0; d0 < 8; ++d0) { int cb = (d0 * 16 + hi * 8) * 2;
    bf16x8 b0 = *reinterpret_cast<const bf16x8*>((const char*)Ks + KSWZ(r32, cb));
    bf16x8 b1 = *reinterpret_cast<const bf16x8*>((const char*)Ks + KSWZ(32 + r32, cb));
    p0 = __builtin_amdgcn_mfma_f32_32x32x16_bf16(b0, qr[d0], p0, 0, 0, 0);
    p1 = __builtin_amdgcn_mfma_f32_32x32x16_bf16(b1, qr[d0], p1, 0, 0, 0); }
}
__device__ __forceinline__ int v_st(int k, int c) { const int kk = (k & ~0xC) | ((k & 4) << 1) | ((k & 8) >> 1); return ((kk >> 3) * 4 + (c >> 5)) * 512 + ((kk & 7) * 32 + (c & 31)) * 2; }
__device__ __forceinline__ int v_rd_base(int lane) { return ((lane & 3) << 3) | (((lane >> 2) & 3) << 6) | (((lane >> 4) & 1) << 5) | (((lane >> 5) & 1) << 8); }
constexpr int v_rd_off(int d0, int ks, int half) { return d0 * 512 + ks * 4096 + half * 2048; }
template <int OFF> __device__ __forceinline__ s16x4 tr_read(int vb) {
  s16x4 r; asm volatile("ds_read_b64_tr_b16 %0, %1 offset:%2" : "=&v"(r) : "v"(vb), "i"(OFF) : "memory"); return r;
}
template <int D0> __device__ __forceinline__ void pv_one(f32x16& od, int vb, bf16x8 pa0, bf16x8 pa1, bf16x8 pa2, bf16x8 pa3) {
  const s16x4 l0 = tr_read<v_rd_off(D0, 0, 0)>(vb), h0 = tr_read<v_rd_off(D0, 0, 1)>(vb), l1 = tr_read<v_rd_off(D0, 1, 0)>(vb), h1 = tr_read<v_rd_off(D0, 1, 1)>(vb);
  const s16x4 l2 = tr_read<v_rd_off(D0, 2, 0)>(vb), h2 = tr_read<v_rd_off(D0, 2, 1)>(vb), l3 = tr_read<v_rd_off(D0, 3, 0)>(vb), h3 = tr_read<v_rd_off(D0, 3, 1)>(vb);
  asm volatile("s_waitcnt lgkmcnt(0)" ::: "memory"); SBAR();
#define PK(L, H) (bf16x8){L[0], L[1], L[2], L[3], H[0], H[1], H[2], H[3]}
  od = __builtin_amdgcn_mfma_f32_32x32x16_bf16(pa0, PK(l0, h0), od, 0, 0, 0);
  od = __builtin_amdgcn_mfma_f32_32x32x16_bf16(pa1, PK(l1, h1), od, 0, 0, 0);
  od = __builtin_amdgcn_mfma_f32_32x32x16_bf16(pa2, PK(l2, h2), od, 0, 0, 0);
  od = __builtin_amdgcn_mfma_f32_32x32x16_bf16(pa3, PK(l3, h3), od, 0, 0, 0);
#undef PK
}
__device__ __forceinline__ void pv_d0(f32x16* o, int vb, bf16x8 pa0, bf16x8 pa1, bf16x8 pa2, bf16x8 pa3) {
  pv_one<0>(o[0], vb, pa0, pa1, pa2, pa3); pv_one<1>(o[1], vb, pa0, pa1, pa2, pa3); pv_one<2>(o[2], vb, pa0, pa1, pa2, pa3); pv_one<3>(o[3], vb, pa0, pa1, pa2, pa3);
}

template <typename TQ>
__device__ __forceinline__ void attn_dense_body(const TQ* __restrict__ Qb, const bf16* __restrict__ Kh, const bf16* __restrict__ Vh,
                                                unsigned short* __restrict__ Ob, int seq, char* lds) {
  using St = Stage<bf16>; using SQ = Stage<TQ>;
  const int tid = fresh_tid(), wid = tid >> 6, lane = tid & 63, r32 = lane & 31, hi = lane >> 5;
  bf16* V_lds = (bf16*)lds; bf16* K_lds = (bf16*)(lds + 2 * SHM_V);
  float* ws = (float*)(lds + 2 * SHM_V + 2 * SHM_K) + wid * 64; float* li_l = ws; float* al_l = ws + 32;
  float m_reg = -1e30f, l_reg = 0; f32x16 o[4] = {}; bf16x8 qr[8];
  const TQ* Qw = Qb + (long)(wid * QBLK + r32) * LDQ + hi * 8;
#pragma unroll
  for (int d0 = 0; d0 < 8; ++d0) qr[d0] = SQ::tobf(SQ::ld8(Qw + d0 * 16));
  const int sr = tid >> 4, sc = (tid & 15) * 8, vst0 = v_st(sr, sc), vst1 = v_st(32 + sr, sc);
  const int vb0 = (int)(uintptr_t)V_lds + v_rd_base(lane);
  struct { typename St::T vs0, vs1, ks0, ks1; } sr_[SDEPTH];
#define SLOAD(i, k0) do { sr_[i].vs0 = St::ld8(&Vh[(long)((k0) + sr) * LDK + sc]); sr_[i].vs1 = St::ld8(&Vh[(long)((k0) + 32 + sr) * LDK + sc]); \
    sr_[i].ks0 = St::ld8(&Kh[(long)((k0) + sr) * LDK + sc]); sr_[i].ks1 = St::ld8(&Kh[(long)((k0) + 32 + sr) * LDK + sc]); } while (0)
#define SWRITE(b, i) do { *(bf16x8*)((char*)V_lds + (b) * SHM_V + vst0) = St::tobf(sr_[i].vs0);          \
    *(bf16x8*)((char*)V_lds + (b) * SHM_V + vst1) = St::tobf(sr_[i].vs1); int kc = sc * 2;               \
    *(bf16x8*)((char*)K_lds + (b) * SHM_K + KSWZ(sr, kc)) = St::tobf(sr_[i].ks0);                       \
    *(bf16x8*)((char*)K_lds + (b) * SHM_K + KSWZ(32 + sr, kc)) = St::tobf(sr_[i].ks1); } while (0)
#define SWAIT() do { if constexpr (SDEPTH == 2) asm volatile("s_waitcnt vmcnt(4)" ::: "memory"); else asm volatile("s_waitcnt vmcnt(0)" ::: "memory"); } while (0)
#define RESC(a) do { if (__any((a) < 1.f)) { if (hi == 0) al_l[r32] = (a); asm volatile("s_waitcnt lgkmcnt(0)" ::: "memory"); \
    for (int d = 0; d < 4; ++d) for (int r = 0; r < 16; ++r) o[d][r] *= al_l[crow(r, hi)]; } } while (0)
  f32x16 pA0, pA1, pB0, pB1; float mnA, mnB, alA, alB; bf16x8 pa0, pa1, pa2, pa3; const int NT = seq / KVBLK;
  constexpr int SE = 0, SO = SDEPTH - 1;
  SLOAD(SE, 0); asm volatile("s_waitcnt vmcnt(0)" ::: "memory"); SWRITE(0, SE); __syncthreads();
  qkt(pA0, pA1, K_lds, qr, r32, hi); partialSM(pA0, pA1, m_reg, mnA, alA);
  SLOAD(SO, KVBLK); if constexpr (SDEPTH == 2) { if (2 < NT) SLOAD(SE, 2 * KVBLK); }
  SWAIT(); SWRITE(1, SO); __syncthreads();
  for (int j = 1; j + 1 < NT; j += 2) {
    SBAR(); qkt(pB0, pB1, (bf16*)((char*)K_lds + SHM_K), qr, r32, hi);
    finishSM(pA0, pA1, alA, l_reg, pa0, pa1, pa2, pa3); SBAR();
    SLOAD(SO, (j + SDEPTH) * KVBLK); SBAR();
    pv_d0(o, vb0, pa0, pa1, pa2, pa3); partialSM(pB0, pB1, m_reg, mnB, alB);
    __syncthreads(); SWAIT(); SWRITE(0, SE);
    RESC(alB); __syncthreads();
    SBAR(); qkt(pA0, pA1, K_lds, qr, r32, hi);
    finishSM(pB0, pB1, alB, l_reg, pa0, pa1, pa2, pa3); SBAR();
    if (SDEPTH == 1 || j + 3 < NT) SLOAD(SE, (j + 1 + SDEPTH) * KVBLK); SBAR();
    pv_d0(o, vb0 + (int)SHM_V, pa0, pa1, pa2, pa3); partialSM(pA0, pA1, m_reg, mnA, alA);
    __syncthreads(); SWAIT(); SWRITE(1, SO);
    RESC(alA); __syncthreads();
  }
  SBAR(); qkt(pB0, pB1, (bf16*)((char*)K_lds + SHM_K), qr, r32, hi);
  finishSM(pA0, pA1, alA, l_reg, pa0, pa1, pa2, pa3); SBAR();
  pv_d0(o, vb0, pa0, pa1, pa2, pa3); partialSM(pB0, pB1, m_reg, mnB, alB);
  __syncthreads(); RESC(alB);
  finishSM(pB0, pB1, alB, l_reg, pa0, pa1, pa2, pa3); SBAR();
  pv_d0(o, vb0 + (int)SHM_V, pa0, pa1, pa2, pa3);
  if (hi == 0) li_l[r32] = l_reg; asm volatile("s_waitcnt lgkmcnt(0)" ::: "memory");
  float rli[16];
#pragma unroll
  for (int r = 0; r < 16; ++r) rli[r] = __builtin_amdgcn_rcpf(li_l[crow(r, hi)]);
  unsigned short* Ow = Ob + (long)(wid * QBLK) * LDO;
#pragma unroll
  for (int r = 0; r < 16; ++r) { int orow = crow(r, hi);
    for (int d0 = 0; d0 < 4; ++d0) Ow[(long)orow * LDO + d0 * 32 + r32] = bf1(o[d0][r] * rli[r]); }
#undef SLOAD
#undef SWRITE
#undef SWAIT
#undef RESC
}
}

constexpr int DM = 2048, NTOK = 6144, NPROMPT = 4096, INW = 15872;
constexpr int C_HQ = 0, C_HF = 1024, C_HI = 3072, C_HG = 4096, C_DQ = 5120, C_DK = 6144, C_DV = 7168, C_GQ = 8192, C_GK = 9216, C_GV = 9472, C_GATE = 9728;
constexpr int KROWS = 4096 + 2 * 1280;
constexpr int KVW = 1280;
constexpr float EPS = 1e-6f;
constexpr int NPH = 23;

constexpr size_t MiB = 1u << 20;
constexpr size_t WS_CTL = 0, CTL_ZERO_BYTES = 1 * MiB;
constexpr size_t WS_MOD = 1 * MiB, WS_ROPE = 2 * MiB, WS_WIN = 3 * MiB, WS_WBR = 127 * MiB, WS_WOUT = 151 * MiB, WS_WPQ = 167 * MiB, WS_PU = 183 * MiB, WS_PV = 311 * MiB;
constexpr size_t WS_H = 439 * MiB, WS_Z = 463 * MiB, WS_QA = 649 * MiB, WS_KA = 685 * MiB, WS_VA = 702 * MiB, WS_OA = 719 * MiB, WS_OH = 791 * MiB, WS_BR = 839 * MiB, WS_MG = 875 * MiB;
constexpr size_t WS_XM = 899 * MiB, WS_X1 = 947 * MiB, WS_PE = 995 * MiB, WS_PG = 998 * MiB, WS_END = 1001 * MiB;
constexpr size_t WS_UV8 = WS_PU, WS_SC = WS_PV;
constexpr size_t WS_QP = WS_OA;
constexpr size_t WS_MGP = WS_OH;
static_assert(WS_WIN + (size_t)2 * INW * DM * 2 <= WS_WBR && WS_Z + (size_t)NTOK * INW * 2 <= WS_QA && WS_KA + (size_t)KROWS * KVW * 2 <= WS_VA && WS_VA + (size_t)KROWS * KVW * 2 <= WS_OA, "d_ws map");
static_assert(WS_OA + (size_t)NTOK * 3072 * 4 <= WS_OH && WS_OH + (size_t)2 * NTOK * 1024 * 4 <= WS_BR && WS_BR + (size_t)3 * NTOK * 1024 * 2 <= WS_MG, "d_ws map 2");
constexpr int CW_BAR = 4096;

constexpr int LDS_BYTES = 163840, RING_OFF = 1024;

#define GAS __attribute__((address_space(1)))
#define LAS __attribute__((address_space(3)))
typedef unsigned short bf16;
typedef unsigned v4u __attribute__((ext_vector_type(4)));
typedef unsigned v2u __attribute__((ext_vector_type(2)));
typedef float f32x4 __attribute__((ext_vector_type(4)));
typedef float f32x2 __attribute__((ext_vector_type(2)));
typedef __bf16 bf16x2_t __attribute__((ext_vector_type(2)));
__device__ __forceinline__ unsigned pk2(float lo, float hi) { const f32x2 v = {lo, hi}; const bf16x2_t b = __builtin_convertvector(v, bf16x2_t); return __builtin_bit_cast(unsigned, b); }
__device__ __forceinline__ unsigned f2bf(float f) { return pk2(f, f) & 0xffffu; }
__device__ __forceinline__ float bflo(unsigned w) { return __uint_as_float(w << 16); }
__device__ __forceinline__ float bfhi(unsigned w) { return __uint_as_float(w & 0xffff0000u); }
__device__ __forceinline__ float wave_sum(float v) {
#pragma unroll
    for (int o = 1; o < 64; o <<= 1) v += __shfl_xor(v, o);
    return v;
}
__device__ __forceinline__ void ld16bf(const bf16* p, float (&v)[16]) {
    const v4u a = *(const v4u*)p, b = *(const v4u*)(p + 8);
    v[0] = bflo(a.x); v[1] = bfhi(a.x); v[2] = bflo(a.y); v[3] = bfhi(a.y); v[4] = bflo(a.z); v[5] = bfhi(a.z); v[6] = bflo(a.w); v[7] = bfhi(a.w);
    v[8] = bflo(b.x); v[9] = bfhi(b.x); v[10] = bflo(b.y); v[11] = bfhi(b.y); v[12] = bflo(b.z); v[13] = bfhi(b.z); v[14] = bflo(b.w); v[15] = bfhi(b.w);
}
__device__ __forceinline__ void ld16f(const float* p, float (&v)[16]) {
#pragma unroll
    for (int i = 0; i < 4; ++i) { const f32x4 x = *(const f32x4*)(p + 4 * i); v[4 * i] = x[0]; v[4 * i + 1] = x[1]; v[4 * i + 2] = x[2]; v[4 * i + 3] = x[3]; }
}
__device__ __forceinline__ void st16bf(bf16* p, const float (&v)[16]) {
    v4u a, b; a.x = pk2(v[0], v[1]); a.y = pk2(v[2], v[3]); a.z = pk2(v[4], v[5]); a.w = pk2(v[6], v[7]); b.x = pk2(v[8], v[9]); b.y = pk2(v[10], v[11]); b.z = pk2(v[12], v[13]); b.w = pk2(v[14], v[15]);
    *(v4u*)p = a; *(v4u*)(p + 8) = b;
}
__device__ __forceinline__ void st16f(float* p, const float (&v)[16]) {
#pragma unroll
    for (int i = 0; i < 4; ++i) *(f32x4*)(p + 4 * i) = (f32x4){v[4 * i], v[4 * i + 1], v[4 * i + 2], v[4 * i + 3]};
}

#define XB_TMO      128
#define XB_XCNT(j)  (256  + 64 * (j))
#define XB_XSUB(j)  (1280 + 64 * (j))
#define XB_XGEN(j)  (2304 + 64 * (j))
#define XB_TOP      3328
#define XB_TOPGEN   3392
#define XCD_BAR_WORDS 3456
#define XB_SPIN_CAP (1u << 18)

__device__ __forceinline__ unsigned xb_ld(unsigned* p)              { return __hip_atomic_load(p, __ATOMIC_RELAXED, __HIP_MEMORY_SCOPE_AGENT); }
__device__ __forceinline__ unsigned xb_add(unsigned* p, unsigned v) { return __hip_atomic_fetch_add(p, v, __ATOMIC_RELAXED, __HIP_MEMORY_SCOPE_AGENT); }
__device__ __forceinline__ unsigned xb_xcc_id() { return (unsigned)__builtin_amdgcn_s_getreg((3 << 11) | 20) & 0xFu; }
#define XB_SPIN(cond, bar) do { unsigned _sp = 0; while (cond) { __builtin_amdgcn_s_sleep(1); \
    if ((++_sp & 255u) == 0u) { if (xb_ld(&(bar)[XB_TMO])) break; if (_sp > XB_SPIN_CAP) { atomicAdd(&(bar)[XB_TMO], 1u); break; } } } } while (0)

struct XcdBarrier {
    unsigned* bar; unsigned x;
    volatile LAS unsigned* st;
};

__device__ __forceinline__ XcdBarrier xcd_barrier_post(unsigned* bar, volatile LAS unsigned* st) {
    XcdBarrier b; b.bar = bar; b.x = xb_xcc_id(); b.st = st;
    if (threadIdx.x == 0) (void)xb_add(&bar[XB_XCNT(b.x)], 1u);
    return b;
}
__device__ __forceinline__ void xcd_barrier_complete(unsigned* bar, unsigned x, unsigned& nloc, unsigned& nx) {
    const unsigned G = gridDim.x * gridDim.y * gridDim.z;
    unsigned sum, cnt, mine, sp = 0u;
    for (;;) {
        sum = 0u; cnt = 0u; mine = 0u;
#pragma unroll
        for (unsigned j = 0; j < 16; ++j) { const unsigned c = xb_ld(&bar[XB_XCNT(j)]); sum += c; cnt += (c > 0u) ? 1u : 0u; mine = (j == x) ? c : mine; }
        if (sum == G) break;
        __builtin_amdgcn_s_sleep(1);
        if ((++sp & 255u) == 0u) { if (xb_ld(&bar[XB_TMO])) break; if (sp > XB_SPIN_CAP) { atomicAdd(&bar[XB_TMO], 1u); break; } }
    }
    nloc = mine > 0u ? mine : 1u; nx = cnt > 0u ? cnt : 1u;
}

__device__ __forceinline__ void xcd_barrier(const XcdBarrier& b) {
    asm volatile("s_waitcnt vmcnt(0)" ::: "memory");
    __syncthreads();
    if (threadIdx.x == 0) {
        unsigned* bar = b.bar;
        __builtin_amdgcn_s_waitcnt(0);
        unsigned nloc = b.st[0], nx = b.st[1];
        if (nloc == 0u) { xcd_barrier_complete(bar, b.x, nloc, nx); b.st[0] = nloc; b.st[1] = nx; }
        const unsigned old = xb_add(&bar[XB_XSUB(b.x)], 1u);
        const unsigned gen = old / nloc;
        if (old + 1u == (gen + 1u) * nloc) {
            __builtin_amdgcn_fence(__ATOMIC_RELEASE, "agent");
            asm volatile("s_waitcnt vmcnt(0)" ::: "memory");
            const unsigned og = xb_add(&bar[XB_TOP], 1u);
            const unsigned tg = og / nx;
            if (og + 1u == (tg + 1u) * nx) xb_add(&bar[XB_TOPGEN], 1u);
            else XB_SPIN(xb_ld(&bar[XB_TOPGEN]) == tg, bar);
            __builtin_amdgcn_fence(__ATOMIC_ACQUIRE, "agent");
            xb_add(&bar[XB_XGEN(b.x)], 1u);
            asm volatile("s_waitcnt vmcnt(0)" ::: "memory");
        } else {
            XB_SPIN(xb_ld(&bar[XB_XGEN(b.x)]) == gen, bar);
            __builtin_amdgcn_fence(__ATOMIC_ACQUIRE, "agent");
            asm volatile("s_waitcnt vmcnt(0)" ::: "memory");
        }
    }
    __syncthreads();
}
struct Args { const float* in[26]; float* out; unsigned char* ws; int ph_lo, ph_hi; };
constexpr size_t OUT_YP = 0, OUT_DK = 12582912, OUT_DV = 20971520, OUT_GK = 29360128, OUT_GV = 31457280, OUT_ST = 33554432, OUT_TOTAL = 41943040;
#define LDS_WAIT() asm volatile("s_waitcnt lgkmcnt(0)" ::: "memory")

__device__ __forceinline__ void p0_transpose_item(const float* W, int K, int N, bf16* WT, LAS float* scr, int item, int lane) {
    const int nblk = N / 32, kb = item / nblk, nb = item % nblk, k0 = 64 * kb, n0 = 32 * nb;
    f32x4 tv[8];
#pragma unroll
    for (int i = 0; i < 8; ++i) tv[i] = *(const f32x4*)(W + (size_t)(k0 + (lane >> 3) + 8 * i) * N + n0 + 4 * (lane & 7));
#pragma unroll
    for (int i = 0; i < 8; ++i) { LAS float* d = scr + ((lane >> 3) + 8 * i) * 33 + 4 * (lane & 7); d[0] = tv[i][0]; d[1] = tv[i][1]; d[2] = tv[i][2]; d[3] = tv[i][3]; }
    LDS_WAIT(); asm volatile("" ::: "memory");
    const int c = lane & 7;
#pragma unroll
    for (int j = 0; j < 4; ++j) { const int n = (lane >> 3) + 8 * j; const LAS float* s = scr + (8 * c) * 33 + n;
        v4u o; o.x = pk2(s[0 * 33], s[1 * 33]); o.y = pk2(s[2 * 33], s[3 * 33]); o.z = pk2(s[4 * 33], s[5 * 33]); o.w = pk2(s[6 * 33], s[7 * 33]);
        *(v4u*)(WT + (size_t)(n0 + n) * K + k0 + 8 * c) = o; }
    LDS_WAIT(); asm volatile("" ::: "memory");
}
__device__ __forceinline__ void fp8_row_load(const Args& a, int t, int le, int lane, f32x4 (&x)[8]) {
    const float* src = a.in[24 + t] + (size_t)le * 2048;
#pragma unroll
    for (int j = 0; j < 8; ++j) x[j] = *(const f32x4*)(src + j * 256 + lane * 4);
}
__device__ __forceinline__ void fp8_row_finish(unsigned char* ws, int t, int le, int lane, const f32x4 (&x)[8]) {
    unsigned char* UV8 = ws + WS_UV8; float* SC = (float*)(ws + WS_SC);
    float mx = 0.f;
#pragma unroll
    for (int j = 0; j < 8; ++j) mx = fmaxf(fmaxf(mx, fmaxf(fabsf(x[j][0]), fabsf(x[j][1]))), fmaxf(fabsf(x[j][2]), fabsf(x[j][3])));
#pragma unroll
    for (int o = 1; o < 64; o <<= 1) mx = fmaxf(mx, __shfl_xor(mx, o));
    const float sc = mx > 0.f ? mx * (1.0f / 448.0f) : 1.0f, inv = mx > 0.f ? 448.0f / mx : 0.f;
    unsigned w[8];
#pragma unroll
    for (int j = 0; j < 8; ++j) { int q = __builtin_amdgcn_cvt_pk_fp8_f32(x[j][0] * inv, x[j][1] * inv, 0, false); q = __builtin_amdgcn_cvt_pk_fp8_f32(x[j][2] * inv, x[j][3] * inv, q, true); w[j] = (unsigned)q; }
    unsigned char* dst = UV8 + (size_t)le * 4096 + t * 2048 + lane * 32;
    *(v4u*)dst = (v4u){w[0], w[1], w[2], w[3]}; *(v4u*)(dst + 16) = (v4u){w[4], w[5], w[6], w[7]};
    if (lane == 0) SC[le * 2 + t] = sc;
}
__device__ __forceinline__ void fp8_rows(const Args& a, unsigned char* ws, int i0, int i1, int st, int lebase, int lane) {
    f32x4 xa[8], xb[8];
    if (i0 < i1) fp8_row_load(a, i0 >> 14, lebase + (i0 & 16383), lane, xa);
    for (int i = i0; i < i1; i += 2 * st) {
        const int i2 = i + st, i3 = i + 2 * st;
        if (i2 < i1) fp8_row_load(a, i2 >> 14, lebase + (i2 & 16383), lane, xb);
        fp8_row_finish(ws, i >> 14, lebase + (i & 16383), lane, xa);
        if (i3 < i1) fp8_row_load(a, i3 >> 14, lebase + (i3 & 16383), lane, xa);
        if (i2 < i1) fp8_row_finish(ws, i2 >> 14, lebase + (i2 & 16383), lane, xb);
    }
}
__device__ __forceinline__ void p0_prologue(const Args& a, unsigned char* ws, LAS unsigned char* lds, int G, bool defer_l1) {
    ws = fresh_ws(ws); const int tid = fresh_tid(), lane = tid & 63, wave = __builtin_amdgcn_readfirstlane(tid >> 6);
    const int bx = blockIdx.x;
    __syncthreads();
    {
        LAS float* sil = (LAS float*)(lds + RING_OFF); LAS float* red = sil + 3 * 2048;
        const float* c_ctx = a.in[8]; const float* cc = a.in[2];
        for (int i = tid; i < 3 * 2048; i += 512) { const int r = i >> 11, k = i & 2047; const float c = r == 0 ? c_ctx[k] : cc[(r - 1) * 2048 + k]; sil[i] = c / (1.0f + expf(-c)); }
        __syncthreads();
        const float* mod_w = a.in[9]; const float* mod_b = a.in[10]; float* MOD = (float*)(ws + WS_MOD);
        const int cg = tid % 24, kg = tid / 24;
        for (int task = bx; task < 256; task += G) {
            const int l = task >> 7, col0 = (task & 127) * 96;
            if (kg < 21) {
                float acc[3][4];
#pragma unroll
                for (int r = 0; r < 3; ++r)
#pragma unroll
                    for (int j = 0; j < 4; ++j) acc[r][j] = 0.f;
                const float* wp = mod_w + ((size_t)l * 2048) * 12288 + col0 + cg * 4;
#pragma unroll 4
                for (int k = kg; k < 2048; k += 21) { const f32x4 w = *(const f32x4*)(wp + (size_t)k * 12288); const float s0 = sil[k], s1 = sil[2048 + k], s2 = sil[4096 + k];
#pragma unroll
                    for (int j = 0; j < 4; ++j) { acc[0][j] += s0 * w[j]; acc[1][j] += s1 * w[j]; acc[2][j] += s2 * w[j]; } }
#pragma unroll
                for (int r = 0; r < 3; ++r)
#pragma unroll
                    for (int j = 0; j < 4; ++j) red[(kg * 24 + cg) * 12 + r * 4 + j] = acc[r][j];
            }
            __syncthreads();
            if (tid < 288) { const int r = tid / 96, c = tid % 96, g4 = c >> 2, j = c & 3; float s = 0.f;
                for (int q = 0; q < 21; ++q) s += red[(q * 24 + g4) * 12 + r * 4 + j];
                MOD[(size_t)(l * 3 + r) * 12288 + col0 + c] = s + mod_b[l * 12288 + col0 + c]; }
            __syncthreads();
        }
    }
    {
        f32x2* R64 = (f32x2*)(ws + WS_ROPE); f32x2* R128 = R64 + 64 * 16;
        const int gt = bx * 512 + tid;
        if (gt < 64 * 16) { const int pos = gt >> 4, i = gt & 15; const float inv = exp2f(-13.287712379549449f * (float)i / 16.0f); const float ang = (float)pos * inv; R64[gt] = (f32x2){cosf(ang), sinf(ang)}; }
        else if (gt < 64 * 16 + 64 * 32) { const int g2 = gt - 64 * 16, pos = g2 >> 5, i = g2 & 31; const float inv = exp2f(-13.287712379549449f * (float)i / 32.0f); const float ang = (float)pos * inv; R128[g2] = (f32x2){cosf(ang), sinf(ang)}; }
    }
    {
        LAS float* scr = (LAS float*)(lds + RING_OFF + wave * 16384);
        const int gw = bx * 8 + wave, NGW = G * 8;
        constexpr int I_IN = (DM / 64) * (INW / 32), I_BR = (1024 / 64) * (DM / 32), I_SQ = (DM / 64) * (DM / 32);
        constexpr int NITEMS = 2 * I_IN + 6 * I_BR + 4 * I_SQ;
        for (int it = gw; it < NITEMS; it += NGW) {
            int r = it;
            if (r < 2 * I_IN) { const int l = r / I_IN; p0_transpose_item(a.in[13] + (size_t)l * DM * INW, DM, INW, (bf16*)(ws + WS_WIN) + (size_t)l * INW * DM, scr, r % I_IN, lane); continue; } r -= 2 * I_IN;
            if (r < 6 * I_BR) { const int lc = r / I_BR; p0_transpose_item(a.in[20] + (size_t)lc * 1024 * DM, 1024, DM, (bf16*)(ws + WS_WBR) + (size_t)lc * DM * 1024, scr, r % I_BR, lane); continue; } r -= 6 * I_BR;
            if (r < 2 * I_SQ) { const int l = r / I_SQ; p0_transpose_item(a.in[21] + (size_t)l * DM * DM, DM, DM, (bf16*)(ws + WS_WOUT) + (size_t)l * DM * DM, scr, r % I_SQ, lane); continue; } r -= 2 * I_SQ;
            { const int l = r / I_SQ; p0_transpose_item(a.in[22] + (size_t)l * DM * DM, DM, DM, (bf16*)(ws + WS_WPQ) + (size_t)l * DM * DM, scr, r % I_SQ, lane); }
        }
    }
    {
        const int gw = bx * 8 + wave, NGW = G * 8;
        fp8_rows(a, ws, gw, 32768, NGW, 0, lane);
        if (!defer_l1) fp8_rows(a, ws, gw, 32768, NGW, 16384, lane);
    }
}
__device__ __forceinline__ void fp8_rows_deferred(const Args& a, unsigned char* ws, int slot) {
    ws = fresh_ws(ws); const int tid = fresh_tid(), lane = tid & 63, wave = __builtin_amdgcn_readfirstlane(tid >> 6);
    const int lo_ = slot == 0 ? 0 : slot == 1 ? 6554 : slot == 2 ? 11469 : slot == 3 ? 16384 : slot == 4 ? 22938 : 27853;
    const int hi_ = slot == 0 ? 6554 : slot == 1 ? 11469 : slot == 2 ? 16384 : slot == 3 ? 22938 : slot == 4 ? 27853 : 32768;
    const int gw = ((int)blockIdx.x - 192) * 8 + wave;
    fp8_rows(a, ws, lo_ + gw, hi_, 512, 16384, lane);
}

__device__ __forceinline__ void norm_phase(const float* xp, const float* xs, const float* gain, const float* modl, int ch_sh, int ch_sc, bf16* H, int G) {
    const int tid = fresh_tid(), lane = tid & 63, gw = blockIdx.x * 8 + __builtin_amdgcn_readfirstlane(tid >> 6), NGW = G * 8;
    for (int row = gw; row < NTOK; row += NGW) {
        const float* xr = row < NPROMPT ? xp + (size_t)row * DM : xs + (size_t)(row - NPROMPT) * DM;
        const int r = row < NPROMPT ? 0 : 1 + ((row - NPROMPT) >> 10);
        const float* sh = modl + (size_t)r * 12288 + ch_sh * DM; const float* sc = modl + (size_t)r * 12288 + ch_sc * DM;
        f32x4 v[8]; float ss = 0.f;
#pragma unroll
        for (int j = 0; j < 8; ++j) { v[j] = *(const f32x4*)(xr + j * 256 + lane * 4); ss += (v[j][0] * v[j][0] + v[j][1] * v[j][1]) + (v[j][2] * v[j][2] + v[j][3] * v[j][3]); }
        const float rstd = 1.0f / sqrtf(wave_sum(ss) * (1.0f / DM) + EPS);
#pragma unroll
        for (int j = 0; j < 8; ++j) { const int c = j * 256 + lane * 4; const f32x4 g = *(const f32x4*)(gain + c), s1 = *(const f32x4*)(sc + c), s0 = *(const f32x4*)(sh + c);
            const f32x4 o = v[j] * rstd * g * (s1 + 1.0f) + s0; v2u w; w.x = pk2(o[0], o[1]); w.y = pk2(o[2], o[3]); *(v2u*)(H + (size_t)row * DM + c) = w; }
    }
}

__device__ __forceinline__ void rope_pair(float (&v)[16], const f32x2* tab, int fi0, bool first, int xm) {
#pragma unroll
    for (int e = 0; e < 16; ++e) { const float p = __shfl_xor(v[e], xm); const f32x2 cs = tab[fi0 + e]; v[e] = first ? v[e] * cs.x - p * cs.y : v[e] * cs.x + p * cs.y; }
}
__device__ __forceinline__ void prep_phase(const Args& a, unsigned char* ws, int l, int wg0, int nwg) {
    ws = fresh_ws(ws); const int tid = fresh_tid(), lane = tid & 63, gw = ((int)blockIdx.x - wg0) * 8 + __builtin_amdgcn_readfirstlane(tid >> 6), NGW = nwg * 8;
    const bf16* Z = (const bf16*)(ws + WS_Z); bf16* QA = (bf16*)(ws + WS_QA); bf16* KA = (bf16*)(ws + WS_KA); bf16* VA = (bf16*)(ws + WS_VA);
    const f32x2* R64 = (const f32x2*)(ws + WS_ROPE); const f32x2* R128 = R64 + 64 * 16;
    const float* dqk = a.in[16] + (size_t)l * 2 * 64; const float* gqk = a.in[19] + (size_t)l * 2 * 128;
    float* out = a.out;
    for (int task = gw; task < NTOK + 512; task += NGW) {
        if (task >= NTOK) {
            const int i = task - NTOK, b = i >> 8, p = i & 255; const size_t krow = (size_t)NPROMPT + b * 1280 + 1024 + p;
            float v[16];
            ld16f(a.in[3] + ((size_t)(b * 2 + l) * 256 + p) * 1024 + lane * 16, v); st16bf(KA + krow * KVW + lane * 16, v);
            ld16f(a.in[4] + ((size_t)(b * 2 + l) * 256 + p) * 1024 + lane * 16, v); st16bf(VA + krow * KVW + lane * 16, v);
            if (lane < 16) { ld16f(a.in[5] + ((size_t)(b * 2 + l) * 256 + p) * 256 + lane * 16, v); st16bf(KA + krow * KVW + 1024 + lane * 16, v);
                             ld16f(a.in[6] + ((size_t)(b * 2 + l) * 256 + p) * 256 + lane * 16, v); st16bf(VA + krow * KVW + 1024 + lane * 16, v); }
            continue;
        }
        const int row = task; const bool latent = row >= NPROMPT;
        int b, t; size_t krow;
        if (!latent) { b = row >> 8; t = row & 255; krow = row; } else { b = (row - NPROMPT) >> 10; t = (row - NPROMPT) & 1023; krow = (size_t)NPROMPT + b * 1280 + t; }
        const int prow = t >> 6, pcol = t & 63;
        const bf16* z = Z + (size_t)row * INW;
        const size_t co = ((size_t)(b * 2 + l) * 256 + t);
        float v[16];
        {
            ld16bf(z + C_DQ + lane * 16, v); float ss = 0.f;
#pragma unroll
            for (int e = 0; e < 16; ++e) ss += v[e] * v[e];
            ss += __shfl_xor(ss, 1); ss += __shfl_xor(ss, 2);
            const float rstd = 1.0f / sqrtf(ss * (1.0f / 64.0f) + EPS); const int sub = lane & 3; const float* gn = dqk + sub * 16;
#pragma unroll
            for (int e = 0; e < 16; ++e) v[e] = v[e] * rstd * gn[e];
            if (latent) rope_pair(v, R64 + (sub < 2 ? prow : pcol) * 16, 0, (sub & 1) == 0, 1);
#pragma unroll
            for (int e = 0; e < 16; ++e) v[e] *= 0.125f;
            const int he = lane >> 2, half = he & 1; bf16* q = QA + (size_t)row * 3072 + he * 128;
            st16bf(q + half * 64 + sub * 16, v);
            *(v4u*)(q + (1 - half) * 64 + sub * 16) = (v4u){0u, 0u, 0u, 0u}; *(v4u*)(q + (1 - half) * 64 + sub * 16 + 8) = (v4u){0u, 0u, 0u, 0u};
        }
        {
            ld16bf(z + C_DK + lane * 16, v); float ss = 0.f;
#pragma unroll
            for (int e = 0; e < 16; ++e) ss += v[e] * v[e];
            ss += __shfl_xor(ss, 1); ss += __shfl_xor(ss, 2);
            const float rstd = 1.0f / sqrtf(ss * (1.0f / 64.0f) + EPS); const int sub = lane & 3; const float* gn = dqk + 64 + sub * 16;
#pragma unroll
            for (int e = 0; e < 16; ++e) v[e] = v[e] * rstd * gn[e];
            if (latent) rope_pair(v, R64 + (sub < 2 ? prow : pcol) * 16, 0, (sub & 1) == 0, 1);
            else st16f(out + OUT_DK + co * 1024 + lane * 16, v);
            st16bf(KA + krow * KVW + lane * 16, v);
        }
        {
            ld16bf(z + C_DV + lane * 16, v);
            if (!latent) st16f(out + OUT_DV + co * 1024 + lane * 16, v);
            *(v4u*)(VA + krow * KVW + lane * 16) = *(const v4u*)(z + C_DV + lane * 16); *(v4u*)(VA + krow * KVW + lane * 16 + 8) = *(const v4u*)(z + C_DV + lane * 16 + 8);
        }
        {
            ld16bf(z + C_GQ + lane * 16, v); float ss = 0.f;
#pragma unroll
            for (int e = 0; e < 16; ++e) ss += v[e] * v[e];
            ss += __shfl_xor(ss, 1); ss += __shfl_xor(ss, 2); ss += __shfl_xor(ss, 4);
            const float rstd = 1.0f / sqrtf(ss * (1.0f / 128.0f) + EPS); const int sub = lane & 7; const float* gn = gqk + sub * 16;
#pragma unroll
            for (int e = 0; e < 16; ++e) v[e] = v[e] * rstd * gn[e];
            if (latent) rope_pair(v, R128 + (sub < 4 ? prow : pcol) * 32, (sub & 1) * 16, (sub & 2) == 0, 2);
#pragma unroll
            for (int e = 0; e < 16; ++e) v[e] *= 0.08838834764831845f;
            st16bf(QA + (size_t)row * 3072 + 2048 + lane * 16, v);
        }
        {
            const int ln = lane & 15;
            ld16bf(z + C_GK + ln * 16, v); float ss = 0.f;
#pragma unroll
            for (int e = 0; e < 16; ++e) ss += v[e] * v[e];
            ss += __shfl_xor(ss, 1); ss += __shfl_xor(ss, 2); ss += __shfl_xor(ss, 4);
            const float rstd = 1.0f / sqrtf(ss * (1.0f / 128.0f) + EPS); const int sub = lane & 7; const float* gn = gqk + 128 + sub * 16;
#pragma unroll
            for (int e = 0; e < 16; ++e) v[e] = v[e] * rstd * gn[e];
            if (latent) rope_pair(v, R128 + (sub < 4 ? prow : pcol) * 32, (sub & 1) * 16, (sub & 2) == 0, 2);
            if (lane < 16) { if (!latent) st16f(out + OUT_GK + co * 256 + lane * 16, v); st16bf(KA + krow * KVW + 1024 + lane * 16, v); }
            ld16bf(z + C_GV + ln * 16, v);
            if (lane < 16) { if (!latent) st16f(out + OUT_GV + co * 256 + lane * 16, v); st16bf(VA + krow * KVW + 1024 + lane * 16, v); }
        }
    }
}

typedef short bf16x4s __attribute__((ext_vector_type(4)));
typedef short bf16x8h __attribute__((ext_vector_type(8)));
constexpr int HG_QD = 0, HG_QR = 4352, HG_KR = 8704, HG_KDT = 13056, HG_VT = 17152, HG_DEC = 21248, HG_BUF = 22016, HG_TOTS = 2 * HG_BUF;
__device__ __forceinline__ void hgrn_item(const Args& a, unsigned char* ws, LAS unsigned char* lds, int l, int item, const XcdBarrier* barp = nullptr, int split = -1) {
    ws = fresh_ws(ws); const int tid = fresh_tid(), lane = tid & 63, wave = __builtin_amdgcn_readfirstlane(tid >> 6);
    const bf16* Z = (const bf16*)(ws + WS_Z);
    int b, h, dir, T, row0; const bool latent = item < 32;
    if (latent) { b = item >> 4; h = (item >> 1) & 7; dir = item & 1; T = 1024; row0 = NPROMPT + b * 1024; }
    else { const int it = item - 32; b = it >> 4; h = (it >> 1) & 7; dir = it & 1; T = 256; row0 = b * 256; }
    const int kp = lane, sg = wave;
    const int fr = lane & 15, g = lane >> 4, vb = wave * 16;
    float lb[2] = {0.f, 0.f};
    if (l == 1) { const float* hl = a.in[14];
#pragma unroll
        for (int ch = 0; ch < 2; ++ch) { const float a0 = hl[(dir * 2 + 0) * 1024 + h * 128 + 2 * kp + ch], a1 = hl[(dir * 2 + 1) * 1024 + h * 128 + 2 * kp + ch]; lb[ch] = 1.0f / (1.0f + expf(a0 - a1)); } }
    const size_t sidx = ((((size_t)(b * 2 + l) * 2 + dir) * 8 + h) * 128) * 128;
    f32x4 S[8];
    if (latent) { const float* st = a.in[7] + sidx;
#pragma unroll
        for (int kt = 0; kt < 8; ++kt)
#pragma unroll
            for (int r = 0; r < 4; ++r) S[kt][r] = st[(size_t)(16 * kt + 4 * g + r) * 128 + vb + fr]; }
    else {
#pragma unroll
        for (int kt = 0; kt < 8; ++kt) S[kt] = (f32x4){0.f, 0.f, 0.f, 0.f}; }
    LAS unsigned char* base = lds + RING_OFF;
    LAS float* tots = (LAS float*)(base + HG_TOTS);
    bf16* OH = (bf16*)(ws + WS_OH) + (size_t)dir * NTOK * 1024;
    const long ost = dir ? -1024 : 1024, zst = dir ? -(long)INW : (long)INW;
    bf16* const ob0 = OH + (size_t)(row0 + (dir ? T - 1 : 0)) * 1024 + h * 128 + vb + fr + ost * (4 * g);
    const bf16* const zb0 = Z + (size_t)(row0 + (dir ? T - 1 : 0)) * INW + h * 128 + 2 * kp + zst * (2 * sg);
    const int nchunk = T >> 4;
    unsigned rq0[2], rz0[2], rv0[2], rq1[2], rz1[2], rv1[2], rq2[2], rz2[2], rv2[2], rq3[2], rz3[2], rv3[2];
#define HG_LOAD(rq, rz, rv, c) do { if ((c) < nchunk) { _Pragma("unroll") for (int i = 0; i < 2; ++i) { const bf16* zr = zb0 + zst * ((c) * 16 + i); \
        rq[i] = *(const unsigned*)(zr + C_HQ); rz[i] = *(const unsigned*)(zr + C_HF + dir * 1024); rv[i] = *(const unsigned*)(zr + C_HI); } } } while (0)
#define HG_EXP(x) __builtin_amdgcn_exp2f(1.4426950408889634f * (x))
#ifndef HG_PROBE
#define HG_PROBE 0
#endif
#define HG_STAGE(rq, rz, rv, pbuf) do { \
        float lf[2][2], kk[2][2]; \
        _Pragma("unroll") for (int i = 0; i < 2; ++i) _Pragma("unroll") for (int ch = 0; ch < 2; ++ch) { const float zf = ch ? bfhi(rz[i]) : bflo(rz[i]); const float e = HG_EXP(-fabsf(zf)), inv = __builtin_amdgcn_rcpf(1.0f + e); \
            const float sp = zf >= 0.f ? inv : e * inv, sn = zf >= 0.f ? e * inv : inv; kk[ch][i] = (1.0f - lb[ch]) * sn; lf[ch][i] = 0.6931471805599453f * __builtin_amdgcn_logf(lb[ch] + (1.0f - lb[ch]) * sp); } \
        const float c00 = lf[0][0], c01 = c00 + lf[0][1], c10 = lf[1][0], c11 = c10 + lf[1][1]; \
        *(LAS f32x2*)(tots + sg * 128 + 2 * kp) = (f32x2){c01, c11}; \
        __syncthreads(); \
        f32x2 pre = {0.f, 0.f}, bm = {0.f, 0.f}, b15 = {0.f, 0.f}; \
        _Pragma("unroll") for (int q = 0; q < 8; ++q) { const f32x2 tq = *(const LAS f32x2*)(tots + q * 128 + 2 * kp); if (q < sg) pre += tq; if (q < 4) bm += tq; b15 += tq; } \
        LAS unsigned char* pb_ = base + (pbuf) * HG_BUF; float kd[2][2]; \
        _Pragma("unroll") for (int i = 0; i < 2; ++i) { const int s = 2 * sg + i; float qd[2], qr[2], kr[2]; \
            _Pragma("unroll") for (int ch = 0; ch < 2; ++ch) { const float q = ch ? bfhi(rq[i]) : bflo(rq[i]); const float bb = (ch ? pre.y : pre.x) + (i ? (ch ? c11 : c01) : (ch ? c10 : c00)); \
                const float bmc = ch ? bm.y : bm.x, b15c = ch ? b15.y : b15.x; const float er = HG_EXP(fminf(fmaxf(bb - bmc, -80.f), 80.f)); \
                qd[ch] = q * HG_EXP(bb); qr[ch] = q * er; kr[ch] = kk[ch][i] * __builtin_amdgcn_rcpf(er); kd[ch][i] = kk[ch][i] * HG_EXP(b15c - bb); } \
            *(LAS unsigned*)(pb_ + HG_QD + s * 272 + kp * 4) = pk2(qd[0], qd[1]); \
            *(LAS unsigned*)(pb_ + HG_QR + s * 272 + kp * 4) = pk2(qr[0], qr[1]); \
            *(LAS unsigned*)(pb_ + HG_KR + s * 272 + kp * 4) = pk2(kr[0], kr[1]); } \
        *(LAS unsigned*)(pb_ + HG_KDT + (2 * kp) * 32 + sg * 4) = pk2(kd[0][0], kd[0][1]); *(LAS unsigned*)(pb_ + HG_KDT + (2 * kp + 1) * 32 + sg * 4) = pk2(kd[1][0], kd[1][1]); \
        *(LAS unsigned*)(pb_ + HG_VT + (2 * kp) * 32 + sg * 4) = (rv[0] & 0xffffu) | (rv[1] << 16); *(LAS unsigned*)(pb_ + HG_VT + (2 * kp + 1) * 32 + sg * 4) = (rv[0] >> 16) | (rv[1] & 0xffff0000u); \
        if (sg == 0) *(LAS f32x2*)(pb_ + HG_DEC + kp * 8) = (f32x2){HG_EXP(b15.x), HG_EXP(b15.y)}; \
    } while (0)
#define HG_MFMA(c) do { \
            const LAS unsigned char* pb_ = base + ((c) & 1) * HG_BUF; bf16x8h bv; \
            f32x4 at = {0.f, 0.f, 0.f, 0.f}; \
            _Pragma("unroll") for (int ks = 0; ks < 4; ++ks) { const bf16x8h ka = *(const LAS bf16x8h*)(pb_ + HG_KR + fr * 272 + (32 * ks + 8 * g) * 2), qb = *(const LAS bf16x8h*)(pb_ + HG_QR + fr * 272 + (32 * ks + 8 * g) * 2); \
                at = __builtin_amdgcn_mfma_f32_16x16x32_bf16(ka, qb, at, 0, 0, 0); }            \
            _Pragma("unroll") for (int r = 0; r < 4; ++r) if (4 * g + r > fr) at[r] = 0.f; \
            const v4u pa4 = {pk2(at[0], at[1]), pk2(at[2], at[3]), 0u, 0u}; const bf16x8h pa = __builtin_bit_cast(bf16x8h, pa4);     \
            f32x4 o = {0.f, 0.f, 0.f, 0.f}; \
            _Pragma("unroll") for (int ks = 0; ks < 4; ++ks) { \
                const v4u bs4 = {pk2(S[2 * ks][0], S[2 * ks][1]), pk2(S[2 * ks][2], S[2 * ks][3]), pk2(S[2 * ks + 1][0], S[2 * ks + 1][1]), pk2(S[2 * ks + 1][2], S[2 * ks + 1][3])}; \
                const v2u alo = *(const LAS v2u*)(pb_ + HG_QD + fr * 272 + (32 * ks + 4 * g) * 2), ahi = *(const LAS v2u*)(pb_ + HG_QD + fr * 272 + (32 * ks + 16 + 4 * g) * 2); \
                const v4u a4 = {alo.x, alo.y, ahi.x, ahi.y}; \
                o = __builtin_amdgcn_mfma_f32_16x16x32_bf16(__builtin_bit_cast(bf16x8h, a4), __builtin_bit_cast(bf16x8h, bs4), o, 0, 0, 0); } \
            const v2u bv2 = *(const LAS v2u*)(pb_ + HG_VT + (vb + fr) * 32 + g * 8); const v4u bv4 = {bv2.x, bv2.y, 0u, 0u}; bv = __builtin_bit_cast(bf16x8h, bv4); \
            o = __builtin_amdgcn_mfma_f32_16x16x32_bf16(pa, bv, o, 0, 0, 0); \
            _Pragma("unroll") for (int r = 0; r < 4; ++r) ob0[ost * ((c) * 16 + r)] = (bf16)f2bf(o[r]); \
            _Pragma("unroll") for (int kt = 0; kt < 8; ++kt) { const f32x4 d4 = *(const LAS f32x4*)(pb_ + HG_DEC + (16 * kt + 4 * g) * 4); const v2u ak2 = *(const LAS v2u*)(pb_ + HG_KDT + (16 * kt + fr) * 32 + g * 8); const v4u ak4 = {ak2.x, ak2.y, 0u, 0u}; \
                S[kt] = __builtin_amdgcn_mfma_f32_16x16x32_bf16(__builtin_bit_cast(bf16x8h, ak4), bv, S[kt] * d4, 0, 0, 0); } \
    } while (0)
    HG_LOAD(rq0, rz0, rv0, 0); HG_LOAD(rq1, rz1, rv1, 1); HG_LOAD(rq2, rz2, rv2, 2); HG_LOAD(rq3, rz3, rv3, 3);
    HG_STAGE(rq0, rz0, rv0, 0);
    HG_LOAD(rq0, rz0, rv0, 4);
    __syncthreads();
    for (int c = 0; c < nchunk; c += 4) {
        if (c == split) xcd_barrier(*barp);
        HG_STAGE(rq1, rz1, rv1, 1); HG_LOAD(rq1, rz1, rv1, c + 5); HG_MFMA(c);     __syncthreads();
        HG_STAGE(rq2, rz2, rv2, 0); HG_LOAD(rq2, rz2, rv2, c + 6); HG_MFMA(c + 1); __syncthreads();
        HG_STAGE(rq3, rz3, rv3, 1); HG_LOAD(rq3, rz3, rv3, c + 7); HG_MFMA(c + 2); __syncthreads();
        if (c + 4 < nchunk) { HG_STAGE(rq0, rz0, rv0, 0); HG_LOAD(rq0, rz0, rv0, c + 8); }
        HG_MFMA(c + 3); __syncthreads();
    }
#undef HG_MFMA
#undef HG_EXP
#undef HG_LOAD
#undef HG_STAGE
    if (!latent) { float* st = a.out + OUT_ST + sidx;
#pragma unroll
        for (int kt = 0; kt < 8; ++kt)
#pragma unroll
            for (int r = 0; r < 4; ++r) st[(size_t)(16 * kt + 4 * g + r) * 128 + vb + fr] = S[kt][r]; }
    __syncthreads();
}

__device__ __forceinline__ void attn_unit(unsigned char* ws, char* lds_generic, int u) {
    ws = fresh_ws(ws);
    int b, he, row0, key0, seq;
    if (u < 192) { b = u / 96; const int r = u % 96; he = r >> 2; const int qb = r & 3; row0 = NPROMPT + b * 1024 + qb * 256; key0 = NPROMPT + b * 1280; seq = 1280; }
    else { const int uu = u - 192; b = uu / 24; he = uu % 24; row0 = b * 256; key0 = b * 256; seq = 256; }
    const int kvh = he < 16 ? (he >> 1) : 8 + ((he - 16) >> 2);
    const att::bf16* Q = (const att::bf16*)(ws + WS_QA) + (size_t)row0 * 3072 + he * 128;
    const att::bf16* K = (const att::bf16*)(ws + WS_KA) + (size_t)key0 * KVW + kvh * 128;
    const att::bf16* V = (const att::bf16*)(ws + WS_VA) + (size_t)key0 * KVW + kvh * 128;
    unsigned short* O = (unsigned short*)(ws + WS_OA) + (size_t)row0 * 3072 + he * 128;
    att::attn_dense_body<att::bf16>(Q, K, V, O, seq, lds_generic + RING_OFF);
    __syncthreads();
}

__device__ __forceinline__ void post_phase(const Args& a, unsigned char* ws, int l, int G) {
    ws = fresh_ws(ws); const int tid = fresh_tid(), lane = tid & 63, gw = blockIdx.x * 8 + __builtin_amdgcn_readfirstlane(tid >> 6), NGW = G * 8;
    const bf16* Z = (const bf16*)(ws + WS_Z); const bf16* OA = (const bf16*)(ws + WS_OA); const bf16* OHf = (const bf16*)(ws + WS_OH); const bf16* OHb = OHf + (size_t)NTOK * 1024;
    bf16* BR = (bf16*)(ws + WS_BR);
    const float lam_init = 0.8f - 0.6f * expf(-0.3f * (float)l);
    const float* lp = a.in[17] + (size_t)l * 4 * 64;
    const float s01 = wave_sum(lp[lane] * lp[64 + lane]), s23 = wave_sum(lp[128 + lane] * lp[192 + lane]);
    const float lam = expf(s01) - expf(s23) + lam_init;
    const float* hn = a.in[15] + (size_t)l * 128; const float* sl = a.in[18] + (size_t)l * 128;
    const int sub = lane & 7;
    for (int row = gw; row < NTOK; row += NGW) {
        float v[16], w[16];
        {
            ld16bf(OHf + (size_t)row * 1024 + lane * 16, v); ld16bf(OHb + (size_t)row * 1024 + lane * 16, w); float ss = 0.f;
#pragma unroll
            for (int e = 0; e < 16; ++e) { v[e] += w[e]; ss += v[e] * v[e]; }
            ss += __shfl_xor(ss, 1); ss += __shfl_xor(ss, 2); ss += __shfl_xor(ss, 4);
            const float rstd = 1.0f / sqrtf(ss * (1.0f / 128.0f) + EPS);
            ld16bf(Z + (size_t)row * INW + C_HG + lane * 16, w);
#pragma unroll
            for (int e = 0; e < 16; ++e) { const float g = w[e]; v[e] = v[e] * rstd * hn[sub * 16 + e] * (g / (1.0f + expf(-g))); }
            st16bf(BR + (size_t)row * 1024 + lane * 16, v);
        }
        {
            const int h = lane >> 3; const bf16* o1 = OA + (size_t)row * 3072 + (2 * h) * 128 + sub * 16;
            ld16bf(o1, v); ld16bf(o1 + 128, w); float ss = 0.f;
#pragma unroll
            for (int e = 0; e < 16; ++e) { v[e] -= lam * w[e]; ss += v[e] * v[e]; }
            ss += __shfl_xor(ss, 1); ss += __shfl_xor(ss, 2); ss += __shfl_xor(ss, 4);
            const float rstd = 1.0f / sqrtf(ss * (1.0f / 128.0f) + EPS);
#pragma unroll
            for (int e = 0; e < 16; ++e) v[e] = v[e] * rstd * sl[sub * 16 + e] * (1.0f - lam_init);
            st16bf(BR + (size_t)NTOK * 1024 + (size_t)row * 1024 + lane * 16, v);
        }
        {
            *(v4u*)(BR + (size_t)2 * NTOK * 1024 + (size_t)row * 1024 + lane * 16) = *(const v4u*)(OA + (size_t)row * 3072 + 2048 + lane * 16); *(v4u*)(BR + (size_t)2 * NTOK * 1024 + (size_t)row * 1024 + lane * 16 + 8) = *(const v4u*)(OA + (size_t)row * 3072 + 2048 + lane * 16 + 8);
        }
    }
}

typedef short bf16x8s __attribute__((ext_vector_type(8)));
typedef float f32x16 __attribute__((ext_vector_type(16)));
__device__ __forceinline__ unsigned ford(float f) { const unsigned u = __float_as_uint(f); return u ^ ((u >> 31) ? 0xffffffffu : 0x80000000u); }
__device__ __forceinline__ float funord(unsigned k) { const unsigned u = (k & 0x80000000u) ? (k ^ 0x80000000u) : ~k; return __uint_as_float(u); }
__device__ __forceinline__ void ins16(unsigned (&L)[16], unsigned x) {
#pragma unroll
    for (int i = 0; i < 16; ++i) { const unsigned hi = L[i] > x ? L[i] : x; x = L[i] > x ? x : L[i]; L[i] = hi; }
}
__device__ __forceinline__ void ce_desc(unsigned& a_, unsigned& b_) { const unsigned hi = a_ > b_ ? a_ : b_, lo = a_ > b_ ? b_ : a_; a_ = hi; b_ = lo; }
__device__ __forceinline__ void sort16_desc(unsigned (&x)[16]) {
#pragma unroll
    for (int k = 2; k <= 16; k <<= 1)
#pragma unroll
        for (int j = k >> 1; j > 0; j >>= 1)
#pragma unroll
            for (int i = 0; i < 16; ++i) { const int l = i ^ j; if (l > i) { if ((i & k) == 0) ce_desc(x[i], x[l]); else ce_desc(x[l], x[i]); } }
}
__device__ __forceinline__ void merge16_desc(unsigned (&a_)[16], const unsigned (&b_)[16]) {
#pragma unroll
    for (int i = 0; i < 16; ++i) a_[i] = a_[i] > b_[15 - i] ? a_[i] : b_[15 - i];
#pragma unroll
    for (int j = 8; j > 0; j >>= 1)
#pragma unroll
        for (int i = 0; i < 16; ++i) { const int l = i ^ j; if (l > i) ce_desc(a_[i], a_[l]); }
}
__device__ __forceinline__ void peer_top16(unsigned (&L)[16], const LAS unsigned char* keysL, const bf16* qp, int c, int qrow, int hf) {
    f32x16 acc[4];
#pragma unroll
    for (int tl = 0; tl < 4; ++tl)
#pragma unroll
        for (int r = 0; r < 16; ++r) acc[tl][r] = 0.f;
    bf16x8s bq[8];
#pragma unroll
    for (int ks = 0; ks < 8; ++ks) bq[ks] = *(const bf16x8s*)(qp + c * 128 + ks * 16 + hf * 8);
#pragma unroll
    for (int ks = 0; ks < 8; ++ks)
#pragma unroll
        for (int tl = 0; tl < 4; ++tl) { const bf16x8s ka = *(const LAS bf16x8s*)(keysL + (c * 128 + tl * 32 + qrow) * 256 + (((ks * 2 + hf) ^ (qrow & 15)) << 4));
            acc[tl] = __builtin_amdgcn_mfma_f32_32x32x16_bf16(ka, bq[ks], acc[tl], 0, 0, 0); }
    unsigned K1[16], K2[16], K3[16];
#pragma unroll
    for (int r = 0; r < 16; ++r) { const unsigned kc = 127u - (unsigned)((r & 3) + 8 * (r >> 2)) - 4u * (unsigned)hf;
        L[r] = (ford(acc[0][r]) & 0xffffff80u) | kc; K1[r] = (ford(acc[1][r]) & 0xffffff80u) | (kc - 32u); K2[r] = (ford(acc[2][r]) & 0xffffff80u) | (kc - 64u); K3[r] = (ford(acc[3][r]) & 0xffffff80u) | (kc - 96u); }
    sort16_desc(L); sort16_desc(K1); sort16_desc(K2); sort16_desc(K3);
    merge16_desc(L, K1); merge16_desc(K2, K3); merge16_desc(L, K2);
    unsigned P[16];
#pragma unroll
    for (int i = 0; i < 16; ++i) P[i] = (unsigned)__shfl_xor((int)L[i], 32);
    merge16_desc(L, P);
}
__device__ __forceinline__ float gelu_erf(float x) { return 0.5f * x * (1.0f + erff(x * 0.70710678118654752f)); }
__device__ __forceinline__ void peer_topk_phase(const Args& a, unsigned char* ws, LAS unsigned char* lds, int l, int G) {
    ws = fresh_ws(ws); const int tid = fresh_tid(), lane = tid & 63, wave = __builtin_amdgcn_readfirstlane(tid >> 6);
    LAS unsigned char* keysL = lds + RING_OFF;
    LAS unsigned char* wtab = keysL + 65536 + wave * 2048;
    const float* pk = a.in[23] + (size_t)l * 2 * 128 * 128;
    for (int i = tid; i < 2 * 128 * 16; i += 512) { const int q = i & 15, rk = i >> 4, k = rk & 127;
        const f32x4 x0 = *(const f32x4*)(pk + (size_t)rk * 128 + q * 8), x1 = *(const f32x4*)(pk + (size_t)rk * 128 + q * 8 + 4);
        v4u o; o.x = pk2(x0[0], x0[1]); o.y = pk2(x0[2], x0[3]); o.z = pk2(x1[0], x1[1]); o.w = pk2(x1[2], x1[3]);
        *(LAS v4u*)(keysL + rk * 256 + ((q ^ (k & 15)) << 4)) = o; }
    __syncthreads();
    const bf16* QPb = (const bf16*)(ws + WS_QP); unsigned* PE = (unsigned*)(ws + WS_PE); unsigned* PG = (unsigned*)(ws + WS_PG);
    const int gw = blockIdx.x * 8 + wave, NGW = G * 8;
    const int hf = lane >> 5, qrow = lane & 31, tq = qrow >> 3, hq = qrow & 7;
    for (int tile = gw; tile < NTOK / 3; tile += NGW) {
        const int tok0 = tile * 3;
        const bf16* qp = QPb + (size_t)(tok0 + (tq < 3 ? tq : 2)) * DM + hq * 256;
        unsigned L0[16], L1[16];
        peer_top16(L0, keysL, qp, 0, qrow, hf);
        peer_top16(L1, keysL, qp, 1, qrow, hf);
        unsigned tw[8];
#pragma unroll
        for (int i = 0; i < 4; ++i) { tw[i] = (127u - (L0[4 * i] & 127u)) | ((127u - (L0[4 * i + 1] & 127u)) << 8) | ((127u - (L0[4 * i + 2] & 127u)) << 16) | ((127u - (L0[4 * i + 3] & 127u)) << 24);
                                      tw[4 + i] = (127u - (L1[4 * i] & 127u)) | ((127u - (L1[4 * i + 1] & 127u)) << 8) | ((127u - (L1[4 * i + 2] & 127u)) << 16) | ((127u - (L1[4 * i + 3] & 127u)) << 24); }
        *(LAS v4u*)(wtab + lane * 32) = (v4u){tw[0], tw[1], tw[2], tw[3]}; *(LAS v4u*)(wtab + lane * 32 + 16) = (v4u){tw[4], tw[5], tw[6], tw[7]};
        float v0[16], v1[16];
#pragma unroll
        for (int i = 0; i < 16; ++i) { v0[i] = funord(L0[i] & 0xffffff80u); v1[i] = funord(L1[i] & 0xffffff80u); }
        unsigned C[16], C1[16], C2[16], C3[16];
#pragma unroll
        for (int i = 0; i < 16; ++i) { C[i] = 0u; C1[i] = 0u; C2[i] = 0u; C3[i] = 0u; }
#pragma unroll
        for (int i = 0; i < 16; ++i)
#pragma unroll
            for (int j = 0; j < 16; ++j) if ((i + 1) * (j + 1) <= 16) {
                constexpr int PRE[16] = {0, 16, 24, 29, 33, 36, 38, 40, 42, 43, 44, 45, 46, 47, 48, 49};
                const int s = PRE[i] + j; const unsigned key = (ford(v0[i] + v1[j]) & 0xffffff00u) | (255u - (unsigned)(i * 16 + j));
                if (s < 16) C[s & 15] = key; else if (s < 32) C1[s & 15] = key; else if (s < 48) C2[s & 15] = key; else C3[s & 15] = key; }
        sort16_desc(C); sort16_desc(C1); sort16_desc(C2); sort16_desc(C3);
        merge16_desc(C, C1); merge16_desc(C2, C3); merge16_desc(C, C2);
        LDS_WAIT(); asm volatile("" ::: "memory");
        float ex[16]; float sum = 0.f; const float c0 = funord(C[0] & 0xffffff00u);
#pragma unroll
        for (int r = 0; r < 16; ++r) { ex[r] = expf(funord(C[r] & 0xffffff00u) - c0); sum += ex[r]; }
        const float rs = 1.0f / sum;
        if (tq < 3) { const size_t ob = (size_t)(tok0 + tq) * 128 + hq * 16;
            if (hf == 0) { unsigned ev[16];
#pragma unroll
                for (int r = 0; r < 16; ++r) { const unsigned ci = 255u - (C[r] & 255u); const unsigned k0 = wtab[lane * 32 + (ci >> 4)], k1 = wtab[lane * 32 + 16 + (ci & 15u)]; ev[r] = k0 * 128u + k1; }
#pragma unroll
                for (int r = 0; r < 16; r += 4) *(v4u*)(PE + ob + r) = (v4u){ev[r], ev[r + 1], ev[r + 2], ev[r + 3]}; }
            else {
#pragma unroll
                for (int r = 0; r < 16; r += 4) *(v4u*)(PG + ob + r) = (v4u){__float_as_uint(ex[r] * rs), __float_as_uint(ex[r + 1] * rs), __float_as_uint(ex[r + 2] * rs), __float_as_uint(ex[r + 3] * rs)}; }
        }
        LDS_WAIT(); asm volatile("" ::: "memory");
    }
    __syncthreads();
}
#define PEER_ACC(OUT) do { _Pragma("unroll") for (int j = 0; j < 8; ++j) { const int q = (int)w[t][j >> 2][j & 3]; \
        OUT[2 * j] = __builtin_elementwise_fma(__builtin_amdgcn_cvt_pk_f32_fp8(q, false), wg2, OUT[2 * j]); OUT[2 * j + 1] = __builtin_elementwise_fma(__builtin_amdgcn_cvt_pk_f32_fp8(q, true), wg2, OUT[2 * j + 1]); } } while (0)
__device__ __forceinline__ void fma_ip(float& o, float x, float w) { asm("v_fma_f32 %0, %1, %2, %0" : "+v"(o) : "v"(x), "v"(w)); }
__device__ __forceinline__ void peer_gather_phase(const Args& a, unsigned char* ws, LAS unsigned char* lds, int l, float* xout, int G, unsigned emask = 0xffffu, int skip = 0, bool n1fuse = false) {
    ws = fresh_ws(ws); const int tid = fresh_tid(), lane = tid & 63, wave = __builtin_amdgcn_readfirstlane(tid >> 6);
    LAS unsigned char* wb = lds + RING_OFF + wave * 16384;
    LAS v2u* list = (LAS v2u*)(wb + 12288); LAS unsigned* hist = (LAS unsigned*)(wb + 15360);
    const bf16* H = (const bf16*)(ws + WS_H); const unsigned* PE = (const unsigned*)(ws + WS_PE); const unsigned* PG = (const unsigned*)(ws + WS_PG);
    const unsigned char* UV8 = ws + WS_UV8 + (size_t)l * 16384 * 4096; const float* SC = (const float*)(ws + WS_SC) + (size_t)l * 16384 * 2;
    const float* XM = (const float*)(ws + WS_XM); const float* MOD = (const float*)(ws + WS_MOD) + (size_t)l * 3 * 12288;
    const int gw = blockIdx.x * 8 + wave, NGW = G * 8;
    for (int tile = gw; tile < NTOK / 3; tile += NGW) {
        const int tok0 = tile * 3;
        {
            unsigned e[6], gb[6], pos[6];
            hist[lane] = 0u; hist[64 + lane] = 0u; hist[128 + lane] = 0u;
#pragma unroll
            for (int m = 0; m < 6; ++m) { const size_t ix = (size_t)(tok0 + (m >> 1)) * 128 + ((lane + 64 * m) & 127); e[m] = PE[ix] & emask; gb[m] = PG[ix]; }
            LDS_WAIT(); asm volatile("" ::: "memory");
#pragma unroll
            for (int m = 0; m < 6; ++m) pos[m] = __hip_atomic_fetch_add(hist + (m >> 1) * 64 + (e[m] >> 8), 1u, __ATOMIC_RELAXED, __HIP_MEMORY_SCOPE_WORKGROUP);
            LDS_WAIT(); asm volatile("" ::: "memory");
            const unsigned cnt0 = hist[lane], cnt1 = hist[64 + lane], cnt2 = hist[128 + lane]; unsigned inc0 = cnt0, inc1 = cnt1, inc2 = cnt2;
#pragma unroll
            for (int o = 1; o < 64; o <<= 1) { const unsigned t0 = (unsigned)__shfl_up((int)inc0, o), t1 = (unsigned)__shfl_up((int)inc1, o), t2 = (unsigned)__shfl_up((int)inc2, o); if (lane >= o) { inc0 += t0; inc1 += t1; inc2 += t2; } }
            LDS_WAIT(); asm volatile("" ::: "memory");
            hist[lane] = inc0 - cnt0; hist[64 + lane] = 128u + inc1 - cnt1; hist[128 + lane] = 256u + inc2 - cnt2;
            LDS_WAIT(); asm volatile("" ::: "memory");
#pragma unroll
            for (int m = 0; m < 6; ++m) { const unsigned p_ = hist[(m >> 1) * 64 + (e[m] >> 8)] + pos[m]; list[p_] = (v2u){e[m], gb[m]}; }
            LDS_WAIT(); asm volatile("" ::: "memory");
        }
        if (!(skip & 1)) {
            f32x2 h0[16], h1[16], h2r[16];
#pragma unroll
            for (int j = 0; j < 8; ++j) { const v2u a0 = *(const v2u*)(H + (size_t)(tok0 + 0) * DM + j * 256 + lane * 4), a1 = *(const v2u*)(H + (size_t)(tok0 + 1) * DM + j * 256 + lane * 4), a2 = *(const v2u*)(H + (size_t)(tok0 + 2) * DM + j * 256 + lane * 4);
                h0[2 * j] = (f32x2){bflo(a0.x), bfhi(a0.x)}; h0[2 * j + 1] = (f32x2){bflo(a0.y), bfhi(a0.y)};
                h1[2 * j] = (f32x2){bflo(a1.x), bfhi(a1.x)}; h1[2 * j + 1] = (f32x2){bflo(a1.y), bfhi(a1.y)};
                h2r[2 * j] = (f32x2){bflo(a2.x), bfhi(a2.x)}; h2r[2 * j + 1] = (f32x2){bflo(a2.y), bfhi(a2.y)}; }
#define PU_LOAD(W, SCL, G_, kb_) do { _Pragma("unroll") for (int t = 0; t < 3; ++t) { const v2u r = list[t * 128 + (kb_)]; const int ee = __builtin_amdgcn_readfirstlane((int)r.x); G_[t] = __uint_as_float((unsigned)__builtin_amdgcn_readfirstlane((int)r.y)); \
            const unsigned char* base = UV8 + (size_t)ee * 4096 + lane * 32; W[t][0] = *(const v4u*)base; W[t][1] = *(const v4u*)(base + 16); SCL[t] = *(const f32x2*)(SC + (size_t)ee * 2); } } while (0)
#define PU_DOT(HV, Wt) ({ f32x2 s_ = {0.f, 0.f}; _Pragma("unroll") for (int j = 0; j < 8; ++j) { const int q = (int)Wt[j >> 2][j & 3]; \
            s_ = __builtin_elementwise_fma(__builtin_amdgcn_cvt_pk_f32_fp8(q, false), HV[2 * j], s_); s_ = __builtin_elementwise_fma(__builtin_amdgcn_cvt_pk_f32_fp8(q, true), HV[2 * j + 1], s_); } s_.x + s_.y; })
#define PU_RED(x_) do { x_ += __uint_as_float((unsigned)__builtin_amdgcn_update_dpp(0, (int)__float_as_uint(x_), 0xB1, 0xF, 0xF, false)); x_ += __uint_as_float((unsigned)__builtin_amdgcn_update_dpp(0, (int)__float_as_uint(x_), 0x4E, 0xF, 0xF, false)); \
            x_ += __uint_as_float((unsigned)__builtin_amdgcn_update_dpp(0, (int)__float_as_uint(x_), 0x141, 0xF, 0xF, false)); x_ += __uint_as_float((unsigned)__builtin_amdgcn_update_dpp(0, (int)__float_as_uint(x_), 0x140, 0xF, 0xF, false)); \
            x_ += __uint_as_float((unsigned)__builtin_amdgcn_update_dpp(0, (int)__float_as_uint(x_), 0x142, 0xA, 0xF, false)); x_ += __uint_as_float((unsigned)__builtin_amdgcn_update_dpp(0, (int)__float_as_uint(x_), 0x143, 0xC, 0xF, false)); } while (0)
#define PU_COMP(W, kb_) do { float d0 = PU_DOT(h0, W[0]), d1 = PU_DOT(h1, W[1]), d2 = PU_DOT(h2r, W[2]); PU_RED(d0); PU_RED(d1); PU_RED(d2); \
            if (lane == 63) { dl[(kb_)] = d0; dl[128 + (kb_)] = d1; dl[256 + (kb_)] = d2; } } while (0)
            LAS float* dl = (LAS float*)wb;
            v4u wA[3][2], wB[3][2];
#define PU_LOAD2(W, kb_) do { _Pragma("unroll") for (int t = 0; t < 3; ++t) { const int ee = __builtin_amdgcn_readfirstlane((int)list[t * 128 + (kb_)].x); \
            const unsigned char* base = UV8 + (size_t)ee * 4096 + lane * 32; W[t][0] = *(const v4u*)base; W[t][1] = *(const v4u*)(base + 16); } } while (0)
            PU_LOAD2(wA, 0);
#pragma unroll 1
            for (int kb = 0; kb < 128; kb += 2) {
                PU_LOAD2(wB, kb + 1); PU_COMP(wA, kb);
                if (kb + 2 < 128) PU_LOAD2(wA, kb + 2);
                PU_COMP(wB, kb + 1);
            }
            LDS_WAIT(); asm volatile("" ::: "memory");
#pragma unroll
            for (int m = 0; m < 6; ++m) { const int li = lane + 64 * m; const v2u ent = list[li]; const f32x2 sc2 = *(const f32x2*)(SC + (size_t)ent.x * 2);
                ((LAS float*)list)[2 * li + 1] = __uint_as_float(ent.y) * gelu_erf(dl[li] * sc2.x) * sc2.y; }
#undef PU_LOAD2
#undef PU_RED
#undef PU_LOAD
#undef PU_DOT
#undef PU_COMP
        }
        LDS_WAIT(); asm volatile("" ::: "memory");
        f32x2 out0[16], out1[16], out2[16];
#pragma unroll
        for (int i = 0; i < 16; ++i) { out0[i] = (f32x2){0.f, 0.f}; out1[i] = (f32x2){0.f, 0.f}; out2[i] = (f32x2){0.f, 0.f}; }
#define PV_LOAD(W, G_, kb_) do { _Pragma("unroll") for (int t = 0; t < 3; ++t) { const v2u r = list[t * 128 + (kb_)]; const int ee = __builtin_amdgcn_readfirstlane((int)r.x); G_[t] = __uint_as_float((unsigned)__builtin_amdgcn_readfirstlane((int)r.y)); \
            const unsigned char* base = UV8 + (size_t)ee * 4096 + 2048 + lane * 32; W[t][0] = *(const v4u*)base; W[t][1] = *(const v4u*)(base + 16); } } while (0)
#define PV_FMA(O, X, Wg) do { O.x = __builtin_fmaf(X.x, Wg, O.x); O.y = __builtin_fmaf(X.y, Wg, O.y); } while (0)
#define PV_COMP(W, G_) do { _Pragma("unroll") for (int t = 0; t < 3; ++t) { const float wg = G_[t]; \
            _Pragma("unroll") for (int j = 0; j < 8; ++j) { const int q = (int)W[t][j >> 2][j & 3]; const f32x2 lo = __builtin_amdgcn_cvt_pk_f32_fp8(q, false), hi = __builtin_amdgcn_cvt_pk_f32_fp8(q, true); \
                if (t == 0) { PV_FMA(out0[2 * j], lo, wg); PV_FMA(out0[2 * j + 1], hi, wg); } \
                else if (t == 1) { PV_FMA(out1[2 * j], lo, wg); PV_FMA(out1[2 * j + 1], hi, wg); } \
                else { PV_FMA(out2[2 * j], lo, wg); PV_FMA(out2[2 * j + 1], hi, wg); } } } } while (0)
        if (!(skip & 2)) {
            v4u wA[3][2], wB[3][2]; float gA[3], gB[3];
            PV_LOAD(wA, gA, 0);
#pragma unroll 1
            for (int kb = 0; kb < 128; kb += 2) {
                PV_LOAD(wB, gB, kb + 1); PV_COMP(wA, gA);
                if (kb + 2 < 128) PV_LOAD(wA, gA, kb + 2);
                PV_COMP(wB, gB);
            }
        }
#undef PV_LOAD
#undef PV_COMP
#pragma unroll
        for (int tt = 0; tt < 3; ++tt) {
            const int row = tok0 + tt; const int r = row < NPROMPT ? 0 : 1 + ((row - NPROMPT) >> 10);
            const float* g2 = MOD + (size_t)r * 12288 + 5 * DM;
            float ss = 0.f;
#pragma unroll
            for (int j = 0; j < 8; ++j) { const int c = j * 256 + lane * 4; const size_t off = (size_t)row * DM + c;
                const f32x4 x0 = *(const f32x4*)(XM + off), ga = *(const f32x4*)(g2 + c);
                const f32x2 oa = tt == 0 ? out0[2 * j] : (tt == 1 ? out1[2 * j] : out2[2 * j]), ob = tt == 0 ? out0[2 * j + 1] : (tt == 1 ? out1[2 * j + 1] : out2[2 * j + 1]);
                const f32x4 xo = x0 + ga * (f32x4){oa.x, oa.y, ob.x, ob.y}; *(f32x4*)(xout + off) = xo;
                ss += (xo[0] * xo[0] + xo[1] * xo[1]) + (xo[2] * xo[2] + xo[3] * xo[3]); }
            if (n1fuse) { const float* n1gain = a.in[11] + DM; const float* n1mod = (const float*)(ws + WS_MOD) + (size_t)3 * 12288;
                const float rstd = 1.0f / sqrtf(wave_sum(ss) * (1.0f / DM) + EPS); const float* sh = n1mod + (size_t)r * 12288; const float* sc = sh + DM; bf16* Hw = (bf16*)(ws + WS_H);
#pragma unroll
                for (int j = 0; j < 8; ++j) { const int c = j * 256 + lane * 4; const size_t off = (size_t)row * DM + c;
                    const f32x4 x0 = *(const f32x4*)(XM + off), ga = *(const f32x4*)(g2 + c);
                    const f32x2 oa = tt == 0 ? out0[2 * j] : (tt == 1 ? out1[2 * j] : out2[2 * j]), ob = tt == 0 ? out0[2 * j + 1] : (tt == 1 ? out1[2 * j + 1] : out2[2 * j + 1]);
                    const f32x4 xo = x0 + ga * (f32x4){oa.x, oa.y, ob.x, ob.y};
                    const f32x4 gn = *(const f32x4*)(n1gain + c), s1 = *(const f32x4*)(sc + c), s0 = *(const f32x4*)(sh + c);
                    const f32x4 o = xo * rstd * gn * (s1 + 1.0f) + s0; *(v2u*)(Hw + (size_t)row * DM + c) = (v2u){pk2(o[0], o[1]), pk2(o[2], o[3])}; }
            }
        }
        asm volatile("" ::: "memory");
    }
    __syncthreads();
}
#undef PEER_ACC

__device__ __forceinline__ unsigned dg_hash(unsigned x) { x ^= x >> 16; x *= 0x7feb352du; x ^= x >> 15; x *= 0x846ca68bu; x ^= x >> 16; return x; }
__device__ __forceinline__ void dummy_gather(unsigned char* ws, int mode, int G) {
    ws = fresh_ws(ws); const int tid = fresh_tid(), lane = tid & 63, wave = __builtin_amdgcn_readfirstlane(tid >> 6);
    const unsigned char* UV8 = ws + WS_UV8; const int gw = blockIdx.x * 8 + wave;
    f32x2 hv[16], out[16];
#pragma unroll
    for (int i = 0; i < 16; ++i) { hv[i] = (f32x2){(float)(lane + i) * 0.001f, (float)(lane - i) * 0.002f}; out[i] = (f32x2){0.f, 0.f}; }
    for (int jb = 0; jb < 384; jb += 4) {
        int e[4];
#pragma unroll
        for (int t = 0; t < 4; ++t) { const unsigned hsh = dg_hash((unsigned)(gw * 384 + jb + t) * 2654435761u + 12345u); e[t] = mode == 0 ? (int)(hsh & 16383u) : (int)((((unsigned)(jb + t) / 12u) << 9) | (hsh & 511u)); }
        v4u w[4][4];
#pragma unroll
        for (int t = 0; t < 4; ++t) { const unsigned char* base = UV8 + (size_t)e[t] * 4096 + lane * 32;
            w[t][0] = *(const v4u*)base; w[t][1] = *(const v4u*)(base + 16); w[t][2] = *(const v4u*)(base + 2048); w[t][3] = *(const v4u*)(base + 2048 + 16); }
        float d[4];
#pragma unroll
        for (int t = 0; t < 4; ++t) { f32x2 s = {0.f, 0.f};
#pragma unroll
            for (int j = 0; j < 8; ++j) { const int q = (int)w[t][j >> 2][j & 3];
                s = __builtin_elementwise_fma(__builtin_amdgcn_cvt_pk_f32_fp8(q, false), hv[2 * j], s); s = __builtin_elementwise_fma(__builtin_amdgcn_cvt_pk_f32_fp8(q, true), hv[2 * j + 1], s); }
            d[t] = s.x + s.y; }
#pragma unroll
        for (int o = 1; o < 64; o <<= 1) {
#pragma unroll
            for (int t = 0; t < 4; ++t) d[t] += __shfl_xor(d[t], o); }
#pragma unroll
        for (int t = 0; t < 4; ++t) { const float wg = d[t] * 1e-3f; const f32x2 wg2 = {wg, wg};
#pragma unroll
            for (int j = 0; j < 8; ++j) { const int q = (int)w[t][2 + (j >> 2)][j & 3];
                out[2 * j] = __builtin_elementwise_fma(__builtin_amdgcn_cvt_pk_f32_fp8(q, false), wg2, out[2 * j]); out[2 * j + 1] = __builtin_elementwise_fma(__builtin_amdgcn_cvt_pk_f32_fp8(q, true), wg2, out[2 * j + 1]); } }
    }
    float* scratch = (float*)(ws + WS_PE);
    float acc = 0.f;
#pragma unroll
    for (int i = 0; i < 16; ++i) acc += out[i].x + out[i].y;
    scratch[(size_t)gw * 64 + lane] = acc;
}
__global__ void __launch_bounds__(512, 2) mk_fwd(Args args) {
    extern __shared__ __attribute__((aligned(16))) unsigned char lds_raw[];
    LAS unsigned char* lds = (LAS unsigned char*)lds_raw;
    const int G = gridDim.x;
    unsigned char* ws = args.ws;
    unsigned* ctl = (unsigned*)(ws + WS_CTL);
    for (int u = threadIdx.x; u < RING_OFF / 4; u += 512) ((LAS unsigned*)lds)[u] = 0u;
    __syncthreads();
    const int lo = args.ph_lo, hi = args.ph_hi;
    XcdBarrier bar; bar.bar = ctl + CW_BAR; bar.x = 0; bar.st = (volatile LAS unsigned*)(lds + 32);
    if (hi - lo > 1) bar = xcd_barrier_post(ctl + CW_BAR, (volatile LAS unsigned*)(lds + 32));
#ifndef PH_EN
#define PH_EN 0xfff
#endif
#define PHEN(k) (((PH_EN) >> (k)) & 1)
#ifndef PROBE_DUP
#define PROBE_DUP 0
#endif
#define NREP(k) ((((PROBE_DUP) >> (k)) & 1) ? 2 : 1)
#define IN(k) (lo <= (k) && (k) < hi)
#define SEAM(k) do { if (IN(k) && IN((k) + 1)) xcd_barrier(bar); } while (0)

#ifndef PROBE_XBAR
#define PROBE_XBAR 0
#endif
    if (PHEN(0) && IN(0)) { for (int rep = 0; rep < NREP(0); ++rep) p0_prologue(args, ws, lds, G, lo == 0 && hi == NPH && G == 256); }
    SEAM(0);

    for (int l = 0; l < 2; ++l) {
        ws = fresh_ws(ws);
        const int pb = 1 + 11 * l;
#define MODall ((const float*)(ws + WS_MOD))
#define Hb ((bf16*)(ws + WS_H))
#define Zb ((bf16*)(ws + WS_Z))
        const float* xin_p = l == 0 ? args.in[0] : (const float*)(ws + WS_X1);
        const float* xin_s = l == 0 ? args.in[1] : (const float*)(ws + WS_X1) + (size_t)NPROMPT * DM;
        const float* modl = MODall + (size_t)l * 3 * 12288;
        for (int xb = 0; xb < PROBE_XBAR; ++xb) xcd_barrier(bar);
        const bool n1fused = lo == 0 && hi == NPH;
        const bool defer = lo == 0 && hi == NPH && G == 256 && (int)blockIdx.x >= 192;
        if (!(l == 1 && n1fused)) {
            if (PHEN(1) && IN(pb + 0)) for (int rep = 0; rep < NREP(1); ++rep) norm_phase(xin_p, xin_s, args.in[11] + (size_t)l * DM, modl, 0, 1, Hb, G);
            SEAM(pb + 0);
        }
        if (PHEN(2) && IN(pb + 1)) for (int rep = 0; rep < NREP(2); ++rep) { ws = fresh_ws(ws);
            pg8::Gemm g{Hb, (const bf16*)(ws + WS_WIN) + (size_t)l * INW * DM, NTOK, INW, DM}; pg8::StaticOrder S; S.init(NTOK, INW, G, (int)blockIdx.x);
            pg8::EpiBf16<0> E{Zb, INW, nullptr, 0, 0, 1.f};
            pg8::gemm_phase<pg8::EpiBf16<0>, pg8::StaticOrder, true, true>(lds + RING_OFF, g, S, E);
        }
        SEAM(pb + 1);
        const bool early = IN(pb + 2) && IN(pb + 3) && G > 64;
        if (early && (int)blockIdx.x < 32) { hgrn_item(args, ws, lds, l, (int)blockIdx.x, &bar, 16); }
        else {
            if (PHEN(3) && IN(pb + 2)) for (int rep = 0; rep < NREP(3); ++rep) prep_phase(args, ws, l, early ? 32 : 0, early ? G - 32 : G);
            SEAM(pb + 2);
            if (PHEN(4) && IN(pb + 3)) for (int rep = 0; rep < NREP(4); ++rep) {
                const int bx = blockIdx.x;
                if (G > 64 && bx < 32) { for (int rp = 0; rp < NREP(12); ++rp) hgrn_item(args, ws, lds, l, bx); }
                else {
                    const int u0 = G > 64 ? bx - 32 : bx, us = G > 64 ? G - 32 : G;
                    if (G <= 64) for (int u = bx; u < 32; u += G) hgrn_item(args, ws, lds, l, u);
                    for (int rp = 0; rp < NREP(12); ++rp)
                    for (int u = u0; u < 832; u += us) if (u >= 192 && u < 448) hgrn_item(args, ws, lds, l, 32 + (u - 192));
                    for (int rp = 0; rp < NREP(13); ++rp)
                    for (int u = u0; u < 832; u += us) if (u < 192 || u >= 448) attn_unit(ws, (char*)lds_raw, u < 192 ? u : 192 + (u - 448));
                }
            }
        }
        SEAM(pb + 3);
        if (PHEN(5) && IN(pb + 4)) for (int rep = 0; rep < NREP(5); ++rep) post_phase(args, ws, l, G);
        SEAM(pb + 4);
        if (PHEN(6) && IN(pb + 5)) for (int rep = 0; rep < NREP(6); ++rep) { ws = fresh_ws(ws);
            pg8::StaticOrder S; S.init(NTOK, DM, G, (int)blockIdx.x);
            for (int c = 0; c < 3; ++c) {
                pg8::Gemm g{(const bf16*)(ws + WS_BR) + (size_t)c * NTOK * 1024, (const bf16*)(ws + WS_WBR) + (size_t)(l * 3 + c) * DM * 1024, NTOK, DM, 1024};
                pg8::EpiGate E{Zb, INW, C_GATE + c * DM, (bf16*)(ws + WS_MGP), (bf16*)(ws + WS_MG), DM, c};
                pg8::gemm_phase<pg8::EpiGate, pg8::StaticOrder, true, true>(lds + RING_OFF, g, S, E);
            }
            if (defer) fp8_rows_deferred(args, ws, 3 * l + 0);
        }
        SEAM(pb + 5);
        if (PHEN(7) && IN(pb + 6)) for (int rep = 0; rep < NREP(7); ++rep) { ws = fresh_ws(ws);
            pg8::Gemm g{(const bf16*)(ws + WS_MG), (const bf16*)(ws + WS_WOUT) + (size_t)l * DM * DM, NTOK, DM, DM}; pg8::StaticOrder S; S.init(NTOK, DM, G, (int)blockIdx.x);
            pg8::EpiResid E{xin_p, xin_s, modl + 2 * DM, (float*)(ws + WS_XM)};
            pg8::gemm_phase<pg8::EpiResid, pg8::StaticOrder, true, true>(lds + RING_OFF, g, S, E);
            if (defer) fp8_rows_deferred(args, ws, 3 * l + 1);
        }
        SEAM(pb + 6);
        if (PHEN(8) && IN(pb + 7)) for (int rep = 0; rep < NREP(8); ++rep) norm_phase((const float*)(ws + WS_XM), (const float*)(ws + WS_XM) + (size_t)NPROMPT * DM, args.in[12] + (size_t)l * DM, modl, 3, 4, Hb, G);
        SEAM(pb + 7);
        if (PHEN(9) && IN(pb + 8)) for (int rep = 0; rep < NREP(9); ++rep) { ws = fresh_ws(ws);
            pg8::Gemm g{Hb, (const bf16*)(ws + WS_WPQ) + (size_t)l * DM * DM, NTOK, DM, DM}; pg8::StaticOrder S; S.init(NTOK, DM, G, (int)blockIdx.x);
            pg8::EpiBf16<0> E{(bf16*)(ws + WS_QP), DM, nullptr, 0, 0, 1.f};
            pg8::gemm_phase<pg8::EpiBf16<0>, pg8::StaticOrder, true, true>(lds + RING_OFF, g, S, E);
            if (defer) fp8_rows_deferred(args, ws, 3 * l + 2);
        }
        SEAM(pb + 8);
#ifdef PROBE_DG
        dummy_gather(ws, PROBE_DG, G);
#endif
        if (PHEN(10) && IN(pb + 9)) for (int rep = 0; rep < NREP(10); ++rep) peer_topk_phase(args, ws, lds, l, G);
        SEAM(pb + 9);
        if (PHEN(11) && IN(pb + 10)) for (int rep = 0; rep < NREP(11); ++rep) peer_gather_phase(args, ws, lds, l, l == 0 ? (float*)(ws + WS_X1) : args.out, G, 0xffffu, 0, l == 0 && n1fused);
#ifdef PROBE_GM
        peer_gather_phase(args, ws, lds, l, (float*)(ws + WS_QA), G, PROBE_GM, 0);
#endif
        if (l == 0) SEAM(pb + 10);
    }
#undef MODall
#undef Hb
#undef Zb
#undef IN
#undef SEAM
}

extern "C" void kernel_launch(void* const* d_in, const int* in_sizes, int n_in, void* d_out, int out_size, void* d_ws, size_t ws_size, hipStream_t stream) {
    static int grid = 0;
    if (grid == 0) {
        if (n_in != 26 || (size_t)out_size != OUT_TOTAL || ws_size < WS_END) { fprintf(stderr, "kernel_launch: shape mismatch: n_in %d out %d ws %zu (need %zu)\n", n_in, out_size, ws_size, (size_t)WS_END); grid = -1; return; }
        int dev = 0, cus = 0, per_cu = 0;
        if (hipGetDevice(&dev) != hipSuccess || hipDeviceGetAttribute(&cus, hipDeviceAttributeMultiprocessorCount, dev) != hipSuccess) { grid = -1; return; }
        if (hipFuncSetAttribute((const void*)mk_fwd, hipFuncAttributeMaxDynamicSharedMemorySize, LDS_BYTES) != hipSuccess) { fprintf(stderr, "kernel_launch: hipFuncSetAttribute failed\n"); grid = -1; return; }
        if (hipOccupancyMaxActiveBlocksPerMultiprocessor(&per_cu, (const void*)mk_fwd, 512, LDS_BYTES) != hipSuccess || per_cu < 1) { fprintf(stderr, "kernel_launch: occupancy query says %d\n", per_cu); per_cu = 1; }
        (void)hipGetLastError();
        grid = cus;
    }
    if (grid < 0) return;
    (void)hipMemsetAsync((char*)d_ws + WS_CTL, 0, CTL_ZERO_BYTES, stream);
    Args a{};
    for (int i = 0; i < 26; ++i) a.in[i] = (const float*)d_in[i];
    a.out = (float*)d_out; a.ws = (unsigned char*)d_ws;
#if N_LAUNCH_MODE == 0
    a.ph_lo = 0; a.ph_hi = NPH;
    hipLaunchKernelGGL(mk_fwd, dim3(grid), dim3(512), LDS_BYTES, stream, a);
#else
    for (int p = 0; p < NPH; ++p) { a.ph_lo = p; a.ph_hi = p + 1; hipLaunchKernelGGL(mk_fwd, dim3(grid), dim3(512), LDS_BYTES, stream, a); }
#endif
    const hipError_t le = hipPeekAtLastError();
    if (le != hipSuccess) fprintf(stderr, "kernel_launch: launch failed: %s\n", hipGetErrorName(le));
}
```

```cpp
#include <hip/hip_runtime.h>
#include <hip/hip_bf16.h>
#include <cstdio>
#include <cstdint>
#include <cmath>
#define PROBE_DUP 0
#define HG_PROBE 0
#define PROBE_XBAR 0
#ifndef N_LAUNCH_MODE
#define N_LAUNCH_MODE 0
#endif
__device__ __forceinline__ int fresh_tid() { int t = (int)threadIdx.x; asm volatile("" : "+v"(t)); return t; }
__device__ __forceinline__ unsigned char* fresh_ws(unsigned char* p) { asm volatile("" : "+s"(p)); return p; }
namespace pg8 {
#define PG8_LAS __attribute__((address_space(3)))
typedef unsigned short bf16_t;
typedef short bf16x8 __attribute__((ext_vector_type(8)));
typedef float f32x4 __attribute__((ext_vector_type(4)));
typedef unsigned u32x4 __attribute__((ext_vector_type(4)));
constexpr int BM = 256, BK = 64, HALF = 128, HTB = HALF * BK * 2  , STAGE_BYTES = 8 * HTB, NXCD = 8, WGM = 8;

__host__ __device__ __forceinline__ int lds_byte(int r, int c) { const int st = (r >> 4) * 2 + (c >> 5), rr = r & 15, cc = c & 31, ob = rr * 64 + cc * 2; return st * 1024 + (ob ^ (((ob >> 9) & 1) << 5)); }
__host__ __device__ __forceinline__ void stage_rc(int b, int& R, int& C) { const int st = b / 1024, sb = b % 1024, swz = sb ^ (((sb >> 9) & 1) << 5); R = (st >> 1) * 16 + swz / 64; C = (st & 1) * 32 + (swz % 64) / 2; }
__host__ __device__ __forceinline__ int perm32(int rho) { const int n = rho >> 4, i = rho & 15; return 8 * (i >> 2) + 4 * n + (i & 3); }

struct Unit { int pm, pn; };
struct Gemm { const bf16_t* A; const bf16_t* Bt; int M, N, K; };

struct StaticOrder {
    int nM, nN, nwg, G, c;
    __host__ __device__ void init(int M, int N, int G_, int c_) { nM = M / BM; nN = N / BM; nwg = nM * nN; G = G_; c = c_; }
    __host__ __device__ bool next(int i, Unit& u) const {
        const long L = (long)i * G + c; if (L >= nwg) return false;
        int wgid = (int)L; { const int q = nwg / NXCD, r = nwg % NXCD, xcd = wgid % NXCD, off = wgid / NXCD; wgid = (xcd < r ? xcd * (q + 1) : r * (q + 1) + (xcd - r) * q) + off; }
        const int nig = WGM * nN, gid = wgid / nig, fm = gid * WGM, gsz = (nM - fm) < WGM ? (nM - fm) : WGM;
        u.pm = fm + ((wgid % nig) % gsz); u.pn = (wgid % nig) / gsz; return true;
    }
    __device__ __forceinline__ void a_ready(const Unit&) const {}
    __device__ __forceinline__ void done(const Unit&) const {}
};

__device__ __forceinline__ unsigned cvt_pk_bf16(float lo, float hi) { unsigned r; asm volatile("v_cvt_pk_bf16_f32 %0, %1, %2" : "=v"(r) : "v"(lo), "v"(hi)); return r; }
typedef float f32x2 __attribute__((ext_vector_type(2)));
__device__ __forceinline__ f32x2 gelu_pk(f32x2 v) {
    const f32x2 av = __builtin_elementwise_abs(v), d = av * 0.2316418882f + 1.0f;
    f32x2 t; t.x = __builtin_amdgcn_rcpf(d.x); t.y = __builtin_amdgcn_rcpf(d.y);
    f32x2 q = t * 0.5307027145f + (-0.7265760135f); q = q * t + 0.7107068705f; q = q * t + (-0.142248368f); q = q * t + 0.127414796f; q = q * t;
    const f32x2 s = (v * v) * (-0.72134752044f);
    f32x2 e; e.x = __builtin_amdgcn_exp2f(s.x); e.y = __builtin_amdgcn_exp2f(s.y);
    const f32x2 m = v * (q * e), r = v - m;
    f32x2 o; o.x = v.x < 0.f ? m.x : r.x; o.y = v.y < 0.f ? m.y : r.y; return o;
}

template <int ACT  > struct EpiBf16 {
    static constexpr bool PERM = true, AFTER_DRAIN = false; static_assert(ACT == 0 || ACT == 1, "EpiBf16: ACT is 0 (none) or 1 (gelu_pk)");
    bf16_t* O; int ldc; const float* bias; int split_cols; size_t split_stride; float scale0;
    __device__ __forceinline__ void operator()(const f32x4 (&acc)[2][2][4][2], const Unit& u, int wr, int wc, int fr, int fq) const {
        const int row0 = u.pm * BM + wr * 64 + fr; int colt = u.pn * BM; bf16_t* base = O;
        float sc = 1.f; if (split_cols) { const int t = colt / split_cols; base += (size_t)t * split_stride; colt -= t * split_cols; if (t == 0) sc = scale0; }
        const int col0 = colt + wc * 32 + 8 * fq, bcol0 = u.pn * BM + wc * 32 + 8 * fq;
        f32x4 bv[2][2];
#pragma unroll
        for (int bj = 0; bj < 2; ++bj)
#pragma unroll
            for (int n = 0; n < 2; ++n) bv[bj][n] = bias ? *(const f32x4*)(bias + bcol0 + bj * HALF + 4 * n) : (f32x4){0.f, 0.f, 0.f, 0.f};
#pragma unroll
        for (int ai = 0; ai < 2; ++ai)
#pragma unroll
            for (int m = 0; m < 4; ++m) { bf16_t* rowp = base + (size_t)(row0 + ai * HALF + m * 16) * ldc + col0;
#pragma unroll
                for (int bj = 0; bj < 2; ++bj) { f32x4 v0 = acc[ai][bj][m][0] + bv[bj][0], v1 = acc[ai][bj][m][1] + bv[bj][1];
                    if (ACT == 1) { f32x2 a = gelu_pk((f32x2){v0[0], v0[1]}), b = gelu_pk((f32x2){v0[2], v0[3]}), c = gelu_pk((f32x2){v1[0], v1[1]}), d = gelu_pk((f32x2){v1[2], v1[3]});
                        v0 = (f32x4){a.x, a.y, b.x, b.y}; v1 = (f32x4){c.x, c.y, d.x, d.y}; }
                    v0 = v0 * sc; v1 = v1 * sc; u32x4 w; w.x = cvt_pk_bf16(v0[0], v0[1]); w.y = cvt_pk_bf16(v0[2], v0[3]); w.z = cvt_pk_bf16(v1[0], v1[1]); w.w = cvt_pk_bf16(v1[2], v1[3]);
                    *(u32x4*)(rowp + bj * HALF) = w; } }
    }
};

struct EpiF32 {
    static constexpr bool PERM = false, AFTER_DRAIN = false;
    float* C; int ldc;
    __device__ __forceinline__ void operator()(const f32x4 (&acc)[2][2][4][2], const Unit& u, int wr, int wc, int fr, int fq) const {
        const int row0 = u.pm * BM + wr * 64 + fr, col0 = u.pn * BM + wc * 32 + 4 * fq;
#pragma unroll
        for (int ai = 0; ai < 2; ++ai)
#pragma unroll
            for (int m = 0; m < 4; ++m) { float* rowp = C + (size_t)(row0 + ai * HALF + m * 16) * ldc + col0;
#pragma unroll
                for (int bj = 0; bj < 2; ++bj)
#pragma unroll
                    for (int n = 0; n < 2; ++n) *(f32x4*)(rowp + bj * HALF + n * 16) = acc[ai][bj][m][n]; }
    }
};
__device__ __forceinline__ float sigmoid_f(float x) { return __builtin_amdgcn_rcpf(1.0f + __builtin_amdgcn_exp2f(-1.4426950408889634f * x)); }
struct EpiGate {
    static constexpr bool PERM = true, AFTER_DRAIN = false;
    const bf16_t* Z; int ldz; int gcol0; bf16_t* P; bf16_t* O; int ldc; int MODE;
    __device__ __forceinline__ void operator()(const f32x4 (&acc)[2][2][4][2], const Unit& u, int wr, int wc, int fr, int fq) const {
        const int row0 = u.pm * BM + wr * 64 + fr, col0 = u.pn * BM + wc * 32 + 8 * fq;
#pragma unroll
        for (int ai = 0; ai < 2; ++ai)
#pragma unroll
            for (int m = 0; m < 4; ++m) { const int row = row0 + ai * HALF + m * 16;
#pragma unroll
                for (int bj = 0; bj < 2; ++bj) { const int col = col0 + bj * HALF;
                    const u32x4 gz = *(const u32x4*)(Z + (size_t)row * ldz + gcol0 + col);
                    f32x4 s0, s1;
                    s0[0] = sigmoid_f(__uint_as_float(gz[0] << 16)); s0[1] = sigmoid_f(__uint_as_float(gz[0] & 0xffff0000u));
                    s0[2] = sigmoid_f(__uint_as_float(gz[1] << 16)); s0[3] = sigmoid_f(__uint_as_float(gz[1] & 0xffff0000u));
                    s1[0] = sigmoid_f(__uint_as_float(gz[2] << 16)); s1[1] = sigmoid_f(__uint_as_float(gz[2] & 0xffff0000u));
                    s1[2] = sigmoid_f(__uint_as_float(gz[3] << 16)); s1[3] = sigmoid_f(__uint_as_float(gz[3] & 0xffff0000u));
                    f32x4 v0 = acc[ai][bj][m][0] * s0, v1 = acc[ai][bj][m][1] * s1;
                    bf16_t* pp = P + (size_t)row * ldc + col;
                    if (MODE >= 1) { const u32x4 pw = *(const u32x4*)pp;
                        v0[0] += __uint_as_float(pw[0] << 16); v0[1] += __uint_as_float(pw[0] & 0xffff0000u); v0[2] += __uint_as_float(pw[1] << 16); v0[3] += __uint_as_float(pw[1] & 0xffff0000u);
                        v1[0] += __uint_as_float(pw[2] << 16); v1[1] += __uint_as_float(pw[2] & 0xffff0000u); v1[2] += __uint_as_float(pw[3] << 16); v1[3] += __uint_as_float(pw[3] & 0xffff0000u); }
                    u32x4 w; w.x = cvt_pk_bf16(v0[0], v0[1]); w.y = cvt_pk_bf16(v0[2], v0[3]); w.z = cvt_pk_bf16(v1[0], v1[1]); w.w = cvt_pk_bf16(v1[2], v1[3]);
                    *(u32x4*)((MODE <= 1 ? pp : O + (size_t)row * ldc + col)) = w; } }
    }
};
struct EpiResid {
    static constexpr bool PERM = false, AFTER_DRAIN = false;
    const float* xp; const float* xs; const float* gate; float* out;
    __device__ __forceinline__ void operator()(const f32x4 (&acc)[2][2][4][2], const Unit& u, int wr, int wc, int fr, int fq) const {
        const int row0 = u.pm * BM + wr * 64 + fr, col0 = u.pn * BM + wc * 32 + 4 * fq;
        const bool samp = u.pm >= 16; const int r = samp ? 1 + ((u.pm - 16) >> 2) : 0;
        const float* xb = samp ? xs - (size_t)4096 * 2048 : xp;
        f32x4 gv[2][2];
#pragma unroll
        for (int bj = 0; bj < 2; ++bj)
#pragma unroll
            for (int n = 0; n < 2; ++n) gv[bj][n] = *(const f32x4*)(gate + (size_t)r * 12288 + col0 + bj * HALF + n * 16);
#pragma unroll
        for (int ai = 0; ai < 2; ++ai)
#pragma unroll
            for (int m = 0; m < 4; ++m) { const size_t off = (size_t)(row0 + ai * HALF + m * 16) * 2048 + col0;
#pragma unroll
                for (int bj = 0; bj < 2; ++bj)
#pragma unroll
                    for (int n = 0; n < 2; ++n) { const f32x4 x = *(const f32x4*)(xb + off + bj * HALF + n * 16);
                        *(f32x4*)(out + off + bj * HALF + n * 16) = x + gv[bj][n] * acc[ai][bj][m][n]; } }
    }
};

template <class Epi, class Sched, bool ALIGN_EPI = false, bool SP2 = false>
__device__ __forceinline__ void gemm_phase(PG8_LAS unsigned char* lds, const Gemm g, const Sched& S, const Epi& E) {
    const int tid = fresh_tid(), wid = __builtin_amdgcn_readfirstlane(tid >> 6), lane = tid & 63, wr = wid >> 2, wc = wid & 3, fr = lane & 15, fq = lane >> 4;
    const int K = g.K, nt = K / BK;
    unsigned voffA[2], voffB[2];
#pragma unroll
    for (int i = 0; i < 2; ++i) { int R, C; stage_rc(tid * 16 + i * 8192, R, C); const int Rb = Epi::PERM ? ((R & ~31) + perm32(R & 31)) : R;
        voffA[i] = (unsigned)(R * K + C) * 2u; voffB[i] = (unsigned)(Rb * K + C) * 2u; }
    const size_t kstep = (size_t)(BK * 2);
    const size_t hstep = (size_t)HALF * K * 2;
    const size_t tstep = 2 * hstep;
    const unsigned ldsw = (unsigned)wid * 1024u;
    const int aoff = lds_byte(wr * 64 + fr, fq * 8), boff = lds_byte(wc * 32 + fr, fq * 8);
#define PG8_SA(b, h) (((b) * 2 + (h)) * HTB)
#define PG8_SB(b, h) ((4 + (b) * 2 + (h)) * HTB)
#define PG8_STAGE(bufoff, gbase, voff) do { _Pragma("unroll") for (int _i = 0; _i < 2; ++_i) \
        __builtin_amdgcn_global_load_lds((const unsigned*)((const char*)(gbase) + (voff)[_i]), (PG8_LAS unsigned*)(lds + (bufoff) + ldsw + _i * 8192), 16, 0, 0); } while (0)
#define PG8_LDA(dst, b, h) do { _Pragma("unroll") for (int m = 0; m < 4; ++m) _Pragma("unroll") for (int k = 0; k < 2; ++k) dst[m][k] = *(const PG8_LAS bf16x8*)(lds + PG8_SA(b, h) + aoff + m * 2048 + k * 1024); } while (0)
#define PG8_LDB(dst, b, h) do { _Pragma("unroll") for (int n = 0; n < 2; ++n) _Pragma("unroll") for (int k = 0; k < 2; ++k) dst[n][k] = *(const PG8_LAS bf16x8*)(lds + PG8_SB(b, h) + boff + n * 2048 + k * 1024); } while (0)
#define PG8_MMA(ai, bj, At, Bt) do { __builtin_amdgcn_s_setprio(1); _Pragma("unroll") for (int m = 0; m < 4; ++m) _Pragma("unroll") for (int n = 0; n < 2; ++n) _Pragma("unroll") for (int k = 0; k < 2; ++k) \
        acc[ai][bj][m][n] = __builtin_amdgcn_mfma_f32_16x16x32_bf16(Bt[n][k], At[m][k], acc[ai][bj][m][n], 0, 0, 0); __builtin_amdgcn_s_setprio(0); } while (0)
#define PG8_WAIT_V(n) asm volatile("s_waitcnt vmcnt(" #n ")" ::: "memory")
#define PG8_WAIT_L(n) asm volatile("s_waitcnt lgkmcnt(" #n ")" ::: "memory")
#define PG8_BAR __builtin_amdgcn_s_barrier()
#define PG8_SCHED __builtin_amdgcn_sched_barrier(0)
    Unit cur, nxt; int ui = 0;
    if (!S.next(0, cur)) return;
    f32x4 acc[2][2][4][2];
#pragma unroll
    for (int a = 0; a < 2; ++a)
#pragma unroll
        for (int b = 0; b < 2; ++b)
#pragma unroll
            for (int m = 0; m < 4; ++m)
#pragma unroll
                for (int n = 0; n < 2; ++n) acc[a][b][m][n] = (f32x4){0.f, 0.f, 0.f, 0.f};
    bf16x8 At[4][2], B0[2][2], B1[2][2];
    const char* cA = (const char*)g.A + (size_t)cur.pm * tstep; const char* cB = (const char*)g.Bt + (size_t)cur.pn * tstep;
    S.a_ready(cur);
    if constexpr (SP2) {
        PG8_STAGE(PG8_SB(0, 0), cB, voffB); PG8_STAGE(PG8_SB(0, 1), cB + hstep, voffB); PG8_STAGE(PG8_SA(0, 0), cA, voffA); PG8_STAGE(PG8_SA(0, 1), cA + hstep, voffA);
        if (wr == 1) PG8_BAR;
        PG8_WAIT_V(2); PG8_BAR;
        PG8_STAGE(PG8_SB(1, 0), cB + kstep, voffB); PG8_STAGE(PG8_SA(1, 0), cA + kstep, voffA); PG8_STAGE(PG8_SB(1, 1), cB + hstep + kstep, voffB);
        PG8_WAIT_V(6); PG8_BAR;
    } else {
        PG8_STAGE(PG8_SB(0, 0), cB, voffB); PG8_STAGE(PG8_SA(0, 0), cA, voffA); PG8_STAGE(PG8_SB(0, 1), cB + hstep, voffB); PG8_STAGE(PG8_SA(0, 1), cA + hstep, voffA);
        if (wr == 1) PG8_BAR;
        PG8_WAIT_V(4); PG8_BAR;
        PG8_STAGE(PG8_SB(1, 0), cB + kstep, voffB); PG8_STAGE(PG8_SA(1, 0), cA + kstep, voffA); PG8_STAGE(PG8_SB(1, 1), cB + hstep + kstep, voffB);
        PG8_WAIT_V(6); PG8_BAR;
    }
    for (;;) {
        const bool has_next = S.next(ui + 1, nxt);
        const char* nA = has_next ? (const char*)g.A + (size_t)nxt.pm * tstep : cA; const char* nB = has_next ? (const char*)g.Bt + (size_t)nxt.pn * tstep : cB;
        for (int t = 0; t < nt; t += 2) {
            const bool last = (t == nt - 2);
            const char* a1 = cA + (size_t)(t + 1) * kstep;
            const char* a2 = last ? nA : cA + (size_t)(t + 2) * kstep; const char* b2 = last ? nB : cB + (size_t)(t + 2) * kstep;
            const char* a3 = a2 + kstep; const char* b3 = b2 + kstep;
            if (last && has_next) S.a_ready(nxt);
            if constexpr (SP2) {
            PG8_LDB(B0, 0, 0); PG8_LDB(B1, 0, 1); PG8_SCHED; PG8_LDA(At, 0, 0); PG8_STAGE(PG8_SA(1, 1), a1 + hstep, voffA);
            PG8_WAIT_V(8); PG8_WAIT_L(0); PG8_BAR; PG8_MMA(0, 0, At, B0); PG8_MMA(0, 1, At, B1); PG8_BAR; PG8_SCHED;
            PG8_LDA(At, 0, 1); PG8_STAGE(PG8_SB(0, 0), b2, voffB); PG8_STAGE(PG8_SB(0, 1), b2 + hstep, voffB); PG8_STAGE(PG8_SA(0, 0), a2, voffA);
            PG8_WAIT_V(8); PG8_WAIT_L(0); PG8_BAR; PG8_MMA(1, 0, At, B0); PG8_MMA(1, 1, At, B1); PG8_BAR; PG8_SCHED;
            PG8_LDB(B0, 1, 0); PG8_LDB(B1, 1, 1); PG8_SCHED; PG8_LDA(At, 1, 0); PG8_STAGE(PG8_SA(0, 1), a2 + hstep, voffA);
            PG8_WAIT_V(8); PG8_WAIT_L(0); PG8_BAR; PG8_MMA(0, 0, At, B0); PG8_MMA(0, 1, At, B1); PG8_BAR; PG8_SCHED;
            PG8_LDA(At, 1, 1); PG8_STAGE(PG8_SB(1, 0), b3, voffB); PG8_STAGE(PG8_SB(1, 1), b3 + hstep, voffB); PG8_STAGE(PG8_SA(1, 0), a3, voffA);
            PG8_WAIT_V(8); PG8_WAIT_L(0); PG8_BAR; PG8_MMA(1, 0, At, B0); PG8_MMA(1, 1, At, B1); PG8_BAR; PG8_SCHED;
            } else {
            PG8_LDB(B0, 0, 0); PG8_SCHED; PG8_LDA(At, 0, 0); PG8_STAGE(PG8_SA(1, 1), a1 + hstep, voffA);
            PG8_WAIT_L(8); PG8_BAR; PG8_WAIT_L(0); PG8_MMA(0, 0, At, B0); PG8_BAR; PG8_SCHED;
            PG8_LDB(B1, 0, 1); PG8_STAGE(PG8_SB(0, 0), b2, voffB);
            PG8_BAR; PG8_WAIT_L(0); PG8_MMA(0, 1, At, B1); PG8_BAR;
            PG8_LDA(At, 0, 1); PG8_STAGE(PG8_SA(0, 0), a2, voffA);
            PG8_BAR; PG8_WAIT_L(0); PG8_MMA(1, 0, At, B0); PG8_BAR; PG8_SCHED;
            PG8_STAGE(PG8_SB(0, 1), b2 + hstep, voffB);
            PG8_WAIT_V(6); PG8_BAR; PG8_MMA(1, 1, At, B1); PG8_BAR;
            PG8_LDB(B0, 1, 0); PG8_SCHED; PG8_LDA(At, 1, 0); PG8_STAGE(PG8_SA(0, 1), a2 + hstep, voffA);
            PG8_WAIT_L(8); PG8_BAR; PG8_WAIT_L(0); PG8_MMA(0, 0, At, B0); PG8_BAR; PG8_SCHED;
            PG8_LDB(B1, 1, 1); PG8_STAGE(PG8_SB(1, 0), b3, voffB);
            PG8_BAR; PG8_WAIT_L(0); PG8_MMA(0, 1, At, B1); PG8_BAR;
            PG8_LDA(At, 1, 1); PG8_STAGE(PG8_SA(1, 0), a3, voffA);
            PG8_BAR; PG8_WAIT_L(0); PG8_MMA(1, 0, At, B0); PG8_BAR; PG8_SCHED;
            PG8_STAGE(PG8_SB(1, 1), b3 + hstep, voffB);
            PG8_WAIT_V(6); PG8_BAR; PG8_MMA(1, 1, At, B1); PG8_BAR;
            }
        }
        if constexpr (ALIGN_EPI) { if (wr == 0) PG8_BAR; }
        if constexpr (!Epi::AFTER_DRAIN) { E(acc, cur, wr, wc, fr, fq); S.done(cur); }
        if (!has_next) break;
#pragma unroll
        for (int a = 0; a < 2; ++a)
#pragma unroll
            for (int b = 0; b < 2; ++b)
#pragma unroll
                for (int m = 0; m < 4; ++m)
#pragma unroll
                    for (int n = 0; n < 2; ++n) acc[a][b][m][n] = (f32x4){0.f, 0.f, 0.f, 0.f};
        cur = nxt; cA = nA; cB = nB; ++ui;
        if constexpr (ALIGN_EPI) { if (wr == 1) PG8_BAR; }
    }
    PG8_WAIT_V(0);
    if constexpr (!ALIGN_EPI) { if (wr == 0) PG8_BAR; }
    PG8_BAR;
    if constexpr (Epi::AFTER_DRAIN) { E.fused(acc, cur, wr, wc, fr, fq, lds, wid, lane); S.done(cur); }
#undef PG8_SA
#undef PG8_SB
#undef PG8_STAGE
#undef PG8_LDA
#undef PG8_LDB
#undef PG8_MMA
#undef PG8_WAIT_V
#undef PG8_WAIT_L
#undef PG8_BAR
#undef PG8_SCHED
}
}

namespace att {
using bf16 = __hip_bfloat16;
constexpr int D = 128, NW = 8, QBLK = 32, KVBLK = 64;
constexpr float SCALE = 1.0f;
constexpr float THR = 8.f;
constexpr int SDEPTH = 2;
constexpr int LDQ = 3072, LDK = 1280, LDO = 3072;
constexpr size_t SHM_V = KVBLK * D * 2, SHM_K = KVBLK * D * 2, SHM_ATTN = 2 * SHM_V + 2 * SHM_K + NW * 64 * 4;
typedef __bf16 abf16x2_t __attribute__((ext_vector_type(2))); typedef float af32x2_t __attribute__((ext_vector_type(2)));
__device__ __forceinline__ unsigned short bf1(float x) { const af32x2_t v = {x, x}; const abf16x2_t b = __builtin_convertvector(v, abf16x2_t); return (unsigned short)(__builtin_bit_cast(unsigned, b) & 0xffffu); }
using bf16x8 = __attribute__((ext_vector_type(8))) short;
using s16x4  = __attribute__((ext_vector_type(4))) short;
using f32x16 = __attribute__((ext_vector_type(16))) float;
using f32x8  = __attribute__((ext_vector_type(8))) float;
using u32x4  = __attribute__((ext_vector_type(4))) unsigned;
#define KSWZ(row, colB) ((row) * 256 + ((colB) ^ (((row) & 7) << 4)))
#define SBAR() __builtin_amdgcn_sched_barrier(0)
__device__ __forceinline__ int crow(int r, int hi) { return (r & 3) + 8 * (r >> 2) + 4 * hi; }
__device__ __forceinline__ unsigned cvtpk(float lo, float hi) {
  unsigned r; asm volatile("v_cvt_pk_bf16_f32 %0, %1, %2" : "=v"(r) : "v"(lo), "v"(hi)); return r;
}
template <typename TIn> struct Stage;
template <> struct Stage<bf16>  { using T = bf16x8;
  __device__ static __forceinline__ T ld8(const bf16* p) { return *reinterpret_cast<const bf16x8*>(p); }
  __device__ static __forceinline__ bf16x8 tobf(T x) { return x; } };
template <> struct Stage<float> { using T = f32x8;
  __device__ static __forceinline__ T ld8(const float* p) { return *reinterpret_cast<const f32x8*>(p); }
  __device__ static __forceinline__ bf16x8 tobf(T x) {
    u32x4 w = {cvtpk(x[0], x[1]), cvtpk(x[2], x[3]), cvtpk(x[4], x[5]), cvtpk(x[6], x[7])}; return *reinterpret_cast<bf16x8*>(&w); } };

__device__ __forceinline__ void partialSM(f32x16& p0, f32x16& p1, float& m_reg, float& mn, float& alpha) {
  constexpr float C = SCALE * 1.4426950408889634f;
  float pmax = p0[0]; for (int r = 1; r < 16; ++r) pmax = fmaxf(pmax, p0[r]); for (int r = 0; r < 16; ++r) pmax = fmaxf(pmax, p1[r]);
  { auto rr = __builtin_amdgcn_permlane32_swap(__float_as_uint(pmax), __float_as_uint(pmax), false, false);
    pmax = fmaxf(__uint_as_float(rr[0]), __uint_as_float(rr[1])); }
  if (__builtin_expect(__all(pmax - m_reg <= THR / SCALE), 1)) { mn = m_reg; alpha = 1.f; }
  else { mn = fmaxf(m_reg, pmax); alpha = __builtin_amdgcn_exp2f((m_reg - mn) * C); m_reg = mn; }
  float mnC = -mn * C;
  for (int r = 0; r < 16; ++r) p0[r] = fmaf(p0[r], C, mnC); for (int r = 0; r < 16; ++r) p1[r] = fmaf(p1[r], C, mnC);
  for (int r = 0; r < 16; ++r) p0[r] = __builtin_amdgcn_exp2f(p0[r]);
}
__device__ __forceinline__ void finishSM(f32x16& p0, f32x16& p1, float alpha, float& l_reg, bf16x8& pa0, bf16x8& pa1, bf16x8& pa2, bf16x8& pa3) {
  for (int r = 0; r < 16; ++r) p1[r] = __builtin_amdgcn_exp2f(p1[r]);
  float ps = 0; for (int r = 0; r < 16; ++r) ps += p0[r]; for (int r = 0; r < 16; ++r) ps += p1[r];
  { auto rr = __builtin_amdgcn_permlane32_swap(__float_as_uint(ps), __float_as_uint(ps), false, false);
    ps = __uint_as_float(rr[0]) + __uint_as_float(rr[1]); }
  l_reg = l_reg * alpha + ps;
#define PK4(P, BASE, OUT) do { unsigned a0 = cvtpk(P[BASE + 0], P[BASE + 1]), a1 = cvtpk(P[BASE + 2], P[BASE + 3]);   \
    unsigned b0 = cvtpk(P[BASE + 4], P[BASE + 5]), b1 = cvtpk(P[BASE + 6], P[BASE + 7]);                              \
    auto r0 = __builtin_amdgcn_permlane32_swap(a0, b0, false, false); auto r1 = __builtin_amdgcn_permlane32_swap(a1, b1, false, false); \
    u32x4 w = {r0[0], r1[0], r0[1], r1[1]}; OUT = *reinterpret_cast<bf16x8*>(&w); } while (0)
  PK4(p0, 0, pa0); PK4(p0, 8, pa1); PK4(p1, 0, pa2); PK4(p1, 8, pa3);
#undef PK4
}
__device__ __forceinline__ void qkt(f32x16& p0, f32x16& p1, const bf16* Ks, const bf16x8* qr, int r32, int hi) {
  p0 = f32x16{}; p1 = f32x16{};
  for (int d0 = 0; d0 < 8; ++d0) { int cb = (d0 * 16 + hi * 8) * 2;
    bf16x8 b0 = *reinterpret_cast<const bf16x8*>((const char*)Ks + KSWZ(r32, cb));
    bf16x8 b1 = *reinterpret_cast<const bf16x8*>((const char*)Ks + KSWZ(32 + r32, cb));
    p0 = __builtin_amdgcn_mfma_f32_32x32x16_bf16(b0, qr[d0], p0, 0, 0, 0);
    p1 = __builtin_amdgcn_mfma_f32_32x32x16_bf16(b1, qr[d0], p1, 0, 0, 0); }
}
__device__ __forceinline__ int v_st(int k, int c) { const int kk = (k & ~0xC) | ((k & 4) << 1) | ((k & 8) >> 1); return ((kk >> 3) * 4 + (c >> 5)) * 512 + ((kk & 7) * 32 + (c & 31)) * 2; }
__device__ __forceinline__ int v_rd_base(int lane) { return ((lane & 3) << 3) | (((lane >> 2) & 3) << 6) | (((lane >> 4) & 1) << 5) | (((lane >> 5) & 1) << 8); }
constexpr int v_rd_off(int d0, int ks, int half) { return d0 * 512 + ks * 4096 + half * 2048; }
template <int OFF> __device__ __forceinline__ s16x4 tr_read(int vb) {
  s16x4 r; asm volatile("ds_read_b64_tr_b16 %0, %1 offset:%2" : "=&v"(r) : "v"(vb), "i"(OFF) : "memory"); return r;
}
template <int D0> __device__ __forceinline__ void pv_one(f32x16& od, int vb, bf16x8 pa0, bf16x8 pa1, bf16x8 pa2, bf16x8 pa3) {
  const s16x4 l0 = tr_read<v_rd_off(D0, 0, 0)>(vb), h0 = tr_read<v_rd_off(D0, 0, 1)>(vb), l1 = tr_read<v_rd_off(D0, 1, 0)>(vb), h1 = tr_read<v_rd_off(D0, 1, 1)>(vb);
  const s16x4 l2 = tr_read<v_rd_off(D0, 2, 0)>(vb), h2 = tr_read<v_rd_off(D0, 2, 1)>(vb), l3 = tr_read<v_rd_off(D0, 3, 0)>(vb), h3 = tr_read<v_rd_off(D0, 3, 1)>(vb);
  asm volatile("s_waitcnt lgkmcnt(0)" ::: "memory"); SBAR();
#define PK(L, H) (bf16x8){L[0], L[1], L[2], L[3], H[0], H[1], H[2], H[3]}
  od = __builtin_amdgcn_mfma_f32_32x32x16_bf16(pa0, PK(l0, h0), od, 0, 0, 0);
  od = __builtin_amdgcn_mfma_f32_32x32x16_bf16(pa1, PK(l1, h1), od, 0, 0, 0);
  od = __builtin_amdgcn_mfma_f32_32x32x16_bf16(pa2, PK(l2, h2), od, 0, 0, 0);
  od = __builtin_amdgcn_mfma_f32_32x32x16_bf16(pa3, PK(l3, h3), od, 0, 0, 0);
#undef PK
}
__device__ __forceinline__ void pv_d0(f32x16* o, int vb, bf16x8 pa0, bf16x8 pa1, bf16x8 pa2, bf16x8 pa3) {
  pv_one<0>(o[0], vb, pa0, pa1, pa2, pa3); pv_one<1>(o[1], vb, pa0, pa1, pa2, pa3); pv_one<2>(o[2], vb, pa0, pa1, pa2, pa3); pv_one<3>(o[3], vb, pa0, pa1, pa2, pa3);
}

template <typename TQ>
__device__ __forceinline__ void attn_dense_body(const TQ* __restrict__ Qb, const bf16* __restrict__ Kh, const bf16* __restrict__ Vh,
                                                unsigned short* __restrict__ Ob, int seq, char* lds) {
  using St = Stage<bf16>; using SQ = Stage<TQ>;
  const int tid = fresh_tid(), wid = tid >> 6, lane = tid & 63, r32 = lane & 31, hi = lane >> 5;
  bf16* V_lds = (bf16*)lds; bf16* K_lds = (bf16*)(lds + 2 * SHM_V);
  float* ws = (float*)(lds + 2 * SHM_V + 2 * SHM_K) + wid * 64; float* li_l = ws; float* al_l = ws + 32;
  float m_reg = -1e30f, l_reg = 0; f32x16 o[4] = {}; bf16x8 qr[8];
  const TQ* Qw = Qb + (long)(wid * QBLK + r32) * LDQ + hi * 8;
#pragma unroll
  for (int d0 = 0; d0 < 8; ++d0) qr[d0] = SQ::tobf(SQ::ld8(Qw + d0 * 16));
  const int sr = tid >> 4, sc = (tid & 15) * 8, vst0 = v_st(sr, sc), vst1 = v_st(32 + sr, sc);
  const int vb0 = (int)(uintptr_t)V_lds + v_rd_base(lane);
  struct { typename St::T vs0, vs1, ks0, ks1; } sr_[SDEPTH];
#define SLOAD(i, k0) do { sr_[i].vs0 = St::ld8(&Vh[(long)((k0) + sr) * LDK + sc]); sr_[i].vs1 = St::ld8(&Vh[(long)((k0) + 32 + sr) * LDK + sc]); \
    sr_[i].ks0 = St::ld8(&Kh[(long)((k0) + sr) * LDK + sc]); sr_[i].ks1 = St::ld8(&Kh[(long)((k0) + 32 + sr) * LDK + sc]); } while (0)
#define SWRITE(b, i) do { *(bf16x8*)((char*)V_lds + (b) * SHM_V + vst0) = St::tobf(sr_[i].vs0);          \
    *(bf16x8*)((char*)V_lds + (b) * SHM_V + vst1) = St::tobf(sr_[i].vs1); int kc = sc * 2;               \
    *(bf16x8*)((char*)K_lds + (b) * SHM_K + KSWZ(sr, kc)) = St::tobf(sr_[i].ks0);                       \
    *(bf16x8*)((char*)K_lds + (b) * SHM_K + KSWZ(32 + sr, kc)) = St::tobf(sr_[i].ks1); } while (0)
#define SWAIT() do { if constexpr (SDEPTH == 2) asm volatile("s_waitcnt vmcnt(4)" ::: "memory"); else asm volatile("s_waitcnt vmcnt(0)" ::: "memory"); } while (0)
#define RESC(a) do { if (__any((a) < 1.f)) { if (hi == 0) al_l[r32] = (a); asm volatile("s_waitcnt lgkmcnt(0)" ::: "memory"); \
    for (int d = 0; d < 4; ++d) for (int r = 0; r < 16; ++r) o[d][r] *= al_l[crow(r, hi)]; } } while (0)
  f32x16 pA0, pA1, pB0, pB1; float mnA, mnB, alA, alB; bf16x8 pa0, pa1, pa2, pa3; const int NT = seq / KVBLK;
  constexpr int SE = 0, SO = SDEPTH - 1;
  SLOAD(SE, 0); asm volatile("s_waitcnt vmcnt(0)" ::: "memory"); SWRITE(0, SE); __syncthreads();
  qkt(pA0, pA1, K_lds, qr, r32, hi); partialSM(pA0, pA1, m_reg, mnA, alA);
  SLOAD(SO, KVBLK); if constexpr (SDEPTH == 2) { if (2 < NT) SLOAD(SE, 2 * KVBLK); }
  SWAIT(); SWRITE(1, SO); __syncthreads();
  for (int j = 1; j + 1 < NT; j += 2) {
    SBAR(); qkt(pB0, pB1, (bf16*)((char*)K_lds + SHM_K), qr, r32, hi);
    finishSM(pA0, pA1, alA, l_reg, pa0, pa1, pa2, pa3); SBAR();
    SLOAD(SO, (j + SDEPTH) * KVBLK); SBAR();
    pv_d0(o, vb0, pa0, pa1, pa2, pa3); partialSM(pB0, pB1, m_reg, mnB, alB);
    __syncthreads(); SWAIT(); SWRITE(0, SE);
    RESC(alB); __syncthreads();
    SBAR(); qkt(pA0, pA1, K_lds, qr, r32, hi);
    finishSM(pB0, pB1, alB, l_reg, pa0, pa1, pa2, pa3); SBAR();
    if (SDEPTH == 1 || j + 3 < NT) SLOAD(SE, (j + 1 + SDEPTH) * KVBLK); SBAR();
    pv_d0(o, vb0 + (int)SHM_V, pa0, pa1, pa2, pa3); partialSM(pA0, pA1, m_reg, mnA, alA);
    __syncthreads(); SWAIT(); SWRITE(1, SO);
    RESC(alA); __syncthreads();
  }
  SBAR(); qkt(pB0, pB1, (bf16*)((char*)K_lds + SHM_K), qr, r32, hi);
  finishSM(pA0, pA1, alA, l_reg, pa0, pa1, pa2, pa3); SBAR();
  pv_d0(o, vb0, pa0, pa1, pa2, pa3); partialSM(pB0, pB1, m_reg, mnB, alB);
  __syncthreads(); RESC(alB);
  finishSM(pB0, pB1, alB, l_reg, pa0, pa1, pa2, pa3); SBAR();
  pv_d0(o, vb0 + (int)SHM_V, pa0, pa1, pa2, pa3);
  if (hi == 0) li_l[r32] = l_reg; asm volatile("s_waitcnt lgkmcnt(0)" ::: "memory");
  float rli[16];
#pragma unroll
  for (int r = 0; r < 16; ++r) rli[r] = __builtin_amdgcn_rcpf(li_l[crow(r, hi)]);
  unsigned short* Ow = Ob + (long)(wid * QBLK) * LDO;
#pragma unroll
  for (int r = 0; r < 16; ++r) { int orow = crow(r, hi);
    for (int d0 = 0; d0 < 4; ++d0) Ow[(long)orow * LDO + d0 * 32 + r32] = bf1(o[d0][r] * rli[r]); }
#undef SLOAD
#undef SWRITE
#undef SWAIT
#undef RESC
}
}

constexpr int DM = 2048, NTOK = 6144, NPROMPT = 4096, INW = 15872;
constexpr int C_HQ = 0, C_HF = 1024, C_HI = 3072, C_HG = 4096, C_DQ = 5120, C_DK = 6144, C_DV = 7168, C_GQ = 8192, C_GK = 9216, C_GV = 9472, C_GATE = 9728;
constexpr int KROWS = 4096 + 2 * 1280;
constexpr int KVW = 1280;
constexpr float EPS = 1e-6f;
constexpr int NPH = 23;

constexpr size_t MiB = 1u << 20;
constexpr size_t WS_CTL = 0, CTL_ZERO_BYTES = 1 * MiB;
constexpr size_t WS_MOD = 1 * MiB, WS_ROPE = 2 * MiB, WS_WIN = 3 * MiB, WS_WBR = 127 * MiB, WS_WOUT = 151 * MiB, WS_WPQ = 167 * MiB, WS_PU = 183 * MiB, WS_PV = 311 * MiB;
constexpr size_t WS_H = 439 * MiB, WS_Z = 463 * MiB, WS_QA = 649 * MiB, WS_KA = 685 * MiB, WS_VA = 702 * MiB, WS_OA = 719 * MiB, WS_OH = 791 * MiB, WS_BR = 839 * MiB, WS_MG = 875 * MiB;
constexpr size_t WS_XM = 899 * MiB, WS_X1 = 947 * MiB, WS_PE = 995 * MiB, WS_PG = 998 * MiB, WS_END = 1001 * MiB;
constexpr size_t WS_UV8 = WS_PU, WS_SC = WS_PV;
constexpr size_t WS_QP = WS_OA;
constexpr size_t WS_MGP = WS_OH;
static_assert(WS_WIN + (size_t)2 * INW * DM * 2 <= WS_WBR && WS_Z + (size_t)NTOK * INW * 2 <= WS_QA && WS_KA + (size_t)KROWS * KVW * 2 <= WS_VA && WS_VA + (size_t)KROWS * KVW * 2 <= WS_OA, "d_ws map");
static_assert(WS_OA + (size_t)NTOK * 3072 * 4 <= WS_OH && WS_OH + (size_t)2 * NTOK * 1024 * 4 <= WS_BR && WS_BR + (size_t)3 * NTOK * 1024 * 2 <= WS_MG, "d_ws map 2");
constexpr int CW_BAR = 4096;

constexpr int LDS_BYTES = 163840, RING_OFF = 1024;

#define GAS __attribute__((address_space(1)))
#define LAS __attribute__((address_space(3)))
typedef unsigned short bf16;
typedef unsigned v4u __attribute__((ext_vector_type(4)));
typedef unsigned v2u __attribute__((ext_vector_type(2)));
typedef float f32x4 __attribute__((ext_vector_type(4)));
typedef float f32x2 __attribute__((ext_vector_type(2)));
typedef __bf16 bf16x2_t __attribute__((ext_vector_type(2)));
__device__ __forceinline__ unsigned pk2(float lo, float hi) { const f32x2 v = {lo, hi}; const bf16x2_t b = __builtin_convertvector(v, bf16x2_t); return __builtin_bit_cast(unsigned, b); }
__device__ __forceinline__ unsigned f2bf(float f) { return pk2(f, f) & 0xffffu; }
__device__ __forceinline__ float bflo(unsigned w) { return __uint_as_float(w << 16); }
__device__ __forceinline__ float bfhi(unsigned w) { return __uint_as_float(w & 0xffff0000u); }
__device__ __forceinline__ float wave_sum(float v) {
#pragma unroll
    for (int o = 1; o < 64; o <<= 1) v += __shfl_xor(v, o);
    return v;
}
__device__ __forceinline__ void ld16bf(const bf16* p, float (&v)[16]) {
    const v4u a = *(const v4u*)p, b = *(const v4u*)(p + 8);
    v[0] = bflo(a.x); v[1] = bfhi(a.x); v[2] = bflo(a.y); v[3] = bfhi(a.y); v[4] = bflo(a.z); v[5] = bfhi(a.z); v[6] = bflo(a.w); v[7] = bfhi(a.w);
    v[8] = bflo(b.x); v[9] = bfhi(b.x); v[10] = bflo(b.y); v[11] = bfhi(b.y); v[12] = bflo(b.z); v[13] = bfhi(b.z); v[14] = bflo(b.w); v[15] = bfhi(b.w);
}
__device__ __forceinline__ void ld16f(const float* p, float (&v)[16]) {
#pragma unroll
    for (int i = 0; i < 4; ++i) { const f32x4 x = *(const f32x4*)(p + 4 * i); v[4 * i] = x[0]; v[4 * i + 1] = x[1]; v[4 * i + 2] = x[2]; v[4 * i + 3] = x[3]; }
}
__device__ __forceinline__ void st16bf(bf16* p, const float (&v)[16]) {
    v4u a, b; a.x = pk2(v[0], v[1]); a.y = pk2(v[2], v[3]); a.z = pk2(v[4], v[5]); a.w = pk2(v[6], v[7]); b.x = pk2(v[8], v[9]); b.y = pk2(v[10], v[11]); b.z = pk2(v[12], v[13]); b.w = pk2(v[14], v[15]);
    *(v4u*)p = a; *(v4u*)(p + 8) = b;
}
__device__ __forceinline__ void st16f(float* p, const float (&v)[16]) {
#pragma unroll
    for (int i = 0; i < 4; ++i) *(f32x4*)(p + 4 * i) = (f32x4){v[4 * i], v[4 * i + 1], v[4 * i + 2], v[4 * i + 3]};
}

#define XB_TMO      128
#define XB_XCNT(j)  (256  + 64 * (j))
#define XB_XSUB(j)  (1280 + 64 * (j))
#define XB_XGEN(j)  (2304 + 64 * (j))
#define XB_TOP      3328
#define XB_TOPGEN   3392
#define XCD_BAR_WORDS 3456
#define XB_SPIN_CAP (1u << 18)

__device__ __forceinline__ unsigned xb_ld(unsigned* p)              { return __hip_atomic_load(p, __ATOMIC_RELAXED, __HIP_MEMORY_SCOPE_AGENT); }
__device__ __forceinline__ unsigned xb_add(unsigned* p, unsigned v) { return __hip_atomic_fetch_add(p, v, __ATOMIC_RELAXED, __HIP_MEMORY_SCOPE_AGENT); }
__device__ __forceinline__ unsigned xb_xcc_id() { return (unsigned)__builtin_amdgcn_s_getreg((3 << 11) | 20) & 0xFu; }
#define XB_SPIN(cond, bar) do { unsigned _sp = 0; while (cond) { __builtin_amdgcn_s_sleep(1); \
    if ((++_sp & 255u) == 0u) { if (xb_ld(&(bar)[XB_TMO])) break; if (_sp > XB_SPIN_CAP) { atomicAdd(&(bar)[XB_TMO], 1u); break; } } } } while (0)

struct XcdBarrier {
    unsigned* bar; unsigned x;
    volatile LAS unsigned* st;
};

__device__ __forceinline__ XcdBarrier xcd_barrier_post(unsigned* bar, volatile LAS unsigned* st) {
    XcdBarrier b; b.bar = bar; b.x = xb_xcc_id(); b.st = st;
    if (threadIdx.x == 0) (void)xb_add(&bar[XB_XCNT(b.x)], 1u);
    return b;
}
__device__ __forceinline__ void xcd_barrier_complete(unsigned* bar, unsigned x, unsigned& nloc, unsigned& nx) {
    const unsigned G = gridDim.x * gridDim.y * gridDim.z;
    unsigned sum, cnt, mine, sp = 0u;
    for (;;) {
        sum = 0u; cnt = 0u; mine = 0u;
#pragma unroll
        for (unsigned j = 0; j < 16; ++j) { const unsigned c = xb_ld(&bar[XB_XCNT(j)]); sum += c; cnt += (c > 0u) ? 1u : 0u; mine = (j == x) ? c : mine; }
        if (sum == G) break;
        __builtin_amdgcn_s_sleep(1);
        if ((++sp & 255u) == 0u) { if (xb_ld(&bar[XB_TMO])) break; if (sp > XB_SPIN_CAP) { atomicAdd(&bar[XB_TMO], 1u); break; } }
    }
    nloc = mine > 0u ? mine : 1u; nx = cnt > 0u ? cnt : 1u;
}

__device__ __forceinline__ void xcd_barrier(const XcdBarrier& b) {
    asm volatile("s_waitcnt vmcnt(0)" ::: "memory");
    __syncthreads();
    if (threadIdx.x == 0) {
        unsigned* bar = b.bar;
        __builtin_amdgcn_s_waitcnt(0);
        unsigned nloc = b.st[0], nx = b.st[1];
        if (nloc == 0u) { xcd_barrier_complete(bar, b.x, nloc, nx); b.st[0] = nloc; b.st[1] = nx; }
        const unsigned old = xb_add(&bar[XB_XSUB(b.x)], 1u);
        const unsigned gen = old / nloc;
        if (old + 1u == (gen + 1u) * nloc) {
            __builtin_amdgcn_fence(__ATOMIC_RELEASE, "agent");
            asm volatile("s_waitcnt vmcnt(0)" ::: "memory");
            const unsigned og = xb_add(&bar[XB_TOP], 1u);
            const unsigned tg = og / nx;
            if (og + 1u == (tg + 1u) * nx) xb_add(&bar[XB_TOPGEN], 1u);
            else XB_SPIN(xb_ld(&bar[XB_TOPGEN]) == tg, bar);
            __builtin_amdgcn_fence(__ATOMIC_ACQUIRE, "agent");
            xb_add(&bar[XB_XGEN(b.x)], 1u);
            asm volatile("s_waitcnt vmcnt(0)" ::: "memory");
        } else {
            XB_SPIN(xb_ld(&bar[XB_XGEN(b.x)]) == gen, bar);
            __builtin_amdgcn_fence(__ATOMIC_ACQUIRE, "agent");
            asm volatile("s_waitcnt vmcnt(0)" ::: "memory");
        }
    }
    __syncthreads();
}
struct Args { const float* in[26]; float* out; unsigned char* ws; int ph_lo, ph_hi; };
constexpr size_t OUT_YP = 0, OUT_DK = 12582912, OUT_DV = 20971520, OUT_GK = 29360128, OUT_GV = 31457280, OUT_ST = 33554432, OUT_TOTAL = 41943040;
#define LDS_WAIT() asm volatile("s_waitcnt lgkmcnt(0)" ::: "memory")

__device__ __forceinline__ void p0_transpose_item(const float* W, int K, int N, bf16* WT, LAS float* scr, int item, int lane) {
    const int nblk = N / 32, kb = item / nblk, nb = item % nblk, k0 = 64 * kb, n0 = 32 * nb;
    f32x4 tv[8];
#pragma unroll
    for (int i = 0; i < 8; ++i) tv[i] = *(const f32x4*)(W + (size_t)(k0 + (lane >> 3) + 8 * i) * N + n0 + 4 * (lane & 7));
#pragma unroll
    for (int i = 0; i < 8; ++i) { LAS float* d = scr + ((lane >> 3) + 8 * i) * 33 + 4 * (lane & 7); d[0] = tv[i][0]; d[1] = tv[i][1]; d[2] = tv[i][2]; d[3] = tv[i][3]; }
    LDS_WAIT(); asm volatile("" ::: "memory");
    const int c = lane & 7;
#pragma unroll
    for (int j = 0; j < 4; ++j) { const int n = (lane >> 3) + 8 * j; const LAS float* s = scr + (8 * c) * 33 + n;
        v4u o; o.x = pk2(s[0 * 33], s[1 * 33]); o.y = pk2(s[2 * 33], s[3 * 33]); o.z = pk2(s[4 * 33], s[5 * 33]); o.w = pk2(s[6 * 33], s[7 * 33]);
        *(v4u*)(WT + (size_t)(n0 + n) * K + k0 + 8 * c) = o; }
    LDS_WAIT(); asm volatile("" ::: "memory");
}
__device__ __forceinline__ void fp8_row_load(const Args& a, int t, int le, int lane, f32x4 (&x)[8]) {
    const float* src = a.in[24 + t] + (size_t)le * 2048;
#pragma unroll
    for (int j = 0; j < 8; ++j) x[j] = *(const f32x4*)(src + j * 256 + lane * 4);
}
__device__ __forceinline__ void fp8_row_finish(unsigned char* ws, int t, int le, int lane, const f32x4 (&x)[8]) {
    unsigned char* UV8 = ws + WS_UV8; float* SC = (float*)(ws + WS_SC);
    float mx = 0.f;
#pragma unroll
    for (int j = 0; j < 8; ++j) mx = fmaxf(fmaxf(mx, fmaxf(fabsf(x[j][0]), fabsf(x[j][1]))), fmaxf(fabsf(x[j][2]), fabsf(x[j][3])));
#pragma unroll
    for (int o = 1; o < 64; o <<= 1) mx = fmaxf(mx, __shfl_xor(mx, o));
    const float sc = mx > 0.f ? mx * (1.0f / 448.0f) : 1.0f, inv = mx > 0.f ? 448.0f / mx : 0.f;
    unsigned w[8];
#pragma unroll
    for (int j = 0; j < 8; ++j) { int q = __builtin_amdgcn_cvt_pk_fp8_f32(x[j][0] * inv, x[j][1] * inv, 0, false); q = __builtin_amdgcn_cvt_pk_fp8_f32(x[j][2] * inv, x[j][3] * inv, q, true); w[j] = (unsigned)q; }
    unsigned char* dst = UV8 + (size_t)le * 4096 + t * 2048 + lane * 32;
    *(v4u*)dst = (v4u){w[0], w[1], w[2], w[3]}; *(v4u*)(dst + 16) = (v4u){w[4], w[5], w[6], w[7]};
    if (lane == 0) SC[le * 2 + t] = sc;
}
__device__ __forceinline__ void fp8_rows(const Args& a, unsigned char* ws, int i0, int i1, int st, int lebase, int lane) {
    f32x4 xa[8], xb[8];
    if (i0 < i1) fp8_row_load(a, i0 >> 14, lebase + (i0 & 16383), lane, xa);
    for (int i = i0; i < i1; i += 2 * st) {
        const int i2 = i + st, i3 = i + 2 * st;
        if (i2 < i1) fp8_row_load(a, i2 >> 14, lebase + (i2 & 16383), lane, xb);
        fp8_row_finish(ws, i >> 14, lebase + (i & 16383), lane, xa);
        if (i3 < i1) fp8_row_load(a, i3 >> 14, lebase + (i3 & 16383), lane, xa);
        if (i2 < i1) fp8_row_finish(ws, i2 >> 14, lebase + (i2 & 16383), lane, xb);
    }
}
__device__ __forceinline__ void p0_prologue(const Args& a, unsigned char* ws, LAS unsigned char* lds, int G, bool defer_l1) {
    ws = fresh_ws(ws); const int tid = fresh_tid(), lane = tid & 63, wave = __builtin_amdgcn_readfirstlane(tid >> 6);
    const int bx = blockIdx.x;
    __syncthreads();
    {
        LAS float* sil = (LAS float*)(lds + RING_OFF); LAS float* red = sil + 3 * 2048;
        const float* c_ctx = a.in[8]; const float* cc = a.in[2];
        for (int i = tid; i < 3 * 2048; i += 512) { const int r = i >> 11, k = i & 2047; const float c = r == 0 ? c_ctx[k] : cc[(r - 1) * 2048 + k]; sil[i] = c / (1.0f + expf(-c)); }
        __syncthreads();
        const float* mod_w = a.in[9]; const float* mod_b = a.in[10]; float* MOD = (float*)(ws + WS_MOD);
        const int cg = tid % 24, kg = tid / 24;
        for (int task = bx; task < 256; task += G) {
            const int l = task >> 7, col0 = (task & 127) * 96;
            if (kg < 21) {
                float acc[3][4];
#pragma unroll
                for (int r = 0; r < 3; ++r)
#pragma unroll
                    for (int j = 0; j < 4; ++j) acc[r][j] = 0.f;
                const float* wp = mod_w + ((size_t)l * 2048) * 12288 + col0 + cg * 4;
#pragma unroll 4
                for (int k = kg; k < 2048; k += 21) { const f32x4 w = *(const f32x4*)(wp + (size_t)k * 12288); const float s0 = sil[k], s1 = sil[2048 + k], s2 = sil[4096 + k];
#pragma unroll
                    for (int j = 0; j < 4; ++j) { acc[0][j] += s0 * w[j]; acc[1][j] += s1 * w[j]; acc[2][j] += s2 * w[j]; } }
#pragma unroll
                for (int r = 0; r < 3; ++r)
#pragma unroll
                    for (int j = 0; j < 4; ++j) red[(kg * 24 + cg) * 12 + r * 4 + j] = acc[r][j];
            }
            __syncthreads();
            if (tid < 288) { const int r = tid / 96, c = tid % 96, g4 = c >> 2, j = c & 3; float s = 0.f;
                for (int q = 0; q < 21; ++q) s += red[(q * 24 + g4) * 12 + r * 4 + j];
                MOD[(size_t)(l * 3 + r) * 12288 + col0 + c] = s + mod_b[l * 12288 + col0 + c]; }
            __syncthreads();
        }
    }
    {
        f32x2* R64 = (f32x2*)(ws + WS_ROPE); f32x2* R128 = R64 + 64 * 16;
        const int gt = bx * 512 + tid;
        if (gt < 64 * 16) { const int pos = gt >> 4, i = gt & 15; const float inv = exp2f(-13.287712379549449f * (float)i / 16.0f); const float ang = (float)pos * inv; R64[gt] = (f32x2){cosf(ang), sinf(ang)}; }
        else if (gt < 64 * 16 + 64 * 32) { const int g2 = gt - 64 * 16, pos = g2 >> 5, i = g2 & 31; const float inv = exp2f(-13.287712379549449f * (float)i / 32.0f); const float ang = (float)pos * inv; R128[g2] = (f32x2){cosf(ang), sinf(ang)}; }
    }
    {
        LAS float* scr = (LAS float*)(lds + RING_OFF + wave * 16384);
        const int gw = bx * 8 + wave, NGW = G * 8;
        constexpr int I_IN = (DM / 64) * (INW / 32), I_BR = (1024 / 64) * (DM / 32), I_SQ = (DM / 64) * (DM / 32);
        constexpr int NITEMS = 2 * I_IN + 6 * I_BR + 4 * I_SQ;
        for (int it = gw; it < NITEMS; it += NGW) {
            int r = it;
            if (r < 2 * I_IN) { const int l = r / I_IN; p0_transpose_item(a.in[13] + (size_t)l * DM * INW, DM, INW, (bf16*)(ws + WS_WIN) + (size_t)l * INW * DM, scr, r % I_IN, lane); continue; } r -= 2 * I_IN;
            if (r < 6 * I_BR) { const int lc = r / I_BR; p0_transpose_item(a.in[20] + (size_t)lc * 1024 * DM, 1024, DM, (bf16*)(ws + WS_WBR) + (size_t)lc * DM * 1024, scr, r % I_BR, lane); continue; } r -= 6 * I_BR;
            if (r < 2 * I_SQ) { const int l = r / I_SQ; p0_transpose_item(a.in[21] + (size_t)l * DM * DM, DM, DM, (bf16*)(ws + WS_WOUT) + (size_t)l * DM * DM, scr, r % I_SQ, lane); continue; } r -= 2 * I_SQ;
            { const int l = r / I_SQ; p0_transpose_item(a.in[22] + (size_t)l * DM * DM, DM, DM, (bf16*)(ws + WS_WPQ) + (size_t)l * DM * DM, scr, r % I_SQ, lane); }
        }
    }
    {
        const int gw = bx * 8 + wave, NGW = G * 8;
        fp8_rows(a, ws, gw, 32768, NGW, 0, lane);
        if (!defer_l1) fp8_rows(a, ws, gw, 32768, NGW, 16384, lane);
    }
}
__device__ __forceinline__ void fp8_rows_deferred(const Args& a, unsigned char* ws, int slot) {
    ws = fresh_ws(ws); const int tid = fresh_tid(), lane = tid & 63, wave = __builtin_amdgcn_readfirstlane(tid >> 6);
    const int lo_ = slot == 0 ? 0 : slot == 1 ? 6554 : slot == 2 ? 11469 : slot == 3 ? 16384 : slot == 4 ? 22938 : 27853;
    const int hi_ = slot == 0 ? 6554 : slot == 1 ? 11469 : slot == 2 ? 16384 : slot == 3 ? 22938 : slot == 4 ? 27853 : 32768;
    const int gw = ((int)blockIdx.x - 192) * 8 + wave;
    fp8_rows(a, ws, lo_ + gw, hi_, 512, 16384, lane);
}

__device__ __forceinline__ void norm_phase(const float* xp, const float* xs, const float* gain, const float* modl, int ch_sh, int ch_sc, bf16* H, int G) {
    const int tid = fresh_tid(), lane = tid & 63, gw = blockIdx.x * 8 + __builtin_amdgcn_readfirstlane(tid >> 6), NGW = G * 8;
    for (int row = gw; row < NTOK; row += NGW) {
        const float* xr = row < NPROMPT ? xp + (size_t)row * DM : xs + (size_t)(row - NPROMPT) * DM;
        const int r = row < NPROMPT ? 0 : 1 + ((row - NPROMPT) >> 10);
        const float* sh = modl + (size_t)r * 12288 + ch_sh * DM; const float* sc = modl + (size_t)r * 12288 + ch_sc * DM;
        f32x4 v[8]; float ss = 0.f;
#pragma unroll
        for (int j = 0; j < 8; ++j) { v[j] = *(const f32x4*)(xr + j * 256 + lane * 4); ss += (v[j][0] * v[j][0] + v[j][1] * v[j][1]) + (v[j][2] * v[j][2] + v[j][3] * v[j][3]); }
        const float rstd = 1.0f / sqrtf(wave_sum(ss) * (1.0f / DM) + EPS);
#pragma unroll
        for (int j = 0; j < 8; ++j) { const int c = j * 256 + lane * 4; const f32x4 g = *(const f32x4*)(gain + c), s1 = *(const f32x4*)(sc + c), s0 = *(const f32x4*)(sh + c);
            const f32x4 o = v[j] * rstd * g * (s1 + 1.0f) + s0; v2u w; w.x = pk2(o[0], o[1]); w.y = pk2(o[2], o[3]); *(v2u*)(H + (size_t)row * DM + c) = w; }
    }
}

__device__ __forceinline__ void rope_pair(float (&v)[16], const f32x2* tab, int fi0, bool first, int xm) {
#pragma unroll
    for (int e = 0; e < 16; ++e) { const float p = __shfl_xor(v[e], xm); const f32x2 cs = tab[fi0 + e]; v[e] = first ? v[e] * cs.x - p * cs.y : v[e] * cs.x + p * cs.y; }
}
__device__ __forceinline__ void prep_phase(const Args& a, unsigned char* ws, int l, int wg0, int nwg) {
    ws = fresh_ws(ws); const int tid = fresh_tid(), lane = tid & 63, gw = ((int)blockIdx.x - wg0) * 8 + __builtin_amdgcn_readfirstlane(tid >> 6), NGW = nwg * 8;
    const bf16* Z = (const bf16*)(ws + WS_Z); bf16* QA = (bf16*)(ws + WS_QA); bf16* KA = (bf16*)(ws + WS_KA); bf16* VA = (bf16*)(ws + WS_VA);
    const f32x2* R64 = (const f32x2*)(ws + WS_ROPE); const f32x2* R128 = R64 + 64 * 16;
    const float* dqk = a.in[16] + (size_t)l * 2 * 64; const float* gqk = a.in[19] + (size_t)l * 2 * 128;
    float* out = a.out;
    for (int task = gw; task < NTOK + 512; task += NGW) {
        if (task >= NTOK) {
            const int i = task - NTOK, b = i >> 8, p = i & 255; const size_t krow = (size_t)NPROMPT + b * 1280 + 1024 + p;
            float v[16];
            ld16f(a.in[3] + ((size_t)(b * 2 + l) * 256 + p) * 1024 + lane * 16, v); st16bf(KA + krow * KVW + lane * 16, v);
            ld16f(a.in[4] + ((size_t)(b * 2 + l) * 256 + p) * 1024 + lane * 16, v); st16bf(VA + krow * KVW + lane * 16, v);
            if (lane < 16) { ld16f(a.in[5] + ((size_t)(b * 2 + l) * 256 + p) * 256 + lane * 16, v); st16bf(KA + krow * KVW + 1024 + lane * 16, v);
                             ld16f(a.in[6] + ((size_t)(b * 2 + l) * 256 + p) * 256 + lane * 16, v); st16bf(VA + krow * KVW + 1024 + lane * 16, v); }
            continue;
        }
        const int row = task; const bool latent = row >= NPROMPT;
        int b, t; size_t krow;
        if (!latent) { b = row >> 8; t = row & 255; krow = row; } else { b = (row - NPROMPT) >> 10; t = (row - NPROMPT) & 1023; krow = (size_t)NPROMPT + b * 1280 + t; }
        const int prow = t >> 6, pcol = t & 63;
        const bf16* z = Z + (size_t)row * INW;
        const size_t co = ((size_t)(b * 2 + l) * 256 + t);
        float v[16];
        {
            ld16bf(z + C_DQ + lane * 16, v); float ss = 0.f;
#pragma unroll
            for (int e = 0; e < 16; ++e) ss += v[e] * v[e];
            ss += __shfl_xor(ss, 1); ss += __shfl_xor(ss, 2);
            const float rstd = 1.0f / sqrtf(ss * (1.0f / 64.0f) + EPS); const int sub = lane & 3; const float* gn = dqk + sub * 16;
#pragma unroll
            for (int e = 0; e < 16; ++e) v[e] = v[e] * rstd * gn[e];
            if (latent) rope_pair(v, R64 + (sub < 2 ? prow : pcol) * 16, 0, (sub & 1) == 0, 1);
#pragma unroll
            for (int e = 0; e < 16; ++e) v[e] *= 0.125f;
            const int he = lane >> 2, half = he & 1; bf16* q = QA + (size_t)row * 3072 + he * 128;
            st16bf(q + half * 64 + sub * 16, v);
            *(v4u*)(q + (1 - half) * 64 + sub * 16) = (v4u){0u, 0u, 0u, 0u}; *(v4u*)(q + (1 - half) * 64 + sub * 16 + 8) = (v4u){0u, 0u, 0u, 0u};
        }
        {
            ld16bf(z + C_DK + lane * 16, v); float ss = 0.f;
#pragma unroll
            for (int e = 0; e < 16; ++e) ss += v[e] * v[e];
            ss += __shfl_xor(ss, 1); ss += __shfl_xor(ss, 2);
            const float rstd = 1.0f / sqrtf(ss * (1.0f / 64.0f) + EPS); const int sub = lane & 3; const float* gn = dqk + 64 + sub * 16;
#pragma unroll
            for (int e = 0; e < 16; ++e) v[e] = v[e] * rstd * gn[e];
            if (latent) rope_pair(v, R64 + (sub < 2 ? prow : pcol) * 16, 0, (sub & 1) == 0, 1);
            else st16f(out + OUT_DK + co * 1024 + lane * 16, v);
            st16bf(KA + krow * KVW + lane * 16, v);
        }
        {
            ld16bf(z + C_DV + lane * 16, v);
            if (!latent) st16f(out + OUT_DV + co * 1024 + lane * 16, v);
            *(v4u*)(VA + krow * KVW + lane * 16) = *(const v4u*)(z + C_DV + lane * 16); *(v4u*)(VA + krow * KVW + lane * 16 + 8) = *(const v4u*)(z + C_DV + lane * 16 + 8);
        }
        {
            ld16bf(z + C_GQ + lane * 16, v); float ss = 0.f;
#pragma unroll
            for (int e = 0; e < 16; ++e) ss += v[e] * v[e];
            ss += __shfl_xor(ss, 1); ss += __shfl_xor(ss, 2); ss += __shfl_xor(ss, 4);
            const float rstd = 1.0f / sqrtf(ss * (1.0f / 128.0f) + EPS); const int sub = lane & 7; const float* gn = gqk + sub * 16;
#pragma unroll
            for (int e = 0; e < 16; ++e) v[e] = v[e] * rstd * gn[e];
            if (latent) rope_pair(v, R128 + (sub < 4 ? prow : pcol) * 32, (sub & 1) * 16, (sub & 2) == 0, 2);
#pragma unroll
            for (int e = 0; e < 16; ++e) v[e] *= 0.08838834764831845f;
            st16bf(QA + (size_t)row * 3072 + 2048 + lane * 16, v);
        }
        {
            const int ln = lane & 15;
            ld16bf(z + C_GK + ln * 16, v); float ss = 0.f;
#pragma unroll
            for (int e = 0; e < 16; ++e) ss += v[e] * v[e];
            ss += __shfl_xor(ss, 1); ss += __shfl_xor(ss, 2); ss += __shfl_xor(ss, 4);
            const float rstd = 1.0f / sqrtf(ss * (1.0f / 128.0f) + EPS); const int sub = lane & 7; const float* gn = gqk + 128 + sub * 16;
#pragma unroll
            for (int e = 0; e < 16; ++e) v[e] = v[e] * rstd * gn[e];
            if (latent) rope_pair(v, R128 + (sub < 4 ? prow : pcol) * 32, (sub & 1) * 16, (sub & 2) == 0, 2);
            if (lane < 16) { if (!latent) st16f(out + OUT_GK + co * 256 + lane * 16, v); st16bf(KA + krow * KVW + 1024 + lane * 16, v); }
            ld16bf(z + C_GV + ln * 16, v);
            if (lane < 16) { if (!latent) st16f(out + OUT_GV + co * 256 + lane * 16, v); st16bf(VA + krow * KVW + 1024 + lane * 16, v); }
        }
    }
}

typedef short bf16x4s __attribute__((ext_vector_type(4)));
typedef short bf16x8h __attribute__((ext_vector_type(8)));
constexpr int HG_QD = 0, HG_QR = 4352, HG_KR = 8704, HG_KDT = 13056, HG_VT = 17152, HG_DEC = 21248, HG_BUF = 22016, HG_TOTS = 2 * HG_BUF;
__device__ __forceinline__ void hgrn_item(const Args& a, unsigned char* ws, LAS unsigned char* lds, int l, int item, const XcdBarrier* barp = nullptr, int split = -1) {
    ws = fresh_ws(ws); const int tid = fresh_tid(), lane = tid & 63, wave = __builtin_amdgcn_readfirstlane(tid >> 6);
    const bf16* Z = (const bf16*)(ws + WS_Z);
    int b, h, dir, T, row0; const bool latent = item < 32;
    if (latent) { b = item >> 4; h = (item >> 1) & 7; dir = item & 1; T = 1024; row0 = NPROMPT + b * 1024; }
    else { const int it = item - 32; b = it >> 4; h = (it >> 1) & 7; dir = it & 1; T = 256; row0 = b * 256; }
    const bool stager = wave < 4;
    const int cl = lane & 15, gr = lane >> 4, kc = (wave & 3) * 16 + cl;
    const int fr = lane & 15, g = lane >> 4, vb = (wave & 3) * 32;
    const size_t sidx = ((((size_t)(b * 2 + l) * 2 + dir) * 8 + h) * 128) * 128;
    LAS unsigned char* base = lds + RING_OFF;
    const long ost = dir ? -1024 : 1024, zst = dir ? -(long)INW : (long)INW;
    const int nchunk = T >> 4;
#define HG_EXP(x) __builtin_amdgcn_exp2f(1.4426950408889634f * (x))
    if (stager) {
        float lb[2] = {0.f, 0.f};
        if (l == 1) { const float* hl = a.in[14];
#pragma unroll
            for (int ch = 0; ch < 2; ++ch) { const float a0 = hl[(dir * 2 + 0) * 1024 + h * 128 + 2 * kc + ch], a1 = hl[(dir * 2 + 1) * 1024 + h * 128 + 2 * kc + ch]; lb[ch] = 1.0f / (1.0f + expf(a0 - a1)); } }
        const bf16* const zb0 = Z + (size_t)(row0 + (dir ? T - 1 : 0)) * INW + h * 128 + 2 * kc + zst * (4 * gr);
        unsigned rqA[4], rzA[4], rvA[4], rqB[4], rzB[4], rvB[4];
#define HG_LOAD(rq, rz, rv, c) do { if ((c) < nchunk) { _Pragma("unroll") for (int i = 0; i < 4; ++i) { const bf16* zr = zb0 + zst * ((c) * 16 + i); \
            rq[i] = *(const unsigned*)(zr + C_HQ); rz[i] = *(const unsigned*)(zr + C_HF + dir * 1024); rv[i] = *(const unsigned*)(zr + C_HI); } } } while (0)
#define HG_STAGE(rq, rz, rv, pbuf) do { \
            float lf[2][4], kk[2][4]; \
            _Pragma("unroll") for (int i = 0; i < 4; ++i) _Pragma("unroll") for (int ch = 0; ch < 2; ++ch) { const float zf = ch ? bfhi(rz[i]) : bflo(rz[i]); const float e = HG_EXP(-fabsf(zf)), inv = __builtin_amdgcn_rcpf(1.0f + e); \
                const float sp = zf >= 0.f ? inv : e * inv, sn = zf >= 0.f ? e * inv : inv; kk[ch][i] = (1.0f - lb[ch]) * sn; lf[ch][i] = 0.6931471805599453f * __builtin_amdgcn_logf(lb[ch] + (1.0f - lb[ch]) * sp); } \
            float cs[2][4], pre[2], bm[2], b15[2]; \
            _Pragma("unroll") for (int ch = 0; ch < 2; ++ch) { cs[ch][0] = lf[ch][0]; cs[ch][1] = cs[ch][0] + lf[ch][1]; cs[ch][2] = cs[ch][1] + lf[ch][2]; cs[ch][3] = cs[ch][2] + lf[ch][3]; \
                float P = cs[ch][3]; float t_ = __shfl_up(P, 16); if (gr >= 1) P += t_; t_ = __shfl_up(P, 32); if (gr >= 2) P += t_;        \
                pre[ch] = P - cs[ch][3]; bm[ch] = __shfl(P, 16 + cl); b15[ch] = __shfl(P, 48 + cl); } \
            LAS unsigned char* pb_ = base + (pbuf) * HG_BUF; float kd[2][4]; \
            _Pragma("unroll") for (int i = 0; i < 4; ++i) { const int s = 4 * gr + i; float qd[2], qr[2], kr[2]; \
                _Pragma("unroll") for (int ch = 0; ch < 2; ++ch) { const float q = ch ? bfhi(rq[i]) : bflo(rq[i]); const float bb = pre[ch] + cs[ch][i]; \
                    const float er = HG_EXP(fminf(fmaxf(bb - bm[ch], -80.f), 80.f)); \
                    qd[ch] = q * HG_EXP(bb); qr[ch] = q * er; kr[ch] = kk[ch][i] * __builtin_amdgcn_rcpf(er); kd[ch][i] = kk[ch][i] * HG_EXP(b15[ch] - bb); } \
                *(LAS unsigned*)(pb_ + HG_QD + s * 272 + kc * 4) = pk2(qd[0], qd[1]); \
                *(LAS unsigned*)(pb_ + HG_QR + s * 272 + kc * 4) = pk2(qr[0], qr[1]); \
                *(LAS unsigned*)(pb_ + HG_KR + s * 272 + kc * 4) = pk2(kr[0], kr[1]); } \
            *(LAS v2u*)(pb_ + HG_KDT + (2 * kc) * 32 + gr * 8) = (v2u){pk2(kd[0][0], kd[0][1]), pk2(kd[0][2], kd[0][3])}; *(LAS v2u*)(pb_ + HG_KDT + (2 * kc + 1) * 32 + gr * 8) = (v2u){pk2(kd[1][0], kd[1][1]), pk2(kd[1][2], kd[1][3])}; \
            *(LAS v2u*)(pb_ + HG_VT + (2 * kc) * 32 + gr * 8) = (v2u){(rv[0] & 0xffffu) | (rv[1] << 16), (rv[2] & 0xffffu) | (rv[3] << 16)}; \
            *(LAS v2u*)(pb_ + HG_VT + (2 * kc + 1) * 32 + gr * 8) = (v2u){(rv[0] >> 16) | (rv[1] & 0xffff0000u), (rv[2] >> 16) | (rv[3] & 0xffff0000u)}; \
            if (gr == 0) *(LAS f32x2*)(pb_ + HG_DEC + kc * 8) = (f32x2){HG_EXP(b15[0]), HG_EXP(b15[1])}; \
        } while (0)
        HG_LOAD(rqA, rzA, rvA, 0); HG_LOAD(rqB, rzB, rvB, 1);
        HG_STAGE(rqA, rzA, rvA, 0);
        HG_LOAD(rqA, rzA, rvA, 2);
        __syncthreads();
        for (int c = 0; c < nchunk; c += 2) {
            if (c == split) xcd_barrier(*barp);
            HG_STAGE(rqB, rzB, rvB, 1); HG_LOAD(rqB, rzB, rvB, c + 3);
            __syncthreads();
            if (c + 2 < nchunk) { HG_STAGE(rqA, rzA, rvA, 0); HG_LOAD(rqA, rzA, rvA, c + 4); }
            __syncthreads();
        }
#undef HG_LOAD
#undef HG_STAGE
        __syncthreads();
    } else {
        bf16* OH = (bf16*)(ws + WS_OH) + (size_t)dir * NTOK * 1024;
        bf16* const ob0 = OH + (size_t)(row0 + (dir ? T - 1 : 0)) * 1024 + h * 128 + vb + fr + ost * (4 * g);
        f32x4 S0[8], S1[8];
        if (latent) { const float* st = a.in[7] + sidx;
#pragma unroll
            for (int kt = 0; kt < 8; ++kt)
#pragma unroll
                for (int r = 0; r < 4; ++r) { S0[kt][r] = st[(size_t)(16 * kt + 4 * g + r) * 128 + vb + fr]; S1[kt][r] = st[(size_t)(16 * kt + 4 * g + r) * 128 + vb + 16 + fr]; } }
        else {
#pragma unroll
            for (int kt = 0; kt < 8; ++kt) { S0[kt] = (f32x4){0.f, 0.f, 0.f, 0.f}; S1[kt] = (f32x4){0.f, 0.f, 0.f, 0.f}; } }
#define HG_OTILE(SS, nt_, c) do { f32x4 o = {0.f, 0.f, 0.f, 0.f}; \
            _Pragma("unroll") for (int ks = 0; ks < 4; ++ks) { \
                const v4u bs4 = {pk2(SS[2 * ks][0], SS[2 * ks][1]), pk2(SS[2 * ks][2], SS[2 * ks][3]), pk2(SS[2 * ks + 1][0], SS[2 * ks + 1][1]), pk2(SS[2 * ks + 1][2], SS[2 * ks + 1][3])}; \
                o = __builtin_amdgcn_mfma_f32_16x16x32_bf16(__builtin_bit_cast(bf16x8h, qa[ks]), __builtin_bit_cast(bf16x8h, bs4), o, 0, 0, 0); } \
            const v2u bv2 = *(const LAS v2u*)(pb_ + HG_VT + (vb + 16 * (nt_) + fr) * 32 + g * 8); const v4u bv4 = {bv2.x, bv2.y, 0u, 0u}; const bf16x8h bv = __builtin_bit_cast(bf16x8h, bv4); \
            o = __builtin_amdgcn_mfma_f32_16x16x32_bf16(pa, bv, o, 0, 0, 0); \
            _Pragma("unroll") for (int r = 0; r < 4; ++r) ob0[ost * ((c) * 16 + r) + 16 * (nt_)] = (bf16)f2bf(o[r]); \
            _Pragma("unroll") for (int kt = 0; kt < 8; ++kt) SS[kt] = __builtin_amdgcn_mfma_f32_16x16x32_bf16(__builtin_bit_cast(bf16x8h, ak[kt]), bv, SS[kt] * dd[kt], 0, 0, 0); } while (0)
#define HG_MFMA(c) do { \
            const LAS unsigned char* pb_ = base + ((c) & 1) * HG_BUF; \
            f32x4 at = {0.f, 0.f, 0.f, 0.f}; \
            _Pragma("unroll") for (int ks = 0; ks < 4; ++ks) { const bf16x8h ka = *(const LAS bf16x8h*)(pb_ + HG_KR + fr * 272 + (32 * ks + 8 * g) * 2), qb = *(const LAS bf16x8h*)(pb_ + HG_QR + fr * 272 + (32 * ks + 8 * g) * 2); \
                at = __builtin_amdgcn_mfma_f32_16x16x32_bf16(ka, qb, at, 0, 0, 0); }            \
            _Pragma("unroll") for (int r = 0; r < 4; ++r) if (4 * g + r > fr) at[r] = 0.f; \
            const v4u pa4 = {pk2(at[0], at[1]), pk2(at[2], at[3]), 0u, 0u}; const bf16x8h pa = __builtin_bit_cast(bf16x8h, pa4);     \
            v4u qa[4]; v4u ak[8]; f32x4 dd[8]; \
            _Pragma("unroll") for (int ks = 0; ks < 4; ++ks) { const v2u alo = *(const LAS v2u*)(pb_ + HG_QD + fr * 272 + (32 * ks + 4 * g) * 2), ahi = *(const LAS v2u*)(pb_ + HG_QD + fr * 272 + (32 * ks + 16 + 4 * g) * 2); qa[ks] = (v4u){alo.x, alo.y, ahi.x, ahi.y}; } \
            _Pragma("unroll") for (int kt = 0; kt < 8; ++kt) { dd[kt] = *(const LAS f32x4*)(pb_ + HG_DEC + (16 * kt + 4 * g) * 4); const v2u ak2 = *(const LAS v2u*)(pb_ + HG_KDT + (16 * kt + fr) * 32 + g * 8); ak[kt] = (v4u){ak2.x, ak2.y, 0u, 0u}; } \
            HG_OTILE(S0, 0, c); HG_OTILE(S1, 1, c); \
        } while (0)
        __syncthreads();
        for (int c = 0; c < nchunk; c += 2) {
            if (c == split) xcd_barrier(*barp);
            HG_MFMA(c);
            __syncthreads();
            HG_MFMA(c + 1);
            __syncthreads();
        }
#undef HG_MFMA
#undef HG_OTILE
        if (!latent) { float* st = a.out + OUT_ST + sidx;
#pragma unroll
            for (int kt = 0; kt < 8; ++kt)
#pragma unroll
                for (int r = 0; r < 4; ++r) { st[(size_t)(16 * kt + 4 * g + r) * 128 + vb + fr] = S0[kt][r]; st[(size_t)(16 * kt + 4 * g + r) * 128 + vb + 16 + fr] = S1[kt][r]; } }
        __syncthreads();
    }
#undef HG_EXP
}

__device__ __forceinline__ void attn_unit(unsigned char* ws, char* lds_generic, int u) {
    ws = fresh_ws(ws);
    int b, he, row0, key0, seq;
    if (u < 192) { b = u / 96; const int r = u % 96; he = r >> 2; const int qb = r & 3; row0 = NPROMPT + b * 1024 + qb * 256; key0 = NPROMPT + b * 1280; seq = 1280; }
    else { const int uu = u - 192; b = uu / 24; he = uu % 24; row0 = b * 256; key0 = b * 256; seq = 256; }
    const int kvh = he < 16 ? (he >> 1) : 8 + ((he - 16) >> 2);
    const att::bf16* Q = (const att::bf16*)(ws + WS_QA) + (size_t)row0 * 3072 + he * 128;
    const att::bf16* K = (const att::bf16*)(ws + WS_KA) + (size_t)key0 * KVW + kvh * 128;
    const att::bf16* V = (const att::bf16*)(ws + WS_VA) + (size_t)key0 * KVW + kvh * 128;
    unsigned short* O = (unsigned short*)(ws + WS_OA) + (size_t)row0 * 3072 + he * 128;
    att::attn_dense_body<att::bf16>(Q, K, V, O, seq, lds_generic + RING_OFF);
    __syncthreads();
}

__device__ __forceinline__ void post_phase(const Args& a, unsigned char* ws, int l, int G) {
    ws = fresh_ws(ws); const int tid = fresh_tid(), lane = tid & 63, gw = blockIdx.x * 8 + __builtin_amdgcn_readfirstlane(tid >> 6), NGW = G * 8;
    const bf16* Z = (const bf16*)(ws + WS_Z); const bf16* OA = (const bf16*)(ws + WS_OA); const bf16* OHf = (const bf16*)(ws + WS_OH); const bf16* OHb = OHf + (size_t)NTOK * 1024;
    bf16* BR = (bf16*)(ws + WS_BR);
    const float lam_init = 0.8f - 0.6f * expf(-0.3f * (float)l);
    const float* lp = a.in[17] + (size_t)l * 4 * 64;
    const float s01 = wave_sum(lp[lane] * lp[64 + lane]), s23 = wave_sum(lp[128 + lane] * lp[192 + lane]);
    const float lam = expf(s01) - expf(s23) + lam_init;
    const float* hn = a.in[15] + (size_t)l * 128; const float* sl = a.in[18] + (size_t)l * 128;
    const int sub = lane & 7;
    for (int row = gw; row < NTOK; row += NGW) {
        float v[16], w[16];
        {
            ld16bf(OHf + (size_t)row * 1024 + lane * 16, v); ld16bf(OHb + (size_t)row * 1024 + lane * 16, w); float ss = 0.f;
#pragma unroll
            for (int e = 0; e < 16; ++e) { v[e] += w[e]; ss += v[e] * v[e]; }
            ss += __shfl_xor(ss, 1); ss += __shfl_xor(ss, 2); ss += __shfl_xor(ss, 4);
            const float rstd = 1.0f / sqrtf(ss * (1.0f / 128.0f) + EPS);
            ld16bf(Z + (size_t)row * INW + C_HG + lane * 16, w);
#pragma unroll
            for (int e = 0; e < 16; ++e) { const float g = w[e]; v[e] = v[e] * rstd * hn[sub * 16 + e] * (g / (1.0f + expf(-g))); }
            st16bf(BR + (size_t)row * 1024 + lane * 16, v);
        }
        {
            const int h = lane >> 3; const bf16* o1 = OA + (size_t)row * 3072 + (2 * h) * 128 + sub * 16;
            ld16bf(o1, v); ld16bf(o1 + 128, w); float ss = 0.f;
#pragma unroll
            for (int e = 0; e < 16; ++e) { v[e] -= lam * w[e]; ss += v[e] * v[e]; }
            ss += __shfl_xor(ss, 1); ss += __shfl_xor(ss, 2); ss += __shfl_xor(ss, 4);
            const float rstd = 1.0f / sqrtf(ss * (1.0f / 128.0f) + EPS);
#pragma unroll
            for (int e = 0; e < 16; ++e) v[e] = v[e] * rstd * sl[sub * 16 + e] * (1.0f - lam_init);
            st16bf(BR + (size_t)NTOK * 1024 + (size_t)row * 1024 + lane * 16, v);
        }
        {
            *(v4u*)(BR + (size_t)2 * NTOK * 1024 + (size_t)row * 1024 + lane * 16) = *(const v4u*)(OA + (size_t)row * 3072 + 2048 + lane * 16); *(v4u*)(BR + (size_t)2 * NTOK * 1024 + (size_t)row * 1024 + lane * 16 + 8) = *(const v4u*)(OA + (size_t)row * 3072 + 2048 + lane * 16 + 8);
        }
    }
}

typedef short bf16x8s __attribute__((ext_vector_type(8)));
typedef float f32x16 __attribute__((ext_vector_type(16)));
__device__ __forceinline__ unsigned ford(float f) { const unsigned u = __float_as_uint(f); return u ^ ((u >> 31) ? 0xffffffffu : 0x80000000u); }
__device__ __forceinline__ float funord(unsigned k) { const unsigned u = (k & 0x80000000u) ? (k ^ 0x80000000u) : ~k; return __uint_as_float(u); }
__device__ __forceinline__ void ins16(unsigned (&L)[16], unsigned x) {
#pragma unroll
    for (int i = 0; i < 16; ++i) { const unsigned hi = L[i] > x ? L[i] : x; x = L[i] > x ? x : L[i]; L[i] = hi; }
}
__device__ __forceinline__ void ce_desc(unsigned& a_, unsigned& b_) { const unsigned hi = a_ > b_ ? a_ : b_, lo = a_ > b_ ? b_ : a_; a_ = hi; b_ = lo; }
__device__ __forceinline__ void sort16_desc(unsigned (&x)[16]) {
#pragma unroll
    for (int k = 2; k <= 16; k <<= 1)
#pragma unroll
        for (int j = k >> 1; j > 0; j >>= 1)
#pragma unroll
            for (int i = 0; i < 16; ++i) { const int l = i ^ j; if (l > i) { if ((i & k) == 0) ce_desc(x[i], x[l]); else ce_desc(x[l], x[i]); } }
}
__device__ __forceinline__ void merge16_desc(unsigned (&a_)[16], const unsigned (&b_)[16]) {
#pragma unroll
    for (int i = 0; i < 16; ++i) a_[i] = a_[i] > b_[15 - i] ? a_[i] : b_[15 - i];
#pragma unroll
    for (int j = 8; j > 0; j >>= 1)
#pragma unroll
        for (int i = 0; i < 16; ++i) { const int l = i ^ j; if (l > i) ce_desc(a_[i], a_[l]); }
}
__device__ __forceinline__ void peer_top16(unsigned (&L)[16], const LAS unsigned char* keysL, const bf16* qp, int c, int qrow, int hf) {
    f32x16 acc[4];
#pragma unroll
    for (int tl = 0; tl < 4; ++tl)
#pragma unroll
        for (int r = 0; r < 16; ++r) acc[tl][r] = 0.f;
    bf16x8s bq[8];
#pragma unroll
    for (int ks = 0; ks < 8; ++ks) bq[ks] = *(const bf16x8s*)(qp + c * 128 + ks * 16 + hf * 8);
#pragma unroll
    for (int ks = 0; ks < 8; ++ks)
#pragma unroll
        for (int tl = 0; tl < 4; ++tl) { const bf16x8s ka = *(const LAS bf16x8s*)(keysL + (c * 128 + tl * 32 + qrow) * 256 + (((ks * 2 + hf) ^ (qrow & 15)) << 4));
            acc[tl] = __builtin_amdgcn_mfma_f32_32x32x16_bf16(ka, bq[ks], acc[tl], 0, 0, 0); }
    unsigned K1[16], K2[16], K3[16];
#pragma unroll
    for (int r = 0; r < 16; ++r) { const unsigned kc = 127u - (unsigned)((r & 3) + 8 * (r >> 2)) - 4u * (unsigned)hf;
        L[r] = (ford(acc[0][r]) & 0xffffff80u) | kc; K1[r] = (ford(acc[1][r]) & 0xffffff80u) | (kc - 32u); K2[r] = (ford(acc[2][r]) & 0xffffff80u) | (kc - 64u); K3[r] = (ford(acc[3][r]) & 0xffffff80u) | (kc - 96u); }
    sort16_desc(L); sort16_desc(K1); sort16_desc(K2); sort16_desc(K3);
    merge16_desc(L, K1); merge16_desc(K2, K3); merge16_desc(L, K2);
    unsigned P[16];
#pragma unroll
    for (int i = 0; i < 16; ++i) P[i] = (unsigned)__shfl_xor((int)L[i], 32);
    merge16_desc(L, P);
}
__device__ __forceinline__ float gelu_erf(float x) { return 0.5f * x * (1.0f + erff(x * 0.70710678118654752f)); }
__device__ __forceinline__ void peer_topk_phase(const Args& a, unsigned char* ws, LAS unsigned char* lds, int l, int G) {
    ws = fresh_ws(ws); const int tid = fresh_tid(), lane = tid & 63, wave = __builtin_amdgcn_readfirstlane(tid >> 6);
    LAS unsigned char* keysL = lds + RING_OFF;
    LAS unsigned char* wtab = keysL + 65536 + wave * 2048;
    const float* pk = a.in[23] + (size_t)l * 2 * 128 * 128;
    for (int i = tid; i < 2 * 128 * 16; i += 512) { const int q = i & 15, rk = i >> 4, k = rk & 127;
        const f32x4 x0 = *(const f32x4*)(pk + (size_t)rk * 128 + q * 8), x1 = *(const f32x4*)(pk + (size_t)rk * 128 + q * 8 + 4);
        v4u o; o.x = pk2(x0[0], x0[1]); o.y = pk2(x0[2], x0[3]); o.z = pk2(x1[0], x1[1]); o.w = pk2(x1[2], x1[3]);
        *(LAS v4u*)(keysL + rk * 256 + ((q ^ (k & 15)) << 4)) = o; }
    __syncthreads();
    const bf16* QPb = (const bf16*)(ws + WS_QP); unsigned* PE = (unsigned*)(ws + WS_PE); unsigned* PG = (unsigned*)(ws + WS_PG);
    const int gw = blockIdx.x * 8 + wave, NGW = G * 8;
    const int hf = lane >> 5, qrow = lane & 31, tq = qrow >> 3, hq = qrow & 7;
    for (int tile = gw; tile < NTOK / 3; tile += NGW) {
        const int tok0 = tile * 3;
        const bf16* qp = QPb + (size_t)(tok0 + (tq < 3 ? tq : 2)) * DM + hq * 256;
        unsigned L0[16], L1[16];
        peer_top16(L0, keysL, qp, 0, qrow, hf);
        peer_top16(L1, keysL, qp, 1, qrow, hf);
        unsigned tw[8];
#pragma unroll
        for (int i = 0; i < 4; ++i) { tw[i] = (127u - (L0[4 * i] & 127u)) | ((127u - (L0[4 * i + 1] & 127u)) << 8) | ((127u - (L0[4 * i + 2] & 127u)) << 16) | ((127u - (L0[4 * i + 3] & 127u)) << 24);
                                      tw[4 + i] = (127u - (L1[4 * i] & 127u)) | ((127u - (L1[4 * i + 1] & 127u)) << 8) | ((127u - (L1[4 * i + 2] & 127u)) << 16) | ((127u - (L1[4 * i + 3] & 127u)) << 24); }
        *(LAS v4u*)(wtab + lane * 32) = (v4u){tw[0], tw[1], tw[2], tw[3]}; *(LAS v4u*)(wtab + lane * 32 + 16) = (v4u){tw[4], tw[5], tw[6], tw[7]};
        float v0[16], v1[16];
#pragma unroll
        for (int i = 0; i < 16; ++i) { v0[i] = funord(L0[i] & 0xffffff80u); v1[i] = funord(L1[i] & 0xffffff80u); }
        unsigned C[16], C1[16], C2[16], C3[16];
#pragma unroll
        for (int i = 0; i < 16; ++i) { C[i] = 0u; C1[i] = 0u; C2[i] = 0u; C3[i] = 0u; }
#pragma unroll
        for (int i = 0; i < 16; ++i)
#pragma unroll
            for (int j = 0; j < 16; ++j) if ((i + 1) * (j + 1) <= 16) {
                constexpr int PRE[16] = {0, 16, 24, 29, 33, 36, 38, 40, 42, 43, 44, 45, 46, 47, 48, 49};
                const int s = PRE[i] + j; const unsigned key = (ford(v0[i] + v1[j]) & 0xffffff00u) | (255u - (unsigned)(i * 16 + j));
                if (s < 16) C[s & 15] = key; else if (s < 32) C1[s & 15] = key; else if (s < 48) C2[s & 15] = key; else C3[s & 15] = key; }
        sort16_desc(C); sort16_desc(C1); sort16_desc(C2); sort16_desc(C3);
        merge16_desc(C, C1); merge16_desc(C2, C3); merge16_desc(C, C2);
        LDS_WAIT(); asm volatile("" ::: "memory");
        float ex[16]; float sum = 0.f; const float c0 = funord(C[0] & 0xffffff00u);
#pragma unroll
        for (int r = 0; r < 16; ++r) { ex[r] = expf(funord(C[r] & 0xffffff00u) - c0); sum += ex[r]; }
        const float rs = 1.0f / sum;
        if (tq < 3) { const size_t ob = (size_t)(tok0 + tq) * 128 + hq * 16;
            if (hf == 0) { unsigned ev[16];
#pragma unroll
                for (int r = 0; r < 16; ++r) { const unsigned ci = 255u - (C[r] & 255u); const unsigned k0 = wtab[lane * 32 + (ci >> 4)], k1 = wtab[lane * 32 + 16 + (ci & 15u)]; ev[r] = k0 * 128u + k1; }
#pragma unroll
                for (int r = 0; r < 16; r += 4) *(v4u*)(PE + ob + r) = (v4u){ev[r], ev[r + 1], ev[r + 2], ev[r + 3]}; }
            else {
#pragma unroll
                for (int r = 0; r < 16; r += 4) *(v4u*)(PG + ob + r) = (v4u){__float_as_uint(ex[r] * rs), __float_as_uint(ex[r + 1] * rs), __float_as_uint(ex[r + 2] * rs), __float_as_uint(ex[r + 3] * rs)}; }
        }
        LDS_WAIT(); asm volatile("" ::: "memory");
    }
    __syncthreads();
}
#define PEER_ACC(OUT) do { _Pragma("unroll") for (int j = 0; j < 8; ++j) { const int q = (int)w[t][j >> 2][j & 3]; \
        OUT[2 * j] = __builtin_elementwise_fma(__builtin_amdgcn_cvt_pk_f32_fp8(q, false), wg2, OUT[2 * j]); OUT[2 * j + 1] = __builtin_elementwise_fma(__builtin_amdgcn_cvt_pk_f32_fp8(q, true), wg2, OUT[2 * j + 1]); } } while (0)
__device__ __forceinline__ void fma_ip(float& o, float x, float w) { asm("v_fma_f32 %0, %1, %2, %0" : "+v"(o) : "v"(x), "v"(w)); }
__device__ __forceinline__ void peer_gather_phase(const Args& a, unsigned char* ws, LAS unsigned char* lds, int l, float* xout, int G, unsigned emask = 0xffffu, int skip = 0, bool n1fuse = false) {
    ws = fresh_ws(ws); const int tid = fresh_tid(), lane = tid & 63, wave = __builtin_amdgcn_readfirstlane(tid >> 6);
    LAS unsigned char* wb = lds + RING_OFF + wave * 16384;
    LAS v2u* list = (LAS v2u*)(wb + 12288); LAS unsigned* hist = (LAS unsigned*)(wb + 15360);
    const bf16* H = (const bf16*)(ws + WS_H); const unsigned* PE = (const unsigned*)(ws + WS_PE); const unsigned* PG = (const unsigned*)(ws + WS_PG);
    const unsigned char* UV8 = ws + WS_UV8 + (size_t)l * 16384 * 4096; const float* SC = (const float*)(ws + WS_SC) + (size_t)l * 16384 * 2;
    const float* XM = (const float*)(ws + WS_XM); const float* MOD = (const float*)(ws + WS_MOD) + (size_t)l * 3 * 12288;
    const int gw = blockIdx.x * 8 + wave, NGW = G * 8;
    for (int tile = gw; tile < NTOK / 3; tile += NGW) {
        const int tok0 = tile * 3;
        {
            unsigned e[6], gb[6], pos[6];
            hist[lane] = 0u; hist[64 + lane] = 0u; hist[128 + lane] = 0u;
#pragma unroll
            for (int m = 0; m < 6; ++m) { const size_t ix = (size_t)(tok0 + (m >> 1)) * 128 + ((lane + 64 * m) & 127); e[m] = PE[ix] & emask; gb[m] = PG[ix]; }
            LDS_WAIT(); asm volatile("" ::: "memory");
#pragma unroll
            for (int m = 0; m < 6; ++m) pos[m] = __hip_atomic_fetch_add(hist + (m >> 1) * 64 + (e[m] >> 8), 1u, __ATOMIC_RELAXED, __HIP_MEMORY_SCOPE_WORKGROUP);
            LDS_WAIT(); asm volatile("" ::: "memory");
            const unsigned cnt0 = hist[lane], cnt1 = hist[64 + lane], cnt2 = hist[128 + lane]; unsigned inc0 = cnt0, inc1 = cnt1, inc2 = cnt2;
#pragma unroll
            for (int o = 1; o < 64; o <<= 1) { const unsigned t0 = (unsigned)__shfl_up((int)inc0, o), t1 = (unsigned)__shfl_up((int)inc1, o), t2 = (unsigned)__shfl_up((int)inc2, o); if (lane >= o) { inc0 += t0; inc1 += t1; inc2 += t2; } }
            LDS_WAIT(); asm volatile("" ::: "memory");
            hist[lane] = inc0 - cnt0; hist[64 + lane] = 128u + inc1 - cnt1; hist[128 + lane] = 256u + inc2 - cnt2;
            LDS_WAIT(); asm volatile("" ::: "memory");
#pragma unroll
            for (int m = 0; m < 6; ++m) { const unsigned p_ = hist[(m >> 1) * 64 + (e[m] >> 8)] + pos[m]; list[p_] = (v2u){e[m], gb[m]}; }
            LDS_WAIT(); asm volatile("" ::: "memory");
        }
        if (!(skip & 1)) {
            f32x2 h0[16], h1[16], h2r[16];
#pragma unroll
            for (int j = 0; j < 8; ++j) { const v2u a0 = *(const v2u*)(H + (size_t)(tok0 + 0) * DM + j * 256 + lane * 4), a1 = *(const v2u*)(H + (size_t)(tok0 + 1) * DM + j * 256 + lane * 4), a2 = *(const v2u*)(H + (size_t)(tok0 + 2) * DM + j * 256 + lane * 4);
                h0[2 * j] = (f32x2){bflo(a0.x), bfhi(a0.x)}; h0[2 * j + 1] = (f32x2){bflo(a0.y), bfhi(a0.y)};
                h1[2 * j] = (f32x2){bflo(a1.x), bfhi(a1.x)}; h1[2 * j + 1] = (f32x2){bflo(a1.y), bfhi(a1.y)};
                h2r[2 * j] = (f32x2){bflo(a2.x), bfhi(a2.x)}; h2r[2 * j + 1] = (f32x2){bflo(a2.y), bfhi(a2.y)}; }
#define PU_LOAD(W, SCL, G_, kb_) do { _Pragma("unroll") for (int t = 0; t < 3; ++t) { const v2u r = list[t * 128 + (kb_)]; const int ee = __builtin_amdgcn_readfirstlane((int)r.x); G_[t] = __uint_as_float((unsigned)__builtin_amdgcn_readfirstlane((int)r.y)); \
            const unsigned char* base = UV8 + (size_t)ee * 4096 + lane * 32; W[t][0] = *(const v4u*)base; W[t][1] = *(const v4u*)(base + 16); SCL[t] = *(const f32x2*)(SC + (size_t)ee * 2); } } while (0)
#define PU_DOT(HV, Wt) ({ f32x2 s_ = {0.f, 0.f}; _Pragma("unroll") for (int j = 0; j < 8; ++j) { const int q = (int)Wt[j >> 2][j & 3]; \
            s_ = __builtin_elementwise_fma(__builtin_amdgcn_cvt_pk_f32_fp8(q, false), HV[2 * j], s_); s_ = __builtin_elementwise_fma(__builtin_amdgcn_cvt_pk_f32_fp8(q, true), HV[2 * j + 1], s_); } s_.x + s_.y; })
#define PU_RED(x_) do { x_ += __uint_as_float((unsigned)__builtin_amdgcn_update_dpp(0, (int)__float_as_uint(x_), 0xB1, 0xF, 0xF, false)); x_ += __uint_as_float((unsigned)__builtin_amdgcn_update_dpp(0, (int)__float_as_uint(x_), 0x4E, 0xF, 0xF, false)); \
            x_ += __uint_as_float((unsigned)__builtin_amdgcn_update_dpp(0, (int)__float_as_uint(x_), 0x141, 0xF, 0xF, false)); x_ += __uint_as_float((unsigned)__builtin_amdgcn_update_dpp(0, (int)__float_as_uint(x_), 0x140, 0xF, 0xF, false)); \
            x_ += __uint_as_float((unsigned)__builtin_amdgcn_update_dpp(0, (int)__float_as_uint(x_), 0x142, 0xA, 0xF, false)); x_ += __uint_as_float((unsigned)__builtin_amdgcn_update_dpp(0, (int)__float_as_uint(x_), 0x143, 0xC, 0xF, false)); } while (0)
#define PU_COMP(W, kb_) do { float d0 = PU_DOT(h0, W[0]), d1 = PU_DOT(h1, W[1]), d2 = PU_DOT(h2r, W[2]); PU_RED(d0); PU_RED(d1); PU_RED(d2); \
            if (lane == 63) { dl[(kb_)] = d0; dl[128 + (kb_)] = d1; dl[256 + (kb_)] = d2; } } while (0)
            LAS float* dl = (LAS float*)wb;
            v4u wA[3][2], wB[3][2];
#define PU_LOAD2(W, kb_) do { _Pragma("unroll") for (int t = 0; t < 3; ++t) { const int ee = __builtin_amdgcn_readfirstlane((int)list[t * 128 + (kb_)].x); \
            const unsigned char* base = UV8 + (size_t)ee * 4096 + lane * 32; W[t][0] = *(const v4u*)base; W[t][1] = *(const v4u*)(base + 16); } } while (0)
            PU_LOAD2(wA, 0);
#pragma unroll 1
            for (int kb = 0; kb < 128; kb += 2) {
                PU_LOAD2(wB, kb + 1); PU_COMP(wA, kb);
                if (kb + 2 < 128) PU_LOAD2(wA, kb + 2);
                PU_COMP(wB, kb + 1);
            }
            LDS_WAIT(); asm volatile("" ::: "memory");
#pragma unroll
            for (int m = 0; m < 6; ++m) { const int li = lane + 64 * m; const v2u ent = list[li]; const f32x2 sc2 = *(const f32x2*)(SC + (size_t)ent.x * 2);
                ((LAS float*)list)[2 * li + 1] = __uint_as_float(ent.y) * gelu_erf(dl[li] * sc2.x) * sc2.y; }
#undef PU_LOAD2
#undef PU_RED
#undef PU_LOAD
#undef PU_DOT
#undef PU_COMP
        }
        LDS_WAIT(); asm volatile("" ::: "memory");
        f32x2 out0[16], out1[16], out2[16];
#pragma unroll
        for (int i = 0; i < 16; ++i) { out0[i] = (f32x2){0.f, 0.f}; out1[i] = (f32x2){0.f, 0.f}; out2[i] = (f32x2){0.f, 0.f}; }
#define PV_LOAD(W, G_, kb_) do { _Pragma("unroll") for (int t = 0; t < 3; ++t) { const v2u r = list[t * 128 + (kb_)]; const int ee = __builtin_amdgcn_readfirstlane((int)r.x); G_[t] = __uint_as_float((unsigned)__builtin_amdgcn_readfirstlane((int)r.y)); \
            const unsigned char* base = UV8 + (size_t)ee * 4096 + 2048 + lane * 32; W[t][0] = *(const v4u*)base; W[t][1] = *(const v4u*)(base + 16); } } while (0)
#define PV_FMA(O, X, Wg) do { O.x = __builtin_fmaf(X.x, Wg, O.x); O.y = __builtin_fmaf(X.y, Wg, O.y); } while (0)
#define PV_COMP(W, G_) do { _Pragma("unroll") for (int t = 0; t < 3; ++t) { const float wg = G_[t]; \
            _Pragma("unroll") for (int j = 0; j < 8; ++j) { const int q = (int)W[t][j >> 2][j & 3]; const f32x2 lo = __builtin_amdgcn_cvt_pk_f32_fp8(q, false), hi = __builtin_amdgcn_cvt_pk_f32_fp8(q, true); \
                if (t == 0) { PV_FMA(out0[2 * j], lo, wg); PV_FMA(out0[2 * j + 1], hi, wg); } \
                else if (t == 1) { PV_FMA(out1[2 * j], lo, wg); PV_FMA(out1[2 * j + 1], hi, wg); } \
                else { PV_FMA(out2[2 * j], lo, wg); PV_FMA(out2[2 * j + 1], hi, wg); } } } } while (0)
        if (!(skip & 2)) {
            v4u wA[3][2], wB[3][2]; float gA[3], gB[3];
            PV_LOAD(wA, gA, 0);
#pragma unroll 1
            for (int kb = 0; kb < 128; kb += 2) {
                PV_LOAD(wB, gB, kb + 1); PV_COMP(wA, gA);
                if (kb + 2 < 128) PV_LOAD(wA, gA, kb + 2);
                PV_COMP(wB, gB);
            }
        }
#undef PV_LOAD
#undef PV_COMP
#pragma unroll
        for (int tt = 0; tt < 3; ++tt) {
            const int row = tok0 + tt; const int r = row < NPROMPT ? 0 : 1 + ((row - NPROMPT) >> 10);
            const float* g2 = MOD + (size_t)r * 12288 + 5 * DM;
            float ss = 0.f;
#pragma unroll
            for (int j = 0; j < 8; ++j) { const int c = j * 256 + lane * 4; const size_t off = (size_t)row * DM + c;
                const f32x4 x0 = *(const f32x4*)(XM + off), ga = *(const f32x4*)(g2 + c);
                const f32x2 oa = tt == 0 ? out0[2 * j] : (tt == 1 ? out1[2 * j] : out2[2 * j]), ob = tt == 0 ? out0[2 * j + 1] : (tt == 1 ? out1[2 * j + 1] : out2[2 * j + 1]);
                const f32x4 xo = x0 + ga * (f32x4){oa.x, oa.y, ob.x, ob.y}; *(f32x4*)(xout + off) = xo;
                ss += (xo[0] * xo[0] + xo[1] * xo[1]) + (xo[2] * xo[2] + xo[3] * xo[3]); }
            if (n1fuse) { const float* n1gain = a.in[11] + DM; const float* n1mod = (const float*)(ws + WS_MOD) + (size_t)3 * 12288;
                const float rstd = 1.0f / sqrtf(wave_sum(ss) * (1.0f / DM) + EPS); const float* sh = n1mod + (size_t)r * 12288; const float* sc = sh + DM; bf16* Hw = (bf16*)(ws + WS_H);
#pragma unroll
                for (int j = 0; j < 8; ++j) { const int c = j * 256 + lane * 4; const size_t off = (size_t)row * DM + c;
                    const f32x4 x0 = *(const f32x4*)(XM + off), ga = *(const f32x4*)(g2 + c);
                    const f32x2 oa = tt == 0 ? out0[2 * j] : (tt == 1 ? out1[2 * j] : out2[2 * j]), ob = tt == 0 ? out0[2 * j + 1] : (tt == 1 ? out1[2 * j + 1] : out2[2 * j + 1]);
                    const f32x4 xo = x0 + ga * (f32x4){oa.x, oa.y, ob.x, ob.y};
                    const f32x4 gn = *(const f32x4*)(n1gain + c), s1 = *(const f32x4*)(sc + c), s0 = *(const f32x4*)(sh + c);
                    const f32x4 o = xo * rstd * gn * (s1 + 1.0f) + s0; *(v2u*)(Hw + (size_t)row * DM + c) = (v2u){pk2(o[0], o[1]), pk2(o[2], o[3])}; }
            }
        }
        asm volatile("" ::: "memory");
    }
    __syncthreads();
}
#undef PEER_ACC

__device__ __forceinline__ unsigned dg_hash(unsigned x) { x ^= x >> 16; x *= 0x7feb352du; x ^= x >> 15; x *= 0x846ca68bu; x ^= x >> 16; return x; }
__device__ __forceinline__ void dummy_gather(unsigned char* ws, int mode, int G) {
    ws = fresh_ws(ws); const int tid = fresh_tid(), lane = tid & 63, wave = __builtin_amdgcn_readfirstlane(tid >> 6);
    const unsigned char* UV8 = ws + WS_UV8; const int gw = blockIdx.x * 8 + wave;
    f32x2 hv[16], out[16];
#pragma unroll
    for (int i = 0; i < 16; ++i) { hv[i] = (f32x2){(float)(lane + i) * 0.001f, (float)(lane - i) * 0.002f}; out[i] = (f32x2){0.f, 0.f}; }
    for (int jb = 0; jb < 384; jb += 4) {
        int e[4];
#pragma unroll
        for (int t = 0; t < 4; ++t) { const unsigned hsh = dg_hash((unsigned)(gw * 384 + jb + t) * 2654435761u + 12345u); e[t] = mode == 0 ? (int)(hsh & 16383u) : (int)((((unsigned)(jb + t) / 12u) << 9) | (hsh & 511u)); }
        v4u w[4][4];
#pragma unroll
        for (int t = 0; t < 4; ++t) { const unsigned char* base = UV8 + (size_t)e[t] * 4096 + lane * 32;
            w[t][0] = *(const v4u*)base; w[t][1] = *(const v4u*)(base + 16); w[t][2] = *(const v4u*)(base + 2048); w[t][3] = *(const v4u*)(base + 2048 + 16); }
        float d[4];
#pragma unroll
        for (int t = 0; t < 4; ++t) { f32x2 s = {0.f, 0.f};
#pragma unroll
            for (int j = 0; j < 8; ++j) { const int q = (int)w[t][j >> 2][j & 3];
                s = __builtin_elementwise_fma(__builtin_amdgcn_cvt_pk_f32_fp8(q, false), hv[2 * j], s); s = __builtin_elementwise_fma(__builtin_amdgcn_cvt_pk_f32_fp8(q, true), hv[2 * j + 1], s); }
            d[t] = s.x + s.y; }
#pragma unroll
        for (int o = 1; o < 64; o <<= 1) {
#pragma unroll
            for (int t = 0; t < 4; ++t) d[t] += __shfl_xor(d[t], o); }
#pragma unroll
        for (int t = 0; t < 4; ++t) { const float wg = d[t] * 1e-3f; const f32x2 wg2 = {wg, wg};
#pragma unroll
            for (int j = 0; j < 8; ++j) { const int q = (int)w[t][2 + (j >> 2)][j & 3];
                out[2 * j] = __builtin_elementwise_fma(__builtin_amdgcn_cvt_pk_f32_fp8(q, false), wg2, out[2 * j]); out[2 * j + 1] = __builtin_elementwise_fma(__builtin_amdgcn_cvt_pk_f32_fp8(q, true), wg2, out[2 * j + 1]); } }
    }
    float* scratch = (float*)(ws + WS_PE);
    float acc = 0.f;
#pragma unroll
    for (int i = 0; i < 16; ++i) acc += out[i].x + out[i].y;
    scratch[(size_t)gw * 64 + lane] = acc;
}
__global__ void __launch_bounds__(512, 2) mk_fwd(Args args) {
    extern __shared__ __attribute__((aligned(16))) unsigned char lds_raw[];
    LAS unsigned char* lds = (LAS unsigned char*)lds_raw;
    const int G = gridDim.x;
    unsigned char* ws = args.ws;
    unsigned* ctl = (unsigned*)(ws + WS_CTL);
    for (int u = threadIdx.x; u < RING_OFF / 4; u += 512) ((LAS unsigned*)lds)[u] = 0u;
    __syncthreads();
    const int lo = args.ph_lo, hi = args.ph_hi;
    XcdBarrier bar; bar.bar = ctl + CW_BAR; bar.x = 0; bar.st = (volatile LAS unsigned*)(lds + 32);
    if (hi - lo > 1) bar = xcd_barrier_post(ctl + CW_BAR, (volatile LAS unsigned*)(lds + 32));
#ifndef PH_EN
#define PH_EN 0xfff
#endif
#define PHEN(k) (((PH_EN) >> (k)) & 1)
#ifndef PROBE_DUP
#define PROBE_DUP 0
#endif
#define NREP(k) ((((PROBE_DUP) >> (k)) & 1) ? 2 : 1)
#define IN(k) (lo <= (k) && (k) < hi)
#define SEAM(k) do { if (IN(k) && IN((k) + 1)) xcd_barrier(bar); } while (0)

#ifndef PROBE_XBAR
#define PROBE_XBAR 0
#endif
    if (PHEN(0) && IN(0)) { for (int rep = 0; rep < NREP(0); ++rep) p0_prologue(args, ws, lds, G, lo == 0 && hi == NPH && G == 256); }
    SEAM(0);

    for (int l = 0; l < 2; ++l) {
        ws = fresh_ws(ws);
        const int pb = 1 + 11 * l;
#define MODall ((const float*)(ws + WS_MOD))
#define Hb ((bf16*)(ws + WS_H))
#define Zb ((bf16*)(ws + WS_Z))
        const float* xin_p = l == 0 ? args.in[0] : (const float*)(ws + WS_X1);
        const float* xin_s = l == 0 ? args.in[1] : (const float*)(ws + WS_X1) + (size_t)NPROMPT * DM;
        const float* modl = MODall + (size_t)l * 3 * 12288;
        for (int xb = 0; xb < PROBE_XBAR; ++xb) xcd_barrier(bar);
        const bool n1fused = lo == 0 && hi == NPH;
        const bool defer = lo == 0 && hi == NPH && G == 256 && (int)blockIdx.x >= 192;
        if (!(l == 1 && n1fused)) {
            if (PHEN(1) && IN(pb + 0)) for (int rep = 0; rep < NREP(1); ++rep) norm_phase(xin_p, xin_s, args.in[11] + (size_t)l * DM, modl, 0, 1, Hb, G);
            SEAM(pb + 0);
        }
        if (PHEN(2) && IN(pb + 1)) for (int rep = 0; rep < NREP(2); ++rep) { ws = fresh_ws(ws);
            pg8::Gemm g{Hb, (const bf16*)(ws + WS_WIN) + (size_t)l * INW * DM, NTOK, INW, DM}; pg8::StaticOrder S; S.init(NTOK, INW, G, (int)blockIdx.x);
            pg8::EpiBf16<0> E{Zb, INW, nullptr, 0, 0, 1.f};
            pg8::gemm_phase<pg8::EpiBf16<0>, pg8::StaticOrder, true, true>(lds + RING_OFF, g, S, E);
        }
        SEAM(pb + 1);
        const bool early = IN(pb + 2) && IN(pb + 3) && G > 64;
        if (early && (int)blockIdx.x < 32) { hgrn_item(args, ws, lds, l, (int)blockIdx.x, &bar, 16); }
        else {
            if (PHEN(3) && IN(pb + 2)) for (int rep = 0; rep < NREP(3); ++rep) prep_phase(args, ws, l, early ? 32 : 0, early ? G - 32 : G);
            SEAM(pb + 2);
            if (PHEN(4) && IN(pb + 3)) for (int rep = 0; rep < NREP(4); ++rep) {
                const int bx = blockIdx.x;
                if (G > 64 && bx < 32) { for (int rp = 0; rp < NREP(12); ++rp) hgrn_item(args, ws, lds, l, bx); }
                else {
                    const int u0 = G > 64 ? bx - 32 : bx, us = G > 64 ? G - 32 : G;
                    if (G <= 64) for (int u = bx; u < 32; u += G) hgrn_item(args, ws, lds, l, u);
                    for (int rp = 0; rp < NREP(12); ++rp)
                    for (int u = u0; u < 832; u += us) if (u >= 192 && u < 448) hgrn_item(args, ws, lds, l, 32 + (u - 192));
                    for (int rp = 0; rp < NREP(13); ++rp)
                    for (int u = u0; u < 832; u += us) if (u < 192 || u >= 448) attn_unit(ws, (char*)lds_raw, u < 192 ? u : 192 + (u - 448));
                }
            }
        }
        SEAM(pb + 3);
        if (PHEN(5) && IN(pb + 4)) for (int rep = 0; rep < NREP(5); ++rep) post_phase(args, ws, l, G);
        SEAM(pb + 4);
        if (PHEN(6) && IN(pb + 5)) for (int rep = 0; rep < NREP(6); ++rep) { ws = fresh_ws(ws);
            pg8::StaticOrder S; S.init(NTOK, DM, G, (int)blockIdx.x);
            for (int c = 0; c < 3; ++c) {
                pg8::Gemm g{(const bf16*)(ws + WS_BR) + (size_t)c * NTOK * 1024, (const bf16*)(ws + WS_WBR) + (size_t)(l * 3 + c) * DM * 1024, NTOK, DM, 1024};
                pg8::EpiGate E{Zb, INW, C_GATE + c * DM, (bf16*)(ws + WS_MGP), (bf16*)(ws + WS_MG), DM, c};
                pg8::gemm_phase<pg8::EpiGate, pg8::StaticOrder, true, true>(lds + RING_OFF, g, S, E);
            }
            if (defer) fp8_rows_deferred(args, ws, 3 * l + 0);
        }
        SEAM(pb + 5);
        if (PHEN(7) && IN(pb + 6)) for (int rep = 0; rep < NREP(7); ++rep) { ws = fresh_ws(ws);
            pg8::Gemm g{(const bf16*)(ws + WS_MG), (const bf16*)(ws + WS_WOUT) + (size_t)l * DM * DM, NTOK, DM, DM}; pg8::StaticOrder S; S.init(NTOK, DM, G, (int)blockIdx.x);
            pg8::EpiResid E{xin_p, xin_s, modl + 2 * DM, (float*)(ws + WS_XM)};
            pg8::gemm_phase<pg8::EpiResid, pg8::StaticOrder, true, true>(lds + RING_OFF, g, S, E);
            if (defer) fp8_rows_deferred(args, ws, 3 * l + 1);
        }
        SEAM(pb + 6);
        if (PHEN(8) && IN(pb + 7)) for (int rep = 0; rep < NREP(8); ++rep) norm_phase((const float*)(ws + WS_XM), (const float*)(ws + WS_XM) + (size_t)NPROMPT * DM, args.in[12] + (size_t)l * DM, modl, 3, 4, Hb, G);
        SEAM(pb + 7);
        if (PHEN(9) && IN(pb + 8)) for (int rep = 0; rep < NREP(9); ++rep) { ws = fresh_ws(ws);
            pg8::Gemm g{Hb, (const bf16*)(ws + WS_WPQ) + (size_t)l * DM * DM, NTOK, DM, DM}; pg8::StaticOrder S; S.init(NTOK, DM, G, (int)blockIdx.x);
            pg8::EpiBf16<0> E{(bf16*)(ws + WS_QP), DM, nullptr, 0, 0, 1.f};
            pg8::gemm_phase<pg8::EpiBf16<0>, pg8::StaticOrder, true, true>(lds + RING_OFF, g, S, E);
            if (defer) fp8_rows_deferred(args, ws, 3 * l + 2);
        }
        SEAM(pb + 8);
#ifdef PROBE_DG
        dummy_gather(ws, PROBE_DG, G);
#endif
        if (PHEN(10) && IN(pb + 9)) for (int rep = 0; rep < NREP(10); ++rep) peer_topk_phase(args, ws, lds, l, G);
        SEAM(pb + 9);
        if (PHEN(11) && IN(pb + 10)) for (int rep = 0; rep < NREP(11); ++rep) peer_gather_phase(args, ws, lds, l, l == 0 ? (float*)(ws + WS_X1) : args.out, G, 0xffffu, 0, l == 0 && n1fused);
#ifdef PROBE_GM
        peer_gather_phase(args, ws, lds, l, (float*)(ws + WS_QA), G, PROBE_GM, 0);
#endif
        if (l == 0) SEAM(pb + 10);
    }
#undef MODall
#undef Hb
#undef Zb
#undef IN
#undef SEAM
}

extern "C" void kernel_launch(void* const* d_in, const int* in_sizes, int n_in, void* d_out, int out_size, void* d_ws, size_t ws_size, hipStream_t stream) {
    static int grid = 0;
    if (grid == 0) {
        if (n_in != 26 || (size_t)out_size != OUT_TOTAL || ws_size < WS_END) { fprintf(stderr, "kernel_launch: shape mismatch: n_in %d out %d ws %zu (need %zu)\n", n_in, out_size, ws_size, (size_t)WS_END); grid = -1; return; }
        int dev = 0, cus = 0, per_cu = 0;
        if (hipGetDevice(&dev) != hipSuccess || hipDeviceGetAttribute(&cus, hipDeviceAttributeMultiprocessorCount, dev) != hipSuccess) { grid = -1; return; }
        if (hipFuncSetAttribute((const void*)mk_fwd, hipFuncAttributeMaxDynamicSharedMemorySize, LDS_BYTES) != hipSuccess) { fprintf(stderr, "kernel_launch: hipFuncSetAttribute failed\n"); grid = -1; return; }
        if (hipOccupancyMaxActiveBlocksPerMultiprocessor(&per_cu, (const void*)mk_fwd, 512, LDS_BYTES) != hipSuccess || per_cu < 1) { fprintf(stderr, "kernel_launch: occupancy query says %d\n", per_cu); per_cu = 1; }
        (void)hipGetLastError();
        grid = cus;
    }
    if (grid < 0) return;
    (void)hipMemsetAsync((char*)d_ws + WS_CTL, 0, CTL_ZERO_BYTES, stream);
    Args a{};
    for (int i = 0; i < 26; ++i) a.in[i] = (const float*)d_in[i];
    a.out = (float*)d_out; a.ws = (unsigned char*)d_ws;
#if N_LAUNCH_MODE == 0
    a.ph_lo = 0; a.ph_hi = NPH;
    hipLaunchKernelGGL(mk_fwd, dim3(grid), dim3(512), LDS_BYTES, stream, a);
#else
    for (int p = 0; p < NPH; ++p) { a.ph_lo = p; a.ph_hi = p + 1; hipLaunchKernelGGL(mk_fwd, dim3(grid), dim3(512), LDS_BYTES, stream, a); }
#endif
    const hipError_t le = hipPeekAtLastError();
    if (le != hipSuccess) fprintf(stderr, "kernel_launch: launch failed: %s\n", hipGetErrorName(le));
}
```

```cpp
#include <hip/hip_runtime.h>
#include <hip/hip_bf16.h>
#include <cstdio>
#include <cstdint>
#include <cmath>
#define PROBE_DUP 0
#define HG_PROBE 0
#define PROBE_XBAR 0

#ifndef N_LAUNCH_MODE
#define N_LAUNCH_MODE 0
#endif
__device__ __forceinline__ int fresh_tid() { int t = (int)threadIdx.x; asm volatile("" : "+v"(t)); return t; }
__device__ __forceinline__ unsigned char* fresh_ws(unsigned char* p) { asm volatile("" : "+s"(p)); return p; }
namespace pg8 {
#define PG8_LAS __attribute__((address_space(3)))
typedef unsigned short bf16_t;
typedef short bf16x8 __attribute__((ext_vector_type(8)));
typedef float f32x4 __attribute__((ext_vector_type(4)));
typedef unsigned u32x4 __attribute__((ext_vector_type(4)));
constexpr int BM = 256, BK = 64, HALF = 128, HTB = HALF * BK * 2  , STAGE_BYTES = 8 * HTB, NXCD = 8, WGM = 8;

__host__ __device__ __forceinline__ int lds_byte(int r, int c) { const int st = (r >> 4) * 2 + (c >> 5), rr = r & 15, cc = c & 31, ob = rr * 64 + cc * 2; return st * 1024 + (ob ^ (((ob >> 9) & 1) << 5)); }
__host__ __device__ __forceinline__ void stage_rc(int b, int& R, int& C) { const int st = b / 1024, sb = b % 1024, swz = sb ^ (((sb >> 9) & 1) << 5); R = (st >> 1) * 16 + swz / 64; C = (st & 1) * 32 + (swz % 64) / 2; }
__host__ __device__ __forceinline__ int perm32(int rho) { const int n = rho >> 4, i = rho & 15; return 8 * (i >> 2) + 4 * n + (i & 3); }

struct Unit { int pm, pn; };
struct Gemm { const bf16_t* A; const bf16_t* Bt; int M, N, K; };

struct StaticOrder {
    int nM, nN, nwg, G, c;
    __host__ __device__ void init(int M, int N, int G_, int c_) { nM = M / BM; nN = N / BM; nwg = nM * nN; G = G_; c = c_; }
    __host__ __device__ bool next(int i, Unit& u) const {
        const long L = (long)i * G + c; if (L >= nwg) return false;
        int wgid = (int)L; { const int q = nwg / NXCD, r = nwg % NXCD, xcd = wgid % NXCD, off = wgid / NXCD; wgid = (xcd < r ? xcd * (q + 1) : r * (q + 1) + (xcd - r) * q) + off; }
        const int nig = WGM * nN, gid = wgid / nig, fm = gid * WGM, gsz = (nM - fm) < WGM ? (nM - fm) : WGM;
        u.pm = fm + ((wgid % nig) % gsz); u.pn = (wgid % nig) / gsz; return true;
    }
    __device__ __forceinline__ void a_ready(const Unit&) const {}
    __device__ __forceinline__ void done(const Unit&) const {}
};

__device__ __forceinline__ unsigned cvt_pk_bf16(float lo, float hi) { unsigned r; asm volatile("v_cvt_pk_bf16_f32 %0, %1, %2" : "=v"(r) : "v"(lo), "v"(hi)); return r; }
typedef float f32x2 __attribute__((ext_vector_type(2)));
__device__ __forceinline__ f32x2 gelu_pk(f32x2 v) {
    const f32x2 av = __builtin_elementwise_abs(v), d = av * 0.2316418882f + 1.0f;
    f32x2 t; t.x = __builtin_amdgcn_rcpf(d.x); t.y = __builtin_amdgcn_rcpf(d.y);
    f32x2 q = t * 0.5307027145f + (-0.7265760135f); q = q * t + 0.7107068705f; q = q * t + (-0.142248368f); q = q * t + 0.127414796f; q = q * t;
    const f32x2 s = (v * v) * (-0.72134752044f);
    f32x2 e; e.x = __builtin_amdgcn_exp2f(s.x); e.y = __builtin_amdgcn_exp2f(s.y);
    const f32x2 m = v * (q * e), r = v - m;
    f32x2 o; o.x = v.x < 0.f ? m.x : r.x; o.y = v.y < 0.f ? m.y : r.y; return o;
}

template <int ACT  > struct EpiBf16 {
    static constexpr bool PERM = true, AFTER_DRAIN = false; static_assert(ACT == 0 || ACT == 1, "EpiBf16: ACT is 0 (none) or 1 (gelu_pk)");
    bf16_t* O; int ldc; const float* bias; int split_cols; size_t split_stride; float scale0;
    __device__ __forceinline__ void operator()(const f32x4 (&acc)[2][2][4][2], const Unit& u, int wr, int wc, int fr, int fq) const {
        const int row0 = u.pm * BM + wr * 64 + fr; int colt = u.pn * BM; bf16_t* base = O;
        float sc = 1.f; if (split_cols) { const int t = colt / split_cols; base += (size_t)t * split_stride; colt -= t * split_cols; if (t == 0) sc = scale0; }
        const int col0 = colt + wc * 32 + 8 * fq, bcol0 = u.pn * BM + wc * 32 + 8 * fq;
        f32x4 bv[2][2];
#pragma unroll
        for (int bj = 0; bj < 2; ++bj)
#pragma unroll
            for (int n = 0; n < 2; ++n) bv[bj][n] = bias ? *(const f32x4*)(bias + bcol0 + bj * HALF + 4 * n) : (f32x4){0.f, 0.f, 0.f, 0.f};
#pragma unroll
        for (int ai = 0; ai < 2; ++ai)
#pragma unroll
            for (int m = 0; m < 4; ++m) { bf16_t* rowp = base + (size_t)(row0 + ai * HALF + m * 16) * ldc + col0;
#pragma unroll
                for (int bj = 0; bj < 2; ++bj) { f32x4 v0 = acc[ai][bj][m][0] + bv[bj][0], v1 = acc[ai][bj][m][1] + bv[bj][1];
                    if (ACT == 1) { f32x2 a = gelu_pk((f32x2){v0[0], v0[1]}), b = gelu_pk((f32x2){v0[2], v0[3]}), c = gelu_pk((f32x2){v1[0], v1[1]}), d = gelu_pk((f32x2){v1[2], v1[3]});
                        v0 = (f32x4){a.x, a.y, b.x, b.y}; v1 = (f32x4){c.x, c.y, d.x, d.y}; }
                    v0 = v0 * sc; v1 = v1 * sc; u32x4 w; w.x = cvt_pk_bf16(v0[0], v0[1]); w.y = cvt_pk_bf16(v0[2], v0[3]); w.z = cvt_pk_bf16(v1[0], v1[1]); w.w = cvt_pk_bf16(v1[2], v1[3]);
                    *(u32x4*)(rowp + bj * HALF) = w; } }
    }
};

struct EpiF32 {
    static constexpr bool PERM = false, AFTER_DRAIN = false;
    float* C; int ldc;
    __device__ __forceinline__ void operator()(const f32x4 (&acc)[2][2][4][2], const Unit& u, int wr, int wc, int fr, int fq) const {
        const int row0 = u.pm * BM + wr * 64 + fr, col0 = u.pn * BM + wc * 32 + 4 * fq;
#pragma unroll
        for (int ai = 0; ai < 2; ++ai)
#pragma unroll
            for (int m = 0; m < 4; ++m) { float* rowp = C + (size_t)(row0 + ai * HALF + m * 16) * ldc + col0;
#pragma unroll
                for (int bj = 0; bj < 2; ++bj)
#pragma unroll
                    for (int n = 0; n < 2; ++n) *(f32x4*)(rowp + bj * HALF + n * 16) = acc[ai][bj][m][n]; }
    }
};
__device__ __forceinline__ float sigmoid_f(float x) { return __builtin_amdgcn_rcpf(1.0f + __builtin_amdgcn_exp2f(-1.4426950408889634f * x)); }
struct EpiGate {
    static constexpr bool PERM = true, AFTER_DRAIN = false;
    const bf16_t* Z; int ldz; int gcol0; bf16_t* P; bf16_t* O; int ldc; int MODE;
    __device__ __forceinline__ void operator()(const f32x4 (&acc)[2][2][4][2], const Unit& u, int wr, int wc, int fr, int fq) const {
        const int row0 = u.pm * BM + wr * 64 + fr, col0 = u.pn * BM + wc * 32 + 8 * fq;
#pragma unroll
        for (int ai = 0; ai < 2; ++ai)
#pragma unroll
            for (int m = 0; m < 4; ++m) { const int row = row0 + ai * HALF + m * 16;
#pragma unroll
                for (int bj = 0; bj < 2; ++bj) { const int col = col0 + bj * HALF;
                    const u32x4 gz = *(const u32x4*)(Z + (size_t)row * ldz + gcol0 + col);
                    f32x4 s0, s1;
                    s0[0] = sigmoid_f(__uint_as_float(gz[0] << 16)); s0[1] = sigmoid_f(__uint_as_float(gz[0] & 0xffff0000u));
                    s0[2] = sigmoid_f(__uint_as_float(gz[1] << 16)); s0[3] = sigmoid_f(__uint_as_float(gz[1] & 0xffff0000u));
                    s1[0] = sigmoid_f(__uint_as_float(gz[2] << 16)); s1[1] = sigmoid_f(__uint_as_float(gz[2] & 0xffff0000u));
                    s1[2] = sigmoid_f(__uint_as_float(gz[3] << 16)); s1[3] = sigmoid_f(__uint_as_float(gz[3] & 0xffff0000u));
                    f32x4 v0 = acc[ai][bj][m][0] * s0, v1 = acc[ai][bj][m][1] * s1;
                    bf16_t* pp = P + (size_t)row * ldc + col;
                    if (MODE >= 1) { const u32x4 pw = *(const u32x4*)pp;
                        v0[0] += __uint_as_float(pw[0] << 16); v0[1] += __uint_as_float(pw[0] & 0xffff0000u); v0[2] += __uint_as_float(pw[1] << 16); v0[3] += __uint_as_float(pw[1] & 0xffff0000u);
                        v1[0] += __uint_as_float(pw[2] << 16); v1[1] += __uint_as_float(pw[2] & 0xffff0000u); v1[2] += __uint_as_float(pw[3] << 16); v1[3] += __uint_as_float(pw[3] & 0xffff0000u); }
                    u32x4 w; w.x = cvt_pk_bf16(v0[0], v0[1]); w.y = cvt_pk_bf16(v0[2], v0[3]); w.z = cvt_pk_bf16(v1[0], v1[1]); w.w = cvt_pk_bf16(v1[2], v1[3]);
                    *(u32x4*)((MODE <= 1 ? pp : O + (size_t)row * ldc + col)) = w; } }
    }
};
struct EpiResid {
    static constexpr bool PERM = false, AFTER_DRAIN = false;
    const float* xp; const float* xs; const float* gate; float* out;
    __device__ __forceinline__ void operator()(const f32x4 (&acc)[2][2][4][2], const Unit& u, int wr, int wc, int fr, int fq) const {
        const int row0 = u.pm * BM + wr * 64 + fr, col0 = u.pn * BM + wc * 32 + 4 * fq;
        const bool samp = u.pm >= 16; const int r = samp ? 1 + ((u.pm - 16) >> 2) : 0;
        const float* xb = samp ? xs - (size_t)4096 * 2048 : xp;
        f32x4 gv[2][2];
#pragma unroll
        for (int bj = 0; bj < 2; ++bj)
#pragma unroll
            for (int n = 0; n < 2; ++n) gv[bj][n] = *(const f32x4*)(gate + (size_t)r * 12288 + col0 + bj * HALF + n * 16);
#pragma unroll
        for (int ai = 0; ai < 2; ++ai)
#pragma unroll
            for (int m = 0; m < 4; ++m) { const size_t off = (size_t)(row0 + ai * HALF + m * 16) * 2048 + col0;
#pragma unroll
                for (int bj = 0; bj < 2; ++bj)
#pragma unroll
                    for (int n = 0; n < 2; ++n) { const f32x4 x = *(const f32x4*)(xb + off + bj * HALF + n * 16);
                        *(f32x4*)(out + off + bj * HALF + n * 16) = x + gv[bj][n] * acc[ai][bj][m][n]; } }
    }
};
struct EpiNull {
    static constexpr bool PERM = true, AFTER_DRAIN = false;
    float* sink;
    __device__ __forceinline__ void operator()(const f32x4 (&acc)[2][2][4][2], const Unit& u, int wr, int wc, int fr, int fq) const {
        f32x4 s = {0.f, 0.f, 0.f, 0.f};
#pragma unroll
        for (int ai = 0; ai < 2; ++ai)
#pragma unroll
            for (int bj = 0; bj < 2; ++bj)
#pragma unroll
                for (int m = 0; m < 4; ++m)
#pragma unroll
                    for (int n = 0; n < 2; ++n) s += acc[ai][bj][m][n];
        if (s[0] + s[1] + s[2] + s[3] == 1.2345e30f) *sink = 1.f;
    }
};

template <class Epi, class Sched, bool ALIGN_EPI = false, bool SP2 = false>
__device__ __forceinline__ void gemm_phase(PG8_LAS unsigned char* lds, const Gemm g, const Sched& S, const Epi& E) {
    const int tid = fresh_tid(), wid = __builtin_amdgcn_readfirstlane(tid >> 6), lane = tid & 63, wr = wid >> 2, wc = wid & 3, fr = lane & 15, fq = lane >> 4;
    const int K = g.K, nt = K / BK;
    unsigned voffA[2], voffB[2];
#pragma unroll
    for (int i = 0; i < 2; ++i) { int R, C; stage_rc(tid * 16 + i * 8192, R, C); const int Rb = Epi::PERM ? ((R & ~31) + perm32(R & 31)) : R;
        voffA[i] = (unsigned)(R * K + C) * 2u; voffB[i] = (unsigned)(Rb * K + C) * 2u; }
    const size_t kstep = (size_t)(BK * 2);
    const size_t hstep = (size_t)HALF * K * 2;
    const size_t tstep = 2 * hstep;
    const unsigned ldsw = (unsigned)wid * 1024u;
    const int aoff = lds_byte(wr * 64 + fr, fq * 8), boff = lds_byte(wc * 32 + fr, fq * 8);
#define PG8_SA(b, h) (((b) * 2 + (h)) * HTB)
#define PG8_SB(b, h) ((4 + (b) * 2 + (h)) * HTB)
#define PG8_STAGE(bufoff, gbase, voff) do { _Pragma("unroll") for (int _i = 0; _i < 2; ++_i) \
        __builtin_amdgcn_global_load_lds((const unsigned*)((const char*)(gbase) + (voff)[_i]), (PG8_LAS unsigned*)(lds + (bufoff) + ldsw + _i * 8192), 16, 0, 0); } while (0)
#define PG8_LDA(dst, b, h) do { _Pragma("unroll") for (int m = 0; m < 4; ++m) _Pragma("unroll") for (int k = 0; k < 2; ++k) dst[m][k] = *(const PG8_LAS bf16x8*)(lds + PG8_SA(b, h) + aoff + m * 2048 + k * 1024); } while (0)
#define PG8_LDB(dst, b, h) do { _Pragma("unroll") for (int n = 0; n < 2; ++n) _Pragma("unroll") for (int k = 0; k < 2; ++k) dst[n][k] = *(const PG8_LAS bf16x8*)(lds + PG8_SB(b, h) + boff + n * 2048 + k * 1024); } while (0)
#define PG8_MMA(ai, bj, At, Bt) do { __builtin_amdgcn_s_setprio(1); _Pragma("unroll") for (int m = 0; m < 4; ++m) _Pragma("unroll") for (int n = 0; n < 2; ++n) _Pragma("unroll") for (int k = 0; k < 2; ++k) \
        acc[ai][bj][m][n] = __builtin_amdgcn_mfma_f32_16x16x32_bf16(Bt[n][k], At[m][k], acc[ai][bj][m][n], 0, 0, 0); __builtin_amdgcn_s_setprio(0); } while (0)
#define PG8_WAIT_V(n) asm volatile("s_waitcnt vmcnt(" #n ")" ::: "memory")
#define PG8_WAIT_L(n) asm volatile("s_waitcnt lgkmcnt(" #n ")" ::: "memory")
#define PG8_BAR __builtin_amdgcn_s_barrier()
#define PG8_SCHED __builtin_amdgcn_sched_barrier(0)
    Unit cur, nxt; int ui = 0;
    if (!S.next(0, cur)) return;
    f32x4 acc[2][2][4][2];
#pragma unroll
    for (int a = 0; a < 2; ++a)
#pragma unroll
        for (int b = 0; b < 2; ++b)
#pragma unroll
            for (int m = 0; m < 4; ++m)
#pragma unroll
                for (int n = 0; n < 2; ++n) acc[a][b][m][n] = (f32x4){0.f, 0.f, 0.f, 0.f};
    bf16x8 At[4][2], B0[2][2], B1[2][2];
    const char* cA = (const char*)g.A + (size_t)cur.pm * tstep; const char* cB = (const char*)g.Bt + (size_t)cur.pn * tstep;
    S.a_ready(cur);
    if constexpr (SP2) {
        PG8_STAGE(PG8_SB(0, 0), cB, voffB); PG8_STAGE(PG8_SB(0, 1), cB + hstep, voffB); PG8_STAGE(PG8_SA(0, 0), cA, voffA); PG8_STAGE(PG8_SA(0, 1), cA + hstep, voffA);
        if (wr == 1) PG8_BAR;
        PG8_WAIT_V(2); PG8_BAR;
        PG8_STAGE(PG8_SB(1, 0), cB + kstep, voffB); PG8_STAGE(PG8_SA(1, 0), cA + kstep, voffA); PG8_STAGE(PG8_SB(1, 1), cB + hstep + kstep, voffB);
        PG8_WAIT_V(6); PG8_BAR;
    } else {
        PG8_STAGE(PG8_SB(0, 0), cB, voffB); PG8_STAGE(PG8_SA(0, 0), cA, voffA); PG8_STAGE(PG8_SB(0, 1), cB + hstep, voffB); PG8_STAGE(PG8_SA(0, 1), cA + hstep, voffA);
        if (wr == 1) PG8_BAR;
        PG8_WAIT_V(4); PG8_BAR;
        PG8_STAGE(PG8_SB(1, 0), cB + kstep, voffB); PG8_STAGE(PG8_SA(1, 0), cA + kstep, voffA); PG8_STAGE(PG8_SB(1, 1), cB + hstep + kstep, voffB);
        PG8_WAIT_V(6); PG8_BAR;
    }
    for (;;) {
        const bool has_next = S.next(ui + 1, nxt);
        const char* nA = has_next ? (const char*)g.A + (size_t)nxt.pm * tstep : cA; const char* nB = has_next ? (const char*)g.Bt + (size_t)nxt.pn * tstep : cB;
        for (int t = 0; t < nt; t += 2) {
            const bool last = (t == nt - 2);
            const char* a1 = cA + (size_t)(t + 1) * kstep;
            const char* a2 = last ? nA : cA + (size_t)(t + 2) * kstep; const char* b2 = last ? nB : cB + (size_t)(t + 2) * kstep;
            const char* a3 = a2 + kstep; const char* b3 = b2 + kstep;
            if (last && has_next) S.a_ready(nxt);
            if constexpr (SP2) {
            PG8_LDB(B0, 0, 0); PG8_LDB(B1, 0, 1); PG8_SCHED; PG8_LDA(At, 0, 0); PG8_STAGE(PG8_SA(1, 1), a1 + hstep, voffA);
            PG8_WAIT_V(8); PG8_WAIT_L(0); PG8_BAR; PG8_MMA(0, 0, At, B0); PG8_MMA(0, 1, At, B1); PG8_BAR; PG8_SCHED;
            PG8_LDA(At, 0, 1); PG8_STAGE(PG8_SB(0, 0), b2, voffB); PG8_STAGE(PG8_SB(0, 1), b2 + hstep, voffB); PG8_STAGE(PG8_SA(0, 0), a2, voffA);
            PG8_WAIT_V(8); PG8_WAIT_L(0); PG8_BAR; PG8_MMA(1, 0, At, B0); PG8_MMA(1, 1, At, B1); PG8_BAR; PG8_SCHED;
            PG8_LDB(B0, 1, 0); PG8_LDB(B1, 1, 1); PG8_SCHED; PG8_LDA(At, 1, 0); PG8_STAGE(PG8_SA(0, 1), a2 + hstep, voffA);
            PG8_WAIT_V(8); PG8_WAIT_L(0); PG8_BAR; PG8_MMA(0, 0, At, B0); PG8_MMA(0, 1, At, B1); PG8_BAR; PG8_SCHED;
            PG8_LDA(At, 1, 1); PG8_STAGE(PG8_SB(1, 0), b3, voffB); PG8_STAGE(PG8_SB(1, 1), b3 + hstep, voffB); PG8_STAGE(PG8_SA(1, 0), a3, voffA);
            PG8_WAIT_V(8); PG8_WAIT_L(0); PG8_BAR; PG8_MMA(1, 0, At, B0); PG8_MMA(1, 1, At, B1); PG8_BAR; PG8_SCHED;
            } else {
            PG8_LDB(B0, 0, 0); PG8_SCHED; PG8_LDA(At, 0, 0); PG8_STAGE(PG8_SA(1, 1), a1 + hstep, voffA);
            PG8_WAIT_L(8); PG8_BAR; PG8_WAIT_L(0); PG8_MMA(0, 0, At, B0); PG8_BAR; PG8_SCHED;
            PG8_LDB(B1, 0, 1); PG8_STAGE(PG8_SB(0, 0), b2, voffB);
            PG8_BAR; PG8_WAIT_L(0); PG8_MMA(0, 1, At, B1); PG8_BAR;
            PG8_LDA(At, 0, 1); PG8_STAGE(PG8_SA(0, 0), a2, voffA);
            PG8_BAR; PG8_WAIT_L(0); PG8_MMA(1, 0, At, B0); PG8_BAR; PG8_SCHED;
            PG8_STAGE(PG8_SB(0, 1), b2 + hstep, voffB);
            PG8_WAIT_V(6); PG8_BAR; PG8_MMA(1, 1, At, B1); PG8_BAR;
            PG8_LDB(B0, 1, 0); PG8_SCHED; PG8_LDA(At, 1, 0); PG8_STAGE(PG8_SA(0, 1), a2 + hstep, voffA);
            PG8_WAIT_L(8); PG8_BAR; PG8_WAIT_L(0); PG8_MMA(0, 0, At, B0); PG8_BAR; PG8_SCHED;
            PG8_LDB(B1, 1, 1); PG8_STAGE(PG8_SB(1, 0), b3, voffB);
            PG8_BAR; PG8_WAIT_L(0); PG8_MMA(0, 1, At, B1); PG8_BAR;
            PG8_LDA(At, 1, 1); PG8_STAGE(PG8_SA(1, 0), a3, voffA);
            PG8_BAR; PG8_WAIT_L(0); PG8_MMA(1, 0, At, B0); PG8_BAR; PG8_SCHED;
            PG8_STAGE(PG8_SB(1, 1), b3 + hstep, voffB);
            PG8_WAIT_V(6); PG8_BAR; PG8_MMA(1, 1, At, B1); PG8_BAR;
            }
        }
        if constexpr (ALIGN_EPI) { if (wr == 0) PG8_BAR; }
        if constexpr (!Epi::AFTER_DRAIN) { E(acc, cur, wr, wc, fr, fq); S.done(cur); }
        if (!has_next) break;
#pragma unroll
        for (int a = 0; a < 2; ++a)
#pragma unroll
            for (int b = 0; b < 2; ++b)
#pragma unroll
                for (int m = 0; m < 4; ++m)
#pragma unroll
                    for (int n = 0; n < 2; ++n) acc[a][b][m][n] = (f32x4){0.f, 0.f, 0.f, 0.f};
        cur = nxt; cA = nA; cB = nB; ++ui;
        if constexpr (ALIGN_EPI) { if (wr == 1) PG8_BAR; }
    }
    PG8_WAIT_V(0);
    if constexpr (!ALIGN_EPI) { if (wr == 0) PG8_BAR; }
    PG8_BAR;
    if constexpr (Epi::AFTER_DRAIN) { E.fused(acc, cur, wr, wc, fr, fq, lds, wid, lane); S.done(cur); }
#undef PG8_SA
#undef PG8_SB
#undef PG8_STAGE
#undef PG8_LDA
#undef PG8_LDB
#undef PG8_MMA
#undef PG8_WAIT_V
#undef PG8_WAIT_L
#undef PG8_BAR
#undef PG8_SCHED
}
}

namespace att {
using bf16 = __hip_bfloat16;
constexpr int D = 128, NW = 8, QBLK = 32, KVBLK = 64;
constexpr float SCALE = 1.0f;
constexpr float THR = 8.f;
constexpr int SDEPTH = 2;
constexpr int LDQ = 3072, LDK = 1280, LDO = 3072;
constexpr size_t SHM_V = KVBLK * D * 2, SHM_K = KVBLK * D * 2, SHM_ATTN = 2 * SHM_V + 2 * SHM_K + NW * 64 * 4;
typedef __bf16 abf16x2_t __attribute__((ext_vector_type(2))); typedef float af32x2_t __attribute__((ext_vector_type(2)));
__device__ __forceinline__ unsigned short bf1(float x) { const af32x2_t v = {x, x}; const abf16x2_t b = __builtin_convertvector(v, abf16x2_t); return (unsigned short)(__builtin_bit_cast(unsigned, b) & 0xffffu); }
using bf16x8 = __attribute__((ext_vector_type(8))) short;
using s16x4  = __attribute__((ext_vector_type(4))) short;
using f32x16 = __attribute__((ext_vector_type(16))) float;
using f32x8  = __attribute__((ext_vector_type(8))) float;
using u32x4  = __attribute__((ext_vector_type(4))) unsigned;
#define KSWZ(row, colB) ((row) * 256 + ((colB) ^ (((row) & 7) << 4)))
#define SBAR() __builtin_amdgcn_sched_barrier(0)
__device__ __forceinline__ int crow(int r, int hi) { return (r & 3) + 8 * (r >> 2) + 4 * hi; }
__device__ __forceinline__ unsigned cvtpk(float lo, float hi) {
  unsigned r; asm volatile("v_cvt_pk_bf16_f32 %0, %1, %2" : "=v"(r) : "v"(lo), "v"(hi)); return r;
}
template <typename TIn> struct Stage;
template <> struct Stage<bf16>  { using T = bf16x8;
  __device__ static __forceinline__ T ld8(const bf16* p) { return *reinterpret_cast<const bf16x8*>(p); }
  __device__ static __forceinline__ bf16x8 tobf(T x) { return x; } };
template <> struct Stage<float> { using T = f32x8;
  __device__ static __forceinline__ T ld8(const float* p) { return *reinterpret_cast<const f32x8*>(p); }
  __device__ static __forceinline__ bf16x8 tobf(T x) {
    u32x4 w = {cvtpk(x[0], x[1]), cvtpk(x[2], x[3]), cvtpk(x[4], x[5]), cvtpk(x[6], x[7])}; return *reinterpret_cast<bf16x8*>(&w); } };

__device__ __forceinline__ void partialSM(f32x16& p0, f32x16& p1, float& m_reg, float& mn, float& alpha) {
  constexpr float C = SCALE * 1.4426950408889634f;
  float pmax = p0[0]; for (int r = 1; r < 16; ++r) pmax = fmaxf(pmax, p0[r]); for (int r = 0; r < 16; ++r) pmax = fmaxf(pmax, p1[r]);
  { auto rr = __builtin_amdgcn_permlane32_swap(__float_as_uint(pmax), __float_as_uint(pmax), false, false);
    pmax = fmaxf(__uint_as_float(rr[0]), __uint_as_float(rr[1])); }
  if (__builtin_expect(__all(pmax - m_reg <= THR / SCALE), 1)) { mn = m_reg; alpha = 1.f; }
  else { mn = fmaxf(m_reg, pmax); alpha = __builtin_amdgcn_exp2f((m_reg - mn) * C); m_reg = mn; }
  float mnC = -mn * C;
  for (int r = 0; r < 16; ++r) p0[r] = fmaf(p0[r], C, mnC); for (int r = 0; r < 16; ++r) p1[r] = fmaf(p1[r], C, mnC);
  for (int r = 0; r < 16; ++r) p0[r] = __builtin_amdgcn_exp2f(p0[r]);
}
__device__ __forceinline__ void finishSM(f32x16& p0, f32x16& p1, float alpha, float& l_reg, bf16x8& pa0, bf16x8& pa1, bf16x8& pa2, bf16x8& pa3) {
  for (int r = 0; r < 16; ++r) p1[r] = __builtin_amdgcn_exp2f(p1[r]);
  float ps = 0; for (int r = 0; r < 16; ++r) ps += p0[r]; for (int r = 0; r < 16; ++r) ps += p1[r];
  { auto rr = __builtin_amdgcn_permlane32_swap(__float_as_uint(ps), __float_as_uint(ps), false, false);
    ps = __uint_as_float(rr[0]) + __uint_as_float(rr[1]); }
  l_reg = l_reg * alpha + ps;
#define PK4(P, BASE, OUT) do { unsigned a0 = cvtpk(P[BASE + 0], P[BASE + 1]), a1 = cvtpk(P[BASE + 2], P[BASE + 3]);   \
    unsigned b0 = cvtpk(P[BASE + 4], P[BASE + 5]), b1 = cvtpk(P[BASE + 6], P[BASE + 7]);                              \
    auto r0 = __builtin_amdgcn_permlane32_swap(a0, b0, false, false); auto r1 = __builtin_amdgcn_permlane32_swap(a1, b1, false, false); \
    u32x4 w = {r0[0], r1[0], r0[1], r1[1]}; OUT = *reinterpret_cast<bf16x8*>(&w); } while (0)
  PK4(p0, 0, pa0); PK4(p0, 8, pa1); PK4(p1, 0, pa2); PK4(p1, 8, pa3);
#undef PK4
}
__device__ __forceinline__ void qkt(f32x16& p0, f32x16& p1, const bf16* Ks, const bf16x8* qr, int r32, int hi) {
  p0 = f32x16{}; p1 = f32x16{};
  for (int d0 = 0; d0 < 8; ++d0) { int cb = (d0 * 16 + hi * 8) * 2;
    bf16x8 b0 = *reinterpret_cast<const bf16x8*>((const char*)Ks + KSWZ(r32, cb));
    bf16x8 b1 = *reinterpret_cast<const bf16x8*>((const char*)Ks + KSWZ(32 + r32, cb));
    p0 = __builtin_amdgcn_mfma_f32_32x32x16_bf16(b0, qr[d0], p0, 0, 0, 0);
    p1 = __builtin_amdgcn_mfma_f32_32x32x16_bf16(b1, qr[d0], p1, 0, 0, 0); }
}
__device__ __forceinline__ int v_st(int k, int c) { const int kk = (k & ~0xC) | ((k & 4) << 1) | ((k & 8) >> 1); return ((kk >> 3) * 4 + (c >> 5)) * 512 + ((kk & 7) * 32 + (c & 31)) * 2; }
__device__ __forceinline__ int v_rd_base(int lane) { return ((lane & 3) << 3) | (((lane >> 2) & 3) << 6) | (((lane >> 4) & 1) << 5) | (((lane >> 5) & 1) << 8); }
constexpr int v_rd_off(int d0, int ks, int half) { return d0 * 512 + ks * 4096 + half * 2048; }
template <int OFF> __device__ __forceinline__ s16x4 tr_read(int vb) {
  s16x4 r; asm volatile("ds_read_b64_tr_b16 %0, %1 offset:%2" : "=&v"(r) : "v"(vb), "i"(OFF) : "memory"); return r;
}
template <int D0> __device__ __forceinline__ void pv_one(f32x16& od, int vb, bf16x8 pa0, bf16x8 pa1, bf16x8 pa2, bf16x8 pa3) {
  const s16x4 l0 = tr_read<v_rd_off(D0, 0, 0)>(vb), h0 = tr_read<v_rd_off(D0, 0, 1)>(vb), l1 = tr_read<v_rd_off(D0, 1, 0)>(vb), h1 = tr_read<v_rd_off(D0, 1, 1)>(vb);
  const s16x4 l2 = tr_read<v_rd_off(D0, 2, 0)>(vb), h2 = tr_read<v_rd_off(D0, 2, 1)>(vb), l3 = tr_read<v_rd_off(D0, 3, 0)>(vb), h3 = tr_read<v_rd_off(D0, 3, 1)>(vb);
  asm volatile("s_waitcnt lgkmcnt(0)" ::: "memory"); SBAR();
#define PK(L, H) (bf16x8){L[0], L[1], L[2], L[3], H[0], H[1], H[2], H[3]}
  od = __builtin_amdgcn_mfma_f32_32x32x16_bf16(pa0, PK(l0, h0), od, 0, 0, 0);
  od = __builtin_amdgcn_mfma_f32_32x32x16_bf16(pa1, PK(l1, h1), od, 0, 0, 0);
  od = __builtin_amdgcn_mfma_f32_32x32x16_bf16(pa2, PK(l2, h2), od, 0, 0, 0);
  od = __builtin_amdgcn_mfma_f32_32x32x16_bf16(pa3, PK(l3, h3), od, 0, 0, 0);
#undef PK
}
__device__ __forceinline__ void pv_d0(f32x16* o, int vb, bf16x8 pa0, bf16x8 pa1, bf16x8 pa2, bf16x8 pa3) {
  pv_one<0>(o[0], vb, pa0, pa1, pa2, pa3); pv_one<1>(o[1], vb, pa0, pa1, pa2, pa3); pv_one<2>(o[2], vb, pa0, pa1, pa2, pa3); pv_one<3>(o[3], vb, pa0, pa1, pa2, pa3);
}

template <typename TQ>
__device__ __forceinline__ void attn_dense_body(const TQ* __restrict__ Qb, const bf16* __restrict__ Kh, const bf16* __restrict__ Vh,
                                                unsigned short* __restrict__ Ob, int seq, char* lds) {
  using St = Stage<bf16>; using SQ = Stage<TQ>;
  const int tid = fresh_tid(), wid = tid >> 6, lane = tid & 63, r32 = lane & 31, hi = lane >> 5;
  bf16* V_lds = (bf16*)lds; bf16* K_lds = (bf16*)(lds + 2 * SHM_V);
  float* ws = (float*)(lds + 2 * SHM_V + 2 * SHM_K) + wid * 64; float* li_l = ws; float* al_l = ws + 32;
  float m_reg = -1e30f, l_reg = 0; f32x16 o[4] = {}; bf16x8 qr[8];
  const TQ* Qw = Qb + (long)(wid * QBLK + r32) * LDQ + hi * 8;
#pragma unroll
  for (int d0 = 0; d0 < 8; ++d0) qr[d0] = SQ::tobf(SQ::ld8(Qw + d0 * 16));
  const int sr = tid >> 4, sc = (tid & 15) * 8, vst0 = v_st(sr, sc), vst1 = v_st(32 + sr, sc);
  const int vb0 = (int)(uintptr_t)V_lds + v_rd_base(lane);
  struct { typename St::T vs0, vs1, ks0, ks1; } sr_[SDEPTH];
#define SLOAD(i, k0) do { sr_[i].vs0 = St::ld8(&Vh[(long)((k0) + sr) * LDK + sc]); sr_[i].vs1 = St::ld8(&Vh[(long)((k0) + 32 + sr) * LDK + sc]); \
    sr_[i].ks0 = St::ld8(&Kh[(long)((k0) + sr) * LDK + sc]); sr_[i].ks1 = St::ld8(&Kh[(long)((k0) + 32 + sr) * LDK + sc]); } while (0)
#define SWRITE(b, i) do { *(bf16x8*)((char*)V_lds + (b) * SHM_V + vst0) = St::tobf(sr_[i].vs0);          \
    *(bf16x8*)((char*)V_lds + (b) * SHM_V + vst1) = St::tobf(sr_[i].vs1); int kc = sc * 2;               \
    *(bf16x8*)((char*)K_lds + (b) * SHM_K + KSWZ(sr, kc)) = St::tobf(sr_[i].ks0);                       \
    *(bf16x8*)((char*)K_lds + (b) * SHM_K + KSWZ(32 + sr, kc)) = St::tobf(sr_[i].ks1); } while (0)
#define SWAIT() do { if constexpr (SDEPTH == 2) asm volatile("s_waitcnt vmcnt(4)" ::: "memory"); else asm volatile("s_waitcnt vmcnt(0)" ::: "memory"); } while (0)
#define RESC(a) do { if (__any((a) < 1.f)) { if (hi == 0) al_l[r32] = (a); asm volatile("s_waitcnt lgkmcnt(0)" ::: "memory"); \
    for (int d = 0; d < 4; ++d) for (int r = 0; r < 16; ++r) o[d][r] *= al_l[crow(r, hi)]; } } while (0)
  f32x16 pA0, pA1, pB0, pB1; float mnA, mnB, alA, alB; bf16x8 pa0, pa1, pa2, pa3; const int NT = seq / KVBLK;
  constexpr int SE = 0, SO = SDEPTH - 1;
  SLOAD(SE, 0); asm volatile("s_waitcnt vmcnt(0)" ::: "memory"); SWRITE(0, SE); __syncthreads();
  qkt(pA0, pA1, K_lds, qr, r32, hi); partialSM(pA0, pA1, m_reg, mnA, alA);
  SLOAD(SO, KVBLK); if constexpr (SDEPTH == 2) { if (2 < NT) SLOAD(SE, 2 * KVBLK); }
  SWAIT(); SWRITE(1, SO); __syncthreads();
  for (int j = 1; j + 1 < NT; j += 2) {
    SBAR(); qkt(pB0, pB1, (bf16*)((char*)K_lds + SHM_K), qr, r32, hi);
    finishSM(pA0, pA1, alA, l_reg, pa0, pa1, pa2, pa3); SBAR();
    SLOAD(SO, (j + SDEPTH) * KVBLK); SBAR();
    pv_d0(o, vb0, pa0, pa1, pa2, pa3); partialSM(pB0, pB1, m_reg, mnB, alB);
    __syncthreads(); SWAIT(); SWRITE(0, SE);
    RESC(alB); __syncthreads();
    SBAR(); qkt(pA0, pA1, K_lds, qr, r32, hi);
    finishSM(pB0, pB1, alB, l_reg, pa0, pa1, pa2, pa3); SBAR();
    if (SDEPTH == 1 || j + 3 < NT) SLOAD(SE, (j + 1 + SDEPTH) * KVBLK); SBAR();
    pv_d0(o, vb0 + (int)SHM_V, pa0, pa1, pa2, pa3); partialSM(pA0, pA1, m_reg, mnA, alA);
    __syncthreads(); SWAIT(); SWRITE(1, SO);
    RESC(alA); __syncthreads();
  }
  SBAR(); qkt(pB0, pB1, (bf16*)((char*)K_lds + SHM_K), qr, r32, hi);
  finishSM(pA0, pA1, alA, l_reg, pa0, pa1, pa2, pa3); SBAR();
  pv_d0(o, vb0, pa0, pa1, pa2, pa3); partialSM(pB0, pB1, m_reg, mnB, alB);
  __syncthreads(); RESC(alB);
  finishSM(pB0, pB1, alB, l_reg, pa0, pa1, pa2, pa3); SBAR();
  pv_d0(o, vb0 + (int)SHM_V, pa0, pa1, pa2, pa3);
  if (hi == 0) li_l[r32] = l_reg; asm volatile("s_waitcnt lgkmcnt(0)" ::: "memory");
  float rli[16];
#pragma unroll
  for (int r = 0; r < 16; ++r) rli[r] = __builtin_amdgcn_rcpf(li_l[crow(r, hi)]);
  unsigned short* Ow = Ob + (long)(wid * QBLK) * LDO;
#pragma unroll
  for (int r = 0; r < 16; ++r) { int orow = crow(r, hi);
    for (int d0 = 0; d0 < 4; ++d0) Ow[(long)orow * LDO + d0 * 32 + r32] = bf1(o[d0][r] * rli[r]); }
#undef SLOAD
#undef SWRITE
#undef SWAIT
#undef RESC
}
}

constexpr int DM = 2048, NTOK = 6144, NPROMPT = 4096, INW = 15872;
constexpr int C_HQ = 0, C_HF = 1024, C_HI = 3072, C_HG = 4096, C_DQ = 5120, C_DK = 6144, C_DV = 7168, C_GQ = 8192, C_GK = 9216, C_GV = 9472, C_GATE = 9728;
constexpr int KROWS = 4096 + 2 * 1280;
constexpr int KVW = 1280;
constexpr float EPS = 1e-6f;
constexpr int NPH = 23;

constexpr size_t MiB = 1u << 20;
constexpr size_t WS_CTL = 0, CTL_ZERO_BYTES = 1 * MiB;
constexpr size_t WS_MOD = 1 * MiB, WS_ROPE = 2 * MiB, WS_WIN = 3 * MiB, WS_WBR = 127 * MiB, WS_WOUT = 151 * MiB, WS_WPQ = 167 * MiB, WS_PU = 183 * MiB, WS_PV = 311 * MiB;
constexpr size_t WS_H = 439 * MiB, WS_Z = 463 * MiB, WS_QA = 649 * MiB, WS_KA = 685 * MiB, WS_VA = 702 * MiB, WS_OA = 719 * MiB, WS_OH = 791 * MiB, WS_BR = 839 * MiB, WS_MG = 875 * MiB;
constexpr size_t WS_XM = 899 * MiB, WS_X1 = 947 * MiB, WS_PE = 995 * MiB, WS_PG = 998 * MiB, WS_END = 1001 * MiB;
constexpr size_t WS_UV8 = WS_PU, WS_SC = WS_PV;
constexpr size_t WS_QP = WS_OA;
constexpr size_t WS_MGP = WS_OH;
static_assert(WS_WIN + (size_t)2 * INW * DM * 2 <= WS_WBR && WS_Z + (size_t)NTOK * INW * 2 <= WS_QA && WS_KA + (size_t)KROWS * KVW * 2 <= WS_VA && WS_VA + (size_t)KROWS * KVW * 2 <= WS_OA, "d_ws map");
static_assert(WS_OA + (size_t)NTOK * 3072 * 4 <= WS_OH && WS_OH + (size_t)2 * NTOK * 1024 * 4 <= WS_BR && WS_BR + (size_t)3 * NTOK * 1024 * 2 <= WS_MG, "d_ws map 2");
constexpr int CW_BAR = 4096;

constexpr int LDS_BYTES = 163840, RING_OFF = 1024;

#define GAS __attribute__((address_space(1)))
#define LAS __attribute__((address_space(3)))
typedef unsigned short bf16;
typedef unsigned v4u __attribute__((ext_vector_type(4)));
typedef unsigned v2u __attribute__((ext_vector_type(2)));
typedef float f32x4 __attribute__((ext_vector_type(4)));
typedef float f32x2 __attribute__((ext_vector_type(2)));
typedef __bf16 bf16x2_t __attribute__((ext_vector_type(2)));
__device__ __forceinline__ unsigned pk2(float lo, float hi) { const f32x2 v = {lo, hi}; const bf16x2_t b = __builtin_convertvector(v, bf16x2_t); return __builtin_bit_cast(unsigned, b); }
__device__ __forceinline__ unsigned f2bf(float f) { return pk2(f, f) & 0xffffu; }
__device__ __forceinline__ float bflo(unsigned w) { return __uint_as_float(w << 16); }
__device__ __forceinline__ float bfhi(unsigned w) { return __uint_as_float(w & 0xffff0000u); }
__device__ __forceinline__ float wave_sum(float v) {
#pragma unroll
    for (int o = 1; o < 64; o <<= 1) v += __shfl_xor(v, o);
    return v;
}
__device__ __forceinline__ void ld16bf(const bf16* p, float (&v)[16]) {
    const v4u a = *(const v4u*)p, b = *(const v4u*)(p + 8);
    v[0] = bflo(a.x); v[1] = bfhi(a.x); v[2] = bflo(a.y); v[3] = bfhi(a.y); v[4] = bflo(a.z); v[5] = bfhi(a.z); v[6] = bflo(a.w); v[7] = bfhi(a.w);
    v[8] = bflo(b.x); v[9] = bfhi(b.x); v[10] = bflo(b.y); v[11] = bfhi(b.y); v[12] = bflo(b.z); v[13] = bfhi(b.z); v[14] = bflo(b.w); v[15] = bfhi(b.w);
}
__device__ __forceinline__ void ld16f(const float* p, float (&v)[16]) {
#pragma unroll
    for (int i = 0; i < 4; ++i) { const f32x4 x = *(const f32x4*)(p + 4 * i); v[4 * i] = x[0]; v[4 * i + 1] = x[1]; v[4 * i + 2] = x[2]; v[4 * i + 3] = x[3]; }
}
__device__ __forceinline__ void st16bf(bf16* p, const float (&v)[16]) {
    v4u a, b; a.x = pk2(v[0], v[1]); a.y = pk2(v[2], v[3]); a.z = pk2(v[4], v[5]); a.w = pk2(v[6], v[7]); b.x = pk2(v[8], v[9]); b.y = pk2(v[10], v[11]); b.z = pk2(v[12], v[13]); b.w = pk2(v[14], v[15]);
    *(v4u*)p = a; *(v4u*)(p + 8) = b;
}
__device__ __forceinline__ void st16f(float* p, const float (&v)[16]) {
#pragma unroll
    for (int i = 0; i < 4; ++i) *(f32x4*)(p + 4 * i) = (f32x4){v[4 * i], v[4 * i + 1], v[4 * i + 2], v[4 * i + 3]};
}

#define XB_TMO      128
#define XB_XCNT(j)  (256  + 64 * (j))
#define XB_XSUB(j)  (1280 + 64 * (j))
#define XB_XGEN(j)  (2304 + 64 * (j))
#define XB_TOP      3328
#define XB_TOPGEN   3392
#define XCD_BAR_WORDS 3456
#define XB_SPIN_CAP (1u << 18)

__device__ __forceinline__ unsigned xb_ld(unsigned* p)              { return __hip_atomic_load(p, __ATOMIC_RELAXED, __HIP_MEMORY_SCOPE_AGENT); }
__device__ __forceinline__ unsigned xb_add(unsigned* p, unsigned v) { return __hip_atomic_fetch_add(p, v, __ATOMIC_RELAXED, __HIP_MEMORY_SCOPE_AGENT); }
__device__ __forceinline__ unsigned xb_xcc_id() { return (unsigned)__builtin_amdgcn_s_getreg((3 << 11) | 20) & 0xFu; }
#define XB_SPIN(cond, bar) do { unsigned _sp = 0; while (cond) { __builtin_amdgcn_s_sleep(1); \
    if ((++_sp & 255u) == 0u) { if (xb_ld(&(bar)[XB_TMO])) break; if (_sp > XB_SPIN_CAP) { atomicAdd(&(bar)[XB_TMO], 1u); break; } } } } while (0)

struct XcdBarrier {
    unsigned* bar; unsigned x;
    volatile LAS unsigned* st;
};

__device__ __forceinline__ XcdBarrier xcd_barrier_post(unsigned* bar, volatile LAS unsigned* st) {
    XcdBarrier b; b.bar = bar; b.x = xb_xcc_id(); b.st = st;
    if (threadIdx.x == 0) (void)xb_add(&bar[XB_XCNT(b.x)], 1u);
    return b;
}
__device__ __forceinline__ void xcd_barrier_complete(unsigned* bar, unsigned x, unsigned& nloc, unsigned& nx) {
    const unsigned G = gridDim.x * gridDim.y * gridDim.z;
    unsigned sum, cnt, mine, sp = 0u;
    for (;;) {
        sum = 0u; cnt = 0u; mine = 0u;
#pragma unroll
        for (unsigned j = 0; j < 16; ++j) { const unsigned c = xb_ld(&bar[XB_XCNT(j)]); sum += c; cnt += (c > 0u) ? 1u : 0u; mine = (j == x) ? c : mine; }
        if (sum == G) break;
        __builtin_amdgcn_s_sleep(1);
        if ((++sp & 255u) == 0u) { if (xb_ld(&bar[XB_TMO])) break; if (sp > XB_SPIN_CAP) { atomicAdd(&bar[XB_TMO], 1u); break; } }
    }
    nloc = mine > 0u ? mine : 1u; nx = cnt > 0u ? cnt : 1u;
}

__device__ __forceinline__ void xcd_barrier(const XcdBarrier& b) {
    asm volatile("s_waitcnt vmcnt(0)" ::: "memory");
    __syncthreads();
    if (threadIdx.x == 0) {
        unsigned* bar = b.bar;
        __builtin_amdgcn_s_waitcnt(0);
        unsigned nloc = b.st[0], nx = b.st[1];
        if (nloc == 0u) { xcd_barrier_complete(bar, b.x, nloc, nx); b.st[0] = nloc; b.st[1] = nx; }
        const unsigned old = xb_add(&bar[XB_XSUB(b.x)], 1u);
        const unsigned gen = old / nloc;
        if (old + 1u == (gen + 1u) * nloc) {
            __builtin_amdgcn_fence(__ATOMIC_RELEASE, "agent");
            asm volatile("s_waitcnt vmcnt(0)" ::: "memory");
            const unsigned og = xb_add(&bar[XB_TOP], 1u);
            const unsigned tg = og / nx;
            if (og + 1u == (tg + 1u) * nx) xb_add(&bar[XB_TOPGEN], 1u);
            else XB_SPIN(xb_ld(&bar[XB_TOPGEN]) == tg, bar);
            __builtin_amdgcn_fence(__ATOMIC_ACQUIRE, "agent");
            xb_add(&bar[XB_XGEN(b.x)], 1u);
            asm volatile("s_waitcnt vmcnt(0)" ::: "memory");
        } else {
            XB_SPIN(xb_ld(&bar[XB_XGEN(b.x)]) == gen, bar);
            __builtin_amdgcn_fence(__ATOMIC_ACQUIRE, "agent");
            asm volatile("s_waitcnt vmcnt(0)" ::: "memory");
        }
    }
    __syncthreads();
}
struct Args { const float* in[26]; float* out; unsigned char* ws; int ph_lo, ph_hi; };
constexpr size_t OUT_YP = 0, OUT_DK = 12582912, OUT_DV = 20971520, OUT_GK = 29360128, OUT_GV = 31457280, OUT_ST = 33554432, OUT_TOTAL = 41943040;
#define LDS_WAIT() asm volatile("s_waitcnt lgkmcnt(0)" ::: "memory")

__device__ __forceinline__ void p0_transpose_item(const float* W, int K, int N, bf16* WT, LAS float* scr, int item, int lane) {
    const int nblk = N / 32, kb = item / nblk, nb = item % nblk, k0 = 64 * kb, n0 = 32 * nb;
    f32x4 tv[8];
#pragma unroll
    for (int i = 0; i < 8; ++i) tv[i] = *(const f32x4*)(W + (size_t)(k0 + (lane >> 3) + 8 * i) * N + n0 + 4 * (lane & 7));
#pragma unroll
    for (int i = 0; i < 8; ++i) { LAS float* d = scr + ((lane >> 3) + 8 * i) * 33 + 4 * (lane & 7); d[0] = tv[i][0]; d[1] = tv[i][1]; d[2] = tv[i][2]; d[3] = tv[i][3]; }
    LDS_WAIT(); asm volatile("" ::: "memory");
    const int c = lane & 7;
#pragma unroll
    for (int j = 0; j < 4; ++j) { const int n = (lane >> 3) + 8 * j; const LAS float* s = scr + (8 * c) * 33 + n;
        v4u o; o.x = pk2(s[0 * 33], s[1 * 33]); o.y = pk2(s[2 * 33], s[3 * 33]); o.z = pk2(s[4 * 33], s[5 * 33]); o.w = pk2(s[6 * 33], s[7 * 33]);
        *(v4u*)(WT + (size_t)(n0 + n) * K + k0 + 8 * c) = o; }
    LDS_WAIT(); asm volatile("" ::: "memory");
}
__device__ __forceinline__ void fp8_row_load(const Args& a, int t, int le, int lane, f32x4 (&x)[8]) {
    const float* src = a.in[24 + t] + (size_t)le * 2048;
#pragma unroll
    for (int j = 0; j < 8; ++j) x[j] = *(const f32x4*)(src + j * 256 + lane * 4);
}
__device__ __forceinline__ void fp8_row_finish(unsigned char* ws, int t, int le, int lane, const f32x4 (&x)[8]) {
    unsigned char* UV8 = ws + WS_UV8; float* SC = (float*)(ws + WS_SC);
    float mx = 0.f;
#pragma unroll
    for (int j = 0; j < 8; ++j) mx = fmaxf(fmaxf(mx, fmaxf(fabsf(x[j][0]), fabsf(x[j][1]))), fmaxf(fabsf(x[j][2]), fabsf(x[j][3])));
#pragma unroll
    for (int o = 1; o < 64; o <<= 1) mx = fmaxf(mx, __shfl_xor(mx, o));
    const float qmax = t == 0 ? 127.0f : 448.0f;
    const float sc = mx > 0.f ? mx / qmax : 1.0f, inv = mx > 0.f ? qmax / mx : 0.f;
    unsigned w[8];
    if (t == 0) {
#pragma unroll
        for (int j = 0; j < 8; ++j) { const int q0 = (int)rintf(x[j][0] * inv), q1 = (int)rintf(x[j][1] * inv), q2 = (int)rintf(x[j][2] * inv), q3 = (int)rintf(x[j][3] * inv);
            w[j] = (unsigned)(q0 & 0xff) | ((unsigned)(q1 & 0xff) << 8) | ((unsigned)(q2 & 0xff) << 16) | ((unsigned)q3 << 24); }
    } else {
#pragma unroll
        for (int j = 0; j < 8; ++j) { int q = __builtin_amdgcn_cvt_pk_fp8_f32(x[j][0] * inv, x[j][1] * inv, 0, false); q = __builtin_amdgcn_cvt_pk_fp8_f32(x[j][2] * inv, x[j][3] * inv, q, true); w[j] = (unsigned)q; }
    }
    unsigned char* dst = UV8 + (size_t)le * 4096 + t * 2048 + lane * 32;
    *(v4u*)dst = (v4u){w[0], w[1], w[2], w[3]}; *(v4u*)(dst + 16) = (v4u){w[4], w[5], w[6], w[7]};
    if (lane == 0) SC[le * 2 + t] = sc;
}
__device__ __forceinline__ void fp8_rows(const Args& a, unsigned char* ws, int i0, int i1, int st, int lebase, int lane) {
    f32x4 xa[8], xb[8];
    if (i0 < i1) fp8_row_load(a, i0 >> 14, lebase + (i0 & 16383), lane, xa);
    for (int i = i0; i < i1; i += 2 * st) {
        const int i2 = i + st, i3 = i + 2 * st;
        if (i2 < i1) fp8_row_load(a, i2 >> 14, lebase + (i2 & 16383), lane, xb);
        fp8_row_finish(ws, i >> 14, lebase + (i & 16383), lane, xa);
        if (i3 < i1) fp8_row_load(a, i3 >> 14, lebase + (i3 & 16383), lane, xa);
        if (i2 < i1) fp8_row_finish(ws, i2 >> 14, lebase + (i2 & 16383), lane, xb);
    }
}
__device__ __forceinline__ void p0_prologue(const Args& a, unsigned char* ws, LAS unsigned char* lds, int G, bool defer_l1) {
    ws = fresh_ws(ws); const int tid = fresh_tid(), lane = tid & 63, wave = __builtin_amdgcn_readfirstlane(tid >> 6);
    const int bx = blockIdx.x;
    __syncthreads();
    {
        LAS float* sil = (LAS float*)(lds + RING_OFF); LAS float* red = sil + 3 * 2048;
        const float* c_ctx = a.in[8]; const float* cc = a.in[2];
        for (int i = tid; i < 3 * 2048; i += 512) { const int r = i >> 11, k = i & 2047; const float c = r == 0 ? c_ctx[k] : cc[(r - 1) * 2048 + k]; sil[i] = c / (1.0f + expf(-c)); }
        __syncthreads();
        const float* mod_w = a.in[9]; const float* mod_b = a.in[10]; float* MOD = (float*)(ws + WS_MOD);
        const int cg = tid % 24, kg = tid / 24;
        for (int task = bx; task < 256; task += G) {
            const int l = task >> 7, col0 = (task & 127) * 96;
            if (kg < 21) {
                float acc[3][4];
#pragma unroll
                for (int r = 0; r < 3; ++r)
#pragma unroll
                    for (int j = 0; j < 4; ++j) acc[r][j] = 0.f;
                const float* wp = mod_w + ((size_t)l * 2048) * 12288 + col0 + cg * 4;
#pragma unroll 4
                for (int k = kg; k < 2048; k += 21) { const f32x4 w = *(const f32x4*)(wp + (size_t)k * 12288); const float s0 = sil[k], s1 = sil[2048 + k], s2 = sil[4096 + k];
#pragma unroll
                    for (int j = 0; j < 4; ++j) { acc[0][j] += s0 * w[j]; acc[1][j] += s1 * w[j]; acc[2][j] += s2 * w[j]; } }
#pragma unroll
                for (int r = 0; r < 3; ++r)
#pragma unroll
                    for (int j = 0; j < 4; ++j) red[(kg * 24 + cg) * 12 + r * 4 + j] = acc[r][j];
            }
            __syncthreads();
            if (tid < 288) { const int r = tid / 96, c = tid % 96, g4 = c >> 2, j = c & 3; float s = 0.f;
                for (int q = 0; q < 21; ++q) s += red[(q * 24 + g4) * 12 + r * 4 + j];
                MOD[(size_t)(l * 3 + r) * 12288 + col0 + c] = s + mod_b[l * 12288 + col0 + c]; }
            __syncthreads();
        }
    }
    {
        f32x2* R64 = (f32x2*)(ws + WS_ROPE); f32x2* R128 = R64 + 64 * 16;
        const int gt = bx * 512 + tid;
        if (gt < 64 * 16) { const int pos = gt >> 4, i = gt & 15; const float inv = exp2f(-13.287712379549449f * (float)i / 16.0f); const float ang = (float)pos * inv; R64[gt] = (f32x2){cosf(ang), sinf(ang)}; }
        else if (gt < 64 * 16 + 64 * 32) { const int g2 = gt - 64 * 16, pos = g2 >> 5, i = g2 & 31; const float inv = exp2f(-13.287712379549449f * (float)i / 32.0f); const float ang = (float)pos * inv; R128[g2] = (f32x2){cosf(ang), sinf(ang)}; }
    }
    {
        LAS float* scr = (LAS float*)(lds + RING_OFF + wave * 16384);
        const int gw = bx * 8 + wave, NGW = G * 8;
        constexpr int I_IN = (DM / 64) * (INW / 32), I_BR = (1024 / 64) * (DM / 32), I_SQ = (DM / 64) * (DM / 32);
        constexpr int NITEMS = 2 * I_IN + 6 * I_BR + 4 * I_SQ;
        for (int it = gw; it < NITEMS; it += NGW) {
            int r = it;
            if (r < 2 * I_IN) { const int l = r / I_IN; p0_transpose_item(a.in[13] + (size_t)l * DM * INW, DM, INW, (bf16*)(ws + WS_WIN) + (size_t)l * INW * DM, scr, r % I_IN, lane); continue; } r -= 2 * I_IN;
            if (r < 6 * I_BR) { const int lc = r / I_BR; p0_transpose_item(a.in[20] + (size_t)lc * 1024 * DM, 1024, DM, (bf16*)(ws + WS_WBR) + (size_t)lc * DM * 1024, scr, r % I_BR, lane); continue; } r -= 6 * I_BR;
            if (r < 2 * I_SQ) { const int l = r / I_SQ; p0_transpose_item(a.in[21] + (size_t)l * DM * DM, DM, DM, (bf16*)(ws + WS_WOUT) + (size_t)l * DM * DM, scr, r % I_SQ, lane); continue; } r -= 2 * I_SQ;
            { const int l = r / I_SQ; p0_transpose_item(a.in[22] + (size_t)l * DM * DM, DM, DM, (bf16*)(ws + WS_WPQ) + (size_t)l * DM * DM, scr, r % I_SQ, lane); }
        }
    }
    {
        const int gw = bx * 8 + wave, NGW = G * 8;
        fp8_rows(a, ws, gw, 32768, NGW, 0, lane);
        if (!defer_l1) fp8_rows(a, ws, gw, 32768, NGW, 16384, lane);
    }
}
__device__ __forceinline__ void fp8_rows_deferred(const Args& a, unsigned char* ws, int slot) {
    ws = fresh_ws(ws); const int tid = fresh_tid(), lane = tid & 63, wave = __builtin_amdgcn_readfirstlane(tid >> 6);
    const int lo_ = slot == 0 ? 0 : slot == 1 ? 6554 : slot == 2 ? 11469 : slot == 3 ? 16384 : slot == 4 ? 22938 : 27853;
    const int hi_ = slot == 0 ? 6554 : slot == 1 ? 11469 : slot == 2 ? 16384 : slot == 3 ? 22938 : slot == 4 ? 27853 : 32768;
    const int gw = ((int)blockIdx.x - 192) * 8 + wave;
    fp8_rows(a, ws, lo_ + gw, hi_, 512, 16384, lane);
}

__device__ __forceinline__ void norm_phase(const float* xp, const float* xs, const float* gain, const float* modl, int ch_sh, int ch_sc, bf16* H, int G) {
    const int tid = fresh_tid(), lane = tid & 63, gw = blockIdx.x * 8 + __builtin_amdgcn_readfirstlane(tid >> 6), NGW = G * 8;
    for (int row = gw; row < NTOK; row += NGW) {
        const float* xr = row < NPROMPT ? xp + (size_t)row * DM : xs + (size_t)(row - NPROMPT) * DM;
        const int r = row < NPROMPT ? 0 : 1 + ((row - NPROMPT) >> 10);
        const float* sh = modl + (size_t)r * 12288 + ch_sh * DM; const float* sc = modl + (size_t)r * 12288 + ch_sc * DM;
        f32x4 v[8]; float ss = 0.f;
#pragma unroll
        for (int j = 0; j < 8; ++j) { v[j] = *(const f32x4*)(xr + j * 256 + lane * 4); ss += (v[j][0] * v[j][0] + v[j][1] * v[j][1]) + (v[j][2] * v[j][2] + v[j][3] * v[j][3]); }
        const float rstd = 1.0f / sqrtf(wave_sum(ss) * (1.0f / DM) + EPS);
#pragma unroll
        for (int j = 0; j < 8; ++j) { const int c = j * 256 + lane * 4; const f32x4 g = *(const f32x4*)(gain + c), s1 = *(const f32x4*)(sc + c), s0 = *(const f32x4*)(sh + c);
            const f32x4 o = v[j] * rstd * g * (s1 + 1.0f) + s0; v2u w; w.x = pk2(o[0], o[1]); w.y = pk2(o[2], o[3]); *(v2u*)(H + (size_t)row * DM + c) = w; }
    }
}

__device__ __forceinline__ void rope_pair(float (&v)[16], const f32x2* tab, int fi0, bool first, int xm) {
#pragma unroll
    for (int e = 0; e < 16; ++e) { const float p = __shfl_xor(v[e], xm); const f32x2 cs = tab[fi0 + e]; v[e] = first ? v[e] * cs.x - p * cs.y : v[e] * cs.x + p * cs.y; }
}
__device__ __forceinline__ void prep_phase(const Args& a, unsigned char* ws, int l, int wg0, int nwg) {
    ws = fresh_ws(ws); const int tid = fresh_tid(), lane = tid & 63, gw = ((int)blockIdx.x - wg0) * 8 + __builtin_amdgcn_readfirstlane(tid >> 6), NGW = nwg * 8;
    const bf16* Z = (const bf16*)(ws + WS_Z); bf16* QA = (bf16*)(ws + WS_QA); bf16* KA = (bf16*)(ws + WS_KA); bf16* VA = (bf16*)(ws + WS_VA);
    const f32x2* R64 = (const f32x2*)(ws + WS_ROPE); const f32x2* R128 = R64 + 64 * 16;
    const float* dqk = a.in[16] + (size_t)l * 2 * 64; const float* gqk = a.in[19] + (size_t)l * 2 * 128;
    float* out = a.out;
    for (int task = gw; task < NTOK + 512; task += NGW) {
        if (task >= NTOK) {
            const int i = task - NTOK, b = i >> 8, p = i & 255; const size_t krow = (size_t)NPROMPT + b * 1280 + 1024 + p;
            float v[16];
            ld16f(a.in[3] + ((size_t)(b * 2 + l) * 256 + p) * 1024 + lane * 16, v); st16bf(KA + krow * KVW + lane * 16, v);
            ld16f(a.in[4] + ((size_t)(b * 2 + l) * 256 + p) * 1024 + lane * 16, v); st16bf(VA + krow * KVW + lane * 16, v);
            if (lane < 16) { ld16f(a.in[5] + ((size_t)(b * 2 + l) * 256 + p) * 256 + lane * 16, v); st16bf(KA + krow * KVW + 1024 + lane * 16, v);
                             ld16f(a.in[6] + ((size_t)(b * 2 + l) * 256 + p) * 256 + lane * 16, v); st16bf(VA + krow * KVW + 1024 + lane * 16, v); }
            continue;
        }
        const int row = task; const bool latent = row >= NPROMPT;
        int b, t; size_t krow;
        if (!latent) { b = row >> 8; t = row & 255; krow = row; } else { b = (row - NPROMPT) >> 10; t = (row - NPROMPT) & 1023; krow = (size_t)NPROMPT + b * 1280 + t; }
        const int prow = t >> 6, pcol = t & 63;
        const bf16* z = Z + (size_t)row * INW;
        const size_t co = ((size_t)(b * 2 + l) * 256 + t);
        float v[16];
        {
            ld16bf(z + C_DQ + lane * 16, v); float ss = 0.f;
#pragma unroll
            for (int e = 0; e < 16; ++e) ss += v[e] * v[e];
            ss += __shfl_xor(ss, 1); ss += __shfl_xor(ss, 2);
            const float rstd = 1.0f / sqrtf(ss * (1.0f / 64.0f) + EPS); const int sub = lane & 3; const float* gn = dqk + sub * 16;
#pragma unroll
            for (int e = 0; e < 16; ++e) v[e] = v[e] * rstd * gn[e];
            if (latent) rope_pair(v, R64 + (sub < 2 ? prow : pcol) * 16, 0, (sub & 1) == 0, 1);
#pragma unroll
            for (int e = 0; e < 16; ++e) v[e] *= 0.125f;
            const int he = lane >> 2, half = he & 1; bf16* q = QA + (size_t)row * 3072 + he * 128;
            st16bf(q + half * 64 + sub * 16, v);
            *(v4u*)(q + (1 - half) * 64 + sub * 16) = (v4u){0u, 0u, 0u, 0u}; *(v4u*)(q + (1 - half) * 64 + sub * 16 + 8) = (v4u){0u, 0u, 0u, 0u};
        }
        {
            ld16bf(z + C_DK + lane * 16, v); float ss = 0.f;
#pragma unroll
            for (int e = 0; e < 16; ++e) ss += v[e] * v[e];
            ss += __shfl_xor(ss, 1); ss += __shfl_xor(ss, 2);
            const float rstd = 1.0f / sqrtf(ss * (1.0f / 64.0f) + EPS); const int sub = lane & 3; const float* gn = dqk + 64 + sub * 16;
#pragma unroll
            for (int e = 0; e < 16; ++e) v[e] = v[e] * rstd * gn[e];
            if (latent) rope_pair(v, R64 + (sub < 2 ? prow : pcol) * 16, 0, (sub & 1) == 0, 1);
            else st16f(out + OUT_DK + co * 1024 + lane * 16, v);
            st16bf(KA + krow * KVW + lane * 16, v);
        }
        {
            ld16bf(z + C_DV + lane * 16, v);
            if (!latent) st16f(out + OUT_DV + co * 1024 + lane * 16, v);
            *(v4u*)(VA + krow * KVW + lane * 16) = *(const v4u*)(z + C_DV + lane * 16); *(v4u*)(VA + krow * KVW + lane * 16 + 8) = *(const v4u*)(z + C_DV + lane * 16 + 8);
        }
        {
            ld16bf(z + C_GQ + lane * 16, v); float ss = 0.f;
#pragma unroll
            for (int e = 0; e < 16; ++e) ss += v[e] * v[e];
            ss += __shfl_xor(ss, 1); ss += __shfl_xor(ss, 2); ss += __shfl_xor(ss, 4);
            const float rstd = 1.0f / sqrtf(ss * (1.0f / 128.0f) + EPS); const int sub = lane & 7; const float* gn = gqk + sub * 16;
#pragma unroll
            for (int e = 0; e < 16; ++e) v[e] = v[e] * rstd * gn[e];
            if (latent) rope_pair(v, R128 + (sub < 4 ? prow : pcol) * 32, (sub & 1) * 16, (sub & 2) == 0, 2);
#pragma unroll
            for (int e = 0; e < 16; ++e) v[e] *= 0.08838834764831845f;
            st16bf(QA + (size_t)row * 3072 + 2048 + lane * 16, v);
        }
        {
            const int ln = lane & 15;
            ld16bf(z + C_GK + ln * 16, v); float ss = 0.f;
#pragma unroll
            for (int e = 0; e < 16; ++e) ss += v[e] * v[e];
            ss += __shfl_xor(ss, 1); ss += __shfl_xor(ss, 2); ss += __shfl_xor(ss, 4);
            const float rstd = 1.0f / sqrtf(ss * (1.0f / 128.0f) + EPS); const int sub = lane & 7; const float* gn = gqk + 128 + sub * 16;
#pragma unroll
            for (int e = 0; e < 16; ++e) v[e] = v[e] * rstd * gn[e];
            if (latent) rope_pair(v, R128 + (sub < 4 ? prow : pcol) * 32, (sub & 1) * 16, (sub & 2) == 0, 2);
            if (lane < 16) { if (!latent) st16f(out + OUT_GK + co * 256 + lane * 16, v); st16bf(KA + krow * KVW + 1024 + lane * 16, v); }
            ld16bf(z + C_GV + ln * 16, v);
            if (lane < 16) { if (!latent) st16f(out + OUT_GV + co * 256 + lane * 16, v); st16bf(VA + krow * KVW + 1024 + lane * 16, v); }
        }
    }
}

typedef short bf16x4s __attribute__((ext_vector_type(4)));
typedef short bf16x8h __attribute__((ext_vector_type(8)));
constexpr int HG_QD = 0, HG_QR = 4352, HG_KR = 8704, HG_KDT = 13056, HG_VT = 17152, HG_DEC = 21248, HG_BUF = 22016, HG_TOTS = 2 * HG_BUF;
__device__ __forceinline__ void hgrn_item(const Args& a, unsigned char* ws, LAS unsigned char* lds, int l, int item, const XcdBarrier* barp = nullptr, int split = -1) {
    ws = fresh_ws(ws); const int tid = fresh_tid(), lane = tid & 63, wave = __builtin_amdgcn_readfirstlane(tid >> 6);
    const bf16* Z = (const bf16*)(ws + WS_Z);
    int b, h, dir, T, row0; const bool latent = item < 32;
    if (latent) { b = item >> 4; h = (item >> 1) & 7; dir = item & 1; T = 1024; row0 = NPROMPT + b * 1024; }
    else { const int it = item - 32; b = it >> 4; h = (it >> 1) & 7; dir = it & 1; T = 256; row0 = b * 256; }
    const bool stager = wave < 4;
    const int cl = lane & 15, gr = lane >> 4, kc = (wave & 3) * 16 + cl;
    const int fr = lane & 15, g = lane >> 4, vb = (wave & 3) * 32;
    const size_t sidx = ((((size_t)(b * 2 + l) * 2 + dir) * 8 + h) * 128) * 128;
    LAS unsigned char* base = lds + RING_OFF;
    const long ost = dir ? -1024 : 1024, zst = dir ? -(long)INW : (long)INW;
    const int nchunk = T >> 4;
#define HG_EXP(x) __builtin_amdgcn_exp2f(1.4426950408889634f * (x))
    if (stager) {
        float lb[2] = {0.f, 0.f};
        if (l == 1) { const float* hl = a.in[14];
#pragma unroll
            for (int ch = 0; ch < 2; ++ch) { const float a0 = hl[(dir * 2 + 0) * 1024 + h * 128 + 2 * kc + ch], a1 = hl[(dir * 2 + 1) * 1024 + h * 128 + 2 * kc + ch]; lb[ch] = 1.0f / (1.0f + expf(a0 - a1)); } }
        const bf16* const zb0 = Z + (size_t)(row0 + (dir ? T - 1 : 0)) * INW + h * 128 + 2 * kc + zst * (4 * gr);
        unsigned rqA[4], rzA[4], rvA[4], rqB[4], rzB[4], rvB[4];
#define HG_LOAD(rq, rz, rv, c) do { if ((c) < nchunk) { _Pragma("unroll") for (int i = 0; i < 4; ++i) { const bf16* zr = zb0 + zst * ((c) * 16 + i); \
            rq[i] = *(const unsigned*)(zr + C_HQ); rz[i] = *(const unsigned*)(zr + C_HF + dir * 1024); rv[i] = *(const unsigned*)(zr + C_HI); } } } while (0)
#define HG_STAGE(rq, rz, rv, pbuf) do { \
            float lf[2][4], kk[2][4]; \
            _Pragma("unroll") for (int i = 0; i < 4; ++i) _Pragma("unroll") for (int ch = 0; ch < 2; ++ch) { const float zf = ch ? bfhi(rz[i]) : bflo(rz[i]); const float e = HG_EXP(-fabsf(zf)), inv = __builtin_amdgcn_rcpf(1.0f + e); \
                const float sp = zf >= 0.f ? inv : e * inv, sn = zf >= 0.f ? e * inv : inv; kk[ch][i] = (1.0f - lb[ch]) * sn; lf[ch][i] = 0.6931471805599453f * __builtin_amdgcn_logf(lb[ch] + (1.0f - lb[ch]) * sp); } \
            float cs[2][4], pre[2], bm[2], b15[2]; \
            _Pragma("unroll") for (int ch = 0; ch < 2; ++ch) { cs[ch][0] = lf[ch][0]; cs[ch][1] = cs[ch][0] + lf[ch][1]; cs[ch][2] = cs[ch][1] + lf[ch][2]; cs[ch][3] = cs[ch][2] + lf[ch][3]; \
                float P = cs[ch][3]; float t_ = __shfl_up(P, 16); if (gr >= 1) P += t_; t_ = __shfl_up(P, 32); if (gr >= 2) P += t_;        \
                pre[ch] = P - cs[ch][3]; bm[ch] = __shfl(P, 16 + cl); b15[ch] = __shfl(P, 48 + cl); } \
            LAS unsigned char* pb_ = base + (pbuf) * HG_BUF; float kd[2][4]; \
            _Pragma("unroll") for (int i = 0; i < 4; ++i) { const int s = 4 * gr + i; float qd[2], qr[2], kr[2]; \
                _Pragma("unroll") for (int ch = 0; ch < 2; ++ch) { const float q = ch ? bfhi(rq[i]) : bflo(rq[i]); const float bb = pre[ch] + cs[ch][i]; \
                    const float er = HG_EXP(fminf(fmaxf(bb - bm[ch], -80.f), 80.f)); \
                    qd[ch] = q * HG_EXP(bb); qr[ch] = q * er; kr[ch] = kk[ch][i] * __builtin_amdgcn_rcpf(er); kd[ch][i] = kk[ch][i] * HG_EXP(b15[ch] - bb); } \
                *(LAS unsigned*)(pb_ + HG_QD + s * 272 + kc * 4) = pk2(qd[0], qd[1]); \
                *(LAS unsigned*)(pb_ + HG_QR + s * 272 + kc * 4) = pk2(qr[0], qr[1]); \
                *(LAS unsigned*)(pb_ + HG_KR + s * 272 + kc * 4) = pk2(kr[0], kr[1]); } \
            *(LAS v2u*)(pb_ + HG_KDT + (2 * kc) * 32 + gr * 8) = (v2u){pk2(kd[0][0], kd[0][1]), pk2(kd[0][2], kd[0][3])}; *(LAS v2u*)(pb_ + HG_KDT + (2 * kc + 1) * 32 + gr * 8) = (v2u){pk2(kd[1][0], kd[1][1]), pk2(kd[1][2], kd[1][3])}; \
            *(LAS v2u*)(pb_ + HG_VT + (2 * kc) * 32 + gr * 8) = (v2u){(rv[0] & 0xffffu) | (rv[1] << 16), (rv[2] & 0xffffu) | (rv[3] << 16)}; \
            *(LAS v2u*)(pb_ + HG_VT + (2 * kc + 1) * 32 + gr * 8) = (v2u){(rv[0] >> 16) | (rv[1] & 0xffff0000u), (rv[2] >> 16) | (rv[3] & 0xffff0000u)}; \
            if (gr == 0) *(LAS f32x2*)(pb_ + HG_DEC + kc * 8) = (f32x2){HG_EXP(b15[0]), HG_EXP(b15[1])}; \
        } while (0)
        HG_LOAD(rqA, rzA, rvA, 0); HG_LOAD(rqB, rzB, rvB, 1);
        HG_STAGE(rqA, rzA, rvA, 0);
        HG_LOAD(rqA, rzA, rvA, 2);
        __syncthreads();
        for (int c = 0; c < nchunk; c += 2) {
            if (c == split) xcd_barrier(*barp);
            HG_STAGE(rqB, rzB, rvB, 1); HG_LOAD(rqB, rzB, rvB, c + 3);
            __syncthreads();
            if (c + 2 < nchunk) { HG_STAGE(rqA, rzA, rvA, 0); HG_LOAD(rqA, rzA, rvA, c + 4); }
            __syncthreads();
        }
#undef HG_LOAD
#undef HG_STAGE
        __syncthreads();
    } else {
        bf16* OH = (bf16*)(ws + WS_OH) + (size_t)dir * NTOK * 1024;
        bf16* const ob0 = OH + (size_t)(row0 + (dir ? T - 1 : 0)) * 1024 + h * 128 + vb + fr + ost * (4 * g);
        f32x4 S0[8], S1[8];
        if (latent) { const float* st = a.in[7] + sidx;
#pragma unroll
            for (int kt = 0; kt < 8; ++kt)
#pragma unroll
                for (int r = 0; r < 4; ++r) { S0[kt][r] = st[(size_t)(16 * kt + 4 * g + r) * 128 + vb + fr]; S1[kt][r] = st[(size_t)(16 * kt + 4 * g + r) * 128 + vb + 16 + fr]; } }
        else {
#pragma unroll
            for (int kt = 0; kt < 8; ++kt) { S0[kt] = (f32x4){0.f, 0.f, 0.f, 0.f}; S1[kt] = (f32x4){0.f, 0.f, 0.f, 0.f}; } }
#define HG_OTILE(SS, nt_, c) do { f32x4 o = {0.f, 0.f, 0.f, 0.f}; \
            _Pragma("unroll") for (int ks = 0; ks < 4; ++ks) { \
                const v4u bs4 = {pk2(SS[2 * ks][0], SS[2 * ks][1]), pk2(SS[2 * ks][2], SS[2 * ks][3]), pk2(SS[2 * ks + 1][0], SS[2 * ks + 1][1]), pk2(SS[2 * ks + 1][2], SS[2 * ks + 1][3])}; \
                o = __builtin_amdgcn_mfma_f32_16x16x32_bf16(__builtin_bit_cast(bf16x8h, qa[ks]), __builtin_bit_cast(bf16x8h, bs4), o, 0, 0, 0); } \
            const v2u bv2 = *(const LAS v2u*)(pb_ + HG_VT + (vb + 16 * (nt_) + fr) * 32 + g * 8); const v4u bv4 = {bv2.x, bv2.y, 0u, 0u}; const bf16x8h bv = __builtin_bit_cast(bf16x8h, bv4); \
            o = __builtin_amdgcn_mfma_f32_16x16x32_bf16(pa, bv, o, 0, 0, 0); \
            _Pragma("unroll") for (int r = 0; r < 4; ++r) ob0[ost * ((c) * 16 + r) + 16 * (nt_)] = (bf16)f2bf(o[r]); \
            _Pragma("unroll") for (int kt = 0; kt < 8; ++kt) SS[kt] = __builtin_amdgcn_mfma_f32_16x16x32_bf16(__builtin_bit_cast(bf16x8h, ak[kt]), bv, SS[kt] * dd[kt], 0, 0, 0); } while (0)
#define HG_MFMA(c) do { \
            const LAS unsigned char* pb_ = base + ((c) & 1) * HG_BUF; \
            f32x4 at = {0.f, 0.f, 0.f, 0.f}; \
            _Pragma("unroll") for (int ks = 0; ks < 4; ++ks) { const bf16x8h ka = *(const LAS bf16x8h*)(pb_ + HG_KR + fr * 272 + (32 * ks + 8 * g) * 2), qb = *(const LAS bf16x8h*)(pb_ + HG_QR + fr * 272 + (32 * ks + 8 * g) * 2); \
                at = __builtin_amdgcn_mfma_f32_16x16x32_bf16(ka, qb, at, 0, 0, 0); }            \
            _Pragma("unroll") for (int r = 0; r < 4; ++r) if (4 * g + r > fr) at[r] = 0.f; \
            const v4u pa4 = {pk2(at[0], at[1]), pk2(at[2], at[3]), 0u, 0u}; const bf16x8h pa = __builtin_bit_cast(bf16x8h, pa4);     \
            v4u qa[4]; v4u ak[8]; f32x4 dd[8]; \
            _Pragma("unroll") for (int ks = 0; ks < 4; ++ks) { const v2u alo = *(const LAS v2u*)(pb_ + HG_QD + fr * 272 + (32 * ks + 4 * g) * 2), ahi = *(const LAS v2u*)(pb_ + HG_QD + fr * 272 + (32 * ks + 16 + 4 * g) * 2); qa[ks] = (v4u){alo.x, alo.y, ahi.x, ahi.y}; } \
            _Pragma("unroll") for (int kt = 0; kt < 8; ++kt) { dd[kt] = *(const LAS f32x4*)(pb_ + HG_DEC + (16 * kt + 4 * g) * 4); const v2u ak2 = *(const LAS v2u*)(pb_ + HG_KDT + (16 * kt + fr) * 32 + g * 8); ak[kt] = (v4u){ak2.x, ak2.y, 0u, 0u}; } \
            HG_OTILE(S0, 0, c); HG_OTILE(S1, 1, c); \
        } while (0)
        __syncthreads();
        for (int c = 0; c < nchunk; c += 2) {
            if (c == split) xcd_barrier(*barp);
            HG_MFMA(c);
            __syncthreads();
            HG_MFMA(c + 1);
            __syncthreads();
        }
#undef HG_MFMA
#undef HG_OTILE
        if (!latent) { float* st = a.out + OUT_ST + sidx;
#pragma unroll
            for (int kt = 0; kt < 8; ++kt)
#pragma unroll
                for (int r = 0; r < 4; ++r) { st[(size_t)(16 * kt + 4 * g + r) * 128 + vb + fr] = S0[kt][r]; st[(size_t)(16 * kt + 4 * g + r) * 128 + vb + 16 + fr] = S1[kt][r]; } }
        __syncthreads();
    }
#undef HG_EXP
}

__device__ __forceinline__ void attn_unit(unsigned char* ws, char* lds_generic, int u) {
    ws = fresh_ws(ws);
    int b, he, row0, key0, seq;
    if (u < 192) { b = u / 96; const int r = u % 96; he = r >> 2; const int qb = r & 3; row0 = NPROMPT + b * 1024 + qb * 256; key0 = NPROMPT + b * 1280; seq = 1280; }
    else { const int uu = u - 192; b = uu / 24; he = uu % 24; row0 = b * 256; key0 = b * 256; seq = 256; }
    const int kvh = he < 16 ? (he >> 1) : 8 + ((he - 16) >> 2);
    const att::bf16* Q = (const att::bf16*)(ws + WS_QA) + (size_t)row0 * 3072 + he * 128;
    const att::bf16* K = (const att::bf16*)(ws + WS_KA) + (size_t)key0 * KVW + kvh * 128;
    const att::bf16* V = (const att::bf16*)(ws + WS_VA) + (size_t)key0 * KVW + kvh * 128;
    unsigned short* O = (unsigned short*)(ws + WS_OA) + (size_t)row0 * 3072 + he * 128;
    att::attn_dense_body<att::bf16>(Q, K, V, O, seq, lds_generic + RING_OFF);
    __syncthreads();
}

__device__ __forceinline__ void post_phase(const Args& a, unsigned char* ws, int l, int G) {
    ws = fresh_ws(ws); const int tid = fresh_tid(), lane = tid & 63, gw = blockIdx.x * 8 + __builtin_amdgcn_readfirstlane(tid >> 6), NGW = G * 8;
    const bf16* Z = (const bf16*)(ws + WS_Z); const bf16* OA = (const bf16*)(ws + WS_OA); const bf16* OHf = (const bf16*)(ws + WS_OH); const bf16* OHb = OHf + (size_t)NTOK * 1024;
    bf16* BR = (bf16*)(ws + WS_BR);
    const float lam_init = 0.8f - 0.6f * expf(-0.3f * (float)l);
    const float* lp = a.in[17] + (size_t)l * 4 * 64;
    const float s01 = wave_sum(lp[lane] * lp[64 + lane]), s23 = wave_sum(lp[128 + lane] * lp[192 + lane]);
    const float lam = expf(s01) - expf(s23) + lam_init;
    const float* hn = a.in[15] + (size_t)l * 128; const float* sl = a.in[18] + (size_t)l * 128;
    const int sub = lane & 7;
    for (int row = gw; row < NTOK; row += NGW) {
        float v[16], w[16];
        {
            ld16bf(OHf + (size_t)row * 1024 + lane * 16, v); ld16bf(OHb + (size_t)row * 1024 + lane * 16, w); float ss = 0.f;
#pragma unroll
            for (int e = 0; e < 16; ++e) { v[e] += w[e]; ss += v[e] * v[e]; }
            ss += __shfl_xor(ss, 1); ss += __shfl_xor(ss, 2); ss += __shfl_xor(ss, 4);
            const float rstd = 1.0f / sqrtf(ss * (1.0f / 128.0f) + EPS);
            ld16bf(Z + (size_t)row * INW + C_HG + lane * 16, w);
#pragma unroll
            for (int e = 0; e < 16; ++e) { const float g = w[e]; v[e] = v[e] * rstd * hn[sub * 16 + e] * (g / (1.0f + expf(-g))); }
            st16bf(BR + (size_t)row * 1024 + lane * 16, v);
        }
        {
            const int h = lane >> 3; const bf16* o1 = OA + (size_t)row * 3072 + (2 * h) * 128 + sub * 16;
            ld16bf(o1, v); ld16bf(o1 + 128, w); float ss = 0.f;
#pragma unroll
            for (int e = 0; e < 16; ++e) { v[e] -= lam * w[e]; ss += v[e] * v[e]; }
            ss += __shfl_xor(ss, 1); ss += __shfl_xor(ss, 2); ss += __shfl_xor(ss, 4);
            const float rstd = 1.0f / sqrtf(ss * (1.0f / 128.0f) + EPS);
#pragma unroll
            for (int e = 0; e < 16; ++e) v[e] = v[e] * rstd * sl[sub * 16 + e] * (1.0f - lam_init);
            st16bf(BR + (size_t)NTOK * 1024 + (size_t)row * 1024 + lane * 16, v);
        }
        {
            *(v4u*)(BR + (size_t)2 * NTOK * 1024 + (size_t)row * 1024 + lane * 16) = *(const v4u*)(OA + (size_t)row * 3072 + 2048 + lane * 16); *(v4u*)(BR + (size_t)2 * NTOK * 1024 + (size_t)row * 1024 + lane * 16 + 8) = *(const v4u*)(OA + (size_t)row * 3072 + 2048 + lane * 16 + 8);
        }
    }
}

typedef short bf16x8s __attribute__((ext_vector_type(8)));
typedef float f32x16 __attribute__((ext_vector_type(16)));
__device__ __forceinline__ unsigned ford(float f) { const unsigned u = __float_as_uint(f); return u ^ ((u >> 31) ? 0xffffffffu : 0x80000000u); }
__device__ __forceinline__ float funord(unsigned k) { const unsigned u = (k & 0x80000000u) ? (k ^ 0x80000000u) : ~k; return __uint_as_float(u); }
__device__ __forceinline__ void ins16(unsigned (&L)[16], unsigned x) {
#pragma unroll
    for (int i = 0; i < 16; ++i) { const unsigned hi = L[i] > x ? L[i] : x; x = L[i] > x ? x : L[i]; L[i] = hi; }
}
__device__ __forceinline__ void ce_desc(unsigned& a_, unsigned& b_) { const unsigned hi = a_ > b_ ? a_ : b_, lo = a_ > b_ ? b_ : a_; a_ = hi; b_ = lo; }
__device__ __forceinline__ void sort16_desc(unsigned (&x)[16]) {
#pragma unroll
    for (int k = 2; k <= 16; k <<= 1)
#pragma unroll
        for (int j = k >> 1; j > 0; j >>= 1)
#pragma unroll
            for (int i = 0; i < 16; ++i) { const int l = i ^ j; if (l > i) { if ((i & k) == 0) ce_desc(x[i], x[l]); else ce_desc(x[l], x[i]); } }
}
__device__ __forceinline__ void merge16_desc(unsigned (&a_)[16], const unsigned (&b_)[16]) {
#pragma unroll
    for (int i = 0; i < 16; ++i) a_[i] = a_[i] > b_[15 - i] ? a_[i] : b_[15 - i];
#pragma unroll
    for (int j = 8; j > 0; j >>= 1)
#pragma unroll
        for (int i = 0; i < 16; ++i) { const int l = i ^ j; if (l > i) ce_desc(a_[i], a_[l]); }
}
__device__ __forceinline__ void peer_top16(unsigned (&L)[16], const LAS unsigned char* keysL, const bf16* qp, int c, int qrow, int hf) {
    f32x16 acc[4];
#pragma unroll
    for (int tl = 0; tl < 4; ++tl)
#pragma unroll
        for (int r = 0; r < 16; ++r) acc[tl][r] = 0.f;
    bf16x8s bq[8];
#pragma unroll
    for (int ks = 0; ks < 8; ++ks) bq[ks] = *(const bf16x8s*)(qp + c * 128 + ks * 16 + hf * 8);
#pragma unroll
    for (int ks = 0; ks < 8; ++ks)
#pragma unroll
        for (int tl = 0; tl < 4; ++tl) { const bf16x8s ka = *(const LAS bf16x8s*)(keysL + (c * 128 + tl * 32 + qrow) * 256 + (((ks * 2 + hf) ^ (qrow & 15)) << 4));
            acc[tl] = __builtin_amdgcn_mfma_f32_32x32x16_bf16(ka, bq[ks], acc[tl], 0, 0, 0); }
    unsigned K1[16], K2[16], K3[16];
#pragma unroll
    for (int r = 0; r < 16; ++r) { const unsigned kc = 127u - (unsigned)((r & 3) + 8 * (r >> 2)) - 4u * (unsigned)hf;
        L[r] = (ford(acc[0][r]) & 0xffffff80u) | kc; K1[r] = (ford(acc[1][r]) & 0xffffff80u) | (kc - 32u); K2[r] = (ford(acc[2][r]) & 0xffffff80u) | (kc - 64u); K3[r] = (ford(acc[3][r]) & 0xffffff80u) | (kc - 96u); }
    sort16_desc(L); sort16_desc(K1); sort16_desc(K2); sort16_desc(K3);
    merge16_desc(L, K1); merge16_desc(K2, K3); merge16_desc(L, K2);
    unsigned P[16];
#pragma unroll
    for (int i = 0; i < 16; ++i) P[i] = (unsigned)__shfl_xor((int)L[i], 32);
    merge16_desc(L, P);
}
__device__ __forceinline__ float gelu_erf(float x) { return 0.5f * x * (1.0f + erff(x * 0.70710678118654752f)); }
__device__ __forceinline__ void peer_topk_phase(const Args& a, unsigned char* ws, LAS unsigned char* lds, int l, int G) {
    ws = fresh_ws(ws); const int tid = fresh_tid(), lane = tid & 63, wave = __builtin_amdgcn_readfirstlane(tid >> 6);
    LAS unsigned char* keysL = lds + RING_OFF;
    LAS unsigned char* wtab = keysL + 65536 + wave * 2048;
    const float* pk = a.in[23] + (size_t)l * 2 * 128 * 128;
    for (int i = tid; i < 2 * 128 * 16; i += 512) { const int q = i & 15, rk = i >> 4, k = rk & 127;
        const f32x4 x0 = *(const f32x4*)(pk + (size_t)rk * 128 + q * 8), x1 = *(const f32x4*)(pk + (size_t)rk * 128 + q * 8 + 4);
        v4u o; o.x = pk2(x0[0], x0[1]); o.y = pk2(x0[2], x0[3]); o.z = pk2(x1[0], x1[1]); o.w = pk2(x1[2], x1[3]);
        *(LAS v4u*)(keysL + rk * 256 + ((q ^ (k & 15)) << 4)) = o; }
    __syncthreads();
    const bf16* QPb = (const bf16*)(ws + WS_QP); unsigned* PE = (unsigned*)(ws + WS_PE); unsigned* PG = (unsigned*)(ws + WS_PG);
    const int gw = blockIdx.x * 8 + wave, NGW = G * 8;
    const int hf = lane >> 5, qrow = lane & 31, tq = qrow >> 3, hq = qrow & 7;
    for (int tile = gw; tile < NTOK / 3; tile += NGW) {
        const int tok0 = tile * 3;
        const bf16* qp = QPb + (size_t)(tok0 + (tq < 3 ? tq : 2)) * DM + hq * 256;
        unsigned L0[16], L1[16];
        peer_top16(L0, keysL, qp, 0, qrow, hf);
        peer_top16(L1, keysL, qp, 1, qrow, hf);
        unsigned tw[8];
#pragma unroll
        for (int i = 0; i < 4; ++i) { tw[i] = (127u - (L0[4 * i] & 127u)) | ((127u - (L0[4 * i + 1] & 127u)) << 8) | ((127u - (L0[4 * i + 2] & 127u)) << 16) | ((127u - (L0[4 * i + 3] & 127u)) << 24);
                                      tw[4 + i] = (127u - (L1[4 * i] & 127u)) | ((127u - (L1[4 * i + 1] & 127u)) << 8) | ((127u - (L1[4 * i + 2] & 127u)) << 16) | ((127u - (L1[4 * i + 3] & 127u)) << 24); }
        *(LAS v4u*)(wtab + lane * 32) = (v4u){tw[0], tw[1], tw[2], tw[3]}; *(LAS v4u*)(wtab + lane * 32 + 16) = (v4u){tw[4], tw[5], tw[6], tw[7]};
        float v0[16], v1[16];
#pragma unroll
        for (int i = 0; i < 16; ++i) { v0[i] = funord(L0[i] & 0xffffff80u); v1[i] = funord(L1[i] & 0xffffff80u); }
        unsigned C[16], C1[16], C2[16], C3[16];
#pragma unroll
        for (int i = 0; i < 16; ++i) { C[i] = 0u; C1[i] = 0u; C2[i] = 0u; C3[i] = 0u; }
#pragma unroll
        for (int i = 0; i < 16; ++i)
#pragma unroll
            for (int j = 0; j < 16; ++j) if ((i + 1) * (j + 1) <= 16) {
                constexpr int PRE[16] = {0, 16, 24, 29, 33, 36, 38, 40, 42, 43, 44, 45, 46, 47, 48, 49};
                const int s = PRE[i] + j; const unsigned key = (ford(v0[i] + v1[j]) & 0xffffff00u) | (255u - (unsigned)(i * 16 + j));
                if (s < 16) C[s & 15] = key; else if (s < 32) C1[s & 15] = key; else if (s < 48) C2[s & 15] = key; else C3[s & 15] = key; }
        sort16_desc(C); sort16_desc(C1); sort16_desc(C2); sort16_desc(C3);
        merge16_desc(C, C1); merge16_desc(C2, C3); merge16_desc(C, C2);
        LDS_WAIT(); asm volatile("" ::: "memory");
        float ex[16]; float sum = 0.f; const float c0 = funord(C[0] & 0xffffff00u);
#pragma unroll
        for (int r = 0; r < 16; ++r) { ex[r] = expf(funord(C[r] & 0xffffff00u) - c0); sum += ex[r]; }
        const float rs = 1.0f / sum;
        if (tq < 3) { const size_t ob = (size_t)(tok0 + tq) * 128 + hq * 16;
            if (hf == 0) { unsigned ev[16];
#pragma unroll
                for (int r = 0; r < 16; ++r) { const unsigned ci = 255u - (C[r] & 255u); const unsigned k0 = wtab[lane * 32 + (ci >> 4)], k1 = wtab[lane * 32 + 16 + (ci & 15u)]; ev[r] = k0 * 128u + k1; }
#pragma unroll
                for (int r = 0; r < 16; r += 4) *(v4u*)(PE + ob + r) = (v4u){ev[r], ev[r + 1], ev[r + 2], ev[r + 3]}; }
            else {
#pragma unroll
                for (int r = 0; r < 16; r += 4) *(v4u*)(PG + ob + r) = (v4u){__float_as_uint(ex[r] * rs), __float_as_uint(ex[r + 1] * rs), __float_as_uint(ex[r + 2] * rs), __float_as_uint(ex[r + 3] * rs)}; }
        }
        LDS_WAIT(); asm volatile("" ::: "memory");
    }
    __syncthreads();
}
#define PEER_ACC(OUT) do { _Pragma("unroll") for (int j = 0; j < 8; ++j) { const int q = (int)w[t][j >> 2][j & 3]; \
        OUT[2 * j] = __builtin_elementwise_fma(__builtin_amdgcn_cvt_pk_f32_fp8(q, false), wg2, OUT[2 * j]); OUT[2 * j + 1] = __builtin_elementwise_fma(__builtin_amdgcn_cvt_pk_f32_fp8(q, true), wg2, OUT[2 * j + 1]); } } while (0)
__device__ __forceinline__ void fma_ip(float& o, float x, float w) { asm("v_fma_f32 %0, %1, %2, %0" : "+v"(o) : "v"(x), "v"(w)); }
__device__ __forceinline__ void peer_gather_phase(const Args& a, unsigned char* ws, LAS unsigned char* lds, int l, float* xout, int G, unsigned emask = 0xffffu, int skip = 0, bool n1fuse = false) {
    ws = fresh_ws(ws); const int tid = fresh_tid(), lane = tid & 63, wave = __builtin_amdgcn_readfirstlane(tid >> 6);
    LAS unsigned char* wb = lds + RING_OFF + wave * 16384;
    LAS v2u* list = (LAS v2u*)(wb + 12288); LAS unsigned* hist = (LAS unsigned*)(wb + 15360);
    const bf16* H = (const bf16*)(ws + WS_H); const unsigned* PE = (const unsigned*)(ws + WS_PE); const unsigned* PG = (const unsigned*)(ws + WS_PG);
    const unsigned char* UV8 = ws + WS_UV8 + (size_t)l * 16384 * 4096; const float* SC = (const float*)(ws + WS_SC) + (size_t)l * 16384 * 2;
    const float* XM = (const float*)(ws + WS_XM); const float* MOD = (const float*)(ws + WS_MOD) + (size_t)l * 3 * 12288;
    const int gw = blockIdx.x * 8 + wave, NGW = G * 8;
    for (int tile = gw; tile < NTOK / 3; tile += NGW) {
        const int tok0 = tile * 3;
        {
            unsigned e[6], gb[6], pos[6];
            hist[lane] = 0u; hist[64 + lane] = 0u; hist[128 + lane] = 0u;
#pragma unroll
            for (int m = 0; m < 6; ++m) { const size_t ix = (size_t)(tok0 + (m >> 1)) * 128 + ((lane + 64 * m) & 127); e[m] = PE[ix] & emask; gb[m] = PG[ix]; }
            LDS_WAIT(); asm volatile("" ::: "memory");
#pragma unroll
            for (int m = 0; m < 6; ++m) pos[m] = __hip_atomic_fetch_add(hist + (m >> 1) * 64 + (e[m] >> 8), 1u, __ATOMIC_RELAXED, __HIP_MEMORY_SCOPE_WORKGROUP);
            LDS_WAIT(); asm volatile("" ::: "memory");
            const unsigned cnt0 = hist[lane], cnt1 = hist[64 + lane], cnt2 = hist[128 + lane]; unsigned inc0 = cnt0, inc1 = cnt1, inc2 = cnt2;
#pragma unroll
            for (int o = 1; o < 64; o <<= 1) { const unsigned t0 = (unsigned)__shfl_up((int)inc0, o), t1 = (unsigned)__shfl_up((int)inc1, o), t2 = (unsigned)__shfl_up((int)inc2, o); if (lane >= o) { inc0 += t0; inc1 += t1; inc2 += t2; } }
            LDS_WAIT(); asm volatile("" ::: "memory");
            hist[lane] = inc0 - cnt0; hist[64 + lane] = 128u + inc1 - cnt1; hist[128 + lane] = 256u + inc2 - cnt2;
            LDS_WAIT(); asm volatile("" ::: "memory");
#pragma unroll
            for (int m = 0; m < 6; ++m) { const unsigned p_ = hist[(m >> 1) * 64 + (e[m] >> 8)] + pos[m]; list[p_] = (v2u){e[m], gb[m]}; }
            LDS_WAIT(); asm volatile("" ::: "memory");
        }
        if (!(skip & 1)) {
            unsigned hq[3][8]; float hs[3];
#pragma unroll
            for (int t = 0; t < 3; ++t) { float hv[8][4]; float mx = 0.f;
#pragma unroll
                for (int j = 0; j < 8; ++j) { const v2u a0 = *(const v2u*)(H + (size_t)(tok0 + t) * DM + j * 256 + lane * 4); hv[j][0] = bflo(a0.x); hv[j][1] = bfhi(a0.x); hv[j][2] = bflo(a0.y); hv[j][3] = bfhi(a0.y);
                    mx = fmaxf(fmaxf(mx, fmaxf(fabsf(hv[j][0]), fabsf(hv[j][1]))), fmaxf(fabsf(hv[j][2]), fabsf(hv[j][3]))); }
#pragma unroll
                for (int o = 1; o < 64; o <<= 1) mx = fmaxf(mx, __shfl_xor(mx, o));
                const float inv = mx > 0.f ? 127.0f / mx : 0.f; hs[t] = mx * (1.0f / 127.0f);
#pragma unroll
                for (int j = 0; j < 8; ++j) { const int q0 = (int)rintf(hv[j][0] * inv), q1 = (int)rintf(hv[j][1] * inv), q2 = (int)rintf(hv[j][2] * inv), q3 = (int)rintf(hv[j][3] * inv);
                    hq[t][j] = (unsigned)(q0 & 0xff) | ((unsigned)(q1 & 0xff) << 8) | ((unsigned)(q2 & 0xff) << 16) | ((unsigned)q3 << 24); } }
#define PU_LOAD(W, SCL, G_, kb_) do { _Pragma("unroll") for (int t = 0; t < 3; ++t) { const v2u r = list[t * 128 + (kb_)]; const int ee = __builtin_amdgcn_readfirstlane((int)r.x); G_[t] = __uint_as_float((unsigned)__builtin_amdgcn_readfirstlane((int)r.y)); \
            const unsigned char* base = UV8 + (size_t)ee * 4096 + lane * 32; W[t][0] = *(const v4u*)base; W[t][1] = *(const v4u*)(base + 16); SCL[t] = *(const f32x2*)(SC + (size_t)ee * 2); } } while (0)
#define PU_DOT(HV, Wt) ({ int s_ = 0; _Pragma("unroll") for (int j = 0; j < 8; ++j) s_ = __builtin_amdgcn_sdot4((int)Wt[j >> 2][j & 3], (int)HV[j], s_, false); s_; })
#define PU_RED(x_) do { x_ += __builtin_amdgcn_update_dpp(0, x_, 0xB1, 0xF, 0xF, false); x_ += __builtin_amdgcn_update_dpp(0, x_, 0x4E, 0xF, 0xF, false); \
            x_ += __builtin_amdgcn_update_dpp(0, x_, 0x141, 0xF, 0xF, false); x_ += __builtin_amdgcn_update_dpp(0, x_, 0x140, 0xF, 0xF, false); \
            x_ += __builtin_amdgcn_update_dpp(0, x_, 0x142, 0xA, 0xF, false); x_ += __builtin_amdgcn_update_dpp(0, x_, 0x143, 0xC, 0xF, false); } while (0)
#define PU_COMP(W, kb_) do { int d0 = PU_DOT(hq[0], W[0]), d1 = PU_DOT(hq[1], W[1]), d2 = PU_DOT(hq[2], W[2]); PU_RED(d0); PU_RED(d1); PU_RED(d2); \
            if (lane == 63) { dl[(kb_)] = d0; dl[128 + (kb_)] = d1; dl[256 + (kb_)] = d2; } } while (0)
            LAS int* dl = (LAS int*)wb;
            v4u wA[3][2], wB[3][2];
#define PU_LOAD2(W, kb_) do { _Pragma("unroll") for (int t = 0; t < 3; ++t) { const int ee = __builtin_amdgcn_readfirstlane((int)list[t * 128 + (kb_)].x); \
            const unsigned char* base = UV8 + (size_t)ee * 4096 + lane * 32; W[t][0] = *(const v4u*)base; W[t][1] = *(const v4u*)(base + 16); } } while (0)
            PU_LOAD2(wA, 0);
#pragma unroll 1
            for (int kb = 0; kb < 128; kb += 2) {
                PU_LOAD2(wB, kb + 1); PU_COMP(wA, kb);
                if (kb + 2 < 128) PU_LOAD2(wA, kb + 2);
                PU_COMP(wB, kb + 1);
            }
            LDS_WAIT(); asm volatile("" ::: "memory");
#pragma unroll
            for (int m = 0; m < 6; ++m) { const int li = lane + 64 * m; const v2u ent = list[li]; const f32x2 sc2 = *(const f32x2*)(SC + (size_t)ent.x * 2);
                ((LAS float*)list)[2 * li + 1] = __uint_as_float(ent.y) * gelu_erf((float)dl[li] * (sc2.x * hs[m >> 1])) * sc2.y; }
#undef PU_LOAD2
#undef PU_RED
#undef PU_LOAD
#undef PU_DOT
#undef PU_COMP
        }
        LDS_WAIT(); asm volatile("" ::: "memory");
        f32x2 out0[16], out1[16], out2[16];
#pragma unroll
        for (int i = 0; i < 16; ++i) { out0[i] = (f32x2){0.f, 0.f}; out1[i] = (f32x2){0.f, 0.f}; out2[i] = (f32x2){0.f, 0.f}; }
#define PV_LOAD(W, G_, kb_) do { _Pragma("unroll") for (int t = 0; t < 3; ++t) { const v2u r = list[t * 128 + (kb_)]; const int ee = __builtin_amdgcn_readfirstlane((int)r.x); G_[t] = __uint_as_float((unsigned)__builtin_amdgcn_readfirstlane((int)r.y)); \
            const unsigned char* base = UV8 + (size_t)ee * 4096 + 2048 + lane * 32; W[t][0] = *(const v4u*)base; W[t][1] = *(const v4u*)(base + 16); } } while (0)
#define PV_FMA(O, X, Wg) do { O.x = __builtin_fmaf(X.x, Wg, O.x); O.y = __builtin_fmaf(X.y, Wg, O.y); } while (0)
#define PV_COMP(W, G_) do { _Pragma("unroll") for (int t = 0; t < 3; ++t) { const float wg = G_[t]; \
            _Pragma("unroll") for (int j = 0; j < 8; ++j) { const int q = (int)W[t][j >> 2][j & 3]; const f32x2 lo = __builtin_amdgcn_cvt_pk_f32_fp8(q, false), hi = __builtin_amdgcn_cvt_pk_f32_fp8(q, true); \
                if (t == 0) { PV_FMA(out0[2 * j], lo, wg); PV_FMA(out0[2 * j + 1], hi, wg); } \
                else if (t == 1) { PV_FMA(out1[2 * j], lo, wg); PV_FMA(out1[2 * j + 1], hi, wg); } \
                else { PV_FMA(out2[2 * j], lo, wg); PV_FMA(out2[2 * j + 1], hi, wg); } } } } while (0)
        if (!(skip & 2)) {
            v4u wA[3][2], wB[3][2]; float gA[3], gB[3];
            PV_LOAD(wA, gA, 0);
#pragma unroll 1
            for (int kb = 0; kb < 128; kb += 2) {
                PV_LOAD(wB, gB, kb + 1); PV_COMP(wA, gA);
                if (kb + 2 < 128) PV_LOAD(wA, gA, kb + 2);
                PV_COMP(wB, gB);
            }
        }
#undef PV_LOAD
#undef PV_COMP
#pragma unroll
        for (int tt = 0; tt < 3; ++tt) {
            const int row = tok0 + tt; const int r = row < NPROMPT ? 0 : 1 + ((row - NPROMPT) >> 10);
            const float* g2 = MOD + (size_t)r * 12288 + 5 * DM;
            float ss = 0.f;
#pragma unroll
            for (int j = 0; j < 8; ++j) { const int c = j * 256 + lane * 4; const size_t off = (size_t)row * DM + c;
                const f32x4 x0 = *(const f32x4*)(XM + off), ga = *(const f32x4*)(g2 + c);
                const f32x2 oa = tt == 0 ? out0[2 * j] : (tt == 1 ? out1[2 * j] : out2[2 * j]), ob = tt == 0 ? out0[2 * j + 1] : (tt == 1 ? out1[2 * j + 1] : out2[2 * j + 1]);
                const f32x4 xo = x0 + ga * (f32x4){oa.x, oa.y, ob.x, ob.y}; *(f32x4*)(xout + off) = xo;
                ss += (xo[0] * xo[0] + xo[1] * xo[1]) + (xo[2] * xo[2] + xo[3] * xo[3]); }
            if (n1fuse) { const float* n1gain = a.in[11] + DM; const float* n1mod = (const float*)(ws + WS_MOD) + (size_t)3 * 12288;
                const float rstd = 1.0f / sqrtf(wave_sum(ss) * (1.0f / DM) + EPS); const float* sh = n1mod + (size_t)r * 12288; const float* sc = sh + DM; bf16* Hw = (bf16*)(ws + WS_H);
#pragma unroll
                for (int j = 0; j < 8; ++j) { const int c = j * 256 + lane * 4; const size_t off = (size_t)row * DM + c;
                    const f32x4 x0 = *(const f32x4*)(XM + off), ga = *(const f32x4*)(g2 + c);
                    const f32x2 oa = tt == 0 ? out0[2 * j] : (tt == 1 ? out1[2 * j] : out2[2 * j]), ob = tt == 0 ? out0[2 * j + 1] : (tt == 1 ? out1[2 * j + 1] : out2[2 * j + 1]);
                    const f32x4 xo = x0 + ga * (f32x4){oa.x, oa.y, ob.x, ob.y};
                    const f32x4 gn = *(const f32x4*)(n1gain + c), s1 = *(const f32x4*)(sc + c), s0 = *(const f32x4*)(sh + c);
                    const f32x4 o = xo * rstd * gn * (s1 + 1.0f) + s0; *(v2u*)(Hw + (size_t)row * DM + c) = (v2u){pk2(o[0], o[1]), pk2(o[2], o[3])}; }
            }
        }
        asm volatile("" ::: "memory");
    }
    __syncthreads();
}
#undef PEER_ACC

__device__ __forceinline__ unsigned dg_hash(unsigned x) { x ^= x >> 16; x *= 0x7feb352du; x ^= x >> 15; x *= 0x846ca68bu; x ^= x >> 16; return x; }
__device__ __forceinline__ void dummy_gather(unsigned char* ws, int mode, int G) {
    ws = fresh_ws(ws); const int tid = fresh_tid(), lane = tid & 63, wave = __builtin_amdgcn_readfirstlane(tid >> 6);
    const unsigned char* UV8 = ws + WS_UV8; const int gw = blockIdx.x * 8 + wave;
    f32x2 hv[16], out[16];
#pragma unroll
    for (int i = 0; i < 16; ++i) { hv[i] = (f32x2){(float)(lane + i) * 0.001f, (float)(lane - i) * 0.002f}; out[i] = (f32x2){0.f, 0.f}; }
    for (int jb = 0; jb < 384; jb += 4) {
        int e[4];
#pragma unroll
        for (int t = 0; t < 4; ++t) { const unsigned hsh = dg_hash((unsigned)(gw * 384 + jb + t) * 2654435761u + 12345u); e[t] = mode == 0 ? (int)(hsh & 16383u) : (int)((((unsigned)(jb + t) / 12u) << 9) | (hsh & 511u)); }
        v4u w[4][4];
#pragma unroll
        for (int t = 0; t < 4; ++t) { const unsigned char* base = UV8 + (size_t)e[t] * 4096 + lane * 32;
            w[t][0] = *(const v4u*)base; w[t][1] = *(const v4u*)(base + 16); w[t][2] = *(const v4u*)(base + 2048); w[t][3] = *(const v4u*)(base + 2048 + 16); }
        float d[4];
#pragma unroll
        for (int t = 0; t < 4; ++t) { f32x2 s = {0.f, 0.f};
#pragma unroll
            for (int j = 0; j < 8; ++j) { const int q = (int)w[t][j >> 2][j & 3];
                s = __builtin_elementwise_fma(__builtin_amdgcn_cvt_pk_f32_fp8(q, false), hv[2 * j], s); s = __builtin_elementwise_fma(__builtin_amdgcn_cvt_pk_f32_fp8(q, true), hv[2 * j + 1], s); }
            d[t] = s.x + s.y; }
#pragma unroll
        for (int o = 1; o < 64; o <<= 1) {
#pragma unroll
            for (int t = 0; t < 4; ++t) d[t] += __shfl_xor(d[t], o); }
#pragma unroll
        for (int t = 0; t < 4; ++t) { const float wg = d[t] * 1e-3f; const f32x2 wg2 = {wg, wg};
#pragma unroll
            for (int j = 0; j < 8; ++j) { const int q = (int)w[t][2 + (j >> 2)][j & 3];
                out[2 * j] = __builtin_elementwise_fma(__builtin_amdgcn_cvt_pk_f32_fp8(q, false), wg2, out[2 * j]); out[2 * j + 1] = __builtin_elementwise_fma(__builtin_amdgcn_cvt_pk_f32_fp8(q, true), wg2, out[2 * j + 1]); } }
    }
    float* scratch = (float*)(ws + WS_PE);
    float acc = 0.f;
#pragma unroll
    for (int i = 0; i < 16; ++i) acc += out[i].x + out[i].y;
    scratch[(size_t)gw * 64 + lane] = acc;
}
#ifdef PROBE_G1NS
struct ProbeOrder : pg8::StaticOrder {
    __device__ bool next(int i, pg8::Unit& u) const { const bool r = pg8::StaticOrder::next(i, u); if (PROBE_G1NS & 2) u.pn &= 1; if (PROBE_G1NS & 4) u.pm &= 1; return r; }
};
#endif
__global__ void __launch_bounds__(512, 2) mk_fwd(Args args) {
    extern __shared__ __attribute__((aligned(16))) unsigned char lds_raw[];
    LAS unsigned char* lds = (LAS unsigned char*)lds_raw;
    const int G = gridDim.x;
    unsigned char* ws = args.ws;
    unsigned* ctl = (unsigned*)(ws + WS_CTL);
    for (int u = threadIdx.x; u < RING_OFF / 4; u += 512) ((LAS unsigned*)lds)[u] = 0u;
    __syncthreads();
    const int lo = args.ph_lo, hi = args.ph_hi;
    XcdBarrier bar; bar.bar = ctl + CW_BAR; bar.x = 0; bar.st = (volatile LAS unsigned*)(lds + 32);
    if (hi - lo > 1) bar = xcd_barrier_post(ctl + CW_BAR, (volatile LAS unsigned*)(lds + 32));
#ifndef PH_EN
#define PH_EN 0xfff
#endif
#define PHEN(k) (((PH_EN) >> (k)) & 1)
#ifndef PROBE_DUP
#define PROBE_DUP 0
#endif
#define NREP(k) ((((PROBE_DUP) >> (k)) & 1) ? 2 : 1)
#define IN(k) (lo <= (k) && (k) < hi)
#define SEAM(k) do { if (IN(k) && IN((k) + 1)) xcd_barrier(bar); } while (0)

#ifndef PROBE_XBAR
#define PROBE_XBAR 0
#endif
    if (PHEN(0) && IN(0)) { for (int rep = 0; rep < NREP(0); ++rep) p0_prologue(args, ws, lds, G, lo == 0 && hi == NPH && G == 256); }
    SEAM(0);

    for (int l = 0; l < 2; ++l) {
        ws = fresh_ws(ws);
        const int pb = 1 + 11 * l;
#define MODall ((const float*)(ws + WS_MOD))
#define Hb ((bf16*)(ws + WS_H))
#define Zb ((bf16*)(ws + WS_Z))
        const float* xin_p = l == 0 ? args.in[0] : (const float*)(ws + WS_X1);
        const float* xin_s = l == 0 ? args.in[1] : (const float*)(ws + WS_X1) + (size_t)NPROMPT * DM;
        const float* modl = MODall + (size_t)l * 3 * 12288;
        for (int xb = 0; xb < PROBE_XBAR; ++xb) xcd_barrier(bar);
        const bool n1fused = lo == 0 && hi == NPH;
        const bool defer = lo == 0 && hi == NPH && G == 256 && (int)blockIdx.x >= 192;
        if (!(l == 1 && n1fused)) {
            if (PHEN(1) && IN(pb + 0)) for (int rep = 0; rep < NREP(1); ++rep) norm_phase(xin_p, xin_s, args.in[11] + (size_t)l * DM, modl, 0, 1, Hb, G);
            SEAM(pb + 0);
        }
#ifdef PROBE_G1NS
        { ws = fresh_ws(ws);
            pg8::Gemm g{Hb, (const bf16*)(ws + WS_WIN) + (size_t)l * INW * DM, NTOK, INW, DM}; ProbeOrder S; S.init(NTOK, INW, G, (int)blockIdx.x);
            pg8::EpiNull E{(float*)(ws + WS_QA)};
            pg8::gemm_phase<pg8::EpiNull, ProbeOrder, true, true>(lds + RING_OFF, g, S, E);
            xcd_barrier(bar);
        }
#endif
        if (PHEN(2) && IN(pb + 1)) for (int rep = 0; rep < NREP(2); ++rep) { ws = fresh_ws(ws);
            pg8::Gemm g{Hb, (const bf16*)(ws + WS_WIN) + (size_t)l * INW * DM, NTOK, INW, DM}; pg8::StaticOrder S; S.init(NTOK, INW, G, (int)blockIdx.x);
            pg8::EpiBf16<0> E{Zb, INW, nullptr, 0, 0, 1.f};
            pg8::gemm_phase<pg8::EpiBf16<0>, pg8::StaticOrder, true, true>(lds + RING_OFF, g, S, E);
        }
        SEAM(pb + 1);
        const bool early = IN(pb + 2) && IN(pb + 3) && G > 64;
        if (early && (int)blockIdx.x < 32) { hgrn_item(args, ws, lds, l, (int)blockIdx.x, &bar, 16); }
        else {
            if (PHEN(3) && IN(pb + 2)) for (int rep = 0; rep < NREP(3); ++rep) prep_phase(args, ws, l, early ? 32 : 0, early ? G - 32 : G);
            SEAM(pb + 2);
            if (PHEN(4) && IN(pb + 3)) for (int rep = 0; rep < NREP(4); ++rep) {
                const int bx = blockIdx.x;
                if (G > 64 && bx < 32) { for (int rp = 0; rp < NREP(12); ++rp) hgrn_item(args, ws, lds, l, bx); }
                else {
                    const int u0 = G > 64 ? bx - 32 : bx, us = G > 64 ? G - 32 : G;
                    if (G <= 64) for (int u = bx; u < 32; u += G) hgrn_item(args, ws, lds, l, u);
                    for (int rp = 0; rp < NREP(12); ++rp)
                    for (int u = u0; u < 832; u += us) if (u >= 192 && u < 448) hgrn_item(args, ws, lds, l, 32 + (u - 192));
                    for (int rp = 0; rp < NREP(13); ++rp)
                    for (int u = u0; u < 832; u += us) if (u < 192 || u >= 448) attn_unit(ws, (char*)lds_raw, u < 192 ? u : 192 + (u - 448));
                }
            }
        }
        SEAM(pb + 3);
        if (PHEN(5) && IN(pb + 4)) for (int rep = 0; rep < NREP(5); ++rep) post_phase(args, ws, l, G);
        SEAM(pb + 4);
        if (PHEN(6) && IN(pb + 5)) for (int rep = 0; rep < NREP(6); ++rep) { ws = fresh_ws(ws);
            pg8::StaticOrder S; S.init(NTOK, DM, G, (int)blockIdx.x);
            for (int c = 0; c < 3; ++c) {
                pg8::Gemm g{(const bf16*)(ws + WS_BR) + (size_t)c * NTOK * 1024, (const bf16*)(ws + WS_WBR) + (size_t)(l * 3 + c) * DM * 1024, NTOK, DM, 1024};
                pg8::EpiGate E{Zb, INW, C_GATE + c * DM, (bf16*)(ws + WS_MGP), (bf16*)(ws + WS_MG), DM, c};
                pg8::gemm_phase<pg8::EpiGate, pg8::StaticOrder, true, true>(lds + RING_OFF, g, S, E);
            }
            if (defer) fp8_rows_deferred(args, ws, 3 * l + 0);
        }
        SEAM(pb + 5);
        if (PHEN(7) && IN(pb + 6)) for (int rep = 0; rep < NREP(7); ++rep) { ws = fresh_ws(ws);
            pg8::Gemm g{(const bf16*)(ws + WS_MG), (const bf16*)(ws + WS_WOUT) + (size_t)l * DM * DM, NTOK, DM, DM}; pg8::StaticOrder S; S.init(NTOK, DM, G, (int)blockIdx.x);
            pg8::EpiResid E{xin_p, xin_s, modl + 2 * DM, (float*)(ws + WS_XM)};
            pg8::gemm_phase<pg8::EpiResid, pg8::StaticOrder, true, true>(lds + RING_OFF, g, S, E);
            if (defer) fp8_rows_deferred(args, ws, 3 * l + 1);
        }
        SEAM(pb + 6);
        if (PHEN(8) && IN(pb + 7)) for (int rep = 0; rep < NREP(8); ++rep) norm_phase((const float*)(ws + WS_XM), (const float*)(ws + WS_XM) + (size_t)NPROMPT * DM, args.in[12] + (size_t)l * DM, modl, 3, 4, Hb, G);
        SEAM(pb + 7);
        if (PHEN(9) && IN(pb + 8)) for (int rep = 0; rep < NREP(9); ++rep) { ws = fresh_ws(ws);
            pg8::Gemm g{Hb, (const bf16*)(ws + WS_WPQ) + (size_t)l * DM * DM, NTOK, DM, DM}; pg8::StaticOrder S; S.init(NTOK, DM, G, (int)blockIdx.x);
            pg8::EpiBf16<0> E{(bf16*)(ws + WS_QP), DM, nullptr, 0, 0, 1.f};
            pg8::gemm_phase<pg8::EpiBf16<0>, pg8::StaticOrder, true, true>(lds + RING_OFF, g, S, E);
            if (defer) fp8_rows_deferred(args, ws, 3 * l + 2);
        }
        SEAM(pb + 8);
#ifdef PROBE_DG
        dummy_gather(ws, PROBE_DG, G);
#endif
        if (PHEN(10) && IN(pb + 9)) for (int rep = 0; rep < NREP(10); ++rep) peer_topk_phase(args, ws, lds, l, G);
        SEAM(pb + 9);
        if (PHEN(11) && IN(pb + 10)) for (int rep = 0; rep < NREP(11); ++rep) peer_gather_phase(args, ws, lds, l, l == 0 ? (float*)(ws + WS_X1) : args.out, G, 0xffffu, 0, l == 0 && n1fused);
#ifdef PROBE_GM
        peer_gather_phase(args, ws, lds, l, (float*)(ws + WS_QA), G, PROBE_GM, 0);
#endif
        if (l == 0) SEAM(pb + 10);
    }
#undef MODall
#undef Hb
#undef Zb
#undef IN
#undef SEAM
}

extern "C" void kernel_launch(void* const* d_in, const int* in_sizes, int n_in, void* d_out, int out_size, void* d_ws, size_t ws_size, hipStream_t stream) {
    static int grid = 0;
    if (grid == 0) {
        if (n_in != 26 || (size_t)out_size != OUT_TOTAL || ws_size < WS_END) { fprintf(stderr, "kernel_launch: shape mismatch: n_in %d out %d ws %zu (need %zu)\n", n_in, out_size, ws_size, (size_t)WS_END); grid = -1; return; }
        int dev = 0, cus = 0, per_cu = 0;
        if (hipGetDevice(&dev) != hipSuccess || hipDeviceGetAttribute(&cus, hipDeviceAttributeMultiprocessorCount, dev) != hipSuccess) { grid = -1; return; }
        if (hipFuncSetAttribute((const void*)mk_fwd, hipFuncAttributeMaxDynamicSharedMemorySize, LDS_BYTES) != hipSuccess) { fprintf(stderr, "kernel_launch: hipFuncSetAttribute failed\n"); grid = -1; return; }
        if (hipOccupancyMaxActiveBlocksPerMultiprocessor(&per_cu, (const void*)mk_fwd, 512, LDS_BYTES) != hipSuccess || per_cu < 1) { fprintf(stderr, "kernel_launch: occupancy query says %d\n", per_cu); per_cu = 1; }
        (void)hipGetLastError();
        grid = cus;
    }
    if (grid < 0) return;
    (void)hipMemsetAsync((char*)d_ws + WS_CTL, 0, CTL_ZERO_BYTES, stream);
    Args a{};
    for (int i = 0; i < 26; ++i) a.in[i] = (const float*)d_in[i];
    a.out = (float*)d_out; a.ws = (unsigned char*)d_ws;
#if N_LAUNCH_MODE == 0
    a.ph_lo = 0; a.ph_hi = NPH;
    hipLaunchKernelGGL(mk_fwd, dim3(grid), dim3(512), LDS_BYTES, stream, a);
#else
    for (int p = 0; p < NPH; ++p) { a.ph_lo = p; a.ph_hi = p + 1; hipLaunchKernelGGL(mk_fwd, dim3(grid), dim3(512), LDS_BYTES, stream, a); }
#endif
    const hipError_t le = hipPeekAtLastError();
    if (le != hipSuccess) fprintf(stderr, "kernel_launch: launch failed: %s\n", hipGetErrorName(le));
}
```

```cpp
#include <hip/hip_runtime.h>
#include <hip/hip_bf16.h>
#include <cstdio>
#include <cstdint>
#include <cmath>
#define PROBE_DUP 0
#define HG_PROBE 0
#define PROBE_XBAR 0

#ifndef N_LAUNCH_MODE
#define N_LAUNCH_MODE 0
#endif
__device__ __forceinline__ int fresh_tid() { int t = (int)threadIdx.x; asm volatile("" : "+v"(t)); return t; }
__device__ __forceinline__ unsigned char* fresh_ws(unsigned char* p) { __attribute__((address_space(1))) unsigned char* g = (__attribute__((address_space(1))) unsigned char*)p; asm volatile("" : "+s"(g)); return (unsigned char*)g; }
namespace pg8 {
#define PG8_LAS __attribute__((address_space(3)))
typedef unsigned short bf16_t;
typedef short bf16x8 __attribute__((ext_vector_type(8)));
typedef float f32x4 __attribute__((ext_vector_type(4)));
typedef unsigned u32x4 __attribute__((ext_vector_type(4)));
constexpr int BM = 256, BK = 64, HALF = 128, HTB = HALF * BK * 2  , STAGE_BYTES = 8 * HTB, NXCD = 8, WGM = 8;

__host__ __device__ __forceinline__ int lds_byte(int r, int c) { const int st = (r >> 4) * 2 + (c >> 5), rr = r & 15, cc = c & 31, ob = rr * 64 + cc * 2; return st * 1024 + (ob ^ (((ob >> 9) & 1) << 5)); }
__host__ __device__ __forceinline__ void stage_rc(int b, int& R, int& C) { const int st = b / 1024, sb = b % 1024, swz = sb ^ (((sb >> 9) & 1) << 5); R = (st >> 1) * 16 + swz / 64; C = (st & 1) * 32 + (swz % 64) / 2; }
__host__ __device__ __forceinline__ int perm32(int rho) { const int n = rho >> 4, i = rho & 15; return 8 * (i >> 2) + 4 * n + (i & 3); }

struct Unit { int pm, pn; };
struct Gemm { const bf16_t* A; const bf16_t* Bt; int M, N, K; };

struct StaticOrder {
    int nM, nN, nwg, G, c;
    __host__ __device__ void init(int M, int N, int G_, int c_) { nM = M / BM; nN = N / BM; nwg = nM * nN; G = G_; c = c_; }
    __host__ __device__ bool next(int i, Unit& u) const {
        const long L = (long)i * G + c; if (L >= nwg) return false;
        int wgid = (int)L; { const int q = nwg / NXCD, r = nwg % NXCD, xcd = wgid % NXCD, off = wgid / NXCD; wgid = (xcd < r ? xcd * (q + 1) : r * (q + 1) + (xcd - r) * q) + off; }
        const int nig = WGM * nN, gid = wgid / nig, fm = gid * WGM, gsz = (nM - fm) < WGM ? (nM - fm) : WGM;
        u.pm = fm + ((wgid % nig) % gsz); u.pn = (wgid % nig) / gsz; return true;
    }
    __device__ __forceinline__ void a_ready(const Unit&) const {}
    __device__ __forceinline__ void done(const Unit&) const {}
};

__device__ __forceinline__ unsigned cvt_pk_bf16(float lo, float hi) { unsigned r; asm volatile("v_cvt_pk_bf16_f32 %0, %1, %2" : "=v"(r) : "v"(lo), "v"(hi)); return r; }
typedef float f32x2 __attribute__((ext_vector_type(2)));
__device__ __forceinline__ f32x2 gelu_pk(f32x2 v) {
    const f32x2 av = __builtin_elementwise_abs(v), d = av * 0.2316418882f + 1.0f;
    f32x2 t; t.x = __builtin_amdgcn_rcpf(d.x); t.y = __builtin_amdgcn_rcpf(d.y);
    f32x2 q = t * 0.5307027145f + (-0.7265760135f); q = q * t + 0.7107068705f; q = q * t + (-0.142248368f); q = q * t + 0.127414796f; q = q * t;
    const f32x2 s = (v * v) * (-0.72134752044f);
    f32x2 e; e.x = __builtin_amdgcn_exp2f(s.x); e.y = __builtin_amdgcn_exp2f(s.y);
    const f32x2 m = v * (q * e), r = v - m;
    f32x2 o; o.x = v.x < 0.f ? m.x : r.x; o.y = v.y < 0.f ? m.y : r.y; return o;
}

template <int ACT  > struct EpiBf16 {
    static constexpr bool PERM = true, AFTER_DRAIN = false; static_assert(ACT == 0 || ACT == 1, "EpiBf16: ACT is 0 (none) or 1 (gelu_pk)");
    bf16_t* O; int ldc; const float* bias; int split_cols; size_t split_stride; float scale0;
    __device__ __forceinline__ void operator()(const f32x4 (&acc)[2][2][4][2], const Unit& u, int wr, int wc, int fr, int fq) const {
        const int row0 = u.pm * BM + wr * 64 + fr; int colt = u.pn * BM; bf16_t* base = O;
        float sc = 1.f; if (split_cols) { const int t = colt / split_cols; base += (size_t)t * split_stride; colt -= t * split_cols; if (t == 0) sc = scale0; }
        const int col0 = colt + wc * 32 + 8 * fq, bcol0 = u.pn * BM + wc * 32 + 8 * fq;
        f32x4 bv[2][2];
#pragma unroll
        for (int bj = 0; bj < 2; ++bj)
#pragma unroll
            for (int n = 0; n < 2; ++n) bv[bj][n] = bias ? *(const f32x4*)(bias + bcol0 + bj * HALF + 4 * n) : (f32x4){0.f, 0.f, 0.f, 0.f};
#pragma unroll
        for (int ai = 0; ai < 2; ++ai)
#pragma unroll
            for (int m = 0; m < 4; ++m) { bf16_t* rowp = base + (size_t)(row0 + ai * HALF + m * 16) * ldc + col0;
#pragma unroll
                for (int bj = 0; bj < 2; ++bj) { f32x4 v0 = acc[ai][bj][m][0] + bv[bj][0], v1 = acc[ai][bj][m][1] + bv[bj][1];
                    if (ACT == 1) { f32x2 a = gelu_pk((f32x2){v0[0], v0[1]}), b = gelu_pk((f32x2){v0[2], v0[3]}), c = gelu_pk((f32x2){v1[0], v1[1]}), d = gelu_pk((f32x2){v1[2], v1[3]});
                        v0 = (f32x4){a.x, a.y, b.x, b.y}; v1 = (f32x4){c.x, c.y, d.x, d.y}; }
                    v0 = v0 * sc; v1 = v1 * sc; u32x4 w; w.x = cvt_pk_bf16(v0[0], v0[1]); w.y = cvt_pk_bf16(v0[2], v0[3]); w.z = cvt_pk_bf16(v1[0], v1[1]); w.w = cvt_pk_bf16(v1[2], v1[3]);
                    *(u32x4*)(rowp + bj * HALF) = w; } }
    }
};

struct EpiF32 {
    static constexpr bool PERM = false, AFTER_DRAIN = false;
    float* C; int ldc;
    __device__ __forceinline__ void operator()(const f32x4 (&acc)[2][2][4][2], const Unit& u, int wr, int wc, int fr, int fq) const {
        const int row0 = u.pm * BM + wr * 64 + fr, col0 = u.pn * BM + wc * 32 + 4 * fq;
#pragma unroll
        for (int ai = 0; ai < 2; ++ai)
#pragma unroll
            for (int m = 0; m < 4; ++m) { float* rowp = C + (size_t)(row0 + ai * HALF + m * 16) * ldc + col0;
#pragma unroll
                for (int bj = 0; bj < 2; ++bj)
#pragma unroll
                    for (int n = 0; n < 2; ++n) *(f32x4*)(rowp + bj * HALF + n * 16) = acc[ai][bj][m][n]; }
    }
};
__device__ __forceinline__ float sigmoid_f(float x) { return __builtin_amdgcn_rcpf(1.0f + __builtin_amdgcn_exp2f(-1.4426950408889634f * x)); }
struct EpiGate {
    static constexpr bool PERM = true, AFTER_DRAIN = false;
    const bf16_t* Z; int ldz; int gcol0; bf16_t* P; bf16_t* O; int ldc; int MODE;
    __device__ __forceinline__ void operator()(const f32x4 (&acc)[2][2][4][2], const Unit& u, int wr, int wc, int fr, int fq) const {
        const int row0 = u.pm * BM + wr * 64 + fr, col0 = u.pn * BM + wc * 32 + 8 * fq;
#pragma unroll
        for (int ai = 0; ai < 2; ++ai)
#pragma unroll
            for (int m = 0; m < 4; ++m) { const int row = row0 + ai * HALF + m * 16;
#pragma unroll
                for (int bj = 0; bj < 2; ++bj) { const int col = col0 + bj * HALF;
                    const u32x4 gz = *(const u32x4*)(Z + (size_t)row * ldz + gcol0 + col);
                    f32x4 s0, s1;
                    s0[0] = sigmoid_f(__uint_as_float(gz[0] << 16)); s0[1] = sigmoid_f(__uint_as_float(gz[0] & 0xffff0000u));
                    s0[2] = sigmoid_f(__uint_as_float(gz[1] << 16)); s0[3] = sigmoid_f(__uint_as_float(gz[1] & 0xffff0000u));
                    s1[0] = sigmoid_f(__uint_as_float(gz[2] << 16)); s1[1] = sigmoid_f(__uint_as_float(gz[2] & 0xffff0000u));
                    s1[2] = sigmoid_f(__uint_as_float(gz[3] << 16)); s1[3] = sigmoid_f(__uint_as_float(gz[3] & 0xffff0000u));
                    f32x4 v0 = acc[ai][bj][m][0] * s0, v1 = acc[ai][bj][m][1] * s1;
                    bf16_t* pp = P + (size_t)row * ldc + col;
                    if (MODE >= 1) { const u32x4 pw = *(const u32x4*)pp;
                        v0[0] += __uint_as_float(pw[0] << 16); v0[1] += __uint_as_float(pw[0] & 0xffff0000u); v0[2] += __uint_as_float(pw[1] << 16); v0[3] += __uint_as_float(pw[1] & 0xffff0000u);
                        v1[0] += __uint_as_float(pw[2] << 16); v1[1] += __uint_as_float(pw[2] & 0xffff0000u); v1[2] += __uint_as_float(pw[3] << 16); v1[3] += __uint_as_float(pw[3] & 0xffff0000u); }
                    u32x4 w; w.x = cvt_pk_bf16(v0[0], v0[1]); w.y = cvt_pk_bf16(v0[2], v0[3]); w.z = cvt_pk_bf16(v1[0], v1[1]); w.w = cvt_pk_bf16(v1[2], v1[3]);
                    *(u32x4*)((MODE <= 1 ? pp : O + (size_t)row * ldc + col)) = w; } }
    }
};
struct EpiResid {
    static constexpr bool PERM = false, AFTER_DRAIN = false;
    const float* xp; const float* xs; const float* gate; float* out;
    __device__ __forceinline__ void operator()(const f32x4 (&acc)[2][2][4][2], const Unit& u, int wr, int wc, int fr, int fq) const {
        const int row0 = u.pm * BM + wr * 64 + fr, col0 = u.pn * BM + wc * 32 + 4 * fq;
        const bool samp = u.pm >= 16; const int r = samp ? 1 + ((u.pm - 16) >> 2) : 0;
        const float* xb = samp ? xs - (size_t)4096 * 2048 : xp;
        f32x4 gv[2][2];
#pragma unroll
        for (int bj = 0; bj < 2; ++bj)
#pragma unroll
            for (int n = 0; n < 2; ++n) gv[bj][n] = *(const f32x4*)(gate + (size_t)r * 12288 + col0 + bj * HALF + n * 16);
#pragma unroll
        for (int ai = 0; ai < 2; ++ai)
#pragma unroll
            for (int m = 0; m < 4; ++m) { const size_t off = (size_t)(row0 + ai * HALF + m * 16) * 2048 + col0;
#pragma unroll
                for (int bj = 0; bj < 2; ++bj)
#pragma unroll
                    for (int n = 0; n < 2; ++n) { const f32x4 x = *(const f32x4*)(xb + off + bj * HALF + n * 16);
                        *(f32x4*)(out + off + bj * HALF + n * 16) = x + gv[bj][n] * acc[ai][bj][m][n]; } }
    }
};
struct EpiNull {
    static constexpr bool PERM = true, AFTER_DRAIN = false;
    float* sink;
    __device__ __forceinline__ void operator()(const f32x4 (&acc)[2][2][4][2], const Unit& u, int wr, int wc, int fr, int fq) const {
        f32x4 s = {0.f, 0.f, 0.f, 0.f};
#pragma unroll
        for (int ai = 0; ai < 2; ++ai)
#pragma unroll
            for (int bj = 0; bj < 2; ++bj)
#pragma unroll
                for (int m = 0; m < 4; ++m)
#pragma unroll
                    for (int n = 0; n < 2; ++n) s += acc[ai][bj][m][n];
        if (s[0] + s[1] + s[2] + s[3] == 1.2345e30f) *sink = 1.f;
    }
};

template <class Epi, class Sched, bool ALIGN_EPI = false, bool SP2 = false>
__device__ __forceinline__ void gemm_phase(PG8_LAS unsigned char* lds, const Gemm g, const Sched& S, const Epi& E) {
    const int tid = fresh_tid(), wid = __builtin_amdgcn_readfirstlane(tid >> 6), lane = tid & 63, wr = wid >> 2, wc = wid & 3, fr = lane & 15, fq = lane >> 4;
    const int K = g.K, nt = K / BK;
    unsigned voffA[2], voffB[2];
#pragma unroll
    for (int i = 0; i < 2; ++i) { int R, C; stage_rc(tid * 16 + i * 8192, R, C); const int Rb = Epi::PERM ? ((R & ~31) + perm32(R & 31)) : R;
        voffA[i] = (unsigned)(R * K + C) * 2u; voffB[i] = (unsigned)(Rb * K + C) * 2u; }
    const size_t kstep = (size_t)(BK * 2);
    const size_t hstep = (size_t)HALF * K * 2;
    const size_t tstep = 2 * hstep;
    const unsigned ldsw = (unsigned)wid * 1024u;
    const int aoff = lds_byte(wr * 64 + fr, fq * 8), boff = lds_byte(wc * 32 + fr, fq * 8);
#define PG8_SA(b, h) (((b) * 2 + (h)) * HTB)
#define PG8_SB(b, h) ((4 + (b) * 2 + (h)) * HTB)
#define PG8_STAGE(bufoff, gbase, voff) do { _Pragma("unroll") for (int _i = 0; _i < 2; ++_i) \
        __builtin_amdgcn_global_load_lds((const unsigned*)((const char*)(gbase) + (voff)[_i]), (PG8_LAS unsigned*)(lds + (bufoff) + ldsw + _i * 8192), 16, 0, 0); } while (0)
#define PG8_LDA(dst, b, h) do { _Pragma("unroll") for (int m = 0; m < 4; ++m) _Pragma("unroll") for (int k = 0; k < 2; ++k) dst[m][k] = *(const PG8_LAS bf16x8*)(lds + PG8_SA(b, h) + aoff + m * 2048 + k * 1024); } while (0)
#define PG8_LDB(dst, b, h) do { _Pragma("unroll") for (int n = 0; n < 2; ++n) _Pragma("unroll") for (int k = 0; k < 2; ++k) dst[n][k] = *(const PG8_LAS bf16x8*)(lds + PG8_SB(b, h) + boff + n * 2048 + k * 1024); } while (0)
#define PG8_MMA(ai, bj, At, Bt) do { __builtin_amdgcn_s_setprio(1); _Pragma("unroll") for (int m = 0; m < 4; ++m) _Pragma("unroll") for (int n = 0; n < 2; ++n) _Pragma("unroll") for (int k = 0; k < 2; ++k) \
        acc[ai][bj][m][n] = __builtin_amdgcn_mfma_f32_16x16x32_bf16(Bt[n][k], At[m][k], acc[ai][bj][m][n], 0, 0, 0); __builtin_amdgcn_s_setprio(0); } while (0)
#define PG8_WAIT_V(n) asm volatile("s_waitcnt vmcnt(" #n ")" ::: "memory")
#define PG8_WAIT_L(n) asm volatile("s_waitcnt lgkmcnt(" #n ")" ::: "memory")
#define PG8_BAR __builtin_amdgcn_s_barrier()
#define PG8_SCHED __builtin_amdgcn_sched_barrier(0)
    Unit cur, nxt; int ui = 0;
    if (!S.next(0, cur)) return;
    f32x4 acc[2][2][4][2];
#pragma unroll
    for (int a = 0; a < 2; ++a)
#pragma unroll
        for (int b = 0; b < 2; ++b)
#pragma unroll
            for (int m = 0; m < 4; ++m)
#pragma unroll
                for (int n = 0; n < 2; ++n) acc[a][b][m][n] = (f32x4){0.f, 0.f, 0.f, 0.f};
    bf16x8 At[4][2], B0[2][2], B1[2][2];
    const char* cA = (const char*)g.A + (size_t)cur.pm * tstep; const char* cB = (const char*)g.Bt + (size_t)cur.pn * tstep;
    S.a_ready(cur);
    if constexpr (SP2) {
        PG8_STAGE(PG8_SB(0, 0), cB, voffB); PG8_STAGE(PG8_SB(0, 1), cB + hstep, voffB); PG8_STAGE(PG8_SA(0, 0), cA, voffA); PG8_STAGE(PG8_SA(0, 1), cA + hstep, voffA);
        if (wr == 1) PG8_BAR;
        PG8_WAIT_V(2); PG8_BAR;
        PG8_STAGE(PG8_SB(1, 0), cB + kstep, voffB); PG8_STAGE(PG8_SA(1, 0), cA + kstep, voffA); PG8_STAGE(PG8_SB(1, 1), cB + hstep + kstep, voffB);
        PG8_WAIT_V(6); PG8_BAR;
    } else {
        PG8_STAGE(PG8_SB(0, 0), cB, voffB); PG8_STAGE(PG8_SA(0, 0), cA, voffA); PG8_STAGE(PG8_SB(0, 1), cB + hstep, voffB); PG8_STAGE(PG8_SA(0, 1), cA + hstep, voffA);
        if (wr == 1) PG8_BAR;
        PG8_WAIT_V(4); PG8_BAR;
        PG8_STAGE(PG8_SB(1, 0), cB + kstep, voffB); PG8_STAGE(PG8_SA(1, 0), cA + kstep, voffA); PG8_STAGE(PG8_SB(1, 1), cB + hstep + kstep, voffB);
        PG8_WAIT_V(6); PG8_BAR;
    }
    for (;;) {
        const bool has_next = S.next(ui + 1, nxt);
        const char* nA = has_next ? (const char*)g.A + (size_t)nxt.pm * tstep : cA; const char* nB = has_next ? (const char*)g.Bt + (size_t)nxt.pn * tstep : cB;
        for (int t = 0; t < nt; t += 2) {
            const bool last = (t == nt - 2);
            const char* a1 = cA + (size_t)(t + 1) * kstep;
            const char* a2 = last ? nA : cA + (size_t)(t + 2) * kstep; const char* b2 = last ? nB : cB + (size_t)(t + 2) * kstep;
            const char* a3 = a2 + kstep; const char* b3 = b2 + kstep;
            if (last && has_next) S.a_ready(nxt);
            if constexpr (SP2) {
            PG8_LDB(B0, 0, 0); PG8_LDB(B1, 0, 1); PG8_SCHED; PG8_LDA(At, 0, 0); PG8_STAGE(PG8_SA(1, 1), a1 + hstep, voffA);
            PG8_WAIT_V(8); PG8_WAIT_L(0); PG8_BAR; PG8_MMA(0, 0, At, B0); PG8_MMA(0, 1, At, B1); PG8_BAR; PG8_SCHED;
            PG8_LDA(At, 0, 1); PG8_STAGE(PG8_SB(0, 0), b2, voffB); PG8_STAGE(PG8_SB(0, 1), b2 + hstep, voffB); PG8_STAGE(PG8_SA(0, 0), a2, voffA);
            PG8_WAIT_V(8); PG8_WAIT_L(0); PG8_BAR; PG8_MMA(1, 0, At, B0); PG8_MMA(1, 1, At, B1); PG8_BAR; PG8_SCHED;
            PG8_LDB(B0, 1, 0); PG8_LDB(B1, 1, 1); PG8_SCHED; PG8_LDA(At, 1, 0); PG8_STAGE(PG8_SA(0, 1), a2 + hstep, voffA);
            PG8_WAIT_V(8); PG8_WAIT_L(0); PG8_BAR; PG8_MMA(0, 0, At, B0); PG8_MMA(0, 1, At, B1); PG8_BAR; PG8_SCHED;
            PG8_LDA(At, 1, 1); PG8_STAGE(PG8_SB(1, 0), b3, voffB); PG8_STAGE(PG8_SB(1, 1), b3 + hstep, voffB); PG8_STAGE(PG8_SA(1, 0), a3, voffA);
            PG8_WAIT_V(8); PG8_WAIT_L(0); PG8_BAR; PG8_MMA(1, 0, At, B0); PG8_MMA(1, 1, At, B1); PG8_BAR; PG8_SCHED;
            } else {
            PG8_LDB(B0, 0, 0); PG8_SCHED; PG8_LDA(At, 0, 0); PG8_STAGE(PG8_SA(1, 1), a1 + hstep, voffA);
            PG8_WAIT_L(8); PG8_BAR; PG8_WAIT_L(0); PG8_MMA(0, 0, At, B0); PG8_BAR; PG8_SCHED;
            PG8_LDB(B1, 0, 1); PG8_STAGE(PG8_SB(0, 0), b2, voffB);
            PG8_BAR; PG8_WAIT_L(0); PG8_MMA(0, 1, At, B1); PG8_BAR;
            PG8_LDA(At, 0, 1); PG8_STAGE(PG8_SA(0, 0), a2, voffA);
            PG8_BAR; PG8_WAIT_L(0); PG8_MMA(1, 0, At, B0); PG8_BAR; PG8_SCHED;
            PG8_STAGE(PG8_SB(0, 1), b2 + hstep, voffB);
            PG8_WAIT_V(6); PG8_BAR; PG8_MMA(1, 1, At, B1); PG8_BAR;
            PG8_LDB(B0, 1, 0); PG8_SCHED; PG8_LDA(At, 1, 0); PG8_STAGE(PG8_SA(0, 1), a2 + hstep, voffA);
            PG8_WAIT_L(8); PG8_BAR; PG8_WAIT_L(0); PG8_MMA(0, 0, At, B0); PG8_BAR; PG8_SCHED;
            PG8_LDB(B1, 1, 1); PG8_STAGE(PG8_SB(1, 0), b3, voffB);
            PG8_BAR; PG8_WAIT_L(0); PG8_MMA(0, 1, At, B1); PG8_BAR;
            PG8_LDA(At, 1, 1); PG8_STAGE(PG8_SA(1, 0), a3, voffA);
            PG8_BAR; PG8_WAIT_L(0); PG8_MMA(1, 0, At, B0); PG8_BAR; PG8_SCHED;
            PG8_STAGE(PG8_SB(1, 1), b3 + hstep, voffB);
            PG8_WAIT_V(6); PG8_BAR; PG8_MMA(1, 1, At, B1); PG8_BAR;
            }
        }
        if constexpr (ALIGN_EPI) { if (wr == 0) PG8_BAR; }
        if constexpr (!Epi::AFTER_DRAIN) { E(acc, cur, wr, wc, fr, fq); S.done(cur); }
        if (!has_next) break;
#pragma unroll
        for (int a = 0; a < 2; ++a)
#pragma unroll
            for (int b = 0; b < 2; ++b)
#pragma unroll
                for (int m = 0; m < 4; ++m)
#pragma unroll
                    for (int n = 0; n < 2; ++n) acc[a][b][m][n] = (f32x4){0.f, 0.f, 0.f, 0.f};
        cur = nxt; cA = nA; cB = nB; ++ui;
        if constexpr (ALIGN_EPI) { if (wr == 1) PG8_BAR; }
    }
    PG8_WAIT_V(0);
    if constexpr (!ALIGN_EPI) { if (wr == 0) PG8_BAR; }
    PG8_BAR;
    if constexpr (Epi::AFTER_DRAIN) { E.fused(acc, cur, wr, wc, fr, fq, lds, wid, lane); S.done(cur); }
#undef PG8_SA
#undef PG8_SB
#undef PG8_STAGE
#undef PG8_LDA
#undef PG8_LDB
#undef PG8_MMA
#undef PG8_WAIT_V
#undef PG8_WAIT_L
#undef PG8_BAR
#undef PG8_SCHED
}
}

namespace att {
using bf16 = __hip_bfloat16;
constexpr int D = 128, NW = 8, QBLK = 32, KVBLK = 64;
constexpr float SCALE = 1.0f;
constexpr float THR = 8.f;
constexpr int SDEPTH = 2;
constexpr int LDQ = 3072, LDK = 1280, LDO = 3072;
constexpr size_t SHM_V = KVBLK * D * 2, SHM_K = KVBLK * D * 2, SHM_ATTN = 2 * SHM_V + 2 * SHM_K + NW * 64 * 4;
typedef __bf16 abf16x2_t __attribute__((ext_vector_type(2))); typedef float af32x2_t __attribute__((ext_vector_type(2)));
__device__ __forceinline__ unsigned short bf1(float x) { const af32x2_t v = {x, x}; const abf16x2_t b = __builtin_convertvector(v, abf16x2_t); return (unsigned short)(__builtin_bit_cast(unsigned, b) & 0xffffu); }
using bf16x8 = __attribute__((ext_vector_type(8))) short;
using s16x4  = __attribute__((ext_vector_type(4))) short;
using f32x16 = __attribute__((ext_vector_type(16))) float;
using f32x8  = __attribute__((ext_vector_type(8))) float;
using u32x4  = __attribute__((ext_vector_type(4))) unsigned;
#define KSWZ(row, colB) ((row) * 256 + ((colB) ^ (((row) & 7) << 4)))
#define SBAR() __builtin_amdgcn_sched_barrier(0)
__device__ __forceinline__ int crow(int r, int hi) { return (r & 3) + 8 * (r >> 2) + 4 * hi; }
__device__ __forceinline__ unsigned cvtpk(float lo, float hi) {
  unsigned r; asm volatile("v_cvt_pk_bf16_f32 %0, %1, %2" : "=v"(r) : "v"(lo), "v"(hi)); return r;
}
template <typename TIn> struct Stage;
template <> struct Stage<bf16>  { using T = bf16x8;
  __device__ static __forceinline__ T ld8(const bf16* p) { return *reinterpret_cast<const bf16x8*>(p); }
  __device__ static __forceinline__ bf16x8 tobf(T x) { return x; } };
template <> struct Stage<float> { using T = f32x8;
  __device__ static __forceinline__ T ld8(const float* p) { return *reinterpret_cast<const f32x8*>(p); }
  __device__ static __forceinline__ bf16x8 tobf(T x) {
    u32x4 w = {cvtpk(x[0], x[1]), cvtpk(x[2], x[3]), cvtpk(x[4], x[5]), cvtpk(x[6], x[7])}; return *reinterpret_cast<bf16x8*>(&w); } };

__device__ __forceinline__ void partialSM(f32x16& p0, f32x16& p1, float& m_reg, float& mn, float& alpha) {
  constexpr float C = SCALE * 1.4426950408889634f;
  float pmax = p0[0]; for (int r = 1; r < 16; ++r) pmax = fmaxf(pmax, p0[r]); for (int r = 0; r < 16; ++r) pmax = fmaxf(pmax, p1[r]);
  { auto rr = __builtin_amdgcn_permlane32_swap(__float_as_uint(pmax), __float_as_uint(pmax), false, false);
    pmax = fmaxf(__uint_as_float(rr[0]), __uint_as_float(rr[1])); }
  if (__builtin_expect(__all(pmax - m_reg <= THR / SCALE), 1)) { mn = m_reg; alpha = 1.f; }
  else { mn = fmaxf(m_reg, pmax); alpha = __builtin_amdgcn_exp2f((m_reg - mn) * C); m_reg = mn; }
  float mnC = -mn * C;
  for (int r = 0; r < 16; ++r) p0[r] = fmaf(p0[r], C, mnC); for (int r = 0; r < 16; ++r) p1[r] = fmaf(p1[r], C, mnC);
  for (int r = 0; r < 16; ++r) p0[r] = __builtin_amdgcn_exp2f(p0[r]);
}
__device__ __forceinline__ void finishSM(f32x16& p0, f32x16& p1, float alpha, float& l_reg, bf16x8& pa0, bf16x8& pa1, bf16x8& pa2, bf16x8& pa3) {
  for (int r = 0; r < 16; ++r) p1[r] = __builtin_amdgcn_exp2f(p1[r]);
  float ps = 0; for (int r = 0; r < 16; ++r) ps += p0[r]; for (int r = 0; r < 16; ++r) ps += p1[r];
  { auto rr = __builtin_amdgcn_permlane32_swap(__float_as_uint(ps), __float_as_uint(ps), false, false);
    ps = __uint_as_float(rr[0]) + __uint_as_float(rr[1]); }
  l_reg = l_reg * alpha + ps;
#define PK4(P, BASE, OUT) do { unsigned a0 = cvtpk(P[BASE + 0], P[BASE + 1]), a1 = cvtpk(P[BASE + 2], P[BASE + 3]);   \
    unsigned b0 = cvtpk(P[BASE + 4], P[BASE + 5]), b1 = cvtpk(P[BASE + 6], P[BASE + 7]);                              \
    auto r0 = __builtin_amdgcn_permlane32_swap(a0, b0, false, false); auto r1 = __builtin_amdgcn_permlane32_swap(a1, b1, false, false); \
    u32x4 w = {r0[0], r1[0], r0[1], r1[1]}; OUT = *reinterpret_cast<bf16x8*>(&w); } while (0)
  PK4(p0, 0, pa0); PK4(p0, 8, pa1); PK4(p1, 0, pa2); PK4(p1, 8, pa3);
#undef PK4
}
__device__ __forceinline__ void qkt(f32x16& p0, f32x16& p1, const bf16* Ks, const bf16x8* qr, int r32, int hi) {
  p0 = f32x16{}; p1 = f32x16{};
  for (int d0 = 0; d0 < 8; ++d0) { int cb = (d0 * 16 + hi * 8) * 2;
    bf16x8 b0 = *reinterpret_cast<const bf16x8*>((const char*)Ks + KSWZ(r32, cb));
    bf16x8 b1 = *reinterpret_cast<const bf16x8*>((const char*)Ks + KSWZ(32 + r32, cb));
    p0 = __builtin_amdgcn_mfma_f32_32x32x16_bf16(b0, qr[d0], p0, 0, 0, 0);
    p1 = __builtin_amdgcn_mfma_f32_32x32x16_bf16(b1, qr[d0], p1, 0, 0, 0); }
}
__device__ __forceinline__ int v_st(int k, int c) { const int kk = (k & ~0xC) | ((k & 4) << 1) | ((k & 8) >> 1); return ((kk >> 3) * 4 + (c >> 5)) * 512 + ((kk & 7) * 32 + (c & 31)) * 2; }
__device__ __forceinline__ int v_rd_base(int lane) { return ((lane & 3) << 3) | (((lane >> 2) & 3) << 6) | (((lane >> 4) & 1) << 5) | (((lane >> 5) & 1) << 8); }
constexpr int v_rd_off(int d0, int ks, int half) { return d0 * 512 + ks * 4096 + half * 2048; }
template <int OFF> __device__ __forceinline__ s16x4 tr_read(int vb) {
  s16x4 r; asm volatile("ds_read_b64_tr_b16 %0, %1 offset:%2" : "=&v"(r) : "v"(vb), "i"(OFF) : "memory"); return r;
}
template <int D0> __device__ __forceinline__ void pv_one(f32x16& od, int vb, bf16x8 pa0, bf16x8 pa1, bf16x8 pa2, bf16x8 pa3) {
  const s16x4 l0 = tr_read<v_rd_off(D0, 0, 0)>(vb), h0 = tr_read<v_rd_off(D0, 0, 1)>(vb), l1 = tr_read<v_rd_off(D0, 1, 0)>(vb), h1 = tr_read<v_rd_off(D0, 1, 1)>(vb);
  const s16x4 l2 = tr_read<v_rd_off(D0, 2, 0)>(vb), h2 = tr_read<v_rd_off(D0, 2, 1)>(vb), l3 = tr_read<v_rd_off(D0, 3, 0)>(vb), h3 = tr_read<v_rd_off(D0, 3, 1)>(vb);
  asm volatile("s_waitcnt lgkmcnt(0)" ::: "memory"); SBAR();
#define PK(L, H) (bf16x8){L[0], L[1], L[2], L[3], H[0], H[1], H[2], H[3]}
  od = __builtin_amdgcn_mfma_f32_32x32x16_bf16(pa0, PK(l0, h0), od, 0, 0, 0);
  od = __builtin_amdgcn_mfma_f32_32x32x16_bf16(pa1, PK(l1, h1), od, 0, 0, 0);
  od = __builtin_amdgcn_mfma_f32_32x32x16_bf16(pa2, PK(l2, h2), od, 0, 0, 0);
  od = __builtin_amdgcn_mfma_f32_32x32x16_bf16(pa3, PK(l3, h3), od, 0, 0, 0);
#undef PK
}
__device__ __forceinline__ void pv_d0(f32x16* o, int vb, bf16x8 pa0, bf16x8 pa1, bf16x8 pa2, bf16x8 pa3) {
  pv_one<0>(o[0], vb, pa0, pa1, pa2, pa3); pv_one<1>(o[1], vb, pa0, pa1, pa2, pa3); pv_one<2>(o[2], vb, pa0, pa1, pa2, pa3); pv_one<3>(o[3], vb, pa0, pa1, pa2, pa3);
}

template <typename TQ>
__device__ __forceinline__ void attn_dense_body(const TQ* __restrict__ Qb, const bf16* __restrict__ Kh, const bf16* __restrict__ Vh,
                                                unsigned short* __restrict__ Ob, int seq, char* lds) {
  using St = Stage<bf16>; using SQ = Stage<TQ>;
  const int tid = fresh_tid(), wid = tid >> 6, lane = tid & 63, r32 = lane & 31, hi = lane >> 5;
  bf16* V_lds = (bf16*)lds; bf16* K_lds = (bf16*)(lds + 2 * SHM_V);
  float* ws = (float*)(lds + 2 * SHM_V + 2 * SHM_K) + wid * 64; float* li_l = ws; float* al_l = ws + 32;
  float m_reg = -1e30f, l_reg = 0; f32x16 o[4] = {}; bf16x8 qr[8];
  const TQ* Qw = Qb + (long)(wid * QBLK + r32) * LDQ + hi * 8;
#pragma unroll
  for (int d0 = 0; d0 < 8; ++d0) qr[d0] = SQ::tobf(SQ::ld8(Qw + d0 * 16));
  const int sr = tid >> 4, sc = (tid & 15) * 8, vst0 = v_st(sr, sc), vst1 = v_st(32 + sr, sc);
  const int vb0 = (int)(uintptr_t)V_lds + v_rd_base(lane);
  struct { typename St::T vs0, vs1, ks0, ks1; } sr_[SDEPTH];
#define SLOAD(i, k0) do { sr_[i].vs0 = St::ld8(&Vh[(long)((k0) + sr) * LDK + sc]); sr_[i].vs1 = St::ld8(&Vh[(long)((k0) + 32 + sr) * LDK + sc]); \
    sr_[i].ks0 = St::ld8(&Kh[(long)((k0) + sr) * LDK + sc]); sr_[i].ks1 = St::ld8(&Kh[(long)((k0) + 32 + sr) * LDK + sc]); } while (0)
#define SWRITE(b, i) do { *(bf16x8*)((char*)V_lds + (b) * SHM_V + vst0) = St::tobf(sr_[i].vs0);          \
    *(bf16x8*)((char*)V_lds + (b) * SHM_V + vst1) = St::tobf(sr_[i].vs1); int kc = sc * 2;               \
    *(bf16x8*)((char*)K_lds + (b) * SHM_K + KSWZ(sr, kc)) = St::tobf(sr_[i].ks0);                       \
    *(bf16x8*)((char*)K_lds + (b) * SHM_K + KSWZ(32 + sr, kc)) = St::tobf(sr_[i].ks1); } while (0)
#define SWAIT() do { if constexpr (SDEPTH == 2) asm volatile("s_waitcnt vmcnt(4)" ::: "memory"); else asm volatile("s_waitcnt vmcnt(0)" ::: "memory"); } while (0)
#define RESC(a) do { if (__any((a) < 1.f)) { if (hi == 0) al_l[r32] = (a); asm volatile("s_waitcnt lgkmcnt(0)" ::: "memory"); \
    for (int d = 0; d < 4; ++d) for (int r = 0; r < 16; ++r) o[d][r] *= al_l[crow(r, hi)]; } } while (0)
  f32x16 pA0, pA1, pB0, pB1; float mnA, mnB, alA, alB; bf16x8 pa0, pa1, pa2, pa3; const int NT = seq / KVBLK;
  constexpr int SE = 0, SO = SDEPTH - 1;
  SLOAD(SE, 0); asm volatile("s_waitcnt vmcnt(0)" ::: "memory"); SWRITE(0, SE); __syncthreads();
  qkt(pA0, pA1, K_lds, qr, r32, hi); partialSM(pA0, pA1, m_reg, mnA, alA);
  SLOAD(SO, KVBLK); if constexpr (SDEPTH == 2) { if (2 < NT) SLOAD(SE, 2 * KVBLK); }
  SWAIT(); SWRITE(1, SO); __syncthreads();
  for (int j = 1; j + 1 < NT; j += 2) {
    SBAR(); qkt(pB0, pB1, (bf16*)((char*)K_lds + SHM_K), qr, r32, hi);
    finishSM(pA0, pA1, alA, l_reg, pa0, pa1, pa2, pa3); SBAR();
    SLOAD(SO, (j + SDEPTH) * KVBLK); SBAR();
    pv_d0(o, vb0, pa0, pa1, pa2, pa3); partialSM(pB0, pB1, m_reg, mnB, alB);
    __syncthreads(); SWAIT(); SWRITE(0, SE);
    RESC(alB); __syncthreads();
    SBAR(); qkt(pA0, pA1, K_lds, qr, r32, hi);
    finishSM(pB0, pB1, alB, l_reg, pa0, pa1, pa2, pa3); SBAR();
    if (SDEPTH == 1 || j + 3 < NT) SLOAD(SE, (j + 1 + SDEPTH) * KVBLK); SBAR();
    pv_d0(o, vb0 + (int)SHM_V, pa0, pa1, pa2, pa3); partialSM(pA0, pA1, m_reg, mnA, alA);
    __syncthreads(); SWAIT(); SWRITE(1, SO);
    RESC(alA); __syncthreads();
  }
  SBAR(); qkt(pB0, pB1, (bf16*)((char*)K_lds + SHM_K), qr, r32, hi);
  finishSM(pA0, pA1, alA, l_reg, pa0, pa1, pa2, pa3); SBAR();
  pv_d0(o, vb0, pa0, pa1, pa2, pa3); partialSM(pB0, pB1, m_reg, mnB, alB);
  __syncthreads(); RESC(alB);
  finishSM(pB0, pB1, alB, l_reg, pa0, pa1, pa2, pa3); SBAR();
  pv_d0(o, vb0 + (int)SHM_V, pa0, pa1, pa2, pa3);
  if (hi == 0) li_l[r32] = l_reg; asm volatile("s_waitcnt lgkmcnt(0)" ::: "memory");
  float rli[16];
#pragma unroll
  for (int r = 0; r < 16; ++r) rli[r] = __builtin_amdgcn_rcpf(li_l[crow(r, hi)]);
  unsigned short* Ow = Ob + (long)(wid * QBLK) * LDO;
#pragma unroll
  for (int r = 0; r < 16; ++r) { int orow = crow(r, hi);
    for (int d0 = 0; d0 < 4; ++d0) Ow[(long)orow * LDO + d0 * 32 + r32] = bf1(o[d0][r] * rli[r]); }
#undef SLOAD
#undef SWRITE
#undef SWAIT
#undef RESC
}
}

constexpr int DM = 2048, NTOK = 6144, NPROMPT = 4096, INW = 15872;
constexpr int C_HQ = 0, C_HF = 1024, C_HI = 3072, C_HG = 4096, C_DQ = 5120, C_DK = 6144, C_DV = 7168, C_GQ = 8192, C_GK = 9216, C_GV = 9472, C_GATE = 9728;
constexpr int KROWS = 4096 + 2 * 1280;
constexpr int KVW = 1280;
constexpr float EPS = 1e-6f;
constexpr int NPH = 23;

constexpr size_t MiB = 1u << 20;
constexpr size_t WS_CTL = 0, CTL_ZERO_BYTES = 1 * MiB;
constexpr size_t WS_MOD = 1 * MiB, WS_ROPE = 2 * MiB, WS_WIN = 3 * MiB, WS_WBR = 127 * MiB, WS_WOUT = 151 * MiB, WS_WPQ = 167 * MiB, WS_PU = 183 * MiB, WS_PV = 311 * MiB;
constexpr size_t WS_H = 439 * MiB, WS_Z = 463 * MiB, WS_QA = 649 * MiB, WS_KA = 685 * MiB, WS_VA = 702 * MiB, WS_OA = 719 * MiB, WS_OH = 791 * MiB, WS_BR = 839 * MiB, WS_MG = 875 * MiB;
constexpr size_t WS_XM = 899 * MiB, WS_X1 = 947 * MiB, WS_PE = 995 * MiB, WS_PG = 998 * MiB, WS_END = 1001 * MiB;
constexpr size_t WS_UV8 = WS_PU, WS_SC = WS_PV;
constexpr size_t WS_QP = WS_OA;
constexpr size_t WS_MGP = WS_OH;
static_assert(WS_WIN + (size_t)2 * INW * DM * 2 <= WS_WBR && WS_Z + (size_t)NTOK * INW * 2 <= WS_QA && WS_KA + (size_t)KROWS * KVW * 2 <= WS_VA && WS_VA + (size_t)KROWS * KVW * 2 <= WS_OA, "d_ws map");
static_assert(WS_OA + (size_t)NTOK * 3072 * 4 <= WS_OH && WS_OH + (size_t)2 * NTOK * 1024 * 4 <= WS_BR && WS_BR + (size_t)3 * NTOK * 1024 * 2 <= WS_MG, "d_ws map 2");
constexpr int CW_BAR = 4096;

constexpr int LDS_BYTES = 163840, RING_OFF = 1024;

#define GAS __attribute__((address_space(1)))
#define LAS __attribute__((address_space(3)))
typedef unsigned short bf16;
typedef unsigned v4u __attribute__((ext_vector_type(4)));
typedef unsigned v2u __attribute__((ext_vector_type(2)));
typedef float f32x4 __attribute__((ext_vector_type(4)));
typedef float f32x2 __attribute__((ext_vector_type(2)));
typedef __bf16 bf16x2_t __attribute__((ext_vector_type(2)));
__device__ __forceinline__ unsigned pk2(float lo, float hi) { const f32x2 v = {lo, hi}; const bf16x2_t b = __builtin_convertvector(v, bf16x2_t); return __builtin_bit_cast(unsigned, b); }
__device__ __forceinline__ unsigned f2bf(float f) { return pk2(f, f) & 0xffffu; }
__device__ __forceinline__ float bflo(unsigned w) { return __uint_as_float(w << 16); }
__device__ __forceinline__ float bfhi(unsigned w) { return __uint_as_float(w & 0xffff0000u); }
__device__ __forceinline__ float wave_sum(float v) {
#pragma unroll
    for (int o = 1; o < 64; o <<= 1) v += __shfl_xor(v, o);
    return v;
}
__device__ __forceinline__ void ld16bf(const bf16* p, float (&v)[16]) {
    const v4u a = *(const v4u*)p, b = *(const v4u*)(p + 8);
    v[0] = bflo(a.x); v[1] = bfhi(a.x); v[2] = bflo(a.y); v[3] = bfhi(a.y); v[4] = bflo(a.z); v[5] = bfhi(a.z); v[6] = bflo(a.w); v[7] = bfhi(a.w);
    v[8] = bflo(b.x); v[9] = bfhi(b.x); v[10] = bflo(b.y); v[11] = bfhi(b.y); v[12] = bflo(b.z); v[13] = bfhi(b.z); v[14] = bflo(b.w); v[15] = bfhi(b.w);
}
__device__ __forceinline__ void ld16f(const float* p, float (&v)[16]) {
#pragma unroll
    for (int i = 0; i < 4; ++i) { const f32x4 x = *(const f32x4*)(p + 4 * i); v[4 * i] = x[0]; v[4 * i + 1] = x[1]; v[4 * i + 2] = x[2]; v[4 * i + 3] = x[3]; }
}
__device__ __forceinline__ void st16bf(bf16* p, const float (&v)[16]) {
    v4u a, b; a.x = pk2(v[0], v[1]); a.y = pk2(v[2], v[3]); a.z = pk2(v[4], v[5]); a.w = pk2(v[6], v[7]); b.x = pk2(v[8], v[9]); b.y = pk2(v[10], v[11]); b.z = pk2(v[12], v[13]); b.w = pk2(v[14], v[15]);
    *(v4u*)p = a; *(v4u*)(p + 8) = b;
}
__device__ __forceinline__ void st16f(float* p, const float (&v)[16]) {
#pragma unroll
    for (int i = 0; i < 4; ++i) *(f32x4*)(p + 4 * i) = (f32x4){v[4 * i], v[4 * i + 1], v[4 * i + 2], v[4 * i + 3]};
}

#define XB_TMO      128
#define XB_XCNT(j)  (256  + 64 * (j))
#define XB_XSUB(j)  (1280 + 64 * (j))
#define XB_XGEN(j)  (2304 + 64 * (j))
#define XB_TOP      3328
#define XB_TOPGEN   3392
#define XCD_BAR_WORDS 3456
#define XB_SPIN_CAP (1u << 18)

__device__ __forceinline__ unsigned xb_ld(unsigned* p)              { return __hip_atomic_load(p, __ATOMIC_RELAXED, __HIP_MEMORY_SCOPE_AGENT); }
__device__ __forceinline__ unsigned xb_add(unsigned* p, unsigned v) { return __hip_atomic_fetch_add(p, v, __ATOMIC_RELAXED, __HIP_MEMORY_SCOPE_AGENT); }
__device__ __forceinline__ unsigned xb_xcc_id() { return (unsigned)__builtin_amdgcn_s_getreg((3 << 11) | 20) & 0xFu; }
#define XB_SPIN(cond, bar) do { unsigned _sp = 0; while (cond) { __builtin_amdgcn_s_sleep(1); \
    if ((++_sp & 255u) == 0u) { if (xb_ld(&(bar)[XB_TMO])) break; if (_sp > XB_SPIN_CAP) { atomicAdd(&(bar)[XB_TMO], 1u); break; } } } } while (0)

struct XcdBarrier {
    unsigned* bar; unsigned x;
    volatile LAS unsigned* st;
};

__device__ __forceinline__ XcdBarrier xcd_barrier_post(unsigned* bar, volatile LAS unsigned* st) {
    XcdBarrier b; b.bar = bar; b.x = xb_xcc_id(); b.st = st;
    if (threadIdx.x == 0) (void)xb_add(&bar[XB_XCNT(b.x)], 1u);
    return b;
}
__device__ __forceinline__ void xcd_barrier_complete(unsigned* bar, unsigned x, unsigned& nloc, unsigned& nx) {
    const unsigned G = gridDim.x * gridDim.y * gridDim.z;
    unsigned sum, cnt, mine, sp = 0u;
    for (;;) {
        sum = 0u; cnt = 0u; mine = 0u;
#pragma unroll
        for (unsigned j = 0; j < 16; ++j) { const unsigned c = xb_ld(&bar[XB_XCNT(j)]); sum += c; cnt += (c > 0u) ? 1u : 0u; mine = (j == x) ? c : mine; }
        if (sum == G) break;
        __builtin_amdgcn_s_sleep(1);
        if ((++sp & 255u) == 0u) { if (xb_ld(&bar[XB_TMO])) break; if (sp > XB_SPIN_CAP) { atomicAdd(&bar[XB_TMO], 1u); break; } }
    }
    nloc = mine > 0u ? mine : 1u; nx = cnt > 0u ? cnt : 1u;
}

__device__ __forceinline__ void xcd_barrier(const XcdBarrier& b) {
    asm volatile("s_waitcnt vmcnt(0)" ::: "memory");
    __syncthreads();
    if (threadIdx.x == 0) {
        unsigned* bar = b.bar;
        __builtin_amdgcn_s_waitcnt(0);
        unsigned nloc = b.st[0], nx = b.st[1];
        if (nloc == 0u) { xcd_barrier_complete(bar, b.x, nloc, nx); b.st[0] = nloc; b.st[1] = nx; }
        const unsigned old = xb_add(&bar[XB_XSUB(b.x)], 1u);
        const unsigned gen = old / nloc;
        if (old + 1u == (gen + 1u) * nloc) {
            __builtin_amdgcn_fence(__ATOMIC_RELEASE, "agent");
            asm volatile("s_waitcnt vmcnt(0)" ::: "memory");
            const unsigned og = xb_add(&bar[XB_TOP], 1u);
            const unsigned tg = og / nx;
            if (og + 1u == (tg + 1u) * nx) xb_add(&bar[XB_TOPGEN], 1u);
            else XB_SPIN(xb_ld(&bar[XB_TOPGEN]) == tg, bar);
            __builtin_amdgcn_fence(__ATOMIC_ACQUIRE, "agent");
            xb_add(&bar[XB_XGEN(b.x)], 1u);
            asm volatile("s_waitcnt vmcnt(0)" ::: "memory");
        } else {
            XB_SPIN(xb_ld(&bar[XB_XGEN(b.x)]) == gen, bar);
            __builtin_amdgcn_fence(__ATOMIC_ACQUIRE, "agent");
            asm volatile("s_waitcnt vmcnt(0)" ::: "memory");
        }
    }
    __syncthreads();
}
struct Args { const float* in[26]; float* out; unsigned char* ws; int ph_lo, ph_hi; };
constexpr size_t OUT_YP = 0, OUT_DK = 12582912, OUT_DV = 20971520, OUT_GK = 29360128, OUT_GV = 31457280, OUT_ST = 33554432, OUT_TOTAL = 41943040;
#define LDS_WAIT() asm volatile("s_waitcnt lgkmcnt(0)" ::: "memory")

__device__ __forceinline__ void p0_transpose_item(const float* W, int K, int N, bf16* WT, LAS float* scr, int item, int lane) {
    const int nblk = N / 32, kb = item / nblk, nb = item % nblk, k0 = 64 * kb, n0 = 32 * nb;
    f32x4 tv[8];
#pragma unroll
    for (int i = 0; i < 8; ++i) tv[i] = *(const f32x4*)(W + (size_t)(k0 + (lane >> 3) + 8 * i) * N + n0 + 4 * (lane & 7));
#pragma unroll
    for (int i = 0; i < 8; ++i) { LAS float* d = scr + ((lane >> 3) + 8 * i) * 33 + 4 * (lane & 7); d[0] = tv[i][0]; d[1] = tv[i][1]; d[2] = tv[i][2]; d[3] = tv[i][3]; }
    LDS_WAIT(); asm volatile("" ::: "memory");
    const int c = lane & 7;
#pragma unroll
    for (int j = 0; j < 4; ++j) { const int n = (lane >> 3) + 8 * j; const LAS float* s = scr + (8 * c) * 33 + n;
        v4u o; o.x = pk2(s[0 * 33], s[1 * 33]); o.y = pk2(s[2 * 33], s[3 * 33]); o.z = pk2(s[4 * 33], s[5 * 33]); o.w = pk2(s[6 * 33], s[7 * 33]);
        *(v4u*)(WT + (size_t)(n0 + n) * K + k0 + 8 * c) = o; }
    LDS_WAIT(); asm volatile("" ::: "memory");
}
__device__ __forceinline__ void fp8_row_load(const Args& a, int t, int le, int lane, f32x4 (&x)[8]) {
    const float* src = a.in[24 + t] + (size_t)le * 2048;
#pragma unroll
    for (int j = 0; j < 8; ++j) x[j] = *(const f32x4*)(src + j * 256 + lane * 4);
}
__device__ __forceinline__ void fp8_row_finish(unsigned char* ws, int t, int le, int lane, const f32x4 (&x)[8]) {
    unsigned char* UV8 = ws + WS_UV8; float* SC = (float*)(ws + WS_SC);
    float mx = 0.f;
#pragma unroll
    for (int j = 0; j < 8; ++j) mx = fmaxf(fmaxf(mx, fmaxf(fabsf(x[j][0]), fabsf(x[j][1]))), fmaxf(fabsf(x[j][2]), fabsf(x[j][3])));
#pragma unroll
    for (int o = 1; o < 64; o <<= 1) mx = fmaxf(mx, __shfl_xor(mx, o));
    const float qmax = t == 0 ? 127.0f : 448.0f;
    const float sc = mx > 0.f ? mx / qmax : 1.0f, inv = mx > 0.f ? qmax / mx : 0.f;
    unsigned w[8];
    if (t == 0) {
#pragma unroll
        for (int j = 0; j < 8; ++j) { const int q0 = (int)rintf(x[j][0] * inv), q1 = (int)rintf(x[j][1] * inv), q2 = (int)rintf(x[j][2] * inv), q3 = (int)rintf(x[j][3] * inv);
            w[j] = (unsigned)(q0 & 0xff) | ((unsigned)(q1 & 0xff) << 8) | ((unsigned)(q2 & 0xff) << 16) | ((unsigned)q3 << 24); }
    } else {
#pragma unroll
        for (int j = 0; j < 8; ++j) { int q = __builtin_amdgcn_cvt_pk_fp8_f32(x[j][0] * inv, x[j][1] * inv, 0, false); q = __builtin_amdgcn_cvt_pk_fp8_f32(x[j][2] * inv, x[j][3] * inv, q, true); w[j] = (unsigned)q; }
    }
    unsigned char* dst = UV8 + (size_t)le * 4096 + t * 2048 + lane * 32;
    *(v4u*)dst = (v4u){w[0], w[1], w[2], w[3]}; *(v4u*)(dst + 16) = (v4u){w[4], w[5], w[6], w[7]};
    if (lane == 0) SC[le * 2 + t] = sc;
}
__device__ __forceinline__ void fp8_rows(const Args& a, unsigned char* ws, int i0, int i1, int st, int lebase, int lane) {
    f32x4 xa[8], xb[8];
    if (i0 < i1) fp8_row_load(a, i0 >> 14, lebase + (i0 & 16383), lane, xa);
    for (int i = i0; i < i1; i += 2 * st) {
        const int i2 = i + st, i3 = i + 2 * st;
        if (i2 < i1) fp8_row_load(a, i2 >> 14, lebase + (i2 & 16383), lane, xb);
        fp8_row_finish(ws, i >> 14, lebase + (i & 16383), lane, xa);
        if (i3 < i1) fp8_row_load(a, i3 >> 14, lebase + (i3 & 16383), lane, xa);
        if (i2 < i1) fp8_row_finish(ws, i2 >> 14, lebase + (i2 & 16383), lane, xb);
    }
}
__device__ __forceinline__ void p0_prologue(const Args& a, unsigned char* ws, LAS unsigned char* lds, int G, bool defer_l1) {
    ws = fresh_ws(ws); const int tid = fresh_tid(), lane = tid & 63, wave = __builtin_amdgcn_readfirstlane(tid >> 6);
    const int bx = blockIdx.x;
    __syncthreads();
    {
        LAS float* sil = (LAS float*)(lds + RING_OFF); LAS float* red = sil + 3 * 2048;
        const float* c_ctx = a.in[8]; const float* cc = a.in[2];
        for (int i = tid; i < 3 * 2048; i += 512) { const int r = i >> 11, k = i & 2047; const float c = r == 0 ? c_ctx[k] : cc[(r - 1) * 2048 + k]; sil[i] = c / (1.0f + expf(-c)); }
        __syncthreads();
        const float* mod_w = a.in[9]; const float* mod_b = a.in[10]; float* MOD = (float*)(ws + WS_MOD);
        const int cg = tid % 24, kg = tid / 24;
        for (int task = bx; task < 256; task += G) {
            const int l = task >> 7, col0 = (task & 127) * 96;
            if (kg < 21) {
                float acc[3][4];
#pragma unroll
                for (int r = 0; r < 3; ++r)
#pragma unroll
                    for (int j = 0; j < 4; ++j) acc[r][j] = 0.f;
                const float* wp = mod_w + ((size_t)l * 2048) * 12288 + col0 + cg * 4;
#pragma unroll 4
                for (int k = kg; k < 2048; k += 21) { const f32x4 w = *(const f32x4*)(wp + (size_t)k * 12288); const float s0 = sil[k], s1 = sil[2048 + k], s2 = sil[4096 + k];
#pragma unroll
                    for (int j = 0; j < 4; ++j) { acc[0][j] += s0 * w[j]; acc[1][j] += s1 * w[j]; acc[2][j] += s2 * w[j]; } }
#pragma unroll
                for (int r = 0; r < 3; ++r)
#pragma unroll
                    for (int j = 0; j < 4; ++j) red[(kg * 24 + cg) * 12 + r * 4 + j] = acc[r][j];
            }
            __syncthreads();
            if (tid < 288) { const int r = tid / 96, c = tid % 96, g4 = c >> 2, j = c & 3; float s = 0.f;
                for (int q = 0; q < 21; ++q) s += red[(q * 24 + g4) * 12 + r * 4 + j];
                MOD[(size_t)(l * 3 + r) * 12288 + col0 + c] = s + mod_b[l * 12288 + col0 + c]; }
            __syncthreads();
        }
    }
    {
        f32x2* R64 = (f32x2*)(ws + WS_ROPE); f32x2* R128 = R64 + 64 * 16;
        const int gt = bx * 512 + tid;
        if (gt < 64 * 16) { const int pos = gt >> 4, i = gt & 15; const float inv = exp2f(-13.287712379549449f * (float)i / 16.0f); const float ang = (float)pos * inv; R64[gt] = (f32x2){cosf(ang), sinf(ang)}; }
        else if (gt < 64 * 16 + 64 * 32) { const int g2 = gt - 64 * 16, pos = g2 >> 5, i = g2 & 31; const float inv = exp2f(-13.287712379549449f * (float)i / 32.0f); const float ang = (float)pos * inv; R128[g2] = (f32x2){cosf(ang), sinf(ang)}; }
    }
    {
        LAS float* scr = (LAS float*)(lds + RING_OFF + wave * 16384);
        const int gw = bx * 8 + wave, NGW = G * 8;
        constexpr int I_IN = (DM / 64) * (INW / 32), I_BR = (1024 / 64) * (DM / 32), I_SQ = (DM / 64) * (DM / 32);
        constexpr int NITEMS = 2 * I_IN + 6 * I_BR + 4 * I_SQ;
        for (int it = gw; it < NITEMS; it += NGW) {
            int r = it;
            if (r < 2 * I_IN) { const int l = r / I_IN; p0_transpose_item(a.in[13] + (size_t)l * DM * INW, DM, INW, (bf16*)(ws + WS_WIN) + (size_t)l * INW * DM, scr, r % I_IN, lane); continue; } r -= 2 * I_IN;
            if (r < 6 * I_BR) { const int lc = r / I_BR; p0_transpose_item(a.in[20] + (size_t)lc * 1024 * DM, 1024, DM, (bf16*)(ws + WS_WBR) + (size_t)lc * DM * 1024, scr, r % I_BR, lane); continue; } r -= 6 * I_BR;
            if (r < 2 * I_SQ) { const int l = r / I_SQ; p0_transpose_item(a.in[21] + (size_t)l * DM * DM, DM, DM, (bf16*)(ws + WS_WOUT) + (size_t)l * DM * DM, scr, r % I_SQ, lane); continue; } r -= 2 * I_SQ;
            { const int l = r / I_SQ; p0_transpose_item(a.in[22] + (size_t)l * DM * DM, DM, DM, (bf16*)(ws + WS_WPQ) + (size_t)l * DM * DM, scr, r % I_SQ, lane); }
        }
    }
    {
        const int gw = bx * 8 + wave, NGW = G * 8;
        fp8_rows(a, ws, gw, 32768, NGW, 0, lane);
        if (!defer_l1) fp8_rows(a, ws, gw, 32768, NGW, 16384, lane);
    }
}
__device__ __forceinline__ void fp8_rows_deferred(const Args& a, unsigned char* ws, int slot) {
    ws = fresh_ws(ws); const int tid = fresh_tid(), lane = tid & 63, wave = __builtin_amdgcn_readfirstlane(tid >> 6);
    const int lo_ = slot == 0 ? 0 : slot == 1 ? 6554 : slot == 2 ? 11469 : slot == 3 ? 16384 : slot == 4 ? 22938 : 27853;
    const int hi_ = slot == 0 ? 6554 : slot == 1 ? 11469 : slot == 2 ? 16384 : slot == 3 ? 22938 : slot == 4 ? 27853 : 32768;
    const int gw = ((int)blockIdx.x - 192) * 8 + wave;
    fp8_rows(a, ws, lo_ + gw, hi_, 512, 16384, lane);
}

__device__ __forceinline__ void norm_phase(const float* xp, const float* xs, const float* gain, const float* modl, int ch_sh, int ch_sc, bf16* H, int G) {
    const int tid = fresh_tid(), lane = tid & 63, gw = blockIdx.x * 8 + __builtin_amdgcn_readfirstlane(tid >> 6), NGW = G * 8;
    for (int row = gw; row < NTOK; row += NGW) {
        const float* xr = row < NPROMPT ? xp + (size_t)row * DM : xs + (size_t)(row - NPROMPT) * DM;
        const int r = row < NPROMPT ? 0 : 1 + ((row - NPROMPT) >> 10);
        const float* sh = modl + (size_t)r * 12288 + ch_sh * DM; const float* sc = modl + (size_t)r * 12288 + ch_sc * DM;
        f32x4 v[8]; float ss = 0.f;
#pragma unroll
        for (int j = 0; j < 8; ++j) { v[j] = *(const f32x4*)(xr + j * 256 + lane * 4); ss += (v[j][0] * v[j][0] + v[j][1] * v[j][1]) + (v[j][2] * v[j][2] + v[j][3] * v[j][3]); }
        const float rstd = 1.0f / sqrtf(wave_sum(ss) * (1.0f / DM) + EPS);
#pragma unroll
        for (int j = 0; j < 8; ++j) { const int c = j * 256 + lane * 4; const f32x4 g = *(const f32x4*)(gain + c), s1 = *(const f32x4*)(sc + c), s0 = *(const f32x4*)(sh + c);
            const f32x4 o = v[j] * rstd * g * (s1 + 1.0f) + s0; v2u w; w.x = pk2(o[0], o[1]); w.y = pk2(o[2], o[3]); *(v2u*)(H + (size_t)row * DM + c) = w; }
    }
}

__device__ __forceinline__ void rope_pair(float (&v)[16], const f32x2* tab, int fi0, bool first, int xm) {
#pragma unroll
    for (int e = 0; e < 16; ++e) { const float p = __shfl_xor(v[e], xm); const f32x2 cs = tab[fi0 + e]; v[e] = first ? v[e] * cs.x - p * cs.y : v[e] * cs.x + p * cs.y; }
}
__device__ __forceinline__ void prep_phase(const Args& a, unsigned char* ws, int l, int wg0, int nwg) {
    ws = fresh_ws(ws); const int tid = fresh_tid(), lane = tid & 63, gw = ((int)blockIdx.x - wg0) * 8 + __builtin_amdgcn_readfirstlane(tid >> 6), NGW = nwg * 8;
    const bf16* Z = (const bf16*)(ws + WS_Z); bf16* QA = (bf16*)(ws + WS_QA); bf16* KA = (bf16*)(ws + WS_KA); bf16* VA = (bf16*)(ws + WS_VA);
    const f32x2* R64 = (const f32x2*)(ws + WS_ROPE); const f32x2* R128 = R64 + 64 * 16;
    const float* dqk = a.in[16] + (size_t)l * 2 * 64; const float* gqk = a.in[19] + (size_t)l * 2 * 128;
    float* out = a.out;
    for (int task = gw; task < NTOK + 512; task += NGW) {
        if (task >= NTOK) {
            const int i = task - NTOK, b = i >> 8, p = i & 255; const size_t krow = (size_t)NPROMPT + b * 1280 + 1024 + p;
            float v[16];
            ld16f(a.in[3] + ((size_t)(b * 2 + l) * 256 + p) * 1024 + lane * 16, v); st16bf(KA + krow * KVW + lane * 16, v);
            ld16f(a.in[4] + ((size_t)(b * 2 + l) * 256 + p) * 1024 + lane * 16, v); st16bf(VA + krow * KVW + lane * 16, v);
            if (lane < 16) { ld16f(a.in[5] + ((size_t)(b * 2 + l) * 256 + p) * 256 + lane * 16, v); st16bf(KA + krow * KVW + 1024 + lane * 16, v);
                             ld16f(a.in[6] + ((size_t)(b * 2 + l) * 256 + p) * 256 + lane * 16, v); st16bf(VA + krow * KVW + 1024 + lane * 16, v); }
            continue;
        }
        const int row = task; const bool latent = row >= NPROMPT;
        int b, t; size_t krow;
        if (!latent) { b = row >> 8; t = row & 255; krow = row; } else { b = (row - NPROMPT) >> 10; t = (row - NPROMPT) & 1023; krow = (size_t)NPROMPT + b * 1280 + t; }
        const int prow = t >> 6, pcol = t & 63;
        const bf16* z = Z + (size_t)row * INW;
        const size_t co = ((size_t)(b * 2 + l) * 256 + t);
        float v[16];
        {
            ld16bf(z + C_DQ + lane * 16, v); float ss = 0.f;
#pragma unroll
            for (int e = 0; e < 16; ++e) ss += v[e] * v[e];
            ss += __shfl_xor(ss, 1); ss += __shfl_xor(ss, 2);
            const float rstd = 1.0f / sqrtf(ss * (1.0f / 64.0f) + EPS); const int sub = lane & 3; const float* gn = dqk + sub * 16;
#pragma unroll
            for (int e = 0; e < 16; ++e) v[e] = v[e] * rstd * gn[e];
            if (latent) rope_pair(v, R64 + (sub < 2 ? prow : pcol) * 16, 0, (sub & 1) == 0, 1);
#pragma unroll
            for (int e = 0; e < 16; ++e) v[e] *= 0.125f;
            const int he = lane >> 2, half = he & 1; bf16* q = QA + (size_t)row * 3072 + he * 128;
            st16bf(q + half * 64 + sub * 16, v);
            *(v4u*)(q + (1 - half) * 64 + sub * 16) = (v4u){0u, 0u, 0u, 0u}; *(v4u*)(q + (1 - half) * 64 + sub * 16 + 8) = (v4u){0u, 0u, 0u, 0u};
        }
        {
            ld16bf(z + C_DK + lane * 16, v); float ss = 0.f;
#pragma unroll
            for (int e = 0; e < 16; ++e) ss += v[e] * v[e];
            ss += __shfl_xor(ss, 1); ss += __shfl_xor(ss, 2);
            const float rstd = 1.0f / sqrtf(ss * (1.0f / 64.0f) + EPS); const int sub = lane & 3; const float* gn = dqk + 64 + sub * 16;
#pragma unroll
            for (int e = 0; e < 16; ++e) v[e] = v[e] * rstd * gn[e];
            if (latent) rope_pair(v, R64 + (sub < 2 ? prow : pcol) * 16, 0, (sub & 1) == 0, 1);
            else st16f(out + OUT_DK + co * 1024 + lane * 16, v);
            st16bf(KA + krow * KVW + lane * 16, v);
        }
        {
            ld16bf(z + C_DV + lane * 16, v);
            if (!latent) st16f(out + OUT_DV + co * 1024 + lane * 16, v);
            *(v4u*)(VA + krow * KVW + lane * 16) = *(const v4u*)(z + C_DV + lane * 16); *(v4u*)(VA + krow * KVW + lane * 16 + 8) = *(const v4u*)(z + C_DV + lane * 16 + 8);
        }
        {
            ld16bf(z + C_GQ + lane * 16, v); float ss = 0.f;
#pragma unroll
            for (int e = 0; e < 16; ++e) ss += v[e] * v[e];
            ss += __shfl_xor(ss, 1); ss += __shfl_xor(ss, 2); ss += __shfl_xor(ss, 4);
            const float rstd = 1.0f / sqrtf(ss * (1.0f / 128.0f) + EPS); const int sub = lane & 7; const float* gn = gqk + sub * 16;
#pragma unroll
            for (int e = 0; e < 16; ++e) v[e] = v[e] * rstd * gn[e];
            if (latent) rope_pair(v, R128 + (sub < 4 ? prow : pcol) * 32, (sub & 1) * 16, (sub & 2) == 0, 2);
#pragma unroll
            for (int e = 0; e < 16; ++e) v[e] *= 0.08838834764831845f;
            st16bf(QA + (size_t)row * 3072 + 2048 + lane * 16, v);
        }
        {
            const int ln = lane & 15;
            ld16bf(z + C_GK + ln * 16, v); float ss = 0.f;
#pragma unroll
            for (int e = 0; e < 16; ++e) ss += v[e] * v[e];
            ss += __shfl_xor(ss, 1); ss += __shfl_xor(ss, 2); ss += __shfl_xor(ss, 4);
            const float rstd = 1.0f / sqrtf(ss * (1.0f / 128.0f) + EPS); const int sub = lane & 7; const float* gn = gqk + 128 + sub * 16;
#pragma unroll
            for (int e = 0; e < 16; ++e) v[e] = v[e] * rstd * gn[e];
            if (latent) rope_pair(v, R128 + (sub < 4 ? prow : pcol) * 32, (sub & 1) * 16, (sub & 2) == 0, 2);
            if (lane < 16) { if (!latent) st16f(out + OUT_GK + co * 256 + lane * 16, v); st16bf(KA + krow * KVW + 1024 + lane * 16, v); }
            ld16bf(z + C_GV + ln * 16, v);
            if (lane < 16) { if (!latent) st16f(out + OUT_GV + co * 256 + lane * 16, v); st16bf(VA + krow * KVW + 1024 + lane * 16, v); }
        }
    }
}

typedef short bf16x4s __attribute__((ext_vector_type(4)));
typedef short bf16x8h __attribute__((ext_vector_type(8)));
constexpr int HG_QD = 0, HG_QR = 4352, HG_KR = 8704, HG_KDT = 13056, HG_VT = 17152, HG_DEC = 21248, HG_BUF = 22016, HG_TOTS = 2 * HG_BUF;
__device__ __forceinline__ void hgrn_item(const Args& a, unsigned char* ws, LAS unsigned char* lds, int l, int item, const XcdBarrier* barp = nullptr, int split = -1) {
    ws = fresh_ws(ws); const int tid = fresh_tid(), lane = tid & 63, wave = __builtin_amdgcn_readfirstlane(tid >> 6);
    const bf16* Z = (const bf16*)(ws + WS_Z);
    int b, h, dir, T, row0; const bool latent = item < 32;
    if (latent) { b = item >> 4; h = (item >> 1) & 7; dir = item & 1; T = 1024; row0 = NPROMPT + b * 1024; }
    else { const int it = item - 32; b = it >> 4; h = (it >> 1) & 7; dir = it & 1; T = 256; row0 = b * 256; }
    const bool stager = wave < 4;
    const int cl = lane & 15, gr = lane >> 4, kc = (wave & 3) * 16 + cl;
    const int fr = lane & 15, g = lane >> 4, vb = (wave & 3) * 32;
    const size_t sidx = ((((size_t)(b * 2 + l) * 2 + dir) * 8 + h) * 128) * 128;
    LAS unsigned char* base = lds + RING_OFF;
    const long ost = dir ? -1024 : 1024, zst = dir ? -(long)INW : (long)INW;
    const int nchunk = T >> 4;
#define HG_EXP(x) __builtin_amdgcn_exp2f(1.4426950408889634f * (x))
    if (stager) {
        float lb[2] = {0.f, 0.f};
        if (l == 1) { const float* hl = a.in[14];
#pragma unroll
            for (int ch = 0; ch < 2; ++ch) { const float a0 = hl[(dir * 2 + 0) * 1024 + h * 128 + 2 * kc + ch], a1 = hl[(dir * 2 + 1) * 1024 + h * 128 + 2 * kc + ch]; lb[ch] = 1.0f / (1.0f + expf(a0 - a1)); } }
        const bf16* const zb0 = Z + (size_t)(row0 + (dir ? T - 1 : 0)) * INW + h * 128 + 2 * kc + zst * (4 * gr);
        unsigned rqA[4], rzA[4], rvA[4], rqB[4], rzB[4], rvB[4];
#define HG_LOAD(rq, rz, rv, c) do { if ((c) < nchunk) { _Pragma("unroll") for (int i = 0; i < 4; ++i) { const bf16* zr = zb0 + zst * ((c) * 16 + i); \
            rq[i] = *(const unsigned*)(zr + C_HQ); rz[i] = *(const unsigned*)(zr + C_HF + dir * 1024); rv[i] = *(const unsigned*)(zr + C_HI); } } } while (0)
#define HG_STAGE(rq, rz, rv, pbuf) do { \
            float lf[2][4], kk[2][4]; \
            _Pragma("unroll") for (int i = 0; i < 4; ++i) _Pragma("unroll") for (int ch = 0; ch < 2; ++ch) { const float zf = ch ? bfhi(rz[i]) : bflo(rz[i]); const float e = HG_EXP(-fabsf(zf)), inv = __builtin_amdgcn_rcpf(1.0f + e); \
                const float sp = zf >= 0.f ? inv : e * inv, sn = zf >= 0.f ? e * inv : inv; kk[ch][i] = (1.0f - lb[ch]) * sn; lf[ch][i] = 0.6931471805599453f * __builtin_amdgcn_logf(lb[ch] + (1.0f - lb[ch]) * sp); } \
            float cs[2][4], pre[2], bm[2], b15[2]; \
            _Pragma("unroll") for (int ch = 0; ch < 2; ++ch) { cs[ch][0] = lf[ch][0]; cs[ch][1] = cs[ch][0] + lf[ch][1]; cs[ch][2] = cs[ch][1] + lf[ch][2]; cs[ch][3] = cs[ch][2] + lf[ch][3]; \
                float P = cs[ch][3]; float t_ = __shfl_up(P, 16); if (gr >= 1) P += t_; t_ = __shfl_up(P, 32); if (gr >= 2) P += t_;        \
                pre[ch] = P - cs[ch][3]; bm[ch] = __shfl(P, 16 + cl); b15[ch] = __shfl(P, 48 + cl); } \
            LAS unsigned char* pb_ = base + (pbuf) * HG_BUF; float kd[2][4]; \
            _Pragma("unroll") for (int i = 0; i < 4; ++i) { const int s = 4 * gr + i; float qd[2], qr[2], kr[2]; \
                _Pragma("unroll") for (int ch = 0; ch < 2; ++ch) { const float q = ch ? bfhi(rq[i]) : bflo(rq[i]); const float bb = pre[ch] + cs[ch][i]; \
                    const float er = HG_EXP(fminf(fmaxf(bb - bm[ch], -80.f), 80.f)); \
                    qd[ch] = q * HG_EXP(bb); qr[ch] = q * er; kr[ch] = kk[ch][i] * __builtin_amdgcn_rcpf(er); kd[ch][i] = kk[ch][i] * HG_EXP(b15[ch] - bb); } \
                *(LAS unsigned*)(pb_ + HG_QD + s * 272 + kc * 4) = pk2(qd[0], qd[1]); \
                *(LAS unsigned*)(pb_ + HG_QR + s * 272 + kc * 4) = pk2(qr[0], qr[1]); \
                *(LAS unsigned*)(pb_ + HG_KR + s * 272 + kc * 4) = pk2(kr[0], kr[1]); } \
            *(LAS v2u*)(pb_ + HG_KDT + (2 * kc) * 32 + gr * 8) = (v2u){pk2(kd[0][0], kd[0][1]), pk2(kd[0][2], kd[0][3])}; *(LAS v2u*)(pb_ + HG_KDT + (2 * kc + 1) * 32 + gr * 8) = (v2u){pk2(kd[1][0], kd[1][1]), pk2(kd[1][2], kd[1][3])}; \
            *(LAS v2u*)(pb_ + HG_VT + (2 * kc) * 32 + gr * 8) = (v2u){(rv[0] & 0xffffu) | (rv[1] << 16), (rv[2] & 0xffffu) | (rv[3] << 16)}; \
            *(LAS v2u*)(pb_ + HG_VT + (2 * kc + 1) * 32 + gr * 8) = (v2u){(rv[0] >> 16) | (rv[1] & 0xffff0000u), (rv[2] >> 16) | (rv[3] & 0xffff0000u)}; \
            if (gr == 0) *(LAS f32x2*)(pb_ + HG_DEC + kc * 8) = (f32x2){HG_EXP(b15[0]), HG_EXP(b15[1])}; \
        } while (0)
        HG_LOAD(rqA, rzA, rvA, 0); HG_LOAD(rqB, rzB, rvB, 1);
        HG_STAGE(rqA, rzA, rvA, 0);
        HG_LOAD(rqA, rzA, rvA, 2);
        __syncthreads();
        for (int c = 0; c < nchunk; c += 2) {
            if (c == split) xcd_barrier(*barp);
            HG_STAGE(rqB, rzB, rvB, 1); HG_LOAD(rqB, rzB, rvB, c + 3);
            __syncthreads();
            if (c + 2 < nchunk) { HG_STAGE(rqA, rzA, rvA, 0); HG_LOAD(rqA, rzA, rvA, c + 4); }
            __syncthreads();
        }
#undef HG_LOAD
#undef HG_STAGE
        __syncthreads();
    } else {
        bf16* OH = (bf16*)(ws + WS_OH) + (size_t)dir * NTOK * 1024;
        bf16* const ob0 = OH + (size_t)(row0 + (dir ? T - 1 : 0)) * 1024 + h * 128 + vb + fr + ost * (4 * g);
        f32x4 S0[8], S1[8];
        if (latent) { const float* st = a.in[7] + sidx;
#pragma unroll
            for (int kt = 0; kt < 8; ++kt)
#pragma unroll
                for (int r = 0; r < 4; ++r) { S0[kt][r] = st[(size_t)(16 * kt + 4 * g + r) * 128 + vb + fr]; S1[kt][r] = st[(size_t)(16 * kt + 4 * g + r) * 128 + vb + 16 + fr]; } }
        else {
#pragma unroll
            for (int kt = 0; kt < 8; ++kt) { S0[kt] = (f32x4){0.f, 0.f, 0.f, 0.f}; S1[kt] = (f32x4){0.f, 0.f, 0.f, 0.f}; } }
#define HG_OTILE(SS, nt_, c) do { f32x4 o = {0.f, 0.f, 0.f, 0.f}; \
            _Pragma("unroll") for (int ks = 0; ks < 4; ++ks) { \
                const v4u bs4 = {pk2(SS[2 * ks][0], SS[2 * ks][1]), pk2(SS[2 * ks][2], SS[2 * ks][3]), pk2(SS[2 * ks + 1][0], SS[2 * ks + 1][1]), pk2(SS[2 * ks + 1][2], SS[2 * ks + 1][3])}; \
                o = __builtin_amdgcn_mfma_f32_16x16x32_bf16(__builtin_bit_cast(bf16x8h, qa[ks]), __builtin_bit_cast(bf16x8h, bs4), o, 0, 0, 0); } \
            const v2u bv2 = *(const LAS v2u*)(pb_ + HG_VT + (vb + 16 * (nt_) + fr) * 32 + g * 8); const v4u bv4 = {bv2.x, bv2.y, 0u, 0u}; const bf16x8h bv = __builtin_bit_cast(bf16x8h, bv4); \
            o = __builtin_amdgcn_mfma_f32_16x16x32_bf16(pa, bv, o, 0, 0, 0); \
            _Pragma("unroll") for (int r = 0; r < 4; ++r) ob0[ost * ((c) * 16 + r) + 16 * (nt_)] = (bf16)f2bf(o[r]); \
            _Pragma("unroll") for (int kt = 0; kt < 8; ++kt) SS[kt] = __builtin_amdgcn_mfma_f32_16x16x32_bf16(__builtin_bit_cast(bf16x8h, ak[kt]), bv, SS[kt] * dd[kt], 0, 0, 0); } while (0)
#define HG_MFMA(c) do { \
            const LAS unsigned char* pb_ = base + ((c) & 1) * HG_BUF; \
            f32x4 at = {0.f, 0.f, 0.f, 0.f}; \
            _Pragma("unroll") for (int ks = 0; ks < 4; ++ks) { const bf16x8h ka = *(const LAS bf16x8h*)(pb_ + HG_KR + fr * 272 + (32 * ks + 8 * g) * 2), qb = *(const LAS bf16x8h*)(pb_ + HG_QR + fr * 272 + (32 * ks + 8 * g) * 2); \
                at = __builtin_amdgcn_mfma_f32_16x16x32_bf16(ka, qb, at, 0, 0, 0); }            \
            _Pragma("unroll") for (int r = 0; r < 4; ++r) if (4 * g + r > fr) at[r] = 0.f; \
            const v4u pa4 = {pk2(at[0], at[1]), pk2(at[2], at[3]), 0u, 0u}; const bf16x8h pa = __builtin_bit_cast(bf16x8h, pa4);     \
            v4u qa[4]; v4u ak[8]; f32x4 dd[8]; \
            _Pragma("unroll") for (int ks = 0; ks < 4; ++ks) { const v2u alo = *(const LAS v2u*)(pb_ + HG_QD + fr * 272 + (32 * ks + 4 * g) * 2), ahi = *(const LAS v2u*)(pb_ + HG_QD + fr * 272 + (32 * ks + 16 + 4 * g) * 2); qa[ks] = (v4u){alo.x, alo.y, ahi.x, ahi.y}; } \
            _Pragma("unroll") for (int kt = 0; kt < 8; ++kt) { dd[kt] = *(const LAS f32x4*)(pb_ + HG_DEC + (16 * kt + 4 * g) * 4); const v2u ak2 = *(const LAS v2u*)(pb_ + HG_KDT + (16 * kt + fr) * 32 + g * 8); ak[kt] = (v4u){ak2.x, ak2.y, 0u, 0u}; } \
            HG_OTILE(S0, 0, c); HG_OTILE(S1, 1, c); \
        } while (0)
        __syncthreads();
        for (int c = 0; c < nchunk; c += 2) {
            if (c == split) xcd_barrier(*barp);
            HG_MFMA(c);
            __syncthreads();
            HG_MFMA(c + 1);
            __syncthreads();
        }
#undef HG_MFMA
#undef HG_OTILE
        if (!latent) { float* st = a.out + OUT_ST + sidx;
#pragma unroll
            for (int kt = 0; kt < 8; ++kt)
#pragma unroll
                for (int r = 0; r < 4; ++r) { st[(size_t)(16 * kt + 4 * g + r) * 128 + vb + fr] = S0[kt][r]; st[(size_t)(16 * kt + 4 * g + r) * 128 + vb + 16 + fr] = S1[kt][r]; } }
        __syncthreads();
    }
#undef HG_EXP
}

__device__ __forceinline__ void attn_unit(unsigned char* ws, char* lds_generic, int u) {
    ws = fresh_ws(ws);
    int b, he, row0, key0, seq;
    if (u < 192) { b = u / 96; const int r = u % 96; he = r >> 2; const int qb = r & 3; row0 = NPROMPT + b * 1024 + qb * 256; key0 = NPROMPT + b * 1280; seq = 1280; }
    else { const int uu = u - 192; b = uu / 24; he = uu % 24; row0 = b * 256; key0 = b * 256; seq = 256; }
    const int kvh = he < 16 ? (he >> 1) : 8 + ((he - 16) >> 2);
    const att::bf16* Q = (const att::bf16*)(ws + WS_QA) + (size_t)row0 * 3072 + he * 128;
    const att::bf16* K = (const att::bf16*)(ws + WS_KA) + (size_t)key0 * KVW + kvh * 128;
    const att::bf16* V = (const att::bf16*)(ws + WS_VA) + (size_t)key0 * KVW + kvh * 128;
    unsigned short* O = (unsigned short*)(ws + WS_OA) + (size_t)row0 * 3072 + he * 128;
    att::attn_dense_body<att::bf16>(Q, K, V, O, seq, lds_generic + RING_OFF);
    __syncthreads();
}

__device__ __forceinline__ void post_phase(const Args& a, unsigned char* ws, int l, int G) {
    ws = fresh_ws(ws); const int tid = fresh_tid(), lane = tid & 63, gw = blockIdx.x * 8 + __builtin_amdgcn_readfirstlane(tid >> 6), NGW = G * 8;
    const bf16* Z = (const bf16*)(ws + WS_Z); const bf16* OA = (const bf16*)(ws + WS_OA); const bf16* OHf = (const bf16*)(ws + WS_OH); const bf16* OHb = OHf + (size_t)NTOK * 1024;
    bf16* BR = (bf16*)(ws + WS_BR);
    const float lam_init = 0.8f - 0.6f * expf(-0.3f * (float)l);
    const float* lp = a.in[17] + (size_t)l * 4 * 64;
    const float s01 = wave_sum(lp[lane] * lp[64 + lane]), s23 = wave_sum(lp[128 + lane] * lp[192 + lane]);
    const float lam = expf(s01) - expf(s23) + lam_init;
    const float* hn = a.in[15] + (size_t)l * 128; const float* sl = a.in[18] + (size_t)l * 128;
    const int sub = lane & 7;
    for (int row = gw; row < NTOK; row += NGW) {
        float v[16], w[16];
        {
            ld16bf(OHf + (size_t)row * 1024 + lane * 16, v); ld16bf(OHb + (size_t)row * 1024 + lane * 16, w); float ss = 0.f;
#pragma unroll
            for (int e = 0; e < 16; ++e) { v[e] += w[e]; ss += v[e] * v[e]; }
            ss += __shfl_xor(ss, 1); ss += __shfl_xor(ss, 2); ss += __shfl_xor(ss, 4);
            const float rstd = 1.0f / sqrtf(ss * (1.0f / 128.0f) + EPS);
            ld16bf(Z + (size_t)row * INW + C_HG + lane * 16, w);
#pragma unroll
            for (int e = 0; e < 16; ++e) { const float g = w[e]; v[e] = v[e] * rstd * hn[sub * 16 + e] * (g / (1.0f + expf(-g))); }
            st16bf(BR + (size_t)row * 1024 + lane * 16, v);
        }
        {
            const int h = lane >> 3; const bf16* o1 = OA + (size_t)row * 3072 + (2 * h) * 128 + sub * 16;
            ld16bf(o1, v); ld16bf(o1 + 128, w); float ss = 0.f;
#pragma unroll
            for (int e = 0; e < 16; ++e) { v[e] -= lam * w[e]; ss += v[e] * v[e]; }
            ss += __shfl_xor(ss, 1); ss += __shfl_xor(ss, 2); ss += __shfl_xor(ss, 4);
            const float rstd = 1.0f / sqrtf(ss * (1.0f / 128.0f) + EPS);
#pragma unroll
            for (int e = 0; e < 16; ++e) v[e] = v[e] * rstd * sl[sub * 16 + e] * (1.0f - lam_init);
            st16bf(BR + (size_t)NTOK * 1024 + (size_t)row * 1024 + lane * 16, v);
        }
        {
            *(v4u*)(BR + (size_t)2 * NTOK * 1024 + (size_t)row * 1024 + lane * 16) = *(const v4u*)(OA + (size_t)row * 3072 + 2048 + lane * 16); *(v4u*)(BR + (size_t)2 * NTOK * 1024 + (size_t)row * 1024 + lane * 16 + 8) = *(const v4u*)(OA + (size_t)row * 3072 + 2048 + lane * 16 + 8);
        }
    }
}

typedef short bf16x8s __attribute__((ext_vector_type(8)));
typedef float f32x16 __attribute__((ext_vector_type(16)));
__device__ __forceinline__ unsigned ford(float f) { const unsigned u = __float_as_uint(f); return u ^ ((u >> 31) ? 0xffffffffu : 0x80000000u); }
__device__ __forceinline__ float funord(unsigned k) { const unsigned u = (k & 0x80000000u) ? (k ^ 0x80000000u) : ~k; return __uint_as_float(u); }
__device__ __forceinline__ void ins16(unsigned (&L)[16], unsigned x) {
#pragma unroll
    for (int i = 0; i < 16; ++i) { const unsigned hi = L[i] > x ? L[i] : x; x = L[i] > x ? x : L[i]; L[i] = hi; }
}
__device__ __forceinline__ void ce_desc(unsigned& a_, unsigned& b_) { const unsigned hi = a_ > b_ ? a_ : b_, lo = a_ > b_ ? b_ : a_; a_ = hi; b_ = lo; }
__device__ __forceinline__ void sort16_desc(unsigned (&x)[16]) {
#pragma unroll
    for (int k = 2; k <= 16; k <<= 1)
#pragma unroll
        for (int j = k >> 1; j > 0; j >>= 1)
#pragma unroll
            for (int i = 0; i < 16; ++i) { const int l = i ^ j; if (l > i) { if ((i & k) == 0) ce_desc(x[i], x[l]); else ce_desc(x[l], x[i]); } }
}
__device__ __forceinline__ void merge16_desc(unsigned (&a_)[16], const unsigned (&b_)[16]) {
#pragma unroll
    for (int i = 0; i < 16; ++i) a_[i] = a_[i] > b_[15 - i] ? a_[i] : b_[15 - i];
#pragma unroll
    for (int j = 8; j > 0; j >>= 1)
#pragma unroll
        for (int i = 0; i < 16; ++i) { const int l = i ^ j; if (l > i) ce_desc(a_[i], a_[l]); }
}
__device__ __forceinline__ void peer_top16(unsigned (&L)[16], const LAS unsigned char* keysL, const bf16* qp, int c, int qrow, int hf) {
    f32x16 acc[4];
#pragma unroll
    for (int tl = 0; tl < 4; ++tl)
#pragma unroll
        for (int r = 0; r < 16; ++r) acc[tl][r] = 0.f;
    bf16x8s bq[8];
#pragma unroll
    for (int ks = 0; ks < 8; ++ks) bq[ks] = *(const bf16x8s*)(qp + c * 128 + ks * 16 + hf * 8);
#pragma unroll
    for (int ks = 0; ks < 8; ++ks)
#pragma unroll
        for (int tl = 0; tl < 4; ++tl) { const bf16x8s ka = *(const LAS bf16x8s*)(keysL + (c * 128 + tl * 32 + qrow) * 256 + (((ks * 2 + hf) ^ (qrow & 15)) << 4));
            acc[tl] = __builtin_amdgcn_mfma_f32_32x32x16_bf16(ka, bq[ks], acc[tl], 0, 0, 0); }
    unsigned K1[16], K2[16], K3[16];
#pragma unroll
    for (int r = 0; r < 16; ++r) { const unsigned kc = 127u - (unsigned)((r & 3) + 8 * (r >> 2)) - 4u * (unsigned)hf;
        L[r] = (ford(acc[0][r]) & 0xffffff80u) | kc; K1[r] = (ford(acc[1][r]) & 0xffffff80u) | (kc - 32u); K2[r] = (ford(acc[2][r]) & 0xffffff80u) | (kc - 64u); K3[r] = (ford(acc[3][r]) & 0xffffff80u) | (kc - 96u); }
    sort16_desc(L); sort16_desc(K1); sort16_desc(K2); sort16_desc(K3);
    merge16_desc(L, K1); merge16_desc(K2, K3); merge16_desc(L, K2);
    unsigned P[16];
#pragma unroll
    for (int i = 0; i < 16; ++i) P[i] = (unsigned)__shfl_xor((int)L[i], 32);
    merge16_desc(L, P);
}
__device__ __forceinline__ float gelu_erf(float x) { return 0.5f * x * (1.0f + erff(x * 0.70710678118654752f)); }
__device__ __forceinline__ void peer_topk_phase(const Args& a, unsigned char* ws, LAS unsigned char* lds, int l, int G) {
    ws = fresh_ws(ws); const int tid = fresh_tid(), lane = tid & 63, wave = __builtin_amdgcn_readfirstlane(tid >> 6);
    LAS unsigned char* keysL = lds + RING_OFF;
    LAS unsigned char* wtab = keysL + 65536 + wave * 2048;
    const float* pk = a.in[23] + (size_t)l * 2 * 128 * 128;
    for (int i = tid; i < 2 * 128 * 16; i += 512) { const int q = i & 15, rk = i >> 4, k = rk & 127;
        const f32x4 x0 = *(const f32x4*)(pk + (size_t)rk * 128 + q * 8), x1 = *(const f32x4*)(pk + (size_t)rk * 128 + q * 8 + 4);
        v4u o; o.x = pk2(x0[0], x0[1]); o.y = pk2(x0[2], x0[3]); o.z = pk2(x1[0], x1[1]); o.w = pk2(x1[2], x1[3]);
        *(LAS v4u*)(keysL + rk * 256 + ((q ^ (k & 15)) << 4)) = o; }
    __syncthreads();
    const bf16* QPb = (const bf16*)(ws + WS_QP); unsigned* PE = (unsigned*)(ws + WS_PE); unsigned* PG = (unsigned*)(ws + WS_PG);
    const int gw = blockIdx.x * 8 + wave, NGW = G * 8;
    const int hf = lane >> 5, qrow = lane & 31, tq = qrow >> 3, hq = qrow & 7;
    for (int tile = gw; tile < NTOK / 3; tile += NGW) {
        const int tok0 = tile * 3;
        const bf16* qp = QPb + (size_t)(tok0 + (tq < 3 ? tq : 2)) * DM + hq * 256;
        unsigned L0[16], L1[16];
        peer_top16(L0, keysL, qp, 0, qrow, hf);
        peer_top16(L1, keysL, qp, 1, qrow, hf);
        unsigned tw[8];
#pragma unroll
        for (int i = 0; i < 4; ++i) { tw[i] = (127u - (L0[4 * i] & 127u)) | ((127u - (L0[4 * i + 1] & 127u)) << 8) | ((127u - (L0[4 * i + 2] & 127u)) << 16) | ((127u - (L0[4 * i + 3] & 127u)) << 24);
                                      tw[4 + i] = (127u - (L1[4 * i] & 127u)) | ((127u - (L1[4 * i + 1] & 127u)) << 8) | ((127u - (L1[4 * i + 2] & 127u)) << 16) | ((127u - (L1[4 * i + 3] & 127u)) << 24); }
        *(LAS v4u*)(wtab + lane * 32) = (v4u){tw[0], tw[1], tw[2], tw[3]}; *(LAS v4u*)(wtab + lane * 32 + 16) = (v4u){tw[4], tw[5], tw[6], tw[7]};
        float v0[16], v1[16];
#pragma unroll
        for (int i = 0; i < 16; ++i) { v0[i] = funord(L0[i] & 0xffffff80u); v1[i] = funord(L1[i] & 0xffffff80u); }
        unsigned C[16], C1[16], C2[16], C3[16];
#pragma unroll
        for (int i = 0; i < 16; ++i) { C[i] = 0u; C1[i] = 0u; C2[i] = 0u; C3[i] = 0u; }
#pragma unroll
        for (int i = 0; i < 16; ++i)
#pragma unroll
            for (int j = 0; j < 16; ++j) if ((i + 1) * (j + 1) <= 16) {
                constexpr int PRE[16] = {0, 16, 24, 29, 33, 36, 38, 40, 42, 43, 44, 45, 46, 47, 48, 49};
                const int s = PRE[i] + j; const unsigned key = (ford(v0[i] + v1[j]) & 0xffffff00u) | (255u - (unsigned)(i * 16 + j));
                if (s < 16) C[s & 15] = key; else if (s < 32) C1[s & 15] = key; else if (s < 48) C2[s & 15] = key; else C3[s & 15] = key; }
        sort16_desc(C); sort16_desc(C1); sort16_desc(C2); sort16_desc(C3);
        merge16_desc(C, C1); merge16_desc(C2, C3); merge16_desc(C, C2);
        LDS_WAIT(); asm volatile("" ::: "memory");
        float ex[16]; float sum = 0.f; const float c0 = funord(C[0] & 0xffffff00u);
#pragma unroll
        for (int r = 0; r < 16; ++r) { ex[r] = expf(funord(C[r] & 0xffffff00u) - c0); sum += ex[r]; }
        const float rs = 1.0f / sum;
        if (tq < 3) { const size_t ob = (size_t)(tok0 + tq) * 128 + hq * 16;
            if (hf == 0) { unsigned ev[16];
#pragma unroll
                for (int r = 0; r < 16; ++r) { const unsigned ci = 255u - (C[r] & 255u); const unsigned k0 = wtab[lane * 32 + (ci >> 4)], k1 = wtab[lane * 32 + 16 + (ci & 15u)]; ev[r] = k0 * 128u + k1; }
#pragma unroll
                for (int r = 0; r < 16; r += 4) *(v4u*)(PE + ob + r) = (v4u){ev[r], ev[r + 1], ev[r + 2], ev[r + 3]}; }
            else {
#pragma unroll
                for (int r = 0; r < 16; r += 4) *(v4u*)(PG + ob + r) = (v4u){__float_as_uint(ex[r] * rs), __float_as_uint(ex[r + 1] * rs), __float_as_uint(ex[r + 2] * rs), __float_as_uint(ex[r + 3] * rs)}; }
        }
        LDS_WAIT(); asm volatile("" ::: "memory");
    }
    __syncthreads();
}
#define PEER_ACC(OUT) do { _Pragma("unroll") for (int j = 0; j < 8; ++j) { const int q = (int)w[t][j >> 2][j & 3]; \
        OUT[2 * j] = __builtin_elementwise_fma(__builtin_amdgcn_cvt_pk_f32_fp8(q, false), wg2, OUT[2 * j]); OUT[2 * j + 1] = __builtin_elementwise_fma(__builtin_amdgcn_cvt_pk_f32_fp8(q, true), wg2, OUT[2 * j + 1]); } } while (0)
__device__ __forceinline__ void fma_ip(float& o, float x, float w) { asm("v_fma_f32 %0, %1, %2, %0" : "+v"(o) : "v"(x), "v"(w)); }
__device__ __forceinline__ void peer_gather_phase(const Args& a, unsigned char* ws, LAS unsigned char* lds, int l, float* xout, int G, unsigned emask = 0xffffu, int skip = 0, bool n1fuse = false) {
    ws = fresh_ws(ws); const int tid = fresh_tid(), lane = tid & 63, wave = __builtin_amdgcn_readfirstlane(tid >> 6);
    LAS unsigned char* wb = lds + RING_OFF + wave * 16384;
    LAS v2u* list = (LAS v2u*)(wb + 12288); LAS unsigned* hist = (LAS unsigned*)(wb + 15360);
    const bf16* H = (const bf16*)(ws + WS_H); const unsigned* PE = (const unsigned*)(ws + WS_PE); const unsigned* PG = (const unsigned*)(ws + WS_PG);
    const unsigned char* UV8 = ws + WS_UV8 + (size_t)l * 16384 * 4096; const float* SC = (const float*)(ws + WS_SC) + (size_t)l * 16384 * 2;
    const float* XM = (const float*)(ws + WS_XM); const float* MOD = (const float*)(ws + WS_MOD) + (size_t)l * 3 * 12288;
    const int gw = blockIdx.x * 8 + wave, NGW = G * 8;
    for (int tile = gw; tile < NTOK / 3; tile += NGW) {
        const int tok0 = tile * 3;
        {
            unsigned e[6], gb[6], pos[6];
            hist[lane] = 0u; hist[64 + lane] = 0u; hist[128 + lane] = 0u;
#pragma unroll
            for (int m = 0; m < 6; ++m) { const size_t ix = (size_t)(tok0 + (m >> 1)) * 128 + ((lane + 64 * m) & 127); e[m] = PE[ix] & emask; gb[m] = PG[ix]; }
            LDS_WAIT(); asm volatile("" ::: "memory");
#pragma unroll
            for (int m = 0; m < 6; ++m) pos[m] = __hip_atomic_fetch_add(hist + (m >> 1) * 64 + (e[m] >> 8), 1u, __ATOMIC_RELAXED, __HIP_MEMORY_SCOPE_WORKGROUP);
            LDS_WAIT(); asm volatile("" ::: "memory");
            const unsigned cnt0 = hist[lane], cnt1 = hist[64 + lane], cnt2 = hist[128 + lane]; unsigned inc0 = cnt0, inc1 = cnt1, inc2 = cnt2;
#pragma unroll
            for (int o = 1; o < 64; o <<= 1) { const unsigned t0 = (unsigned)__shfl_up((int)inc0, o), t1 = (unsigned)__shfl_up((int)inc1, o), t2 = (unsigned)__shfl_up((int)inc2, o); if (lane >= o) { inc0 += t0; inc1 += t1; inc2 += t2; } }
            LDS_WAIT(); asm volatile("" ::: "memory");
            hist[lane] = inc0 - cnt0; hist[64 + lane] = 128u + inc1 - cnt1; hist[128 + lane] = 256u + inc2 - cnt2;
            LDS_WAIT(); asm volatile("" ::: "memory");
#pragma unroll
            for (int m = 0; m < 6; ++m) { const unsigned p_ = hist[(m >> 1) * 64 + (e[m] >> 8)] + pos[m]; list[p_] = (v2u){e[m], gb[m]}; }
            LDS_WAIT(); asm volatile("" ::: "memory");
        }
        if (!(skip & 1)) {
            unsigned hq[3][8]; float hs[3];
#pragma unroll
            for (int t = 0; t < 3; ++t) { float hv[8][4]; float mx = 0.f;
#pragma unroll
                for (int j = 0; j < 8; ++j) { const v2u a0 = *(const v2u*)(H + (size_t)(tok0 + t) * DM + j * 256 + lane * 4); hv[j][0] = bflo(a0.x); hv[j][1] = bfhi(a0.x); hv[j][2] = bflo(a0.y); hv[j][3] = bfhi(a0.y);
                    mx = fmaxf(fmaxf(mx, fmaxf(fabsf(hv[j][0]), fabsf(hv[j][1]))), fmaxf(fabsf(hv[j][2]), fabsf(hv[j][3]))); }
#pragma unroll
                for (int o = 1; o < 64; o <<= 1) mx = fmaxf(mx, __shfl_xor(mx, o));
                const float inv = mx > 0.f ? 127.0f / mx : 0.f; hs[t] = mx * (1.0f / 127.0f);
#pragma unroll
                for (int j = 0; j < 8; ++j) { const int q0 = (int)rintf(hv[j][0] * inv), q1 = (int)rintf(hv[j][1] * inv), q2 = (int)rintf(hv[j][2] * inv), q3 = (int)rintf(hv[j][3] * inv);
                    hq[t][j] = (unsigned)(q0 & 0xff) | ((unsigned)(q1 & 0xff) << 8) | ((unsigned)(q2 & 0xff) << 16) | ((unsigned)q3 << 24); } }
#define PU_LOAD(W, SCL, G_, kb_) do { _Pragma("unroll") for (int t = 0; t < 3; ++t) { const v2u r = list[t * 128 + (kb_)]; const int ee = __builtin_amdgcn_readfirstlane((int)r.x); G_[t] = __uint_as_float((unsigned)__builtin_amdgcn_readfirstlane((int)r.y)); \
            const unsigned char* base = UV8 + (size_t)ee * 4096 + lane * 32; W[t][0] = *(const v4u*)base; W[t][1] = *(const v4u*)(base + 16); SCL[t] = *(const f32x2*)(SC + (size_t)ee * 2); } } while (0)
#define PU_DOT(HV, Wt) ({ int s_ = 0; _Pragma("unroll") for (int j = 0; j < 8; ++j) s_ = __builtin_amdgcn_sdot4((int)Wt[j >> 2][j & 3], (int)HV[j], s_, false); s_; })
#define PU_RED(x_) do { x_ += __builtin_amdgcn_update_dpp(0, x_, 0xB1, 0xF, 0xF, false); x_ += __builtin_amdgcn_update_dpp(0, x_, 0x4E, 0xF, 0xF, false); \
            x_ += __builtin_amdgcn_update_dpp(0, x_, 0x141, 0xF, 0xF, false); x_ += __builtin_amdgcn_update_dpp(0, x_, 0x140, 0xF, 0xF, false); \
            x_ += __builtin_amdgcn_update_dpp(0, x_, 0x142, 0xA, 0xF, false); x_ += __builtin_amdgcn_update_dpp(0, x_, 0x143, 0xC, 0xF, false); } while (0)
#define PU_COMP(W, kb_) do { int d0 = PU_DOT(hq[0], W[0]), d1 = PU_DOT(hq[1], W[1]), d2 = PU_DOT(hq[2], W[2]); PU_RED(d0); PU_RED(d1); PU_RED(d2); \
            if (lane == 63) { dl[(kb_)] = d0; dl[128 + (kb_)] = d1; dl[256 + (kb_)] = d2; } } while (0)
            LAS int* dl = (LAS int*)wb;
            v4u wA[3][2], wB[3][2];
#define PU_LOAD2(W, kb_) do { _Pragma("unroll") for (int t = 0; t < 3; ++t) { const int ee = __builtin_amdgcn_readfirstlane((int)list[t * 128 + (kb_)].x); \
            const unsigned char* base = UV8 + (size_t)ee * 4096 + lane * 32; W[t][0] = *(const v4u*)base; W[t][1] = *(const v4u*)(base + 16); } } while (0)
            PU_LOAD2(wA, 0);
#pragma unroll 1
            for (int kb = 0; kb < 128; kb += 2) {
                PU_LOAD2(wB, kb + 1); PU_COMP(wA, kb);
                if (kb + 2 < 128) PU_LOAD2(wA, kb + 2);
                PU_COMP(wB, kb + 1);
            }
            LDS_WAIT(); asm volatile("" ::: "memory");
#pragma unroll
            for (int m = 0; m < 6; ++m) { const int li = lane + 64 * m; const v2u ent = list[li]; const f32x2 sc2 = *(const f32x2*)(SC + (size_t)ent.x * 2);
                ((LAS float*)list)[2 * li + 1] = __uint_as_float(ent.y) * gelu_erf((float)dl[li] * (sc2.x * hs[m >> 1])) * sc2.y; }
#undef PU_LOAD2
#undef PU_RED
#undef PU_LOAD
#undef PU_DOT
#undef PU_COMP
        }
        LDS_WAIT(); asm volatile("" ::: "memory");
        f32x2 out0[16], out1[16], out2[16];
#pragma unroll
        for (int i = 0; i < 16; ++i) { out0[i] = (f32x2){0.f, 0.f}; out1[i] = (f32x2){0.f, 0.f}; out2[i] = (f32x2){0.f, 0.f}; }
#define PV_LOAD(W, G_, kb_) do { _Pragma("unroll") for (int t = 0; t < 3; ++t) { const v2u r = list[t * 128 + (kb_)]; const int ee = __builtin_amdgcn_readfirstlane((int)r.x); G_[t] = __uint_as_float((unsigned)__builtin_amdgcn_readfirstlane((int)r.y)); \
            const unsigned char* base = UV8 + (size_t)ee * 4096 + 2048 + lane * 32; W[t][0] = *(const v4u*)base; W[t][1] = *(const v4u*)(base + 16); } } while (0)
#define PV_FMA(O, X, Wg) do { O.x = __builtin_fmaf(X.x, Wg, O.x); O.y = __builtin_fmaf(X.y, Wg, O.y); } while (0)
#define PV_COMP(W, G_) do { _Pragma("unroll") for (int t = 0; t < 3; ++t) { const float wg = G_[t]; \
            _Pragma("unroll") for (int j = 0; j < 8; ++j) { const int q = (int)W[t][j >> 2][j & 3]; const f32x2 lo = __builtin_amdgcn_cvt_pk_f32_fp8(q, false), hi = __builtin_amdgcn_cvt_pk_f32_fp8(q, true); \
                if (t == 0) { PV_FMA(out0[2 * j], lo, wg); PV_FMA(out0[2 * j + 1], hi, wg); } \
                else if (t == 1) { PV_FMA(out1[2 * j], lo, wg); PV_FMA(out1[2 * j + 1], hi, wg); } \
                else { PV_FMA(out2[2 * j], lo, wg); PV_FMA(out2[2 * j + 1], hi, wg); } } } } while (0)
        if (!(skip & 2)) {
            v4u wA[3][2], wB[3][2]; float gA[3], gB[3];
            PV_LOAD(wA, gA, 0);
#pragma unroll 1
            for (int kb = 0; kb < 128; kb += 2) {
                PV_LOAD(wB, gB, kb + 1); PV_COMP(wA, gA);
                if (kb + 2 < 128) PV_LOAD(wA, gA, kb + 2);
                PV_COMP(wB, gB);
            }
        }
#undef PV_LOAD
#undef PV_COMP
#pragma unroll
        for (int tt = 0; tt < 3; ++tt) {
            const int row = tok0 + tt; const int r = row < NPROMPT ? 0 : 1 + ((row - NPROMPT) >> 10);
            const float* g2 = MOD + (size_t)r * 12288 + 5 * DM;
            float ss = 0.f;
#pragma unroll
            for (int j = 0; j < 8; ++j) { const int c = j * 256 + lane * 4; const size_t off = (size_t)row * DM + c;
                const f32x4 x0 = *(const f32x4*)(XM + off), ga = *(const f32x4*)(g2 + c);
                const f32x2 oa = tt == 0 ? out0[2 * j] : (tt == 1 ? out1[2 * j] : out2[2 * j]), ob = tt == 0 ? out0[2 * j + 1] : (tt == 1 ? out1[2 * j + 1] : out2[2 * j + 1]);
                const f32x4 xo = x0 + ga * (f32x4){oa.x, oa.y, ob.x, ob.y}; *(f32x4*)(xout + off) = xo;
                ss += (xo[0] * xo[0] + xo[1] * xo[1]) + (xo[2] * xo[2] + xo[3] * xo[3]); }
            if (n1fuse) { const float* n1gain = a.in[11] + DM; const float* n1mod = (const float*)(ws + WS_MOD) + (size_t)3 * 12288;
                const float rstd = 1.0f / sqrtf(wave_sum(ss) * (1.0f / DM) + EPS); const float* sh = n1mod + (size_t)r * 12288; const float* sc = sh + DM; bf16* Hw = (bf16*)(ws + WS_H);
#pragma unroll
                for (int j = 0; j < 8; ++j) { const int c = j * 256 + lane * 4; const size_t off = (size_t)row * DM + c;
                    const f32x4 x0 = *(const f32x4*)(XM + off), ga = *(const f32x4*)(g2 + c);
                    const f32x2 oa = tt == 0 ? out0[2 * j] : (tt == 1 ? out1[2 * j] : out2[2 * j]), ob = tt == 0 ? out0[2 * j + 1] : (tt == 1 ? out1[2 * j + 1] : out2[2 * j + 1]);
                    const f32x4 xo = x0 + ga * (f32x4){oa.x, oa.y, ob.x, ob.y};
                    const f32x4 gn = *(const f32x4*)(n1gain + c), s1 = *(const f32x4*)(sc + c), s0 = *(const f32x4*)(sh + c);
                    const f32x4 o = xo * rstd * gn * (s1 + 1.0f) + s0; *(v2u*)(Hw + (size_t)row * DM + c) = (v2u){pk2(o[0], o[1]), pk2(o[2], o[3])}; }
            }
        }
        asm volatile("" ::: "memory");
    }
    __syncthreads();
}
#undef PEER_ACC

__device__ __forceinline__ unsigned dg_hash(unsigned x) { x ^= x >> 16; x *= 0x7feb352du; x ^= x >> 15; x *= 0x846ca68bu; x ^= x >> 16; return x; }
__device__ __forceinline__ void dummy_gather(unsigned char* ws, int mode, int G) {
    ws = fresh_ws(ws); const int tid = fresh_tid(), lane = tid & 63, wave = __builtin_amdgcn_readfirstlane(tid >> 6);
    const unsigned char* UV8 = ws + WS_UV8; const int gw = blockIdx.x * 8 + wave;
    f32x2 hv[16], out[16];
#pragma unroll
    for (int i = 0; i < 16; ++i) { hv[i] = (f32x2){(float)(lane + i) * 0.001f, (float)(lane - i) * 0.002f}; out[i] = (f32x2){0.f, 0.f}; }
    for (int jb = 0; jb < 384; jb += 4) {
        int e[4];
#pragma unroll
        for (int t = 0; t < 4; ++t) { const unsigned hsh = dg_hash((unsigned)(gw * 384 + jb + t) * 2654435761u + 12345u); e[t] = mode == 0 ? (int)(hsh & 16383u) : (int)((((unsigned)(jb + t) / 12u) << 9) | (hsh & 511u)); }
        v4u w[4][4];
#pragma unroll
        for (int t = 0; t < 4; ++t) { const unsigned char* base = UV8 + (size_t)e[t] * 4096 + lane * 32;
            w[t][0] = *(const v4u*)base; w[t][1] = *(const v4u*)(base + 16); w[t][2] = *(const v4u*)(base + 2048); w[t][3] = *(const v4u*)(base + 2048 + 16); }
        float d[4];
#pragma unroll
        for (int t = 0; t < 4; ++t) { f32x2 s = {0.f, 0.f};
#pragma unroll
            for (int j = 0; j < 8; ++j) { const int q = (int)w[t][j >> 2][j & 3];
                s = __builtin_elementwise_fma(__builtin_amdgcn_cvt_pk_f32_fp8(q, false), hv[2 * j], s); s = __builtin_elementwise_fma(__builtin_amdgcn_cvt_pk_f32_fp8(q, true), hv[2 * j + 1], s); }
            d[t] = s.x + s.y; }
#pragma unroll
        for (int o = 1; o < 64; o <<= 1) {
#pragma unroll
            for (int t = 0; t < 4; ++t) d[t] += __shfl_xor(d[t], o); }
#pragma unroll
        for (int t = 0; t < 4; ++t) { const float wg = d[t] * 1e-3f; const f32x2 wg2 = {wg, wg};
#pragma unroll
            for (int j = 0; j < 8; ++j) { const int q = (int)w[t][2 + (j >> 2)][j & 3];
                out[2 * j] = __builtin_elementwise_fma(__builtin_amdgcn_cvt_pk_f32_fp8(q, false), wg2, out[2 * j]); out[2 * j + 1] = __builtin_elementwise_fma(__builtin_amdgcn_cvt_pk_f32_fp8(q, true), wg2, out[2 * j + 1]); } }
    }
    float* scratch = (float*)(ws + WS_PE);
    float acc = 0.f;
#pragma unroll
    for (int i = 0; i < 16; ++i) acc += out[i].x + out[i].y;
    scratch[(size_t)gw * 64 + lane] = acc;
}
#ifdef PROBE_G1NS
struct ProbeOrder : pg8::StaticOrder {
    __device__ bool next(int i, pg8::Unit& u) const { const bool r = pg8::StaticOrder::next(i, u); if (PROBE_G1NS & 2) u.pn &= 1; if (PROBE_G1NS & 4) u.pm &= 1; return r; }
};
#endif
__global__ void __launch_bounds__(512, 2) mk_fwd(Args args) {
    extern __shared__ __attribute__((aligned(16))) unsigned char lds_raw[];
    LAS unsigned char* lds = (LAS unsigned char*)lds_raw;
    const int G = gridDim.x;
    unsigned char* ws = args.ws;
    unsigned* ctl = (unsigned*)(ws + WS_CTL);
    for (int u = threadIdx.x; u < RING_OFF / 4; u += 512) ((LAS unsigned*)lds)[u] = 0u;
    __syncthreads();
    const int lo = args.ph_lo, hi = args.ph_hi;
    XcdBarrier bar; bar.bar = ctl + CW_BAR; bar.x = 0; bar.st = (volatile LAS unsigned*)(lds + 32);
    if (hi - lo > 1) bar = xcd_barrier_post(ctl + CW_BAR, (volatile LAS unsigned*)(lds + 32));
#ifndef PH_EN
#define PH_EN 0xfff
#endif
#define PHEN(k) (((PH_EN) >> (k)) & 1)
#ifndef PROBE_DUP
#define PROBE_DUP 0
#endif
#define NREP(k) ((((PROBE_DUP) >> (k)) & 1) ? 2 : 1)
#define IN(k) (lo <= (k) && (k) < hi)
#define SEAM(k) do { if (IN(k) && IN((k) + 1)) xcd_barrier(bar); } while (0)

#ifndef PROBE_XBAR
#define PROBE_XBAR 0
#endif
    if (PHEN(0) && IN(0)) { for (int rep = 0; rep < NREP(0); ++rep) p0_prologue(args, ws, lds, G, lo == 0 && hi == NPH && G == 256); }
    SEAM(0);

    for (int l = 0; l < 2; ++l) {
        ws = fresh_ws(ws);
        const int pb = 1 + 11 * l;
#define MODall ((const float*)(ws + WS_MOD))
#define Hb ((bf16*)(ws + WS_H))
#define Zb ((bf16*)(ws + WS_Z))
        const float* xin_p = l == 0 ? args.in[0] : (const float*)(ws + WS_X1);
        const float* xin_s = l == 0 ? args.in[1] : (const float*)(ws + WS_X1) + (size_t)NPROMPT * DM;
        const float* modl = MODall + (size_t)l * 3 * 12288;
        for (int xb = 0; xb < PROBE_XBAR; ++xb) xcd_barrier(bar);
        const bool n1fused = lo == 0 && hi == NPH;
        const bool defer = lo == 0 && hi == NPH && G == 256 && (int)blockIdx.x >= 192;
        if (!(l == 1 && n1fused)) {
            if (PHEN(1) && IN(pb + 0)) for (int rep = 0; rep < NREP(1); ++rep) norm_phase(xin_p, xin_s, args.in[11] + (size_t)l * DM, modl, 0, 1, Hb, G);
            SEAM(pb + 0);
        }
#ifdef PROBE_G1NS
        { ws = fresh_ws(ws);
            pg8::Gemm g{Hb, (const bf16*)(ws + WS_WIN) + (size_t)l * INW * DM, NTOK, INW, DM}; ProbeOrder S; S.init(NTOK, INW, G, (int)blockIdx.x);
            pg8::EpiNull E{(float*)(ws + WS_QA)};
            pg8::gemm_phase<pg8::EpiNull, ProbeOrder, true, true>(lds + RING_OFF, g, S, E);
            xcd_barrier(bar);
        }
#endif
        if (PHEN(2) && IN(pb + 1)) for (int rep = 0; rep < NREP(2); ++rep) { ws = fresh_ws(ws);
            pg8::Gemm g{Hb, (const bf16*)(ws + WS_WIN) + (size_t)l * INW * DM, NTOK, INW, DM}; pg8::StaticOrder S; S.init(NTOK, INW, G, (int)blockIdx.x);
            pg8::EpiBf16<0> E{Zb, INW, nullptr, 0, 0, 1.f};
            pg8::gemm_phase<pg8::EpiBf16<0>, pg8::StaticOrder, true, true>(lds + RING_OFF, g, S, E);
        }
        SEAM(pb + 1);
        const bool early = IN(pb + 2) && IN(pb + 3) && G > 64;
        if (early && (int)blockIdx.x < 32) { hgrn_item(args, ws, lds, l, (int)blockIdx.x, &bar, 16); }
        else {
            if (PHEN(3) && IN(pb + 2)) for (int rep = 0; rep < NREP(3); ++rep) prep_phase(args, ws, l, early ? 32 : 0, early ? G - 32 : G);
            SEAM(pb + 2);
            if (PHEN(4) && IN(pb + 3)) for (int rep = 0; rep < NREP(4); ++rep) {
                const int bx = blockIdx.x;
                if (G > 64 && bx < 32) { for (int rp = 0; rp < NREP(12); ++rp) hgrn_item(args, ws, lds, l, bx); }
                else {
                    const int u0 = G > 64 ? bx - 32 : bx, us = G > 64 ? G - 32 : G;
                    if (G <= 64) for (int u = bx; u < 32; u += G) hgrn_item(args, ws, lds, l, u);
                    for (int rp = 0; rp < NREP(12); ++rp)
                    for (int u = u0; u < 832; u += us) if (u >= 192 && u < 448) hgrn_item(args, ws, lds, l, 32 + (u - 192));
                    for (int rp = 0; rp < NREP(13); ++rp)
                    for (int u = u0; u < 832; u += us) if (u < 192 || u >= 448) attn_unit(ws, (char*)lds_raw, u < 192 ? u : 192 + (u - 448));
                }
            }
        }
        SEAM(pb + 3);
        if (PHEN(5) && IN(pb + 4)) for (int rep = 0; rep < NREP(5); ++rep) post_phase(args, ws, l, G);
        SEAM(pb + 4);
        if (PHEN(6) && IN(pb + 5)) for (int rep = 0; rep < NREP(6); ++rep) { ws = fresh_ws(ws);
            pg8::StaticOrder S; S.init(NTOK, DM, G, (int)blockIdx.x);
            for (int c = 0; c < 3; ++c) {
                pg8::Gemm g{(const bf16*)(ws + WS_BR) + (size_t)c * NTOK * 1024, (const bf16*)(ws + WS_WBR) + (size_t)(l * 3 + c) * DM * 1024, NTOK, DM, 1024};
                pg8::EpiGate E{Zb, INW, C_GATE + c * DM, (bf16*)(ws + WS_MGP), (bf16*)(ws + WS_MG), DM, c};
                pg8::gemm_phase<pg8::EpiGate, pg8::StaticOrder, true, true>(lds + RING_OFF, g, S, E);
            }
            if (defer) fp8_rows_deferred(args, ws, 3 * l + 0);
        }
        SEAM(pb + 5);
        if (PHEN(7) && IN(pb + 6)) for (int rep = 0; rep < NREP(7); ++rep) { ws = fresh_ws(ws);
            pg8::Gemm g{(const bf16*)(ws + WS_MG), (const bf16*)(ws + WS_WOUT) + (size_t)l * DM * DM, NTOK, DM, DM}; pg8::StaticOrder S; S.init(NTOK, DM, G, (int)blockIdx.x);
            pg8::EpiResid E{xin_p, xin_s, modl + 2 * DM, (float*)(ws + WS_XM)};
            pg8::gemm_phase<pg8::EpiResid, pg8::StaticOrder, true, true>(lds + RING_OFF, g, S, E);
            if (defer) fp8_rows_deferred(args, ws, 3 * l + 1);
        }
        SEAM(pb + 6);
        if (PHEN(8) && IN(pb + 7)) for (int rep = 0; rep < NREP(8); ++rep) norm_phase((const float*)(ws + WS_XM), (const float*)(ws + WS_XM) + (size_t)NPROMPT * DM, args.in[12] + (size_t)l * DM, modl, 3, 4, Hb, G);
        SEAM(pb + 7);
        if (PHEN(9) && IN(pb + 8)) for (int rep = 0; rep < NREP(9); ++rep) { ws = fresh_ws(ws);
            pg8::Gemm g{Hb, (const bf16*)(ws + WS_WPQ) + (size_t)l * DM * DM, NTOK, DM, DM}; pg8::StaticOrder S; S.init(NTOK, DM, G, (int)blockIdx.x);
            pg8::EpiBf16<0> E{(bf16*)(ws + WS_QP), DM, nullptr, 0, 0, 1.f};
            pg8::gemm_phase<pg8::EpiBf16<0>, pg8::StaticOrder, true, true>(lds + RING_OFF, g, S, E);
            if (defer) fp8_rows_deferred(args, ws, 3 * l + 2);
        }
        SEAM(pb + 8);
#ifdef PROBE_DG
        dummy_gather(ws, PROBE_DG, G);
#endif
        if (PHEN(10) && IN(pb + 9)) for (int rep = 0; rep < NREP(10); ++rep) peer_topk_phase(args, ws, lds, l, G);
        SEAM(pb + 9);
        if (PHEN(11) && IN(pb + 10)) for (int rep = 0; rep < NREP(11); ++rep) peer_gather_phase(args, ws, lds, l, l == 0 ? (float*)(ws + WS_X1) : args.out, G, 0xffffu, 0, l == 0 && n1fused);
#ifdef PROBE_GS
        peer_gather_phase(args, ws, lds, l, (float*)(ws + WS_QA), G, 0xffffu, PROBE_GS);
#endif
#ifdef PROBE_GM
        peer_gather_phase(args, ws, lds, l, (float*)(ws + WS_QA), G, PROBE_GM, PROBE_GSK);
#endif
        if (l == 0) SEAM(pb + 10);
    }
#undef MODall
#undef Hb
#undef Zb
#undef IN
#undef SEAM
}

extern "C" void kernel_launch(void* const* d_in, const int* in_sizes, int n_in, void* d_out, int out_size, void* d_ws, size_t ws_size, hipStream_t stream) {
    static int grid = 0;
    if (grid == 0) {
        if (n_in != 26 || (size_t)out_size != OUT_TOTAL || ws_size < WS_END) { fprintf(stderr, "kernel_launch: shape mismatch: n_in %d out %d ws %zu (need %zu)\n", n_in, out_size, ws_size, (size_t)WS_END); grid = -1; return; }
        int dev = 0, cus = 0, per_cu = 0;
        if (hipGetDevice(&dev) != hipSuccess || hipDeviceGetAttribute(&cus, hipDeviceAttributeMultiprocessorCount, dev) != hipSuccess) { grid = -1; return; }
        if (hipFuncSetAttribute((const void*)mk_fwd, hipFuncAttributeMaxDynamicSharedMemorySize, LDS_BYTES) != hipSuccess) { fprintf(stderr, "kernel_launch: hipFuncSetAttribute failed\n"); grid = -1; return; }
        if (hipOccupancyMaxActiveBlocksPerMultiprocessor(&per_cu, (const void*)mk_fwd, 512, LDS_BYTES) != hipSuccess || per_cu < 1) { fprintf(stderr, "kernel_launch: occupancy query says %d\n", per_cu); per_cu = 1; }
        (void)hipGetLastError();
        grid = cus;
    }
    if (grid < 0) return;
    (void)hipMemsetAsync((char*)d_ws + WS_CTL, 0, CTL_ZERO_BYTES, stream);
    Args a{};
    for (int i = 0; i < 26; ++i) a.in[i] = (const float*)d_in[i];
    a.out = (float*)d_out; a.ws = (unsigned char*)d_ws;
#if N_LAUNCH_MODE == 0
    a.ph_lo = 0; a.ph_hi = NPH;
    hipLaunchKernelGGL(mk_fwd, dim3(grid), dim3(512), LDS_BYTES, stream, a);
#else
    for (int p = 0; p < NPH; ++p) { a.ph_lo = p; a.ph_hi = p + 1; hipLaunchKernelGGL(mk_fwd, dim3(grid), dim3(512), LDS_BYTES, stream, a); }
#endif
    const hipError_t le = hipPeekAtLastError();
    if (le != hipSuccess) fprintf(stderr, "kernel_launch: launch failed: %s\n", hipGetErrorName(le));
}
```

```cpp
#include <hip/hip_runtime.h>
#include <hip/hip_bf16.h>
#include <cstdio>
#include <cstdint>
#include <cmath>
#define PROBE_DUP 0
#define HG_PROBE 0
#define PROBE_XBAR 0

#ifndef N_LAUNCH_MODE
#define N_LAUNCH_MODE 0
#endif
__device__ __forceinline__ int fresh_tid() { int t = (int)threadIdx.x; asm volatile("" : "+v"(t)); return t; }
__device__ __forceinline__ unsigned char* fresh_ws(unsigned char* p) { __attribute__((address_space(1))) unsigned char* g = (__attribute__((address_space(1))) unsigned char*)p; asm volatile("" : "+s"(g)); return (unsigned char*)g; }
namespace pg8 {
#define PG8_LAS __attribute__((address_space(3)))
typedef unsigned short bf16_t;
typedef short bf16x8 __attribute__((ext_vector_type(8)));
typedef float f32x4 __attribute__((ext_vector_type(4)));
typedef unsigned u32x4 __attribute__((ext_vector_type(4)));
constexpr int BM = 256, BK = 64, HALF = 128, HTB = HALF * BK * 2  , STAGE_BYTES = 8 * HTB, NXCD = 8, WGM = 8;

__host__ __device__ __forceinline__ int lds_byte(int r, int c) { const int st = (r >> 4) * 2 + (c >> 5), rr = r & 15, cc = c & 31, ob = rr * 64 + cc * 2; return st * 1024 + (ob ^ (((ob >> 9) & 1) << 5)); }
__host__ __device__ __forceinline__ void stage_rc(int b, int& R, int& C) { const int st = b / 1024, sb = b % 1024, swz = sb ^ (((sb >> 9) & 1) << 5); R = (st >> 1) * 16 + swz / 64; C = (st & 1) * 32 + (swz % 64) / 2; }
__host__ __device__ __forceinline__ int perm32(int rho) { const int n = rho >> 4, i = rho & 15; return 8 * (i >> 2) + 4 * n + (i & 3); }

struct Unit { int pm, pn; };
struct Gemm { const bf16_t* A; const bf16_t* Bt; int M, N, K; };

struct StaticOrder {
    int nM, nN, nwg, G, c;
    __host__ __device__ void init(int M, int N, int G_, int c_) { nM = M / BM; nN = N / BM; nwg = nM * nN; G = G_; c = c_; }
    __host__ __device__ bool next(int i, Unit& u) const {
        const long L = (long)i * G + c; if (L >= nwg) return false;
        int wgid = (int)L; { const int q = nwg / NXCD, r = nwg % NXCD, xcd = wgid % NXCD, off = wgid / NXCD; wgid = (xcd < r ? xcd * (q + 1) : r * (q + 1) + (xcd - r) * q) + off; }
        const int nig = WGM * nN, gid = wgid / nig, fm = gid * WGM, gsz = (nM - fm) < WGM ? (nM - fm) : WGM;
        u.pm = fm + ((wgid % nig) % gsz); u.pn = (wgid % nig) / gsz; return true;
    }
    __device__ __forceinline__ void a_ready(const Unit&) const {}
    __device__ __forceinline__ void done(const Unit&) const {}
};

__device__ __forceinline__ unsigned cvt_pk_bf16(float lo, float hi) { unsigned r; asm volatile("v_cvt_pk_bf16_f32 %0, %1, %2" : "=v"(r) : "v"(lo), "v"(hi)); return r; }
typedef float f32x2 __attribute__((ext_vector_type(2)));
__device__ __forceinline__ f32x2 gelu_pk(f32x2 v) {
    const f32x2 av = __builtin_elementwise_abs(v), d = av * 0.2316418882f + 1.0f;
    f32x2 t; t.x = __builtin_amdgcn_rcpf(d.x); t.y = __builtin_amdgcn_rcpf(d.y);
    f32x2 q = t * 0.5307027145f + (-0.7265760135f); q = q * t + 0.7107068705f; q = q * t + (-0.142248368f); q = q * t + 0.127414796f; q = q * t;
    const f32x2 s = (v * v) * (-0.72134752044f);
    f32x2 e; e.x = __builtin_amdgcn_exp2f(s.x); e.y = __builtin_amdgcn_exp2f(s.y);
    const f32x2 m = v * (q * e), r = v - m;
    f32x2 o; o.x = v.x < 0.f ? m.x : r.x; o.y = v.y < 0.f ? m.y : r.y; return o;
}

template <int ACT  > struct EpiBf16 {
    static constexpr bool PERM = true, AFTER_DRAIN = false; static_assert(ACT == 0 || ACT == 1, "EpiBf16: ACT is 0 (none) or 1 (gelu_pk)");
    bf16_t* O; int ldc; const float* bias; int split_cols; size_t split_stride; float scale0;
    __device__ __forceinline__ void operator()(const f32x4 (&acc)[2][2][4][2], const Unit& u, int wr, int wc, int fr, int fq) const {
        const int row0 = u.pm * BM + wr * 64 + fr; int colt = u.pn * BM; bf16_t* base = O;
        float sc = 1.f; if (split_cols) { const int t = colt / split_cols; base += (size_t)t * split_stride; colt -= t * split_cols; if (t == 0) sc = scale0; }
        const int col0 = colt + wc * 32 + 8 * fq, bcol0 = u.pn * BM + wc * 32 + 8 * fq;
        f32x4 bv[2][2];
#pragma unroll
        for (int bj = 0; bj < 2; ++bj)
#pragma unroll
            for (int n = 0; n < 2; ++n) bv[bj][n] = bias ? *(const f32x4*)(bias + bcol0 + bj * HALF + 4 * n) : (f32x4){0.f, 0.f, 0.f, 0.f};
#pragma unroll
        for (int ai = 0; ai < 2; ++ai)
#pragma unroll
            for (int m = 0; m < 4; ++m) { bf16_t* rowp = base + (size_t)(row0 + ai * HALF + m * 16) * ldc + col0;
#pragma unroll
                for (int bj = 0; bj < 2; ++bj) { f32x4 v0 = acc[ai][bj][m][0] + bv[bj][0], v1 = acc[ai][bj][m][1] + bv[bj][1];
                    if (ACT == 1) { f32x2 a = gelu_pk((f32x2){v0[0], v0[1]}), b = gelu_pk((f32x2){v0[2], v0[3]}), c = gelu_pk((f32x2){v1[0], v1[1]}), d = gelu_pk((f32x2){v1[2], v1[3]});
                        v0 = (f32x4){a.x, a.y, b.x, b.y}; v1 = (f32x4){c.x, c.y, d.x, d.y}; }
                    v0 = v0 * sc; v1 = v1 * sc; u32x4 w; w.x = cvt_pk_bf16(v0[0], v0[1]); w.y = cvt_pk_bf16(v0[2], v0[3]); w.z = cvt_pk_bf16(v1[0], v1[1]); w.w = cvt_pk_bf16(v1[2], v1[3]);
                    *(u32x4*)(rowp + bj * HALF) = w; } }
    }
};

struct EpiF32 {
    static constexpr bool PERM = false, AFTER_DRAIN = false;
    float* C; int ldc;
    __device__ __forceinline__ void operator()(const f32x4 (&acc)[2][2][4][2], const Unit& u, int wr, int wc, int fr, int fq) const {
        const int row0 = u.pm * BM + wr * 64 + fr, col0 = u.pn * BM + wc * 32 + 4 * fq;
#pragma unroll
        for (int ai = 0; ai < 2; ++ai)
#pragma unroll
            for (int m = 0; m < 4; ++m) { float* rowp = C + (size_t)(row0 + ai * HALF + m * 16) * ldc + col0;
#pragma unroll
                for (int bj = 0; bj < 2; ++bj)
#pragma unroll
                    for (int n = 0; n < 2; ++n) *(f32x4*)(rowp + bj * HALF + n * 16) = acc[ai][bj][m][n]; }
    }
};
__device__ __forceinline__ float sigmoid_f(float x) { return __builtin_amdgcn_rcpf(1.0f + __builtin_amdgcn_exp2f(-1.4426950408889634f * x)); }
struct EpiGate {
    static constexpr bool PERM = true, AFTER_DRAIN = false;
    const bf16_t* Z; int ldz; int gcol0; bf16_t* P; bf16_t* O; int ldc; int MODE;
    __device__ __forceinline__ void operator()(const f32x4 (&acc)[2][2][4][2], const Unit& u, int wr, int wc, int fr, int fq) const {
        const int row0 = u.pm * BM + wr * 64 + fr, col0 = u.pn * BM + wc * 32 + 8 * fq;
#pragma unroll
        for (int ai = 0; ai < 2; ++ai)
#pragma unroll
            for (int m = 0; m < 4; ++m) { const int row = row0 + ai * HALF + m * 16;
#pragma unroll
                for (int bj = 0; bj < 2; ++bj) { const int col = col0 + bj * HALF;
                    const u32x4 gz = *(const u32x4*)(Z + (size_t)row * ldz + gcol0 + col);
                    f32x4 s0, s1;
                    s0[0] = sigmoid_f(__uint_as_float(gz[0] << 16)); s0[1] = sigmoid_f(__uint_as_float(gz[0] & 0xffff0000u));
                    s0[2] = sigmoid_f(__uint_as_float(gz[1] << 16)); s0[3] = sigmoid_f(__uint_as_float(gz[1] & 0xffff0000u));
                    s1[0] = sigmoid_f(__uint_as_float(gz[2] << 16)); s1[1] = sigmoid_f(__uint_as_float(gz[2] & 0xffff0000u));
                    s1[2] = sigmoid_f(__uint_as_float(gz[3] << 16)); s1[3] = sigmoid_f(__uint_as_float(gz[3] & 0xffff0000u));
                    f32x4 v0 = acc[ai][bj][m][0] * s0, v1 = acc[ai][bj][m][1] * s1;
                    bf16_t* pp = P + (size_t)row * ldc + col;
                    if (MODE >= 1) { const u32x4 pw = *(const u32x4*)pp;
                        v0[0] += __uint_as_float(pw[0] << 16); v0[1] += __uint_as_float(pw[0] & 0xffff0000u); v0[2] += __uint_as_float(pw[1] << 16); v0[3] += __uint_as_float(pw[1] & 0xffff0000u);
                        v1[0] += __uint_as_float(pw[2] << 16); v1[1] += __uint_as_float(pw[2] & 0xffff0000u); v1[2] += __uint_as_float(pw[3] << 16); v1[3] += __uint_as_float(pw[3] & 0xffff0000u); }
                    u32x4 w; w.x = cvt_pk_bf16(v0[0], v0[1]); w.y = cvt_pk_bf16(v0[2], v0[3]); w.z = cvt_pk_bf16(v1[0], v1[1]); w.w = cvt_pk_bf16(v1[2], v1[3]);
                    *(u32x4*)((MODE <= 1 ? pp : O + (size_t)row * ldc + col)) = w; } }
    }
};
struct EpiResid {
    static constexpr bool PERM = false, AFTER_DRAIN = false;
    const float* xp; const float* xs; const float* gate; float* out;
    __device__ __forceinline__ void operator()(const f32x4 (&acc)[2][2][4][2], const Unit& u, int wr, int wc, int fr, int fq) const {
        const int row0 = u.pm * BM + wr * 64 + fr, col0 = u.pn * BM + wc * 32 + 4 * fq;
        const bool samp = u.pm >= 16; const int r = samp ? 1 + ((u.pm - 16) >> 2) : 0;
        const float* xb = samp ? xs - (size_t)4096 * 2048 : xp;
        f32x4 gv[2][2];
#pragma unroll
        for (int bj = 0; bj < 2; ++bj)
#pragma unroll
            for (int n = 0; n < 2; ++n) gv[bj][n] = *(const f32x4*)(gate + (size_t)r * 12288 + col0 + bj * HALF + n * 16);
#pragma unroll
        for (int ai = 0; ai < 2; ++ai)
#pragma unroll
            for (int m = 0; m < 4; ++m) { const size_t off = (size_t)(row0 + ai * HALF + m * 16) * 2048 + col0;
#pragma unroll
                for (int bj = 0; bj < 2; ++bj)
#pragma unroll
                    for (int n = 0; n < 2; ++n) { const f32x4 x = *(const f32x4*)(xb + off + bj * HALF + n * 16);
                        *(f32x4*)(out + off + bj * HALF + n * 16) = x + gv[bj][n] * acc[ai][bj][m][n]; } }
    }
};
struct EpiNull {
    static constexpr bool PERM = true, AFTER_DRAIN = false;
    float* sink;
    __device__ __forceinline__ void operator()(const f32x4 (&acc)[2][2][4][2], const Unit& u, int wr, int wc, int fr, int fq) const {
        f32x4 s = {0.f, 0.f, 0.f, 0.f};
#pragma unroll
        for (int ai = 0; ai < 2; ++ai)
#pragma unroll
            for (int bj = 0; bj < 2; ++bj)
#pragma unroll
                for (int m = 0; m < 4; ++m)
#pragma unroll
                    for (int n = 0; n < 2; ++n) s += acc[ai][bj][m][n];
        if (s[0] + s[1] + s[2] + s[3] == 1.2345e30f) *sink = 1.f;
    }
};

template <class Epi, class Sched, bool ALIGN_EPI = false, bool SP2 = false>
__device__ __forceinline__ void gemm_phase(PG8_LAS unsigned char* lds, const Gemm g, const Sched& S, const Epi& E) {
    const int tid = fresh_tid(), wid = __builtin_amdgcn_readfirstlane(tid >> 6), lane = tid & 63, wr = wid >> 2, wc = wid & 3, fr = lane & 15, fq = lane >> 4;
    const int K = g.K, nt = K / BK;
    unsigned voffA[2], voffB[2];
#pragma unroll
    for (int i = 0; i < 2; ++i) { int R, C; stage_rc(tid * 16 + i * 8192, R, C); const int Rb = Epi::PERM ? ((R & ~31) + perm32(R & 31)) : R;
        voffA[i] = (unsigned)(R * K + C) * 2u; voffB[i] = (unsigned)(Rb * K + C) * 2u; }
    const size_t kstep = (size_t)(BK * 2);
    const size_t hstep = (size_t)HALF * K * 2;
    const size_t tstep = 2 * hstep;
    const unsigned ldsw = (unsigned)wid * 1024u;
    const int aoff = lds_byte(wr * 64 + fr, fq * 8), boff = lds_byte(wc * 32 + fr, fq * 8);
#define PG8_SA(b, h) (((b) * 2 + (h)) * HTB)
#define PG8_SB(b, h) ((4 + (b) * 2 + (h)) * HTB)
#define PG8_STAGE(bufoff, gbase, voff) do { _Pragma("unroll") for (int _i = 0; _i < 2; ++_i) \
        __builtin_amdgcn_global_load_lds((const unsigned*)((const char*)(gbase) + (voff)[_i]), (PG8_LAS unsigned*)(lds + (bufoff) + ldsw + _i * 8192), 16, 0, 0); } while (0)
#define PG8_LDA(dst, b, h) do { _Pragma("unroll") for (int m = 0; m < 4; ++m) _Pragma("unroll") for (int k = 0; k < 2; ++k) dst[m][k] = *(const PG8_LAS bf16x8*)(lds + PG8_SA(b, h) + aoff + m * 2048 + k * 1024); } while (0)
#define PG8_LDB(dst, b, h) do { _Pragma("unroll") for (int n = 0; n < 2; ++n) _Pragma("unroll") for (int k = 0; k < 2; ++k) dst[n][k] = *(const PG8_LAS bf16x8*)(lds + PG8_SB(b, h) + boff + n * 2048 + k * 1024); } while (0)
#define PG8_MMA(ai, bj, At, Bt) do { __builtin_amdgcn_s_setprio(1); _Pragma("unroll") for (int m = 0; m < 4; ++m) _Pragma("unroll") for (int n = 0; n < 2; ++n) _Pragma("unroll") for (int k = 0; k < 2; ++k) \
        acc[ai][bj][m][n] = __builtin_amdgcn_mfma_f32_16x16x32_bf16(Bt[n][k], At[m][k], acc[ai][bj][m][n], 0, 0, 0); __builtin_amdgcn_s_setprio(0); } while (0)
#define PG8_WAIT_V(n) asm volatile("s_waitcnt vmcnt(" #n ")" ::: "memory")
#define PG8_WAIT_L(n) asm volatile("s_waitcnt lgkmcnt(" #n ")" ::: "memory")
#define PG8_BAR __builtin_amdgcn_s_barrier()
#define PG8_SCHED __builtin_amdgcn_sched_barrier(0)
    Unit cur, nxt; int ui = 0;
    if (!S.next(0, cur)) return;
    f32x4 acc[2][2][4][2];
#pragma unroll
    for (int a = 0; a < 2; ++a)
#pragma unroll
        for (int b = 0; b < 2; ++b)
#pragma unroll
            for (int m = 0; m < 4; ++m)
#pragma unroll
                for (int n = 0; n < 2; ++n) acc[a][b][m][n] = (f32x4){0.f, 0.f, 0.f, 0.f};
    bf16x8 At[4][2], B0[2][2], B1[2][2];
    const char* cA = (const char*)g.A + (size_t)cur.pm * tstep; const char* cB = (const char*)g.Bt + (size_t)cur.pn * tstep;
    S.a_ready(cur);
    if constexpr (SP2) {
        PG8_STAGE(PG8_SB(0, 0), cB, voffB); PG8_STAGE(PG8_SB(0, 1), cB + hstep, voffB); PG8_STAGE(PG8_SA(0, 0), cA, voffA); PG8_STAGE(PG8_SA(0, 1), cA + hstep, voffA);
        if (wr == 1) PG8_BAR;
        PG8_WAIT_V(2); PG8_BAR;
        PG8_STAGE(PG8_SB(1, 0), cB + kstep, voffB); PG8_STAGE(PG8_SA(1, 0), cA + kstep, voffA); PG8_STAGE(PG8_SB(1, 1), cB + hstep + kstep, voffB);
        PG8_WAIT_V(6); PG8_BAR;
    } else {
        PG8_STAGE(PG8_SB(0, 0), cB, voffB); PG8_STAGE(PG8_SA(0, 0), cA, voffA); PG8_STAGE(PG8_SB(0, 1), cB + hstep, voffB); PG8_STAGE(PG8_SA(0, 1), cA + hstep, voffA);
        if (wr == 1) PG8_BAR;
        PG8_WAIT_V(4); PG8_BAR;
        PG8_STAGE(PG8_SB(1, 0), cB + kstep, voffB); PG8_STAGE(PG8_SA(1, 0), cA + kstep, voffA); PG8_STAGE(PG8_SB(1, 1), cB + hstep + kstep, voffB);
        PG8_WAIT_V(6); PG8_BAR;
    }
    for (;;) {
        const bool has_next = S.next(ui + 1, nxt);
        const char* nA = has_next ? (const char*)g.A + (size_t)nxt.pm * tstep : cA; const char* nB = has_next ? (const char*)g.Bt + (size_t)nxt.pn * tstep : cB;
        for (int t = 0; t < nt; t += 2) {
            const bool last = (t == nt - 2);
            const char* a1 = cA + (size_t)(t + 1) * kstep;
            const char* a2 = last ? nA : cA + (size_t)(t + 2) * kstep; const char* b2 = last ? nB : cB + (size_t)(t + 2) * kstep;
            const char* a3 = a2 + kstep; const char* b3 = b2 + kstep;
            if (last && has_next) S.a_ready(nxt);
            if constexpr (SP2) {
            PG8_LDB(B0, 0, 0); PG8_LDB(B1, 0, 1); PG8_SCHED; PG8_LDA(At, 0, 0); PG8_STAGE(PG8_SA(1, 1), a1 + hstep, voffA);
            PG8_WAIT_V(8); PG8_WAIT_L(0); PG8_BAR; PG8_MMA(0, 0, At, B0); PG8_MMA(0, 1, At, B1); PG8_BAR; PG8_SCHED;
            PG8_LDA(At, 0, 1); PG8_STAGE(PG8_SB(0, 0), b2, voffB); PG8_STAGE(PG8_SB(0, 1), b2 + hstep, voffB); PG8_STAGE(PG8_SA(0, 0), a2, voffA);
            PG8_WAIT_V(8); PG8_WAIT_L(0); PG8_BAR; PG8_MMA(1, 0, At, B0); PG8_MMA(1, 1, At, B1); PG8_BAR; PG8_SCHED;
            PG8_LDB(B0, 1, 0); PG8_LDB(B1, 1, 1); PG8_SCHED; PG8_LDA(At, 1, 0); PG8_STAGE(PG8_SA(0, 1), a2 + hstep, voffA);
            PG8_WAIT_V(8); PG8_WAIT_L(0); PG8_BAR; PG8_MMA(0, 0, At, B0); PG8_MMA(0, 1, At, B1); PG8_BAR; PG8_SCHED;
            PG8_LDA(At, 1, 1); PG8_STAGE(PG8_SB(1, 0), b3, voffB); PG8_STAGE(PG8_SB(1, 1), b3 + hstep, voffB); PG8_STAGE(PG8_SA(1, 0), a3, voffA);
            PG8_WAIT_V(8); PG8_WAIT_L(0); PG8_BAR; PG8_MMA(1, 0, At, B0); PG8_MMA(1, 1, At, B1); PG8_BAR; PG8_SCHED;
            } else {
            PG8_LDB(B0, 0, 0); PG8_SCHED; PG8_LDA(At, 0, 0); PG8_STAGE(PG8_SA(1, 1), a1 + hstep, voffA);
            PG8_WAIT_L(8); PG8_BAR; PG8_WAIT_L(0); PG8_MMA(0, 0, At, B0); PG8_BAR; PG8_SCHED;
            PG8_LDB(B1, 0, 1); PG8_STAGE(PG8_SB(0, 0), b2, voffB);
            PG8_BAR; PG8_WAIT_L(0); PG8_MMA(0, 1, At, B1); PG8_BAR;
            PG8_LDA(At, 0, 1); PG8_STAGE(PG8_SA(0, 0), a2, voffA);
            PG8_BAR; PG8_WAIT_L(0); PG8_MMA(1, 0, At, B0); PG8_BAR; PG8_SCHED;
            PG8_STAGE(PG8_SB(0, 1), b2 + hstep, voffB);
            PG8_WAIT_V(6); PG8_BAR; PG8_MMA(1, 1, At, B1); PG8_BAR;
            PG8_LDB(B0, 1, 0); PG8_SCHED; PG8_LDA(At, 1, 0); PG8_STAGE(PG8_SA(0, 1), a2 + hstep, voffA);
            PG8_WAIT_L(8); PG8_BAR; PG8_WAIT_L(0); PG8_MMA(0, 0, At, B0); PG8_BAR; PG8_SCHED;
            PG8_LDB(B1, 1, 1); PG8_STAGE(PG8_SB(1, 0), b3, voffB);
            PG8_BAR; PG8_WAIT_L(0); PG8_MMA(0, 1, At, B1); PG8_BAR;
            PG8_LDA(At, 1, 1); PG8_STAGE(PG8_SA(1, 0), a3, voffA);
            PG8_BAR; PG8_WAIT_L(0); PG8_MMA(1, 0, At, B0); PG8_BAR; PG8_SCHED;
            PG8_STAGE(PG8_SB(1, 1), b3 + hstep, voffB);
            PG8_WAIT_V(6); PG8_BAR; PG8_MMA(1, 1, At, B1); PG8_BAR;
            }
        }
        if constexpr (ALIGN_EPI) { if (wr == 0) PG8_BAR; }
        if constexpr (!Epi::AFTER_DRAIN) { E(acc, cur, wr, wc, fr, fq); S.done(cur); }
        if (!has_next) break;
#pragma unroll
        for (int a = 0; a < 2; ++a)
#pragma unroll
            for (int b = 0; b < 2; ++b)
#pragma unroll
                for (int m = 0; m < 4; ++m)
#pragma unroll
                    for (int n = 0; n < 2; ++n) acc[a][b][m][n] = (f32x4){0.f, 0.f, 0.f, 0.f};
        cur = nxt; cA = nA; cB = nB; ++ui;
        if constexpr (ALIGN_EPI) { if (wr == 1) PG8_BAR; }
    }
    PG8_WAIT_V(0);
    if constexpr (!ALIGN_EPI) { if (wr == 0) PG8_BAR; }
    PG8_BAR;
    if constexpr (Epi::AFTER_DRAIN) { E.fused(acc, cur, wr, wc, fr, fq, lds, wid, lane); S.done(cur); }
#undef PG8_SA
#undef PG8_SB
#undef PG8_STAGE
#undef PG8_LDA
#undef PG8_LDB
#undef PG8_MMA
#undef PG8_WAIT_V
#undef PG8_WAIT_L
#undef PG8_BAR
#undef PG8_SCHED
}
}

namespace att {
using bf16 = __hip_bfloat16;
constexpr int D = 128, NW = 8, QBLK = 32, KVBLK = 64;
constexpr float SCALE = 1.0f;
constexpr float THR = 8.f;
constexpr int SDEPTH = 2;
constexpr int LDQ = 3072, LDK = 1280, LDO = 3072;
constexpr size_t SHM_V = KVBLK * D * 2, SHM_K = KVBLK * D * 2, SHM_ATTN = 2 * SHM_V + 2 * SHM_K + NW * 64 * 4;
typedef __bf16 abf16x2_t __attribute__((ext_vector_type(2))); typedef float af32x2_t __attribute__((ext_vector_type(2)));
__device__ __forceinline__ unsigned short bf1(float x) { const af32x2_t v = {x, x}; const abf16x2_t b = __builtin_convertvector(v, abf16x2_t); return (unsigned short)(__builtin_bit_cast(unsigned, b) & 0xffffu); }
using bf16x8 = __attribute__((ext_vector_type(8))) short;
using s16x4  = __attribute__((ext_vector_type(4))) short;
using f32x16 = __attribute__((ext_vector_type(16))) float;
using f32x8  = __attribute__((ext_vector_type(8))) float;
using u32x4  = __attribute__((ext_vector_type(4))) unsigned;
#define KSWZ(row, colB) ((row) * 256 + ((colB) ^ (((row) & 7) << 4)))
#define SBAR() __builtin_amdgcn_sched_barrier(0)
__device__ __forceinline__ int crow(int r, int hi) { return (r & 3) + 8 * (r >> 2) + 4 * hi; }
__device__ __forceinline__ unsigned cvtpk(float lo, float hi) {
  unsigned r; asm volatile("v_cvt_pk_bf16_f32 %0, %1, %2" : "=v"(r) : "v"(lo), "v"(hi)); return r;
}
template <typename TIn> struct Stage;
template <> struct Stage<bf16>  { using T = bf16x8;
  __device__ static __forceinline__ T ld8(const bf16* p) { return *reinterpret_cast<const bf16x8*>(p); }
  __device__ static __forceinline__ bf16x8 tobf(T x) { return x; } };
template <> struct Stage<float> { using T = f32x8;
  __device__ static __forceinline__ T ld8(const float* p) { return *reinterpret_cast<const f32x8*>(p); }
  __device__ static __forceinline__ bf16x8 tobf(T x) {
    u32x4 w = {cvtpk(x[0], x[1]), cvtpk(x[2], x[3]), cvtpk(x[4], x[5]), cvtpk(x[6], x[7])}; return *reinterpret_cast<bf16x8*>(&w); } };

__device__ __forceinline__ void partialSM(f32x16& p0, f32x16& p1, float& m_reg, float& mn, float& alpha) {
  constexpr float C = SCALE * 1.4426950408889634f;
  float pmax = p0[0]; for (int r = 1; r < 16; ++r) pmax = fmaxf(pmax, p0[r]); for (int r = 0; r < 16; ++r) pmax = fmaxf(pmax, p1[r]);
  { auto rr = __builtin_amdgcn_permlane32_swap(__float_as_uint(pmax), __float_as_uint(pmax), false, false);
    pmax = fmaxf(__uint_as_float(rr[0]), __uint_as_float(rr[1])); }
  if (__builtin_expect(__all(pmax - m_reg <= THR / SCALE), 1)) { mn = m_reg; alpha = 1.f; }
  else { mn = fmaxf(m_reg, pmax); alpha = __builtin_amdgcn_exp2f((m_reg - mn) * C); m_reg = mn; }
  float mnC = -mn * C;
  for (int r = 0; r < 16; ++r) p0[r] = fmaf(p0[r], C, mnC); for (int r = 0; r < 16; ++r) p1[r] = fmaf(p1[r], C, mnC);
  for (int r = 0; r < 16; ++r) p0[r] = __builtin_amdgcn_exp2f(p0[r]);
}
__device__ __forceinline__ void finishSM(f32x16& p0, f32x16& p1, float alpha, float& l_reg, bf16x8& pa0, bf16x8& pa1, bf16x8& pa2, bf16x8& pa3) {
  for (int r = 0; r < 16; ++r) p1[r] = __builtin_amdgcn_exp2f(p1[r]);
  float ps = 0; for (int r = 0; r < 16; ++r) ps += p0[r]; for (int r = 0; r < 16; ++r) ps += p1[r];
  { auto rr = __builtin_amdgcn_permlane32_swap(__float_as_uint(ps), __float_as_uint(ps), false, false);
    ps = __uint_as_float(rr[0]) + __uint_as_float(rr[1]); }
  l_reg = l_reg * alpha + ps;
#define PK4(P, BASE, OUT) do { unsigned a0 = cvtpk(P[BASE + 0], P[BASE + 1]), a1 = cvtpk(P[BASE + 2], P[BASE + 3]);   \
    unsigned b0 = cvtpk(P[BASE + 4], P[BASE + 5]), b1 = cvtpk(P[BASE + 6], P[BASE + 7]);                              \
    auto r0 = __builtin_amdgcn_permlane32_swap(a0, b0, false, false); auto r1 = __builtin_amdgcn_permlane32_swap(a1, b1, false, false); \
    u32x4 w = {r0[0], r1[0], r0[1], r1[1]}; OUT = *reinterpret_cast<bf16x8*>(&w); } while (0)
  PK4(p0, 0, pa0); PK4(p0, 8, pa1); PK4(p1, 0, pa2); PK4(p1, 8, pa3);
#undef PK4
}
__device__ __forceinline__ void qkt(f32x16& p0, f32x16& p1, const bf16* Ks, const bf16x8* qr, int r32, int hi) {
  p0 = f32x16{}; p1 = f32x16{};
  for (int d0 = 0; d0 < 8; ++d0) { int cb = (d0 * 16 + hi * 8) * 2;
    bf16x8 b0 = *reinterpret_cast<const bf16x8*>((const char*)Ks + KSWZ(r32, cb));
    bf16x8 b1 = *reinterpret_cast<const bf16x8*>((const char*)Ks + KSWZ(32 + r32, cb));
    p0 = __builtin_amdgcn_mfma_f32_32x32x16_bf16(b0, qr[d0], p0, 0, 0, 0);
    p1 = __builtin_amdgcn_mfma_f32_32x32x16_bf16(b1, qr[d0], p1, 0, 0, 0); }
}
__device__ __forceinline__ int v_st(int k, int c) { const int kk = (k & ~0xC) | ((k & 4) << 1) | ((k & 8) >> 1); return ((kk >> 3) * 4 + (c >> 5)) * 512 + ((kk & 7) * 32 + (c & 31)) * 2; }
__device__ __forceinline__ int v_rd_base(int lane) { return ((lane & 3) << 3) | (((lane >> 2) & 3) << 6) | (((lane >> 4) & 1) << 5) | (((lane >> 5) & 1) << 8); }
constexpr int v_rd_off(int d0, int ks, int half) { return d0 * 512 + ks * 4096 + half * 2048; }
template <int OFF> __device__ __forceinline__ s16x4 tr_read(int vb) {
  s16x4 r; asm volatile("ds_read_b64_tr_b16 %0, %1 offset:%2" : "=&v"(r) : "v"(vb), "i"(OFF) : "memory"); return r;
}
template <int D0> __device__ __forceinline__ void pv_one(f32x16& od, int vb, bf16x8 pa0, bf16x8 pa1, bf16x8 pa2, bf16x8 pa3) {
  const s16x4 l0 = tr_read<v_rd_off(D0, 0, 0)>(vb), h0 = tr_read<v_rd_off(D0, 0, 1)>(vb), l1 = tr_read<v_rd_off(D0, 1, 0)>(vb), h1 = tr_read<v_rd_off(D0, 1, 1)>(vb);
  const s16x4 l2 = tr_read<v_rd_off(D0, 2, 0)>(vb), h2 = tr_read<v_rd_off(D0, 2, 1)>(vb), l3 = tr_read<v_rd_off(D0, 3, 0)>(vb), h3 = tr_read<v_rd_off(D0, 3, 1)>(vb);
  asm volatile("s_waitcnt lgkmcnt(0)" ::: "memory"); SBAR();
#define PK(L, H) (bf16x8){L[0], L[1], L[2], L[3], H[0], H[1], H[2], H[3]}
  od = __builtin_amdgcn_mfma_f32_32x32x16_bf16(pa0, PK(l0, h0), od, 0, 0, 0);
  od = __builtin_amdgcn_mfma_f32_32x32x16_bf16(pa1, PK(l1, h1), od, 0, 0, 0);
  od = __builtin_amdgcn_mfma_f32_32x32x16_bf16(pa2, PK(l2, h2), od, 0, 0, 0);
  od = __builtin_amdgcn_mfma_f32_32x32x16_bf16(pa3, PK(l3, h3), od, 0, 0, 0);
#undef PK
}
__device__ __forceinline__ void pv_d0(f32x16* o, int vb, bf16x8 pa0, bf16x8 pa1, bf16x8 pa2, bf16x8 pa3) {
  pv_one<0>(o[0], vb, pa0, pa1, pa2, pa3); pv_one<1>(o[1], vb, pa0, pa1, pa2, pa3); pv_one<2>(o[2], vb, pa0, pa1, pa2, pa3); pv_one<3>(o[3], vb, pa0, pa1, pa2, pa3);
}

template <typename TQ>
__device__ __forceinline__ void attn_dense_body(const TQ* __restrict__ Qb, const bf16* __restrict__ Kh, const bf16* __restrict__ Vh,
                                                unsigned short* __restrict__ Ob, int seq, char* lds) {
  using St = Stage<bf16>; using SQ = Stage<TQ>;
  const int tid = fresh_tid(), wid = tid >> 6, lane = tid & 63, r32 = lane & 31, hi = lane >> 5;
  bf16* V_lds = (bf16*)lds; bf16* K_lds = (bf16*)(lds + 2 * SHM_V);
  float* ws = (float*)(lds + 2 * SHM_V + 2 * SHM_K) + wid * 64; float* li_l = ws; float* al_l = ws + 32;
  float m_reg = -1e30f, l_reg = 0; f32x16 o[4] = {}; bf16x8 qr[8];
  const TQ* Qw = Qb + (long)(wid * QBLK + r32) * LDQ + hi * 8;
#pragma unroll
  for (int d0 = 0; d0 < 8; ++d0) qr[d0] = SQ::tobf(SQ::ld8(Qw + d0 * 16));
  const int sr = tid >> 4, sc = (tid & 15) * 8, vst0 = v_st(sr, sc), vst1 = v_st(32 + sr, sc);
  const int vb0 = (int)(uintptr_t)V_lds + v_rd_base(lane);
  struct { typename St::T vs0, vs1, ks0, ks1; } sr_[SDEPTH];
#define SLOAD(i, k0) do { sr_[i].vs0 = St::ld8(&Vh[(long)((k0) + sr) * LDK + sc]); sr_[i].vs1 = St::ld8(&Vh[(long)((k0) + 32 + sr) * LDK + sc]); \
    sr_[i].ks0 = St::ld8(&Kh[(long)((k0) + sr) * LDK + sc]); sr_[i].ks1 = St::ld8(&Kh[(long)((k0) + 32 + sr) * LDK + sc]); } while (0)
#define SWRITE(b, i) do { *(bf16x8*)((char*)V_lds + (b) * SHM_V + vst0) = St::tobf(sr_[i].vs0);          \
    *(bf16x8*)((char*)V_lds + (b) * SHM_V + vst1) = St::tobf(sr_[i].vs1); int kc = sc * 2;               \
    *(bf16x8*)((char*)K_lds + (b) * SHM_K + KSWZ(sr, kc)) = St::tobf(sr_[i].ks0);                       \
    *(bf16x8*)((char*)K_lds + (b) * SHM_K + KSWZ(32 + sr, kc)) = St::tobf(sr_[i].ks1); } while (0)
#define SWAIT() do { if constexpr (SDEPTH == 2) asm volatile("s_waitcnt vmcnt(4)" ::: "memory"); else asm volatile("s_waitcnt vmcnt(0)" ::: "memory"); } while (0)
#define RESC(a) do { if (__any((a) < 1.f)) { if (hi == 0) al_l[r32] = (a); asm volatile("s_waitcnt lgkmcnt(0)" ::: "memory"); \
    for (int d = 0; d < 4; ++d) for (int r = 0; r < 16; ++r) o[d][r] *= al_l[crow(r, hi)]; } } while (0)
  f32x16 pA0, pA1, pB0, pB1; float mnA, mnB, alA, alB; bf16x8 pa0, pa1, pa2, pa3; const int NT = seq / KVBLK;
  constexpr int SE = 0, SO = SDEPTH - 1;
  SLOAD(SE, 0); asm volatile("s_waitcnt vmcnt(0)" ::: "memory"); SWRITE(0, SE); __syncthreads();
  qkt(pA0, pA1, K_lds, qr, r32, hi); partialSM(pA0, pA1, m_reg, mnA, alA);
  SLOAD(SO, KVBLK); if constexpr (SDEPTH == 2) { if (2 < NT) SLOAD(SE, 2 * KVBLK); }
  SWAIT(); SWRITE(1, SO); __syncthreads();
  for (int j = 1; j + 1 < NT; j += 2) {
    SBAR(); qkt(pB0, pB1, (bf16*)((char*)K_lds + SHM_K), qr, r32, hi);
    finishSM(pA0, pA1, alA, l_reg, pa0, pa1, pa2, pa3); SBAR();
    SLOAD(SO, (j + SDEPTH) * KVBLK); SBAR();
    pv_d0(o, vb0, pa0, pa1, pa2, pa3); partialSM(pB0, pB1, m_reg, mnB, alB);
    __syncthreads(); SWAIT(); SWRITE(0, SE);
    RESC(alB); __syncthreads();
    SBAR(); qkt(pA0, pA1, K_lds, qr, r32, hi);
    finishSM(pB0, pB1, alB, l_reg, pa0, pa1, pa2, pa3); SBAR();
    if (SDEPTH == 1 || j + 3 < NT) SLOAD(SE, (j + 1 + SDEPTH) * KVBLK); SBAR();
    pv_d0(o, vb0 + (int)SHM_V, pa0, pa1, pa2, pa3); partialSM(pA0, pA1, m_reg, mnA, alA);
    __syncthreads(); SWAIT(); SWRITE(1, SO);
    RESC(alA); __syncthreads();
  }
  SBAR(); qkt(pB0, pB1, (bf16*)((char*)K_lds + SHM_K), qr, r32, hi);
  finishSM(pA0, pA1, alA, l_reg, pa0, pa1, pa2, pa3); SBAR();
  pv_d0(o, vb0, pa0, pa1, pa2, pa3); partialSM(pB0, pB1, m_reg, mnB, alB);
  __syncthreads(); RESC(alB);
  finishSM(pB0, pB1, alB, l_reg, pa0, pa1, pa2, pa3); SBAR();
  pv_d0(o, vb0 + (int)SHM_V, pa0, pa1, pa2, pa3);
  if (hi == 0) li_l[r32] = l_reg; asm volatile("s_waitcnt lgkmcnt(0)" ::: "memory");
  float rli[16];
#pragma unroll
  for (int r = 0; r < 16; ++r) rli[r] = __builtin_amdgcn_rcpf(li_l[crow(r, hi)]);
  unsigned short* Ow = Ob + (long)(wid * QBLK) * LDO;
#pragma unroll
  for (int r = 0; r < 16; ++r) { int orow = crow(r, hi);
    for (int d0 = 0; d0 < 4; ++d0) Ow[(long)orow * LDO + d0 * 32 + r32] = bf1(o[d0][r] * rli[r]); }
#undef SLOAD
#undef SWRITE
#undef SWAIT
#undef RESC
}
}

constexpr int DM = 2048, NTOK = 6144, NPROMPT = 4096, INW = 15872;
constexpr int C_HQ = 0, C_HF = 1024, C_HI = 3072, C_HG = 4096, C_DQ = 5120, C_DK = 6144, C_DV = 7168, C_GQ = 8192, C_GK = 9216, C_GV = 9472, C_GATE = 9728;
constexpr int KROWS = 4096 + 2 * 1280;
constexpr int KVW = 1280;
constexpr float EPS = 1e-6f;
constexpr int NPH = 23;

constexpr size_t MiB = 1u << 20;
constexpr size_t WS_CTL = 0, CTL_ZERO_BYTES = 1 * MiB;
constexpr size_t WS_MOD = 1 * MiB, WS_ROPE = 2 * MiB, WS_WIN = 3 * MiB, WS_WBR = 127 * MiB, WS_WOUT = 151 * MiB, WS_WPQ = 167 * MiB, WS_PU = 183 * MiB, WS_PV = 311 * MiB;
constexpr size_t WS_H = 439 * MiB, WS_Z = 463 * MiB, WS_QA = 649 * MiB, WS_KA = 685 * MiB, WS_VA = 702 * MiB, WS_OA = 719 * MiB, WS_OH = 791 * MiB, WS_BR = 839 * MiB, WS_MG = 875 * MiB;
constexpr size_t WS_XM = 899 * MiB, WS_X1 = 947 * MiB, WS_PE = 995 * MiB, WS_PG = 998 * MiB, WS_END = 1001 * MiB;
constexpr size_t WS_UV8 = WS_PU, WS_SC = WS_PV;
constexpr size_t WS_QP = WS_OA;
constexpr size_t WS_MGP = WS_OH;
static_assert(WS_WIN + (size_t)2 * INW * DM * 2 <= WS_WBR && WS_Z + (size_t)NTOK * INW * 2 <= WS_QA && WS_KA + (size_t)KROWS * KVW * 2 <= WS_VA && WS_VA + (size_t)KROWS * KVW * 2 <= WS_OA, "d_ws map");
static_assert(WS_OA + (size_t)NTOK * 3072 * 4 <= WS_OH && WS_OH + (size_t)2 * NTOK * 1024 * 4 <= WS_BR && WS_BR + (size_t)3 * NTOK * 1024 * 2 <= WS_MG, "d_ws map 2");
constexpr int CW_BAR = 4096;

constexpr int LDS_BYTES = 163840, RING_OFF = 1024;

#define GAS __attribute__((address_space(1)))
#define LAS __attribute__((address_space(3)))
typedef unsigned short bf16;
typedef unsigned v4u __attribute__((ext_vector_type(4)));
typedef unsigned v2u __attribute__((ext_vector_type(2)));
typedef float f32x4 __attribute__((ext_vector_type(4)));
typedef float f32x2 __attribute__((ext_vector_type(2)));
typedef __bf16 bf16x2_t __attribute__((ext_vector_type(2)));
__device__ __forceinline__ unsigned pk2(float lo, float hi) { const f32x2 v = {lo, hi}; const bf16x2_t b = __builtin_convertvector(v, bf16x2_t); return __builtin_bit_cast(unsigned, b); }
__device__ __forceinline__ unsigned f2bf(float f) { return pk2(f, f) & 0xffffu; }
__device__ __forceinline__ float bflo(unsigned w) { return __uint_as_float(w << 16); }
__device__ __forceinline__ float bfhi(unsigned w) { return __uint_as_float(w & 0xffff0000u); }
__device__ __forceinline__ float wave_sum(float v) {
#pragma unroll
    for (int o = 1; o < 64; o <<= 1) v += __shfl_xor(v, o);
    return v;
}
__device__ __forceinline__ void ld16bf(const bf16* p, float (&v)[16]) {
    const v4u a = *(const v4u*)p, b = *(const v4u*)(p + 8);
    v[0] = bflo(a.x); v[1] = bfhi(a.x); v[2] = bflo(a.y); v[3] = bfhi(a.y); v[4] = bflo(a.z); v[5] = bfhi(a.z); v[6] = bflo(a.w); v[7] = bfhi(a.w);
    v[8] = bflo(b.x); v[9] = bfhi(b.x); v[10] = bflo(b.y); v[11] = bfhi(b.y); v[12] = bflo(b.z); v[13] = bfhi(b.z); v[14] = bflo(b.w); v[15] = bfhi(b.w);
}
__device__ __forceinline__ void ld16f(const float* p, float (&v)[16]) {
#pragma unroll
    for (int i = 0; i < 4; ++i) { const f32x4 x = *(const f32x4*)(p + 4 * i); v[4 * i] = x[0]; v[4 * i + 1] = x[1]; v[4 * i + 2] = x[2]; v[4 * i + 3] = x[3]; }
}
__device__ __forceinline__ void st16bf(bf16* p, const float (&v)[16]) {
    v4u a, b; a.x = pk2(v[0], v[1]); a.y = pk2(v[2], v[3]); a.z = pk2(v[4], v[5]); a.w = pk2(v[6], v[7]); b.x = pk2(v[8], v[9]); b.y = pk2(v[10], v[11]); b.z = pk2(v[12], v[13]); b.w = pk2(v[14], v[15]);
    *(v4u*)p = a; *(v4u*)(p + 8) = b;
}
__device__ __forceinline__ void st16f(float* p, const float (&v)[16]) {
#pragma unroll
    for (int i = 0; i < 4; ++i) *(f32x4*)(p + 4 * i) = (f32x4){v[4 * i], v[4 * i + 1], v[4 * i + 2], v[4 * i + 3]};
}

#define XB_TMO      128
#define XB_XCNT(j)  (256  + 64 * (j))
#define XB_XSUB(j)  (1280 + 64 * (j))
#define XB_XGEN(j)  (2304 + 64 * (j))
#define XB_TOP      3328
#define XB_TOPGEN   3392
#define XCD_BAR_WORDS 3456
#define XB_SPIN_CAP (1u << 18)

__device__ __forceinline__ unsigned xb_ld(unsigned* p)              { return __hip_atomic_load(p, __ATOMIC_RELAXED, __HIP_MEMORY_SCOPE_AGENT); }
__device__ __forceinline__ unsigned xb_add(unsigned* p, unsigned v) { return __hip_atomic_fetch_add(p, v, __ATOMIC_RELAXED, __HIP_MEMORY_SCOPE_AGENT); }
__device__ __forceinline__ unsigned xb_xcc_id() { return (unsigned)__builtin_amdgcn_s_getreg((3 << 11) | 20) & 0xFu; }
#define XB_SPIN(cond, bar) do { unsigned _sp = 0; while (cond) { __builtin_amdgcn_s_sleep(1); \
    if ((++_sp & 255u) == 0u) { if (xb_ld(&(bar)[XB_TMO])) break; if (_sp > XB_SPIN_CAP) { atomicAdd(&(bar)[XB_TMO], 1u); break; } } } } while (0)

struct XcdBarrier {
    unsigned* bar; unsigned x;
    volatile LAS unsigned* st;
};

__device__ __forceinline__ XcdBarrier xcd_barrier_post(unsigned* bar, volatile LAS unsigned* st) {
    XcdBarrier b; b.bar = bar; b.x = xb_xcc_id(); b.st = st;
    if (threadIdx.x == 0) (void)xb_add(&bar[XB_XCNT(b.x)], 1u);
    return b;
}
__device__ __forceinline__ void xcd_barrier_complete(unsigned* bar, unsigned x, unsigned& nloc, unsigned& nx) {
    const unsigned G = gridDim.x * gridDim.y * gridDim.z;
    unsigned sum, cnt, mine, sp = 0u;
    for (;;) {
        sum = 0u; cnt = 0u; mine = 0u;
#pragma unroll
        for (unsigned j = 0; j < 16; ++j) { const unsigned c = xb_ld(&bar[XB_XCNT(j)]); sum += c; cnt += (c > 0u) ? 1u : 0u; mine = (j == x) ? c : mine; }
        if (sum == G) break;
        __builtin_amdgcn_s_sleep(1);
        if ((++sp & 255u) == 0u) { if (xb_ld(&bar[XB_TMO])) break; if (sp > XB_SPIN_CAP) { atomicAdd(&bar[XB_TMO], 1u); break; } }
    }
    nloc = mine > 0u ? mine : 1u; nx = cnt > 0u ? cnt : 1u;
}

__device__ __forceinline__ void xcd_barrier(const XcdBarrier& b) {
    asm volatile("s_waitcnt vmcnt(0)" ::: "memory");
    __syncthreads();
    if (threadIdx.x == 0) {
        unsigned* bar = b.bar;
        __builtin_amdgcn_s_waitcnt(0);
        unsigned nloc = b.st[0], nx = b.st[1];
        if (nloc == 0u) { xcd_barrier_complete(bar, b.x, nloc, nx); b.st[0] = nloc; b.st[1] = nx; }
        const unsigned old = xb_add(&bar[XB_XSUB(b.x)], 1u);
        const unsigned gen = old / nloc;
        if (old + 1u == (gen + 1u) * nloc) {
            __builtin_amdgcn_fence(__ATOMIC_RELEASE, "agent");
            asm volatile("s_waitcnt vmcnt(0)" ::: "memory");
            const unsigned og = xb_add(&bar[XB_TOP], 1u);
            const unsigned tg = og / nx;
            if (og + 1u == (tg + 1u) * nx) xb_add(&bar[XB_TOPGEN], 1u);
            else XB_SPIN(xb_ld(&bar[XB_TOPGEN]) == tg, bar);
            __builtin_amdgcn_fence(__ATOMIC_ACQUIRE, "agent");
            xb_add(&bar[XB_XGEN(b.x)], 1u);
            asm volatile("s_waitcnt vmcnt(0)" ::: "memory");
        } else {
            XB_SPIN(xb_ld(&bar[XB_XGEN(b.x)]) == gen, bar);
            __builtin_amdgcn_fence(__ATOMIC_ACQUIRE, "agent");
            asm volatile("s_waitcnt vmcnt(0)" ::: "memory");
        }
    }
    __syncthreads();
}
struct Args { const float* in[26]; float* out; unsigned char* ws; int ph_lo, ph_hi; };
constexpr size_t OUT_YP = 0, OUT_DK = 12582912, OUT_DV = 20971520, OUT_GK = 29360128, OUT_GV = 31457280, OUT_ST = 33554432, OUT_TOTAL = 41943040;
#define LDS_WAIT() asm volatile("s_waitcnt lgkmcnt(0)" ::: "memory")

constexpr int TI_IN = (DM / 64) * (INW / 32), TI_BR = (1024 / 64) * (DM / 32), TI_SQ = (DM / 64) * (DM / 32), TI_LAYER = TI_IN + 3 * TI_BR + 2 * TI_SQ;
struct TItem { const float* src; bf16* dst; int N, K; };
__device__ __forceinline__ TItem p0_titem(const Args& a, unsigned char* ws, int l, int r) {
    const float* W; bf16* WT; int K, N, item;
    if (r < TI_IN) { W = a.in[13] + (size_t)l * DM * INW; K = DM; N = INW; WT = (bf16*)(ws + WS_WIN) + (size_t)l * INW * DM; item = r; }
    else if ((r -= TI_IN) < 3 * TI_BR) { const int lc = l * 3 + r / TI_BR; W = a.in[20] + (size_t)lc * 1024 * DM; K = 1024; N = DM; WT = (bf16*)(ws + WS_WBR) + (size_t)lc * DM * 1024; item = r % TI_BR; }
    else if ((r -= 3 * TI_BR) < TI_SQ) { W = a.in[21] + (size_t)l * DM * DM; K = DM; N = DM; WT = (bf16*)(ws + WS_WOUT) + (size_t)l * DM * DM; item = r; }
    else { r -= TI_SQ; W = a.in[22] + (size_t)l * DM * DM; K = DM; N = DM; WT = (bf16*)(ws + WS_WPQ) + (size_t)l * DM * DM; item = r; }
    const int nblk = N / 32, kb = item / nblk, nb = item % nblk, k0 = 64 * kb, n0 = 32 * nb;
    TItem t; t.src = W + (size_t)k0 * N + n0; t.dst = WT + (size_t)n0 * K + k0; t.N = N; t.K = K; return t;
}
__device__ __forceinline__ void p0_tload(const TItem& t, int lane, f32x4 (&tv)[8]) {
#pragma unroll
    for (int i = 0; i < 8; ++i) tv[i] = *(const f32x4*)(t.src + (size_t)((lane >> 3) + 8 * i) * t.N + 4 * (lane & 7));
}
__device__ __forceinline__ void p0_tfinish(const TItem& t, LAS float* scr, int lane, const f32x4 (&tv)[8]) {
#pragma unroll
    for (int i = 0; i < 8; ++i) { LAS float* d = scr + ((lane >> 3) + 8 * i) * 33 + 4 * (lane & 7); d[0] = tv[i][0]; d[1] = tv[i][1]; d[2] = tv[i][2]; d[3] = tv[i][3]; }
    LDS_WAIT(); asm volatile("" ::: "memory");
    const int c = lane & 7;
#pragma unroll
    for (int j = 0; j < 4; ++j) { const int n = (lane >> 3) + 8 * j; const LAS float* s = scr + (8 * c) * 33 + n;
        v4u o; o.x = pk2(s[0 * 33], s[1 * 33]); o.y = pk2(s[2 * 33], s[3 * 33]); o.z = pk2(s[4 * 33], s[5 * 33]); o.w = pk2(s[6 * 33], s[7 * 33]);
        *(v4u*)(t.dst + (size_t)n * t.K + 8 * c) = o; }
    LDS_WAIT(); asm volatile("" ::: "memory");
}
__device__ __forceinline__ void p0_transposes(const Args& a, unsigned char* ws, LAS float* scr, int lane, int l, int r0, int r1, int st) {
    if (r0 >= r1) return;
    f32x4 ta[8], tb[8]; TItem ca = p0_titem(a, ws, l, r0), cb;
    p0_tload(ca, lane, ta);
    for (int r = r0; r < r1; r += 2 * st) {
        const int i2 = r + st < r1 ? r + st : r1 - 1, i3 = r + 2 * st < r1 ? r + 2 * st : r1 - 1;
        cb = p0_titem(a, ws, l, i2); p0_tload(cb, lane, tb); __builtin_amdgcn_sched_barrier(0);
        p0_tfinish(ca, scr, lane, ta); __builtin_amdgcn_sched_barrier(0);
        ca = p0_titem(a, ws, l, i3); p0_tload(ca, lane, ta); __builtin_amdgcn_sched_barrier(0);
        p0_tfinish(cb, scr, lane, tb); __builtin_amdgcn_sched_barrier(0);
    }
}
__device__ __forceinline__ void fp8_row_load(const Args& a, int t, int le, int lane, f32x4 (&x)[8]) {
    const float* src = a.in[24 + t] + (size_t)le * 2048;
#pragma unroll
    for (int j = 0; j < 8; ++j) x[j] = *(const f32x4*)(src + j * 256 + lane * 4);
}
__device__ __forceinline__ void fp8_row_finish(unsigned char* ws, int t, int le, int lane, const f32x4 (&x)[8]) {
    unsigned char* UV8 = ws + WS_UV8; float* SC = (float*)(ws + WS_SC);
    float mx = 0.f;
#pragma unroll
    for (int j = 0; j < 8; ++j) mx = fmaxf(fmaxf(mx, fmaxf(fabsf(x[j][0]), fabsf(x[j][1]))), fmaxf(fabsf(x[j][2]), fabsf(x[j][3])));
#pragma unroll
    for (int o = 1; o < 64; o <<= 1) mx = fmaxf(mx, __shfl_xor(mx, o));
    const float qmax = t == 0 ? 127.0f : 448.0f;
    const float sc = mx > 0.f ? mx / qmax : 1.0f, inv = mx > 0.f ? qmax / mx : 0.f;
    unsigned w[8];
    if (t == 0) {
#pragma unroll
        for (int j = 0; j < 8; ++j) { const int q0 = (int)rintf(x[j][0] * inv), q1 = (int)rintf(x[j][1] * inv), q2 = (int)rintf(x[j][2] * inv), q3 = (int)rintf(x[j][3] * inv);
            w[j] = (unsigned)(q0 & 0xff) | ((unsigned)(q1 & 0xff) << 8) | ((unsigned)(q2 & 0xff) << 16) | ((unsigned)q3 << 24); }
    } else {
#pragma unroll
        for (int j = 0; j < 8; ++j) { int q = __builtin_amdgcn_cvt_pk_fp8_f32(x[j][0] * inv, x[j][1] * inv, 0, false); q = __builtin_amdgcn_cvt_pk_fp8_f32(x[j][2] * inv, x[j][3] * inv, q, true); w[j] = (unsigned)q; }
    }
    unsigned char* dst = UV8 + (size_t)le * 4096 + t * 2048 + lane * 32;
    *(v4u*)dst = (v4u){w[0], w[1], w[2], w[3]}; *(v4u*)(dst + 16) = (v4u){w[4], w[5], w[6], w[7]};
    if (lane == 0) SC[le * 2 + t] = sc;
}
__device__ __forceinline__ void fp8_rows(const Args& a, unsigned char* ws, int i0, int i1, int st, int lebase, int lane) {
    f32x4 xa[8], xb[8];
    if (i0 < i1) fp8_row_load(a, i0 >> 14, lebase + (i0 & 16383), lane, xa);
    for (int i = i0; i < i1; i += 2 * st) {
        const int i2 = i + st, i3 = i + 2 * st;
        if (i2 < i1) fp8_row_load(a, i2 >> 14, lebase + (i2 & 16383), lane, xb);
        fp8_row_finish(ws, i >> 14, lebase + (i & 16383), lane, xa);
        if (i3 < i1) fp8_row_load(a, i3 >> 14, lebase + (i3 & 16383), lane, xa);
        if (i2 < i1) fp8_row_finish(ws, i2 >> 14, lebase + (i2 & 16383), lane, xb);
    }
}
__device__ __forceinline__ void p0_prologue(const Args& a, unsigned char* ws, LAS unsigned char* lds, int G, bool defer_l1) {
    ws = fresh_ws(ws); const int tid = fresh_tid(), lane = tid & 63, wave = __builtin_amdgcn_readfirstlane(tid >> 6);
    const int bx = blockIdx.x;
    __syncthreads();
    {
        LAS float* sil = (LAS float*)(lds + RING_OFF); LAS float* red = sil + 3 * 2048;
        const float* c_ctx = a.in[8]; const float* cc = a.in[2];
        for (int i = tid; i < 3 * 2048; i += 512) { const int r = i >> 11, k = i & 2047; const float c = r == 0 ? c_ctx[k] : cc[(r - 1) * 2048 + k]; sil[i] = c / (1.0f + expf(-c)); }
        __syncthreads();
        const float* mod_w = a.in[9]; const float* mod_b = a.in[10]; float* MOD = (float*)(ws + WS_MOD);
        const int cg = tid % 24, kg = tid / 24;
        for (int task = bx; task < 256; task += G) {
            const int l = task >> 7, col0 = (task & 127) * 96;
            if (kg < 21) {
                float acc[3][4];
#pragma unroll
                for (int r = 0; r < 3; ++r)
#pragma unroll
                    for (int j = 0; j < 4; ++j) acc[r][j] = 0.f;
                const float* wp = mod_w + ((size_t)l * 2048) * 12288 + col0 + cg * 4;
#pragma unroll 4
                for (int k = kg; k < 2048; k += 21) { const f32x4 w = *(const f32x4*)(wp + (size_t)k * 12288); const float s0 = sil[k], s1 = sil[2048 + k], s2 = sil[4096 + k];
#pragma unroll
                    for (int j = 0; j < 4; ++j) { acc[0][j] += s0 * w[j]; acc[1][j] += s1 * w[j]; acc[2][j] += s2 * w[j]; } }
#pragma unroll
                for (int r = 0; r < 3; ++r)
#pragma unroll
                    for (int j = 0; j < 4; ++j) red[(kg * 24 + cg) * 12 + r * 4 + j] = acc[r][j];
            }
            __syncthreads();
            if (tid < 288) { const int r = tid / 96, c = tid % 96, g4 = c >> 2, j = c & 3; float s = 0.f;
                for (int q = 0; q < 21; ++q) s += red[(q * 24 + g4) * 12 + r * 4 + j];
                MOD[(size_t)(l * 3 + r) * 12288 + col0 + c] = s + mod_b[l * 12288 + col0 + c]; }
            __syncthreads();
        }
    }
    {
        f32x2* R64 = (f32x2*)(ws + WS_ROPE); f32x2* R128 = R64 + 64 * 16;
        const int gt = bx * 512 + tid;
        if (gt < 64 * 16) { const int pos = gt >> 4, i = gt & 15; const float inv = exp2f(-13.287712379549449f * (float)i / 16.0f); const float ang = (float)pos * inv; R64[gt] = (f32x2){cosf(ang), sinf(ang)}; }
        else if (gt < 64 * 16 + 64 * 32) { const int g2 = gt - 64 * 16, pos = g2 >> 5, i = g2 & 31; const float inv = exp2f(-13.287712379549449f * (float)i / 32.0f); const float ang = (float)pos * inv; R128[g2] = (f32x2){cosf(ang), sinf(ang)}; }
    }
    {
        LAS float* scr = (LAS float*)(lds + RING_OFF + wave * 16384);
        const int gw = bx * 8 + wave, NGW = G * 8;
        p0_transposes(a, ws, scr, lane, 0, gw, TI_LAYER, NGW);
        if (!defer_l1) p0_transposes(a, ws, scr, lane, 1, gw, TI_LAYER, NGW);
    }
    {
        const int gw = bx * 8 + wave, NGW = G * 8;
        fp8_rows(a, ws, gw, 32768, NGW, 0, lane);
        if (!defer_l1) fp8_rows(a, ws, gw, 32768, NGW, 16384, lane);
    }
}
__device__ __forceinline__ void work_deferred(const Args& a, unsigned char* ws, LAS unsigned char* lds, int slot) {
    ws = fresh_ws(ws); const int tid = fresh_tid(), lane = tid & 63, wave = __builtin_amdgcn_readfirstlane(tid >> 6);
    const int gw = ((int)blockIdx.x - 192) * 8 + wave;
    if (slot < 3) {
        const int lo_ = slot == 0 ? 0 : slot == 1 ? 9216 : 16128, hi_ = slot == 0 ? 9216 : slot == 1 ? 16128 : TI_LAYER;
        p0_transposes(a, ws, (LAS float*)(lds + RING_OFF + wave * 16384), lane, 1, lo_ + gw, hi_, 512);
    } else {
        const int lo_ = slot == 3 ? 0 : slot == 4 ? 13107 : 22938, hi_ = slot == 3 ? 13107 : slot == 4 ? 22938 : 32768;
        fp8_rows(a, ws, lo_ + gw, hi_, 512, 16384, lane);
    }
}

__device__ __forceinline__ void norm_phase(const float* xp, const float* xs, const float* gain, const float* modl, int ch_sh, int ch_sc, bf16* H, int G) {
    const int tid = fresh_tid(), lane = tid & 63, gw = blockIdx.x * 8 + __builtin_amdgcn_readfirstlane(tid >> 6), NGW = G * 8;
    for (int row = gw; row < NTOK; row += NGW) {
        const float* xr = row < NPROMPT ? xp + (size_t)row * DM : xs + (size_t)(row - NPROMPT) * DM;
        const int r = row < NPROMPT ? 0 : 1 + ((row - NPROMPT) >> 10);
        const float* sh = modl + (size_t)r * 12288 + ch_sh * DM; const float* sc = modl + (size_t)r * 12288 + ch_sc * DM;
        f32x4 v[8]; float ss = 0.f;
#pragma unroll
        for (int j = 0; j < 8; ++j) { v[j] = *(const f32x4*)(xr + j * 256 + lane * 4); ss += (v[j][0] * v[j][0] + v[j][1] * v[j][1]) + (v[j][2] * v[j][2] + v[j][3] * v[j][3]); }
        const float rstd = 1.0f / sqrtf(wave_sum(ss) * (1.0f / DM) + EPS);
#pragma unroll
        for (int j = 0; j < 8; ++j) { const int c = j * 256 + lane * 4; const f32x4 g = *(const f32x4*)(gain + c), s1 = *(const f32x4*)(sc + c), s0 = *(const f32x4*)(sh + c);
            const f32x4 o = v[j] * rstd * g * (s1 + 1.0f) + s0; v2u w; w.x = pk2(o[0], o[1]); w.y = pk2(o[2], o[3]); *(v2u*)(H + (size_t)row * DM + c) = w; }
    }
}

__device__ __forceinline__ void rope_pair(float (&v)[16], const f32x2* tab, int fi0, bool first, int xm) {
#pragma unroll
    for (int e = 0; e < 16; ++e) { const float p = __shfl_xor(v[e], xm); const f32x2 cs = tab[fi0 + e]; v[e] = first ? v[e] * cs.x - p * cs.y : v[e] * cs.x + p * cs.y; }
}
__device__ __forceinline__ void prep_phase(const Args& a, unsigned char* ws, int l, int wg0, int nwg) {
    ws = fresh_ws(ws); const int tid = fresh_tid(), lane = tid & 63, gw = ((int)blockIdx.x - wg0) * 8 + __builtin_amdgcn_readfirstlane(tid >> 6), NGW = nwg * 8;
    const bf16* Z = (const bf16*)(ws + WS_Z); bf16* QA = (bf16*)(ws + WS_QA); bf16* KA = (bf16*)(ws + WS_KA); bf16* VA = (bf16*)(ws + WS_VA);
    const f32x2* R64 = (const f32x2*)(ws + WS_ROPE); const f32x2* R128 = R64 + 64 * 16;
    const float* dqk = a.in[16] + (size_t)l * 2 * 64; const float* gqk = a.in[19] + (size_t)l * 2 * 128;
    float* out = a.out;
    for (int task = gw; task < NTOK + 512; task += NGW) {
        if (task >= NTOK) {
            const int i = task - NTOK, b = i >> 8, p = i & 255; const size_t krow = (size_t)NPROMPT + b * 1280 + 1024 + p;
            float v[16];
            ld16f(a.in[3] + ((size_t)(b * 2 + l) * 256 + p) * 1024 + lane * 16, v); st16bf(KA + krow * KVW + lane * 16, v);
            ld16f(a.in[4] + ((size_t)(b * 2 + l) * 256 + p) * 1024 + lane * 16, v); st16bf(VA + krow * KVW + lane * 16, v);
            if (lane < 16) { ld16f(a.in[5] + ((size_t)(b * 2 + l) * 256 + p) * 256 + lane * 16, v); st16bf(KA + krow * KVW + 1024 + lane * 16, v);
                             ld16f(a.in[6] + ((size_t)(b * 2 + l) * 256 + p) * 256 + lane * 16, v); st16bf(VA + krow * KVW + 1024 + lane * 16, v); }
            continue;
        }
        const int row = task; const bool latent = row >= NPROMPT;
        int b, t; size_t krow;
        if (!latent) { b = row >> 8; t = row & 255; krow = row; } else { b = (row - NPROMPT) >> 10; t = (row - NPROMPT) & 1023; krow = (size_t)NPROMPT + b * 1280 + t; }
        const int prow = t >> 6, pcol = t & 63;
        const bf16* z = Z + (size_t)row * INW;
        const size_t co = ((size_t)(b * 2 + l) * 256 + t);
        float v[16];
        {
            ld16bf(z + C_DQ + lane * 16, v); float ss = 0.f;
#pragma unroll
            for (int e = 0; e < 16; ++e) ss += v[e] * v[e];
            ss += __shfl_xor(ss, 1); ss += __shfl_xor(ss, 2);
            const float rstd = 1.0f / sqrtf(ss * (1.0f / 64.0f) + EPS); const int sub = lane & 3; const float* gn = dqk + sub * 16;
#pragma unroll
            for (int e = 0; e < 16; ++e) v[e] = v[e] * rstd * gn[e];
            if (latent) rope_pair(v, R64 + (sub < 2 ? prow : pcol) * 16, 0, (sub & 1) == 0, 1);
#pragma unroll
            for (int e = 0; e < 16; ++e) v[e] *= 0.125f;
            const int he = lane >> 2, half = he & 1; bf16* q = QA + (size_t)row * 3072 + he * 128;
            st16bf(q + half * 64 + sub * 16, v);
            *(v4u*)(q + (1 - half) * 64 + sub * 16) = (v4u){0u, 0u, 0u, 0u}; *(v4u*)(q + (1 - half) * 64 + sub * 16 + 8) = (v4u){0u, 0u, 0u, 0u};
        }
        {
            ld16bf(z + C_DK + lane * 16, v); float ss = 0.f;
#pragma unroll
            for (int e = 0; e < 16; ++e) ss += v[e] * v[e];
            ss += __shfl_xor(ss, 1); ss += __shfl_xor(ss, 2);
            const float rstd = 1.0f / sqrtf(ss * (1.0f / 64.0f) + EPS); const int sub = lane & 3; const float* gn = dqk + 64 + sub * 16;
#pragma unroll
            for (int e = 0; e < 16; ++e) v[e] = v[e] * rstd * gn[e];
            if (latent) rope_pair(v, R64 + (sub < 2 ? prow : pcol) * 16, 0, (sub & 1) == 0, 1);
            else st16f(out + OUT_DK + co * 1024 + lane * 16, v);
            st16bf(KA + krow * KVW + lane * 16, v);
        }
        {
            ld16bf(z + C_DV + lane * 16, v);
            if (!latent) st16f(out + OUT_DV + co * 1024 + lane * 16, v);
            *(v4u*)(VA + krow * KVW + lane * 16) = *(const v4u*)(z + C_DV + lane * 16); *(v4u*)(VA + krow * KVW + lane * 16 + 8) = *(const v4u*)(z + C_DV + lane * 16 + 8);
        }
        {
            ld16bf(z + C_GQ + lane * 16, v); float ss = 0.f;
#pragma unroll
            for (int e = 0; e < 16; ++e) ss += v[e] * v[e];
            ss += __shfl_xor(ss, 1); ss += __shfl_xor(ss, 2); ss += __shfl_xor(ss, 4);
            const float rstd = 1.0f / sqrtf(ss * (1.0f / 128.0f) + EPS); const int sub = lane & 7; const float* gn = gqk + sub * 16;
#pragma unroll
            for (int e = 0; e < 16; ++e) v[e] = v[e] * rstd * gn[e];
            if (latent) rope_pair(v, R128 + (sub < 4 ? prow : pcol) * 32, (sub & 1) * 16, (sub & 2) == 0, 2);
#pragma unroll
            for (int e = 0; e < 16; ++e) v[e] *= 0.08838834764831845f;
            st16bf(QA + (size_t)row * 3072 + 2048 + lane * 16, v);
        }
        {
            const int ln = lane & 15;
            ld16bf(z + C_GK + ln * 16, v); float ss = 0.f;
#pragma unroll
            for (int e = 0; e < 16; ++e) ss += v[e] * v[e];
            ss += __shfl_xor(ss, 1); ss += __shfl_xor(ss, 2); ss += __shfl_xor(ss, 4);
            const float rstd = 1.0f / sqrtf(ss * (1.0f / 128.0f) + EPS); const int sub = lane & 7; const float* gn = gqk + 128 + sub * 16;
#pragma unroll
            for (int e = 0; e < 16; ++e) v[e] = v[e] * rstd * gn[e];
            if (latent) rope_pair(v, R128 + (sub < 4 ? prow : pcol) * 32, (sub & 1) * 16, (sub & 2) == 0, 2);
            if (lane < 16) { if (!latent) st16f(out + OUT_GK + co * 256 + lane * 16, v); st16bf(KA + krow * KVW + 1024 + lane * 16, v); }
            ld16bf(z + C_GV + ln * 16, v);
            if (lane < 16) { if (!latent) st16f(out + OUT_GV + co * 256 + lane * 16, v); st16bf(VA + krow * KVW + 1024 + lane * 16, v); }
        }
    }
}

typedef short bf16x4s __attribute__((ext_vector_type(4)));
typedef short bf16x8h __attribute__((ext_vector_type(8)));
constexpr int HG_QD = 0, HG_QR = 4352, HG_KR = 8704, HG_KDT = 13056, HG_VT = 17152, HG_DEC = 21248, HG_BUF = 22016, HG_TOTS = 2 * HG_BUF;
__device__ __forceinline__ void hgrn_item(const Args& a, unsigned char* ws, LAS unsigned char* lds, int l, int item, const XcdBarrier* barp = nullptr, int split = -1) {
    ws = fresh_ws(ws); const int tid = fresh_tid(), lane = tid & 63, wave = __builtin_amdgcn_readfirstlane(tid >> 6);
    const bf16* Z = (const bf16*)(ws + WS_Z);
    int b, h, dir, T, row0; const bool latent = item < 32;
    if (latent) { b = item >> 4; h = (item >> 1) & 7; dir = item & 1; T = 1024; row0 = NPROMPT + b * 1024; }
    else { const int it = item - 32; b = it >> 4; h = (it >> 1) & 7; dir = it & 1; T = 256; row0 = b * 256; }
    const bool stager = wave < 4;
    const int cl = lane & 15, gr = lane >> 4, kc = (wave & 3) * 16 + cl;
    const int fr = lane & 15, g = lane >> 4, vb = (wave & 3) * 32;
    const size_t sidx = ((((size_t)(b * 2 + l) * 2 + dir) * 8 + h) * 128) * 128;
    LAS unsigned char* base = lds + RING_OFF;
    const long ost = dir ? -1024 : 1024, zst = dir ? -(long)INW : (long)INW;
    const int nchunk = T >> 4;
#define HG_EXP(x) __builtin_amdgcn_exp2f(1.4426950408889634f * (x))
    if (stager) {
        float lb[2] = {0.f, 0.f};
        if (l == 1) { const float* hl = a.in[14];
#pragma unroll
            for (int ch = 0; ch < 2; ++ch) { const float a0 = hl[(dir * 2 + 0) * 1024 + h * 128 + 2 * kc + ch], a1 = hl[(dir * 2 + 1) * 1024 + h * 128 + 2 * kc + ch]; lb[ch] = 1.0f / (1.0f + expf(a0 - a1)); } }
        const bf16* const zb0 = Z + (size_t)(row0 + (dir ? T - 1 : 0)) * INW + h * 128 + 2 * kc + zst * (4 * gr);
        unsigned rqA[4], rzA[4], rvA[4], rqB[4], rzB[4], rvB[4];
#define HG_LOAD(rq, rz, rv, c) do { if ((c) < nchunk) { _Pragma("unroll") for (int i = 0; i < 4; ++i) { const bf16* zr = zb0 + zst * ((c) * 16 + i); \
            rq[i] = *(const unsigned*)(zr + C_HQ); rz[i] = *(const unsigned*)(zr + C_HF + dir * 1024); rv[i] = *(const unsigned*)(zr + C_HI); } } } while (0)
#define HG_STAGE(rq, rz, rv, pbuf) do { \
            float lf[2][4], kk[2][4]; \
            _Pragma("unroll") for (int i = 0; i < 4; ++i) _Pragma("unroll") for (int ch = 0; ch < 2; ++ch) { const float zf = ch ? bfhi(rz[i]) : bflo(rz[i]); const float e = HG_EXP(-fabsf(zf)), inv = __builtin_amdgcn_rcpf(1.0f + e); \
                const float sp = zf >= 0.f ? inv : e * inv, sn = zf >= 0.f ? e * inv : inv; kk[ch][i] = (1.0f - lb[ch]) * sn; lf[ch][i] = 0.6931471805599453f * __builtin_amdgcn_logf(lb[ch] + (1.0f - lb[ch]) * sp); } \
            float cs[2][4], pre[2], bm[2], b15[2]; \
            _Pragma("unroll") for (int ch = 0; ch < 2; ++ch) { cs[ch][0] = lf[ch][0]; cs[ch][1] = cs[ch][0] + lf[ch][1]; cs[ch][2] = cs[ch][1] + lf[ch][2]; cs[ch][3] = cs[ch][2] + lf[ch][3]; \
                float P = cs[ch][3]; float t_ = __shfl_up(P, 16); if (gr >= 1) P += t_; t_ = __shfl_up(P, 32); if (gr >= 2) P += t_;        \
                pre[ch] = P - cs[ch][3]; bm[ch] = __shfl(P, 16 + cl); b15[ch] = __shfl(P, 48 + cl); } \
            LAS unsigned char* pb_ = base + (pbuf) * HG_BUF; float kd[2][4]; \
            _Pragma("unroll") for (int i = 0; i < 4; ++i) { const int s = 4 * gr + i; float qd[2], qr[2], kr[2]; \
                _Pragma("unroll") for (int ch = 0; ch < 2; ++ch) { const float q = ch ? bfhi(rq[i]) : bflo(rq[i]); const float bb = pre[ch] + cs[ch][i]; \
                    const float er = HG_EXP(fminf(fmaxf(bb - bm[ch], -80.f), 80.f)); \
                    qd[ch] = q * HG_EXP(bb); qr[ch] = q * er; kr[ch] = kk[ch][i] * __builtin_amdgcn_rcpf(er); kd[ch][i] = kk[ch][i] * HG_EXP(b15[ch] - bb); } \
                *(LAS unsigned*)(pb_ + HG_QD + s * 272 + kc * 4) = pk2(qd[0], qd[1]); \
                *(LAS unsigned*)(pb_ + HG_QR + s * 272 + kc * 4) = pk2(qr[0], qr[1]); \
                *(LAS unsigned*)(pb_ + HG_KR + s * 272 + kc * 4) = pk2(kr[0], kr[1]); } \
            *(LAS v2u*)(pb_ + HG_KDT + (2 * kc) * 32 + gr * 8) = (v2u){pk2(kd[0][0], kd[0][1]), pk2(kd[0][2], kd[0][3])}; *(LAS v2u*)(pb_ + HG_KDT + (2 * kc + 1) * 32 + gr * 8) = (v2u){pk2(kd[1][0], kd[1][1]), pk2(kd[1][2], kd[1][3])}; \
            *(LAS v2u*)(pb_ + HG_VT + (2 * kc) * 32 + gr * 8) = (v2u){(rv[0] & 0xffffu) | (rv[1] << 16), (rv[2] & 0xffffu) | (rv[3] << 16)}; \
            *(LAS v2u*)(pb_ + HG_VT + (2 * kc + 1) * 32 + gr * 8) = (v2u){(rv[0] >> 16) | (rv[1] & 0xffff0000u), (rv[2] >> 16) | (rv[3] & 0xffff0000u)}; \
            if (gr == 0) *(LAS f32x2*)(pb_ + HG_DEC + kc * 8) = (f32x2){HG_EXP(b15[0]), HG_EXP(b15[1])}; \
        } while (0)
        HG_LOAD(rqA, rzA, rvA, 0); HG_LOAD(rqB, rzB, rvB, 1);
        HG_STAGE(rqA, rzA, rvA, 0);
        HG_LOAD(rqA, rzA, rvA, 2);
        __syncthreads();
        for (int c = 0; c < nchunk; c += 2) {
            if (c == split) xcd_barrier(*barp);
            HG_STAGE(rqB, rzB, rvB, 1); HG_LOAD(rqB, rzB, rvB, c + 3);
            __syncthreads();
            if (c + 2 < nchunk) { HG_STAGE(rqA, rzA, rvA, 0); HG_LOAD(rqA, rzA, rvA, c + 4); }
            __syncthreads();
        }
#undef HG_LOAD
#undef HG_STAGE
        __syncthreads();
    } else {
        bf16* OH = (bf16*)(ws + WS_OH) + (size_t)dir * NTOK * 1024;
        bf16* const ob0 = OH + (size_t)(row0 + (dir ? T - 1 : 0)) * 1024 + h * 128 + vb + fr + ost * (4 * g);
        f32x4 S0[8], S1[8];
        if (latent) { const float* st = a.in[7] + sidx;
#pragma unroll
            for (int kt = 0; kt < 8; ++kt)
#pragma unroll
                for (int r = 0; r < 4; ++r) { S0[kt][r] = st[(size_t)(16 * kt + 4 * g + r) * 128 + vb + fr]; S1[kt][r] = st[(size_t)(16 * kt + 4 * g + r) * 128 + vb + 16 + fr]; } }
        else {
#pragma unroll
            for (int kt = 0; kt < 8; ++kt) { S0[kt] = (f32x4){0.f, 0.f, 0.f, 0.f}; S1[kt] = (f32x4){0.f, 0.f, 0.f, 0.f}; } }
#define HG_OTILE(SS, nt_, c) do { f32x4 o = {0.f, 0.f, 0.f, 0.f}; \
            _Pragma("unroll") for (int ks = 0; ks < 4; ++ks) { \
                const v4u bs4 = {pk2(SS[2 * ks][0], SS[2 * ks][1]), pk2(SS[2 * ks][2], SS[2 * ks][3]), pk2(SS[2 * ks + 1][0], SS[2 * ks + 1][1]), pk2(SS[2 * ks + 1][2], SS[2 * ks + 1][3])}; \
                o = __builtin_amdgcn_mfma_f32_16x16x32_bf16(__builtin_bit_cast(bf16x8h, qa[ks]), __builtin_bit_cast(bf16x8h, bs4), o, 0, 0, 0); } \
            const v2u bv2 = *(const LAS v2u*)(pb_ + HG_VT + (vb + 16 * (nt_) + fr) * 32 + g * 8); const v4u bv4 = {bv2.x, bv2.y, 0u, 0u}; const bf16x8h bv = __builtin_bit_cast(bf16x8h, bv4); \
            o = __builtin_amdgcn_mfma_f32_16x16x32_bf16(pa, bv, o, 0, 0, 0); \
            _Pragma("unroll") for (int r = 0; r < 4; ++r) ob0[ost * ((c) * 16 + r) + 16 * (nt_)] = (bf16)f2bf(o[r]); \
            _Pragma("unroll") for (int kt = 0; kt < 8; ++kt) SS[kt] = __builtin_amdgcn_mfma_f32_16x16x32_bf16(__builtin_bit_cast(bf16x8h, ak[kt]), bv, SS[kt] * dd[kt], 0, 0, 0); } while (0)
#define HG_MFMA(c) do { \
            const LAS unsigned char* pb_ = base + ((c) & 1) * HG_BUF; \
            f32x4 at = {0.f, 0.f, 0.f, 0.f}; \
            _Pragma("unroll") for (int ks = 0; ks < 4; ++ks) { const bf16x8h ka = *(const LAS bf16x8h*)(pb_ + HG_KR + fr * 272 + (32 * ks + 8 * g) * 2), qb = *(const LAS bf16x8h*)(pb_ + HG_QR + fr * 272 + (32 * ks + 8 * g) * 2); \
                at = __builtin_amdgcn_mfma_f32_16x16x32_bf16(ka, qb, at, 0, 0, 0); }            \
            _Pragma("unroll") for (int r = 0; r < 4; ++r) if (4 * g + r > fr) at[r] = 0.f; \
            const v4u pa4 = {pk2(at[0], at[1]), pk2(at[2], at[3]), 0u, 0u}; const bf16x8h pa = __builtin_bit_cast(bf16x8h, pa4);     \
            v4u qa[4]; v4u ak[8]; f32x4 dd[8]; \
            _Pragma("unroll") for (int ks = 0; ks < 4; ++ks) { const v2u alo = *(const LAS v2u*)(pb_ + HG_QD + fr * 272 + (32 * ks + 4 * g) * 2), ahi = *(const LAS v2u*)(pb_ + HG_QD + fr * 272 + (32 * ks + 16 + 4 * g) * 2); qa[ks] = (v4u){alo.x, alo.y, ahi.x, ahi.y}; } \
            _Pragma("unroll") for (int kt = 0; kt < 8; ++kt) { dd[kt] = *(const LAS f32x4*)(pb_ + HG_DEC + (16 * kt + 4 * g) * 4); const v2u ak2 = *(const LAS v2u*)(pb_ + HG_KDT + (16 * kt + fr) * 32 + g * 8); ak[kt] = (v4u){ak2.x, ak2.y, 0u, 0u}; } \
            HG_OTILE(S0, 0, c); HG_OTILE(S1, 1, c); \
        } while (0)
        __syncthreads();
        for (int c = 0; c < nchunk; c += 2) {
            if (c == split) xcd_barrier(*barp);
            HG_MFMA(c);
            __syncthreads();
            HG_MFMA(c + 1);
            __syncthreads();
        }
#undef HG_MFMA
#undef HG_OTILE
        if (!latent) { float* st = a.out + OUT_ST + sidx;
#pragma unroll
            for (int kt = 0; kt < 8; ++kt)
#pragma unroll
                for (int r = 0; r < 4; ++r) { st[(size_t)(16 * kt + 4 * g + r) * 128 + vb + fr] = S0[kt][r]; st[(size_t)(16 * kt + 4 * g + r) * 128 + vb + 16 + fr] = S1[kt][r]; } }
        __syncthreads();
    }
#undef HG_EXP
}

__device__ __forceinline__ void attn_unit(unsigned char* ws, char* lds_generic, int u) {
    ws = fresh_ws(ws);
    int b, he, row0, key0, seq;
    if (u < 192) { b = u / 96; const int r = u % 96; he = r >> 2; const int qb = r & 3; row0 = NPROMPT + b * 1024 + qb * 256; key0 = NPROMPT + b * 1280; seq = 1280; }
    else { const int uu = u - 192; b = uu / 24; he = uu % 24; row0 = b * 256; key0 = b * 256; seq = 256; }
    const int kvh = he < 16 ? (he >> 1) : 8 + ((he - 16) >> 2);
    const att::bf16* Q = (const att::bf16*)(ws + WS_QA) + (size_t)row0 * 3072 + he * 128;
    const att::bf16* K = (const att::bf16*)(ws + WS_KA) + (size_t)key0 * KVW + kvh * 128;
    const att::bf16* V = (const att::bf16*)(ws + WS_VA) + (size_t)key0 * KVW + kvh * 128;
    unsigned short* O = (unsigned short*)(ws + WS_OA) + (size_t)row0 * 3072 + he * 128;
    att::attn_dense_body<att::bf16>(Q, K, V, O, seq, lds_generic + RING_OFF);
    __syncthreads();
}

__device__ __forceinline__ void post_phase(const Args& a, unsigned char* ws, int l, int G) {
    ws = fresh_ws(ws); const int tid = fresh_tid(), lane = tid & 63, gw = blockIdx.x * 8 + __builtin_amdgcn_readfirstlane(tid >> 6), NGW = G * 8;
    const bf16* Z = (const bf16*)(ws + WS_Z); const bf16* OA = (const bf16*)(ws + WS_OA); const bf16* OHf = (const bf16*)(ws + WS_OH); const bf16* OHb = OHf + (size_t)NTOK * 1024;
    bf16* BR = (bf16*)(ws + WS_BR);
    const float lam_init = 0.8f - 0.6f * expf(-0.3f * (float)l);
    const float* lp = a.in[17] + (size_t)l * 4 * 64;
    const float s01 = wave_sum(lp[lane] * lp[64 + lane]), s23 = wave_sum(lp[128 + lane] * lp[192 + lane]);
    const float lam = expf(s01) - expf(s23) + lam_init;
    const float* hn = a.in[15] + (size_t)l * 128; const float* sl = a.in[18] + (size_t)l * 128;
    const int sub = lane & 7;
    for (int row = gw; row < NTOK; row += NGW) {
        float v[16], w[16];
        {
            ld16bf(OHf + (size_t)row * 1024 + lane * 16, v); ld16bf(OHb + (size_t)row * 1024 + lane * 16, w); float ss = 0.f;
#pragma unroll
            for (int e = 0; e < 16; ++e) { v[e] += w[e]; ss += v[e] * v[e]; }
            ss += __shfl_xor(ss, 1); ss += __shfl_xor(ss, 2); ss += __shfl_xor(ss, 4);
            const float rstd = 1.0f / sqrtf(ss * (1.0f / 128.0f) + EPS);
            ld16bf(Z + (size_t)row * INW + C_HG + lane * 16, w);
#pragma unroll
            for (int e = 0; e < 16; ++e) { const float g = w[e]; v[e] = v[e] * rstd * hn[sub * 16 + e] * (g / (1.0f + expf(-g))); }
            st16bf(BR + (size_t)row * 1024 + lane * 16, v);
        }
        {
            const int h = lane >> 3; const bf16* o1 = OA + (size_t)row * 3072 + (2 * h) * 128 + sub * 16;
            ld16bf(o1, v); ld16bf(o1 + 128, w); float ss = 0.f;
#pragma unroll
            for (int e = 0; e < 16; ++e) { v[e] -= lam * w[e]; ss += v[e] * v[e]; }
            ss += __shfl_xor(ss, 1); ss += __shfl_xor(ss, 2); ss += __shfl_xor(ss, 4);
            const float rstd = 1.0f / sqrtf(ss * (1.0f / 128.0f) + EPS);
#pragma unroll
            for (int e = 0; e < 16; ++e) v[e] = v[e] * rstd * sl[sub * 16 + e] * (1.0f - lam_init);
            st16bf(BR + (size_t)NTOK * 1024 + (size_t)row * 1024 + lane * 16, v);
        }
        {
            *(v4u*)(BR + (size_t)2 * NTOK * 1024 + (size_t)row * 1024 + lane * 16) = *(const v4u*)(OA + (size_t)row * 3072 + 2048 + lane * 16); *(v4u*)(BR + (size_t)2 * NTOK * 1024 + (size_t)row * 1024 + lane * 16 + 8) = *(const v4u*)(OA + (size_t)row * 3072 + 2048 + lane * 16 + 8);
        }
    }
}

typedef short bf16x8s __attribute__((ext_vector_type(8)));
typedef float f32x16 __attribute__((ext_vector_type(16)));
__device__ __forceinline__ unsigned ford(float f) { const unsigned u = __float_as_uint(f); return u ^ ((u >> 31) ? 0xffffffffu : 0x80000000u); }
__device__ __forceinline__ float funord(unsigned k) { const unsigned u = (k & 0x80000000u) ? (k ^ 0x80000000u) : ~k; return __uint_as_float(u); }
__device__ __forceinline__ void ins16(unsigned (&L)[16], unsigned x) {
#pragma unroll
    for (int i = 0; i < 16; ++i) { const unsigned hi = L[i] > x ? L[i] : x; x = L[i] > x ? x : L[i]; L[i] = hi; }
}
__device__ __forceinline__ void ce_desc(unsigned& a_, unsigned& b_) { const unsigned hi = a_ > b_ ? a_ : b_, lo = a_ > b_ ? b_ : a_; a_ = hi; b_ = lo; }
__device__ __forceinline__ void sort16_desc(unsigned (&x)[16]) {
#pragma unroll
    for (int k = 2; k <= 16; k <<= 1)
#pragma unroll
        for (int j = k >> 1; j > 0; j >>= 1)
#pragma unroll
            for (int i = 0; i < 16; ++i) { const int l = i ^ j; if (l > i) { if ((i & k) == 0) ce_desc(x[i], x[l]); else ce_desc(x[l], x[i]); } }
}
__device__ __forceinline__ void merge16_desc(unsigned (&a_)[16], const unsigned (&b_)[16]) {
#pragma unroll
    for (int i = 0; i < 16; ++i) a_[i] = a_[i] > b_[15 - i] ? a_[i] : b_[15 - i];
#pragma unroll
    for (int j = 8; j > 0; j >>= 1)
#pragma unroll
        for (int i = 0; i < 16; ++i) { const int l = i ^ j; if (l > i) ce_desc(a_[i], a_[l]); }
}
__device__ __forceinline__ void peer_top16(unsigned (&L)[16], const LAS unsigned char* keysL, const bf16* qp, int c, int qrow, int hf) {
    f32x16 acc[4];
#pragma unroll
    for (int tl = 0; tl < 4; ++tl)
#pragma unroll
        for (int r = 0; r < 16; ++r) acc[tl][r] = 0.f;
    bf16x8s bq[8];
#pragma unroll
    for (int ks = 0; ks < 8; ++ks) bq[ks] = *(const bf16x8s*)(qp + c * 128 + ks * 16 + hf * 8);
#pragma unroll
    for (int ks = 0; ks < 8; ++ks)
#pragma unroll
        for (int tl = 0; tl < 4; ++tl) { const bf16x8s ka = *(const LAS bf16x8s*)(keysL + (c * 128 + tl * 32 + qrow) * 256 + (((ks * 2 + hf) ^ (qrow & 15)) << 4));
            acc[tl] = __builtin_amdgcn_mfma_f32_32x32x16_bf16(ka, bq[ks], acc[tl], 0, 0, 0); }
    unsigned K1[16], K2[16], K3[16];
#pragma unroll
    for (int r = 0; r < 16; ++r) { const unsigned kc = 127u - (unsigned)((r & 3) + 8 * (r >> 2)) - 4u * (unsigned)hf;
        L[r] = (ford(acc[0][r]) & 0xffffff80u) | kc; K1[r] = (ford(acc[1][r]) & 0xffffff80u) | (kc - 32u); K2[r] = (ford(acc[2][r]) & 0xffffff80u) | (kc - 64u); K3[r] = (ford(acc[3][r]) & 0xffffff80u) | (kc - 96u); }
    sort16_desc(L); sort16_desc(K1); sort16_desc(K2); sort16_desc(K3);
    merge16_desc(L, K1); merge16_desc(K2, K3); merge16_desc(L, K2);
    unsigned P[16];
#pragma unroll
    for (int i = 0; i < 16; ++i) P[i] = (unsigned)__shfl_xor((int)L[i], 32);
    merge16_desc(L, P);
}
__device__ __forceinline__ float gelu_erf(float x) { return 0.5f * x * (1.0f + erff(x * 0.70710678118654752f)); }
__device__ __forceinline__ void peer_topk_phase(const Args& a, unsigned char* ws, LAS unsigned char* lds, int l, int G) {
    ws = fresh_ws(ws); const int tid = fresh_tid(), lane = tid & 63, wave = __builtin_amdgcn_readfirstlane(tid >> 6);
    LAS unsigned char* keysL = lds + RING_OFF;
    LAS unsigned char* wtab = keysL + 65536 + wave * 2048;
    const float* pk = a.in[23] + (size_t)l * 2 * 128 * 128;
    for (int i = tid; i < 2 * 128 * 16; i += 512) { const int q = i & 15, rk = i >> 4, k = rk & 127;
        const f32x4 x0 = *(const f32x4*)(pk + (size_t)rk * 128 + q * 8), x1 = *(const f32x4*)(pk + (size_t)rk * 128 + q * 8 + 4);
        v4u o; o.x = pk2(x0[0], x0[1]); o.y = pk2(x0[2], x0[3]); o.z = pk2(x1[0], x1[1]); o.w = pk2(x1[2], x1[3]);
        *(LAS v4u*)(keysL + rk * 256 + ((q ^ (k & 15)) << 4)) = o; }
    __syncthreads();
    const bf16* QPb = (const bf16*)(ws + WS_QP); unsigned* PE = (unsigned*)(ws + WS_PE); unsigned* PG = (unsigned*)(ws + WS_PG);
    const int gw = blockIdx.x * 8 + wave, NGW = G * 8;
    const int hf = lane >> 5, qrow = lane & 31, tq = qrow >> 3, hq = qrow & 7;
    for (int tile = gw; tile < NTOK / 3; tile += NGW) {
        const int tok0 = tile * 3;
        const bf16* qp = QPb + (size_t)(tok0 + (tq < 3 ? tq : 2)) * DM + hq * 256;
        unsigned L0[16], L1[16];
        peer_top16(L0, keysL, qp, 0, qrow, hf);
        peer_top16(L1, keysL, qp, 1, qrow, hf);
        unsigned tw[8];
#pragma unroll
        for (int i = 0; i < 4; ++i) { tw[i] = (127u - (L0[4 * i] & 127u)) | ((127u - (L0[4 * i + 1] & 127u)) << 8) | ((127u - (L0[4 * i + 2] & 127u)) << 16) | ((127u - (L0[4 * i + 3] & 127u)) << 24);
                                      tw[4 + i] = (127u - (L1[4 * i] & 127u)) | ((127u - (L1[4 * i + 1] & 127u)) << 8) | ((127u - (L1[4 * i + 2] & 127u)) << 16) | ((127u - (L1[4 * i + 3] & 127u)) << 24); }
        *(LAS v4u*)(wtab + lane * 32) = (v4u){tw[0], tw[1], tw[2], tw[3]}; *(LAS v4u*)(wtab + lane * 32 + 16) = (v4u){tw[4], tw[5], tw[6], tw[7]};
        float v0[16], v1[16];
#pragma unroll
        for (int i = 0; i < 16; ++i) { v0[i] = funord(L0[i] & 0xffffff80u); v1[i] = funord(L1[i] & 0xffffff80u); }
        unsigned C[16], C1[16], C2[16], C3[16];
#pragma unroll
        for (int i = 0; i < 16; ++i) { C[i] = 0u; C1[i] = 0u; C2[i] = 0u; C3[i] = 0u; }
#pragma unroll
        for (int i = 0; i < 16; ++i)
#pragma unroll
            for (int j = 0; j < 16; ++j) if ((i + 1) * (j + 1) <= 16) {
                constexpr int PRE[16] = {0, 16, 24, 29, 33, 36, 38, 40, 42, 43, 44, 45, 46, 47, 48, 49};
                const int s = PRE[i] + j; const unsigned key = (ford(v0[i] + v1[j]) & 0xffffff00u) | (255u - (unsigned)(i * 16 + j));
                if (s < 16) C[s & 15] = key; else if (s < 32) C1[s & 15] = key; else if (s < 48) C2[s & 15] = key; else C3[s & 15] = key; }
        sort16_desc(C); sort16_desc(C1); sort16_desc(C2); sort16_desc(C3);
        merge16_desc(C, C1); merge16_desc(C2, C3); merge16_desc(C, C2);
        LDS_WAIT(); asm volatile("" ::: "memory");
        float ex[16]; float sum = 0.f; const float c0 = funord(C[0] & 0xffffff00u);
#pragma unroll
        for (int r = 0; r < 16; ++r) { ex[r] = expf(funord(C[r] & 0xffffff00u) - c0); sum += ex[r]; }
        const float rs = 1.0f / sum;
        if (tq < 3) { const size_t ob = (size_t)(tok0 + tq) * 128 + hq * 16;
            if (hf == 0) { unsigned ev[16];
#pragma unroll
                for (int r = 0; r < 16; ++r) { const unsigned ci = 255u - (C[r] & 255u); const unsigned k0 = wtab[lane * 32 + (ci >> 4)], k1 = wtab[lane * 32 + 16 + (ci & 15u)]; ev[r] = k0 * 128u + k1; }
#pragma unroll
                for (int r = 0; r < 16; r += 4) *(v4u*)(PE + ob + r) = (v4u){ev[r], ev[r + 1], ev[r + 2], ev[r + 3]}; }
            else {
#pragma unroll
                for (int r = 0; r < 16; r += 4) *(v4u*)(PG + ob + r) = (v4u){__float_as_uint(ex[r] * rs), __float_as_uint(ex[r + 1] * rs), __float_as_uint(ex[r + 2] * rs), __float_as_uint(ex[r + 3] * rs)}; }
        }
        LDS_WAIT(); asm volatile("" ::: "memory");
    }
    __syncthreads();
}
#define PEER_ACC(OUT) do { _Pragma("unroll") for (int j = 0; j < 8; ++j) { const int q = (int)w[t][j >> 2][j & 3]; \
        OUT[2 * j] = __builtin_elementwise_fma(__builtin_amdgcn_cvt_pk_f32_fp8(q, false), wg2, OUT[2 * j]); OUT[2 * j + 1] = __builtin_elementwise_fma(__builtin_amdgcn_cvt_pk_f32_fp8(q, true), wg2, OUT[2 * j + 1]); } } while (0)
__device__ __forceinline__ void fma_ip(float& o, float x, float w) { asm("v_fma_f32 %0, %1, %2, %0" : "+v"(o) : "v"(x), "v"(w)); }
__device__ __forceinline__ void peer_gather_phase(const Args& a, unsigned char* ws, LAS unsigned char* lds, int l, float* xout, int G, unsigned emask = 0xffffu, int skip = 0, bool n1fuse = false) {
    ws = fresh_ws(ws); const int tid = fresh_tid(), lane = tid & 63, wave = __builtin_amdgcn_readfirstlane(tid >> 6);
    LAS unsigned char* wb = lds + RING_OFF + wave * 16384;
    LAS v2u* list = (LAS v2u*)(wb + 12288); LAS unsigned* hist = (LAS unsigned*)(wb + 15360);
    const bf16* H = (const bf16*)(ws + WS_H); const unsigned* PE = (const unsigned*)(ws + WS_PE); const unsigned* PG = (const unsigned*)(ws + WS_PG);
    const unsigned char* UV8 = ws + WS_UV8 + (size_t)l * 16384 * 4096; const float* SC = (const float*)(ws + WS_SC) + (size_t)l * 16384 * 2;
    const float* XM = (const float*)(ws + WS_XM); const float* MOD = (const float*)(ws + WS_MOD) + (size_t)l * 3 * 12288;
    const int gw = blockIdx.x * 8 + wave, NGW = G * 8;
    for (int tile = gw; tile < NTOK / 3; tile += NGW) {
        const int tok0 = tile * 3;
        {
            unsigned e[6], gb[6], pos[6];
            hist[lane] = 0u; hist[64 + lane] = 0u; hist[128 + lane] = 0u;
#pragma unroll
            for (int m = 0; m < 6; ++m) { const size_t ix = (size_t)(tok0 + (m >> 1)) * 128 + ((lane + 64 * m) & 127); e[m] = PE[ix] & emask; gb[m] = PG[ix]; }
            LDS_WAIT(); asm volatile("" ::: "memory");
#pragma unroll
            for (int m = 0; m < 6; ++m) pos[m] = __hip_atomic_fetch_add(hist + (m >> 1) * 64 + (e[m] >> 8), 1u, __ATOMIC_RELAXED, __HIP_MEMORY_SCOPE_WORKGROUP);
            LDS_WAIT(); asm volatile("" ::: "memory");
            const unsigned cnt0 = hist[lane], cnt1 = hist[64 + lane], cnt2 = hist[128 + lane]; unsigned inc0 = cnt0, inc1 = cnt1, inc2 = cnt2;
#pragma unroll
            for (int o = 1; o < 64; o <<= 1) { const unsigned t0 = (unsigned)__shfl_up((int)inc0, o), t1 = (unsigned)__shfl_up((int)inc1, o), t2 = (unsigned)__shfl_up((int)inc2, o); if (lane >= o) { inc0 += t0; inc1 += t1; inc2 += t2; } }
            LDS_WAIT(); asm volatile("" ::: "memory");
            hist[lane] = inc0 - cnt0; hist[64 + lane] = 128u + inc1 - cnt1; hist[128 + lane] = 256u + inc2 - cnt2;
            LDS_WAIT(); asm volatile("" ::: "memory");
#pragma unroll
            for (int m = 0; m < 6; ++m) { const unsigned p_ = hist[(m >> 1) * 64 + (e[m] >> 8)] + pos[m]; list[p_] = (v2u){e[m], gb[m]}; }
            LDS_WAIT(); asm volatile("" ::: "memory");
        }
        if (!(skip & 1)) {
            unsigned hq[3][8]; float hs[3];
#pragma unroll
            for (int t = 0; t < 3; ++t) { float hv[8][4]; float mx = 0.f;
#pragma unroll
                for (int j = 0; j < 8; ++j) { const v2u a0 = *(const v2u*)(H + (size_t)(tok0 + t) * DM + j * 256 + lane * 4); hv[j][0] = bflo(a0.x); hv[j][1] = bfhi(a0.x); hv[j][2] = bflo(a0.y); hv[j][3] = bfhi(a0.y);
                    mx = fmaxf(fmaxf(mx, fmaxf(fabsf(hv[j][0]), fabsf(hv[j][1]))), fmaxf(fabsf(hv[j][2]), fabsf(hv[j][3]))); }
#pragma unroll
                for (int o = 1; o < 64; o <<= 1) mx = fmaxf(mx, __shfl_xor(mx, o));
                const float inv = mx > 0.f ? 127.0f / mx : 0.f; hs[t] = mx * (1.0f / 127.0f);
#pragma unroll
                for (int j = 0; j < 8; ++j) { const int q0 = (int)rintf(hv[j][0] * inv), q1 = (int)rintf(hv[j][1] * inv), q2 = (int)rintf(hv[j][2] * inv), q3 = (int)rintf(hv[j][3] * inv);
                    hq[t][j] = (unsigned)(q0 & 0xff) | ((unsigned)(q1 & 0xff) << 8) | ((unsigned)(q2 & 0xff) << 16) | ((unsigned)q3 << 24); } }
#define PU_LOAD(W, SCL, G_, kb_) do { _Pragma("unroll") for (int t = 0; t < 3; ++t) { const v2u r = list[t * 128 + (kb_)]; const int ee = __builtin_amdgcn_readfirstlane((int)r.x); G_[t] = __uint_as_float((unsigned)__builtin_amdgcn_readfirstlane((int)r.y)); \
            const unsigned char* base = UV8 + (size_t)ee * 4096 + lane * 32; W[t][0] = *(const v4u*)base; W[t][1] = *(const v4u*)(base + 16); SCL[t] = *(const f32x2*)(SC + (size_t)ee * 2); } } while (0)
#define PU_DOT(HV, Wt) ({ int s_ = 0; _Pragma("unroll") for (int j = 0; j < 8; ++j) s_ = __builtin_amdgcn_sdot4((int)Wt[j >> 2][j & 3], (int)HV[j], s_, false); s_; })
#define PU_RED(x_) do { x_ += __builtin_amdgcn_update_dpp(0, x_, 0xB1, 0xF, 0xF, false); x_ += __builtin_amdgcn_update_dpp(0, x_, 0x4E, 0xF, 0xF, false); \
            x_ += __builtin_amdgcn_update_dpp(0, x_, 0x141, 0xF, 0xF, false); x_ += __builtin_amdgcn_update_dpp(0, x_, 0x140, 0xF, 0xF, false); \
            x_ += __builtin_amdgcn_update_dpp(0, x_, 0x142, 0xA, 0xF, false); x_ += __builtin_amdgcn_update_dpp(0, x_, 0x143, 0xC, 0xF, false); } while (0)
#define PU_COMP(W, kb_) do { int d0 = PU_DOT(hq[0], W[0]), d1 = PU_DOT(hq[1], W[1]), d2 = PU_DOT(hq[2], W[2]); PU_RED(d0); PU_RED(d1); PU_RED(d2); \
            if (lane == 63) { dl[(kb_)] = d0; dl[128 + (kb_)] = d1; dl[256 + (kb_)] = d2; } } while (0)
            LAS int* dl = (LAS int*)wb;
            v4u wA[3][2], wB[3][2];
#define PU_LOAD2(W, kb_) do { _Pragma("unroll") for (int t = 0; t < 3; ++t) { const int ee = __builtin_amdgcn_readfirstlane((int)list[t * 128 + (kb_)].x); \
            const unsigned char* base = UV8 + (size_t)ee * 4096 + lane * 32; W[t][0] = *(const v4u*)base; W[t][1] = *(const v4u*)(base + 16); } } while (0)
            PU_LOAD2(wA, 0);
#pragma unroll 1
            for (int kb = 0; kb < 128; kb += 2) {
                PU_LOAD2(wB, kb + 1); PU_COMP(wA, kb);
                if (kb + 2 < 128) PU_LOAD2(wA, kb + 2);
                PU_COMP(wB, kb + 1);
            }
            LDS_WAIT(); asm volatile("" ::: "memory");
#pragma unroll
            for (int m = 0; m < 6; ++m) { const int li = lane + 64 * m; const v2u ent = list[li]; const f32x2 sc2 = *(const f32x2*)(SC + (size_t)ent.x * 2);
                ((LAS float*)list)[2 * li + 1] = __uint_as_float(ent.y) * gelu_erf((float)dl[li] * (sc2.x * hs[m >> 1])) * sc2.y; }
#undef PU_LOAD2
#undef PU_RED
#undef PU_LOAD
#undef PU_DOT
#undef PU_COMP
        }
        LDS_WAIT(); asm volatile("" ::: "memory");
        f32x2 out0[16], out1[16], out2[16];
#pragma unroll
        for (int i = 0; i < 16; ++i) { out0[i] = (f32x2){0.f, 0.f}; out1[i] = (f32x2){0.f, 0.f}; out2[i] = (f32x2){0.f, 0.f}; }
#define PV_LOAD(W, G_, kb_) do { _Pragma("unroll") for (int t = 0; t < 3; ++t) { const v2u r = list[t * 128 + (kb_)]; const int ee = __builtin_amdgcn_readfirstlane((int)r.x); G_[t] = __uint_as_float((unsigned)__builtin_amdgcn_readfirstlane((int)r.y)); \
            const unsigned char* base = UV8 + (size_t)ee * 4096 + 2048 + lane * 32; W[t][0] = *(const v4u*)base; W[t][1] = *(const v4u*)(base + 16); } } while (0)
#define PV_FMA(O, X, Wg) do { O.x = __builtin_fmaf(X.x, Wg, O.x); O.y = __builtin_fmaf(X.y, Wg, O.y); } while (0)
#define PV_COMP(W, G_) do { _Pragma("unroll") for (int t = 0; t < 3; ++t) { const float wg = G_[t]; \
            _Pragma("unroll") for (int j = 0; j < 8; ++j) { const int q = (int)W[t][j >> 2][j & 3]; const f32x2 lo = __builtin_amdgcn_cvt_pk_f32_fp8(q, false), hi = __builtin_amdgcn_cvt_pk_f32_fp8(q, true); \
                if (t == 0) { PV_FMA(out0[2 * j], lo, wg); PV_FMA(out0[2 * j + 1], hi, wg); } \
                else if (t == 1) { PV_FMA(out1[2 * j], lo, wg); PV_FMA(out1[2 * j + 1], hi, wg); } \
                else { PV_FMA(out2[2 * j], lo, wg); PV_FMA(out2[2 * j + 1], hi, wg); } } } } while (0)
        if (!(skip & 2)) {
            v4u wA[3][2], wB[3][2]; float gA[3], gB[3];
            PV_LOAD(wA, gA, 0);
#pragma unroll 1
            for (int kb = 0; kb < 128; kb += 2) {
                PV_LOAD(wB, gB, kb + 1); PV_COMP(wA, gA);
                if (kb + 2 < 128) PV_LOAD(wA, gA, kb + 2);
                PV_COMP(wB, gB);
            }
        }
#undef PV_LOAD
#undef PV_COMP
#pragma unroll
        for (int tt = 0; tt < 3; ++tt) {
            const int row = tok0 + tt; const int r = row < NPROMPT ? 0 : 1 + ((row - NPROMPT) >> 10);
            const float* g2 = MOD + (size_t)r * 12288 + 5 * DM;
            float ss = 0.f;
#pragma unroll
            for (int j = 0; j < 8; ++j) { const int c = j * 256 + lane * 4; const size_t off = (size_t)row * DM + c;
                const f32x4 x0 = *(const f32x4*)(XM + off), ga = *(const f32x4*)(g2 + c);
                const f32x2 oa = tt == 0 ? out0[2 * j] : (tt == 1 ? out1[2 * j] : out2[2 * j]), ob = tt == 0 ? out0[2 * j + 1] : (tt == 1 ? out1[2 * j + 1] : out2[2 * j + 1]);
                const f32x4 xo = x0 + ga * (f32x4){oa.x, oa.y, ob.x, ob.y}; *(f32x4*)(xout + off) = xo;
                ss += (xo[0] * xo[0] + xo[1] * xo[1]) + (xo[2] * xo[2] + xo[3] * xo[3]); }
            if (n1fuse) { const float* n1gain = a.in[11] + DM; const float* n1mod = (const float*)(ws + WS_MOD) + (size_t)3 * 12288;
                const float rstd = 1.0f / sqrtf(wave_sum(ss) * (1.0f / DM) + EPS); const float* sh = n1mod + (size_t)r * 12288; const float* sc = sh + DM; bf16* Hw = (bf16*)(ws + WS_H);
#pragma unroll
                for (int j = 0; j < 8; ++j) { const int c = j * 256 + lane * 4; const size_t off = (size_t)row * DM + c;
                    const f32x4 x0 = *(const f32x4*)(XM + off), ga = *(const f32x4*)(g2 + c);
                    const f32x2 oa = tt == 0 ? out0[2 * j] : (tt == 1 ? out1[2 * j] : out2[2 * j]), ob = tt == 0 ? out0[2 * j + 1] : (tt == 1 ? out1[2 * j + 1] : out2[2 * j + 1]);
                    const f32x4 xo = x0 + ga * (f32x4){oa.x, oa.y, ob.x, ob.y};
                    const f32x4 gn = *(const f32x4*)(n1gain + c), s1 = *(const f32x4*)(sc + c), s0 = *(const f32x4*)(sh + c);
                    const f32x4 o = xo * rstd * gn * (s1 + 1.0f) + s0; *(v2u*)(Hw + (size_t)row * DM + c) = (v2u){pk2(o[0], o[1]), pk2(o[2], o[3])}; }
            }
        }
        asm volatile("" ::: "memory");
    }
    __syncthreads();
}
#undef PEER_ACC

__device__ __forceinline__ unsigned dg_hash(unsigned x) { x ^= x >> 16; x *= 0x7feb352du; x ^= x >> 15; x *= 0x846ca68bu; x ^= x >> 16; return x; }
__device__ __forceinline__ void dummy_gather(unsigned char* ws, int mode, int G) {
    ws = fresh_ws(ws); const int tid = fresh_tid(), lane = tid & 63, wave = __builtin_amdgcn_readfirstlane(tid >> 6);
    const unsigned char* UV8 = ws + WS_UV8; const int gw = blockIdx.x * 8 + wave;
    f32x2 hv[16], out[16];
#pragma unroll
    for (int i = 0; i < 16; ++i) { hv[i] = (f32x2){(float)(lane + i) * 0.001f, (float)(lane - i) * 0.002f}; out[i] = (f32x2){0.f, 0.f}; }
    for (int jb = 0; jb < 384; jb += 4) {
        int e[4];
#pragma unroll
        for (int t = 0; t < 4; ++t) { const unsigned hsh = dg_hash((unsigned)(gw * 384 + jb + t) * 2654435761u + 12345u); e[t] = mode == 0 ? (int)(hsh & 16383u) : (int)((((unsigned)(jb + t) / 12u) << 9) | (hsh & 511u)); }
        v4u w[4][4];
#pragma unroll
        for (int t = 0; t < 4; ++t) { const unsigned char* base = UV8 + (size_t)e[t] * 4096 + lane * 32;
            w[t][0] = *(const v4u*)base; w[t][1] = *(const v4u*)(base + 16); w[t][2] = *(const v4u*)(base + 2048); w[t][3] = *(const v4u*)(base + 2048 + 16); }
        float d[4];
#pragma unroll
        for (int t = 0; t < 4; ++t) { f32x2 s = {0.f, 0.f};
#pragma unroll
            for (int j = 0; j < 8; ++j) { const int q = (int)w[t][j >> 2][j & 3];
                s = __builtin_elementwise_fma(__builtin_amdgcn_cvt_pk_f32_fp8(q, false), hv[2 * j], s); s = __builtin_elementwise_fma(__builtin_amdgcn_cvt_pk_f32_fp8(q, true), hv[2 * j + 1], s); }
            d[t] = s.x + s.y; }
#pragma unroll
        for (int o = 1; o < 64; o <<= 1) {
#pragma unroll
            for (int t = 0; t < 4; ++t) d[t] += __shfl_xor(d[t], o); }
#pragma unroll
        for (int t = 0; t < 4; ++t) { const float wg = d[t] * 1e-3f; const f32x2 wg2 = {wg, wg};
#pragma unroll
            for (int j = 0; j < 8; ++j) { const int q = (int)w[t][2 + (j >> 2)][j & 3];
                out[2 * j] = __builtin_elementwise_fma(__builtin_amdgcn_cvt_pk_f32_fp8(q, false), wg2, out[2 * j]); out[2 * j + 1] = __builtin_elementwise_fma(__builtin_amdgcn_cvt_pk_f32_fp8(q, true), wg2, out[2 * j + 1]); } }
    }
    float* scratch = (float*)(ws + WS_PE);
    float acc = 0.f;
#pragma unroll
    for (int i = 0; i < 16; ++i) acc += out[i].x + out[i].y;
    scratch[(size_t)gw * 64 + lane] = acc;
}
#ifdef PROBE_G1NS
struct ProbeOrder : pg8::StaticOrder {
    __device__ bool next(int i, pg8::Unit& u) const { const bool r = pg8::StaticOrder::next(i, u); if (PROBE_G1NS & 2) u.pn &= 1; if (PROBE_G1NS & 4) u.pm &= 1; return r; }
};
#endif
__global__ void __launch_bounds__(512, 2) mk_fwd(Args args) {
    extern __shared__ __attribute__((aligned(16))) unsigned char lds_raw[];
    LAS unsigned char* lds = (LAS unsigned char*)lds_raw;
    const int G = gridDim.x;
    unsigned char* ws = args.ws;
    unsigned* ctl = (unsigned*)(ws + WS_CTL);
    for (int u = threadIdx.x; u < RING_OFF / 4; u += 512) ((LAS unsigned*)lds)[u] = 0u;
    __syncthreads();
    const int lo = args.ph_lo, hi = args.ph_hi;
    XcdBarrier bar; bar.bar = ctl + CW_BAR; bar.x = 0; bar.st = (volatile LAS unsigned*)(lds + 32);
    if (hi - lo > 1) bar = xcd_barrier_post(ctl + CW_BAR, (volatile LAS unsigned*)(lds + 32));
#ifndef PH_EN
#define PH_EN 0xfff
#endif
#define PHEN(k) (((PH_EN) >> (k)) & 1)
#ifndef PROBE_DUP
#define PROBE_DUP 0
#endif
#define NREP(k) ((((PROBE_DUP) >> (k)) & 1) ? 2 : 1)
#define IN(k) (lo <= (k) && (k) < hi)
#define SEAM(k) do { if (IN(k) && IN((k) + 1)) xcd_barrier(bar); } while (0)

#ifndef PROBE_XBAR
#define PROBE_XBAR 0
#endif
    if (PHEN(0) && IN(0)) { for (int rep = 0; rep < NREP(0); ++rep) p0_prologue(args, ws, lds, G, lo == 0 && hi == NPH && G == 256); }
    SEAM(0);

    for (int l = 0; l < 2; ++l) {
        ws = fresh_ws(ws);
        const int pb = 1 + 11 * l;
#define MODall ((const float*)(ws + WS_MOD))
#define Hb ((bf16*)(ws + WS_H))
#define Zb ((bf16*)(ws + WS_Z))
        const float* xin_p = l == 0 ? args.in[0] : (const float*)(ws + WS_X1);
        const float* xin_s = l == 0 ? args.in[1] : (const float*)(ws + WS_X1) + (size_t)NPROMPT * DM;
        const float* modl = MODall + (size_t)l * 3 * 12288;
        for (int xb = 0; xb < PROBE_XBAR; ++xb) xcd_barrier(bar);
        const bool n1fused = lo == 0 && hi == NPH;
        const bool defer = lo == 0 && hi == NPH && G == 256 && (int)blockIdx.x >= 192;
        if (!(l == 1 && n1fused)) {
            if (PHEN(1) && IN(pb + 0)) for (int rep = 0; rep < NREP(1); ++rep) norm_phase(xin_p, xin_s, args.in[11] + (size_t)l * DM, modl, 0, 1, Hb, G);
            SEAM(pb + 0);
        }
#ifdef PROBE_G1NS
        { ws = fresh_ws(ws);
            pg8::Gemm g{Hb, (const bf16*)(ws + WS_WIN) + (size_t)l * INW * DM, NTOK, INW, DM}; ProbeOrder S; S.init(NTOK, INW, G, (int)blockIdx.x);
            pg8::EpiNull E{(float*)(ws + WS_QA)};
            pg8::gemm_phase<pg8::EpiNull, ProbeOrder, true, true>(lds + RING_OFF, g, S, E);
            xcd_barrier(bar);
        }
#endif
        if (PHEN(2) && IN(pb + 1)) for (int rep = 0; rep < NREP(2); ++rep) { ws = fresh_ws(ws);
            pg8::Gemm g{Hb, (const bf16*)(ws + WS_WIN) + (size_t)l * INW * DM, NTOK, INW, DM}; pg8::StaticOrder S; S.init(NTOK, INW, G, (int)blockIdx.x);
            pg8::EpiBf16<0> E{Zb, INW, nullptr, 0, 0, 1.f};
            pg8::gemm_phase<pg8::EpiBf16<0>, pg8::StaticOrder, true, true>(lds + RING_OFF, g, S, E);
        }
        SEAM(pb + 1);
        const bool early = IN(pb + 2) && IN(pb + 3) && G > 64;
        if (early && (int)blockIdx.x < 32) { hgrn_item(args, ws, lds, l, (int)blockIdx.x, &bar, 16); }
        else {
            if (PHEN(3) && IN(pb + 2)) for (int rep = 0; rep < NREP(3); ++rep) prep_phase(args, ws, l, early ? 32 : 0, early ? G - 32 : G);
            SEAM(pb + 2);
            if (PHEN(4) && IN(pb + 3)) for (int rep = 0; rep < NREP(4); ++rep) {
                const int bx = blockIdx.x;
                if (G > 64 && bx < 32) { for (int rp = 0; rp < NREP(12); ++rp) hgrn_item(args, ws, lds, l, bx); }
                else {
                    const int u0 = G > 64 ? bx - 32 : bx, us = G > 64 ? G - 32 : G;
                    if (G <= 64) for (int u = bx; u < 32; u += G) hgrn_item(args, ws, lds, l, u);
                    for (int rp = 0; rp < NREP(12); ++rp)
                    for (int u = u0; u < 832; u += us) if (u >= 192 && u < 448) hgrn_item(args, ws, lds, l, 32 + (u - 192));
                    for (int rp = 0; rp < NREP(13); ++rp)
                    for (int u = u0; u < 832; u += us) if (u < 192 || u >= 448) attn_unit(ws, (char*)lds_raw, u < 192 ? u : 192 + (u - 448));
                }
            }
        }
        SEAM(pb + 3);
        if (PHEN(5) && IN(pb + 4)) for (int rep = 0; rep < NREP(5); ++rep) post_phase(args, ws, l, G);
        SEAM(pb + 4);
        if (PHEN(6) && IN(pb + 5)) for (int rep = 0; rep < NREP(6); ++rep) { ws = fresh_ws(ws);
            pg8::StaticOrder S; S.init(NTOK, DM, G, (int)blockIdx.x);
            for (int c = 0; c < 3; ++c) {
                pg8::Gemm g{(const bf16*)(ws + WS_BR) + (size_t)c * NTOK * 1024, (const bf16*)(ws + WS_WBR) + (size_t)(l * 3 + c) * DM * 1024, NTOK, DM, 1024};
                pg8::EpiGate E{Zb, INW, C_GATE + c * DM, (bf16*)(ws + WS_MGP), (bf16*)(ws + WS_MG), DM, c};
                pg8::gemm_phase<pg8::EpiGate, pg8::StaticOrder, true, true>(lds + RING_OFF, g, S, E);
            }
            if (defer) work_deferred(args, ws, lds, 3 * l + 0);
        }
        SEAM(pb + 5);
        if (PHEN(7) && IN(pb + 6)) for (int rep = 0; rep < NREP(7); ++rep) { ws = fresh_ws(ws);
            pg8::Gemm g{(const bf16*)(ws + WS_MG), (const bf16*)(ws + WS_WOUT) + (size_t)l * DM * DM, NTOK, DM, DM}; pg8::StaticOrder S; S.init(NTOK, DM, G, (int)blockIdx.x);
            pg8::EpiResid E{xin_p, xin_s, modl + 2 * DM, (float*)(ws + WS_XM)};
            pg8::gemm_phase<pg8::EpiResid, pg8::StaticOrder, true, true>(lds + RING_OFF, g, S, E);
            if (defer) work_deferred(args, ws, lds, 3 * l + 1);
        }
        SEAM(pb + 6);
        if (PHEN(8) && IN(pb + 7)) for (int rep = 0; rep < NREP(8); ++rep) norm_phase((const float*)(ws + WS_XM), (const float*)(ws + WS_XM) + (size_t)NPROMPT * DM, args.in[12] + (size_t)l * DM, modl, 3, 4, Hb, G);
        SEAM(pb + 7);
        if (PHEN(9) && IN(pb + 8)) for (int rep = 0; rep < NREP(9); ++rep) { ws = fresh_ws(ws);
            pg8::Gemm g{Hb, (const bf16*)(ws + WS_WPQ) + (size_t)l * DM * DM, NTOK, DM, DM}; pg8::StaticOrder S; S.init(NTOK, DM, G, (int)blockIdx.x);
            pg8::EpiBf16<0> E{(bf16*)(ws + WS_QP), DM, nullptr, 0, 0, 1.f};
            pg8::gemm_phase<pg8::EpiBf16<0>, pg8::StaticOrder, true, true>(lds + RING_OFF, g, S, E);
            if (defer) work_deferred(args, ws, lds, 3 * l + 2);
        }
        SEAM(pb + 8);
#ifdef PROBE_DG
        dummy_gather(ws, PROBE_DG, G);
#endif
        if (PHEN(10) && IN(pb + 9)) for (int rep = 0; rep < NREP(10); ++rep) peer_topk_phase(args, ws, lds, l, G);
        SEAM(pb + 9);
        if (PHEN(11) && IN(pb + 10)) for (int rep = 0; rep < NREP(11); ++rep) peer_gather_phase(args, ws, lds, l, l == 0 ? (float*)(ws + WS_X1) : args.out, G, 0xffffu, 0, l == 0 && n1fused);
#ifdef PROBE_GS
        peer_gather_phase(args, ws, lds, l, (float*)(ws + WS_QA), G, 0xffffu, PROBE_GS);
#endif
#ifdef PROBE_GM
        peer_gather_phase(args, ws, lds, l, (float*)(ws + WS_QA), G, PROBE_GM, PROBE_GSK);
#endif
        if (l == 0) SEAM(pb + 10);
    }
#undef MODall
#undef Hb
#undef Zb
#undef IN
#undef SEAM
}

extern "C" void kernel_launch(void* const* d_in, const int* in_sizes, int n_in, void* d_out, int out_size, void* d_ws, size_t ws_size, hipStream_t stream) {
    static int grid = 0;
    if (grid == 0) {
        if (n_in != 26 || (size_t)out_size != OUT_TOTAL || ws_size < WS_END) { fprintf(stderr, "kernel_launch: shape mismatch: n_in %d out %d ws %zu (need %zu)\n", n_in, out_size, ws_size, (size_t)WS_END); grid = -1; return; }
        int dev = 0, cus = 0, per_cu = 0;
        if (hipGetDevice(&dev) != hipSuccess || hipDeviceGetAttribute(&cus, hipDeviceAttributeMultiprocessorCount, dev) != hipSuccess) { grid = -1; return; }
        if (hipFuncSetAttribute((const void*)mk_fwd, hipFuncAttributeMaxDynamicSharedMemorySize, LDS_BYTES) != hipSuccess) { fprintf(stderr, "kernel_launch: hipFuncSetAttribute failed\n"); grid = -1; return; }
        if (hipOccupancyMaxActiveBlocksPerMultiprocessor(&per_cu, (const void*)mk_fwd, 512, LDS_BYTES) != hipSuccess || per_cu < 1) { fprintf(stderr, "kernel_launch: occupancy query says %d\n", per_cu); per_cu = 1; }
        (void)hipGetLastError();
        grid = cus;
    }
    if (grid < 0) return;
    (void)hipMemsetAsync((char*)d_ws + WS_CTL, 0, CTL_ZERO_BYTES, stream);
    Args a{};
    for (int i = 0; i < 26; ++i) a.in[i] = (const float*)d_in[i];
    a.out = (float*)d_out; a.ws = (unsigned char*)d_ws;
#if N_LAUNCH_MODE == 0
    a.ph_lo = 0; a.ph_hi = NPH;
    hipLaunchKernelGGL(mk_fwd, dim3(grid), dim3(512), LDS_BYTES, stream, a);
#else
    for (int p = 0; p < NPH; ++p) { a.ph_lo = p; a.ph_hi = p + 1; hipLaunchKernelGGL(mk_fwd, dim3(grid), dim3(512), LDS_BYTES, stream, a); }
#endif
    const hipError_t le = hipPeekAtLastError();
    if (le != hipSuccess) fprintf(stderr, "kernel_launch: launch failed: %s\n", hipGetErrorName(le));
}
```

```cpp
#include <hip/hip_runtime.h>
#include <hip/hip_bf16.h>
#include <cstdio>
#include <cstdint>
#include <cmath>
#define PROBE_DUP 0
#define HG_PROBE 0
#define PROBE_XBAR 0

#ifndef N_LAUNCH_MODE
#define N_LAUNCH_MODE 0
#endif
__device__ __forceinline__ int fresh_tid() { int t = (int)threadIdx.x; asm volatile("" : "+v"(t)); return t; }
__device__ __forceinline__ unsigned char* fresh_ws(unsigned char* p) { __attribute__((address_space(1))) unsigned char* g = (__attribute__((address_space(1))) unsigned char*)p; asm volatile("" : "+s"(g)); return (unsigned char*)g; }
namespace pg8 {
#define PG8_LAS __attribute__((address_space(3)))
typedef unsigned short bf16_t;
typedef short bf16x8 __attribute__((ext_vector_type(8)));
typedef float f32x4 __attribute__((ext_vector_type(4)));
typedef unsigned u32x4 __attribute__((ext_vector_type(4)));
constexpr int BM = 256, BK = 64, HALF = 128, HTB = HALF * BK * 2  , STAGE_BYTES = 8 * HTB, NXCD = 8, WGM = 8;

__host__ __device__ __forceinline__ int lds_byte(int r, int c) { const int st = (r >> 4) * 2 + (c >> 5), rr = r & 15, cc = c & 31, ob = rr * 64 + cc * 2; return st * 1024 + (ob ^ (((ob >> 9) & 1) << 5)); }
__host__ __device__ __forceinline__ void stage_rc(int b, int& R, int& C) { const int st = b / 1024, sb = b % 1024, swz = sb ^ (((sb >> 9) & 1) << 5); R = (st >> 1) * 16 + swz / 64; C = (st & 1) * 32 + (swz % 64) / 2; }
__host__ __device__ __forceinline__ int perm32(int rho) { const int n = rho >> 4, i = rho & 15; return 8 * (i >> 2) + 4 * n + (i & 3); }

struct Unit { int pm, pn; };
struct Gemm { const bf16_t* A; const bf16_t* Bt; int M, N, K; };

struct StaticOrder {
    int nM, nN, nwg, G, c;
    __host__ __device__ void init(int M, int N, int G_, int c_) { nM = M / BM; nN = N / BM; nwg = nM * nN; G = G_; c = c_; }
    __host__ __device__ bool next(int i, Unit& u) const {
        const long L = (long)i * G + c; if (L >= nwg) return false;
        int wgid = (int)L; { const int q = nwg / NXCD, r = nwg % NXCD, xcd = wgid % NXCD, off = wgid / NXCD; wgid = (xcd < r ? xcd * (q + 1) : r * (q + 1) + (xcd - r) * q) + off; }
        const int nig = WGM * nN, gid = wgid / nig, fm = gid * WGM, gsz = (nM - fm) < WGM ? (nM - fm) : WGM;
        u.pm = fm + ((wgid % nig) % gsz); u.pn = (wgid % nig) / gsz; return true;
    }
    __device__ __forceinline__ void a_ready(const Unit&) const {}
    __device__ __forceinline__ void done(const Unit&) const {}
};

__device__ __forceinline__ unsigned cvt_pk_bf16(float lo, float hi) { unsigned r; asm volatile("v_cvt_pk_bf16_f32 %0, %1, %2" : "=v"(r) : "v"(lo), "v"(hi)); return r; }
typedef float f32x2 __attribute__((ext_vector_type(2)));
__device__ __forceinline__ f32x2 gelu_pk(f32x2 v) {
    const f32x2 av = __builtin_elementwise_abs(v), d = av * 0.2316418882f + 1.0f;
    f32x2 t; t.x = __builtin_amdgcn_rcpf(d.x); t.y = __builtin_amdgcn_rcpf(d.y);
    f32x2 q = t * 0.5307027145f + (-0.7265760135f); q = q * t + 0.7107068705f; q = q * t + (-0.142248368f); q = q * t + 0.127414796f; q = q * t;
    const f32x2 s = (v * v) * (-0.72134752044f);
    f32x2 e; e.x = __builtin_amdgcn_exp2f(s.x); e.y = __builtin_amdgcn_exp2f(s.y);
    const f32x2 m = v * (q * e), r = v - m;
    f32x2 o; o.x = v.x < 0.f ? m.x : r.x; o.y = v.y < 0.f ? m.y : r.y; return o;
}

template <int ACT  > struct EpiBf16 {
    static constexpr bool PERM = true, AFTER_DRAIN = false; static_assert(ACT == 0 || ACT == 1, "EpiBf16: ACT is 0 (none) or 1 (gelu_pk)");
    bf16_t* O; int ldc; const float* bias; int split_cols; size_t split_stride; float scale0;
    __device__ __forceinline__ void operator()(const f32x4 (&acc)[2][2][4][2], const Unit& u, int wr, int wc, int fr, int fq) const {
        const int row0 = u.pm * BM + wr * 64 + fr; int colt = u.pn * BM; bf16_t* base = O;
        float sc = 1.f; if (split_cols) { const int t = colt / split_cols; base += (size_t)t * split_stride; colt -= t * split_cols; if (t == 0) sc = scale0; }
        const int col0 = colt + wc * 32 + 8 * fq, bcol0 = u.pn * BM + wc * 32 + 8 * fq;
        f32x4 bv[2][2];
#pragma unroll
        for (int bj = 0; bj < 2; ++bj)
#pragma unroll
            for (int n = 0; n < 2; ++n) bv[bj][n] = bias ? *(const f32x4*)(bias + bcol0 + bj * HALF + 4 * n) : (f32x4){0.f, 0.f, 0.f, 0.f};
#pragma unroll
        for (int ai = 0; ai < 2; ++ai)
#pragma unroll
            for (int m = 0; m < 4; ++m) { bf16_t* rowp = base + (size_t)(row0 + ai * HALF + m * 16) * ldc + col0;
#pragma unroll
                for (int bj = 0; bj < 2; ++bj) { f32x4 v0 = acc[ai][bj][m][0] + bv[bj][0], v1 = acc[ai][bj][m][1] + bv[bj][1];
                    if (ACT == 1) { f32x2 a = gelu_pk((f32x2){v0[0], v0[1]}), b = gelu_pk((f32x2){v0[2], v0[3]}), c = gelu_pk((f32x2){v1[0], v1[1]}), d = gelu_pk((f32x2){v1[2], v1[3]});
                        v0 = (f32x4){a.x, a.y, b.x, b.y}; v1 = (f32x4){c.x, c.y, d.x, d.y}; }
                    v0 = v0 * sc; v1 = v1 * sc; u32x4 w; w.x = cvt_pk_bf16(v0[0], v0[1]); w.y = cvt_pk_bf16(v0[2], v0[3]); w.z = cvt_pk_bf16(v1[0], v1[1]); w.w = cvt_pk_bf16(v1[2], v1[3]);
                    *(u32x4*)(rowp + bj * HALF) = w; } }
    }
};

struct EpiF32 {
    static constexpr bool PERM = false, AFTER_DRAIN = false;
    float* C; int ldc;
    __device__ __forceinline__ void operator()(const f32x4 (&acc)[2][2][4][2], const Unit& u, int wr, int wc, int fr, int fq) const {
        const int row0 = u.pm * BM + wr * 64 + fr, col0 = u.pn * BM + wc * 32 + 4 * fq;
#pragma unroll
        for (int ai = 0; ai < 2; ++ai)
#pragma unroll
            for (int m = 0; m < 4; ++m) { float* rowp = C + (size_t)(row0 + ai * HALF + m * 16) * ldc + col0;
#pragma unroll
                for (int bj = 0; bj < 2; ++bj)
#pragma unroll
                    for (int n = 0; n < 2; ++n) *(f32x4*)(rowp + bj * HALF + n * 16) = acc[ai][bj][m][n]; }
    }
};
__device__ __forceinline__ float sigmoid_f(float x) { return __builtin_amdgcn_rcpf(1.0f + __builtin_amdgcn_exp2f(-1.4426950408889634f * x)); }
struct EpiGate {
    static constexpr bool PERM = true, AFTER_DRAIN = false;
    const bf16_t* Z; int ldz; int gcol0; bf16_t* P; bf16_t* O; int ldc; int MODE;
    __device__ __forceinline__ void operator()(const f32x4 (&acc)[2][2][4][2], const Unit& u, int wr, int wc, int fr, int fq) const {
        const int row0 = u.pm * BM + wr * 64 + fr, col0 = u.pn * BM + wc * 32 + 8 * fq;
#pragma unroll
        for (int ai = 0; ai < 2; ++ai)
#pragma unroll
            for (int m = 0; m < 4; ++m) { const int row = row0 + ai * HALF + m * 16;
#pragma unroll
                for (int bj = 0; bj < 2; ++bj) { const int col = col0 + bj * HALF;
                    const u32x4 gz = *(const u32x4*)(Z + (size_t)row * ldz + gcol0 + col);
                    f32x4 s0, s1;
                    s0[0] = sigmoid_f(__uint_as_float(gz[0] << 16)); s0[1] = sigmoid_f(__uint_as_float(gz[0] & 0xffff0000u));
                    s0[2] = sigmoid_f(__uint_as_float(gz[1] << 16)); s0[3] = sigmoid_f(__uint_as_float(gz[1] & 0xffff0000u));
                    s1[0] = sigmoid_f(__uint_as_float(gz[2] << 16)); s1[1] = sigmoid_f(__uint_as_float(gz[2] & 0xffff0000u));
                    s1[2] = sigmoid_f(__uint_as_float(gz[3] << 16)); s1[3] = sigmoid_f(__uint_as_float(gz[3] & 0xffff0000u));
                    f32x4 v0 = acc[ai][bj][m][0] * s0, v1 = acc[ai][bj][m][1] * s1;
                    bf16_t* pp = P + (size_t)row * ldc + col;
                    if (MODE >= 1) { const u32x4 pw = *(const u32x4*)pp;
                        v0[0] += __uint_as_float(pw[0] << 16); v0[1] += __uint_as_float(pw[0] & 0xffff0000u); v0[2] += __uint_as_float(pw[1] << 16); v0[3] += __uint_as_float(pw[1] & 0xffff0000u);
                        v1[0] += __uint_as_float(pw[2] << 16); v1[1] += __uint_as_float(pw[2] & 0xffff0000u); v1[2] += __uint_as_float(pw[3] << 16); v1[3] += __uint_as_float(pw[3] & 0xffff0000u); }
                    u32x4 w; w.x = cvt_pk_bf16(v0[0], v0[1]); w.y = cvt_pk_bf16(v0[2], v0[3]); w.z = cvt_pk_bf16(v1[0], v1[1]); w.w = cvt_pk_bf16(v1[2], v1[3]);
                    *(u32x4*)((MODE <= 1 ? pp : O + (size_t)row * ldc + col)) = w; } }
    }
};
struct EpiResid {
    static constexpr bool PERM = false, AFTER_DRAIN = false;
    const float* xp; const float* xs; const float* gate; float* out;
    __device__ __forceinline__ void operator()(const f32x4 (&acc)[2][2][4][2], const Unit& u, int wr, int wc, int fr, int fq) const {
        const int row0 = u.pm * BM + wr * 64 + fr, col0 = u.pn * BM + wc * 32 + 4 * fq;
        const bool samp = u.pm >= 16; const int r = samp ? 1 + ((u.pm - 16) >> 2) : 0;
        const float* xb = samp ? xs - (size_t)4096 * 2048 : xp;
        f32x4 gv[2][2];
#pragma unroll
        for (int bj = 0; bj < 2; ++bj)
#pragma unroll
            for (int n = 0; n < 2; ++n) gv[bj][n] = *(const f32x4*)(gate + (size_t)r * 12288 + col0 + bj * HALF + n * 16);
#pragma unroll
        for (int ai = 0; ai < 2; ++ai)
#pragma unroll
            for (int m = 0; m < 4; ++m) { const size_t off = (size_t)(row0 + ai * HALF + m * 16) * 2048 + col0;
#pragma unroll
                for (int bj = 0; bj < 2; ++bj)
#pragma unroll
                    for (int n = 0; n < 2; ++n) { const f32x4 x = *(const f32x4*)(xb + off + bj * HALF + n * 16);
                        *(f32x4*)(out + off + bj * HALF + n * 16) = x + gv[bj][n] * acc[ai][bj][m][n]; } }
    }
};
struct EpiNull {
    static constexpr bool PERM = true, AFTER_DRAIN = false;
    float* sink;
    __device__ __forceinline__ void operator()(const f32x4 (&acc)[2][2][4][2], const Unit& u, int wr, int wc, int fr, int fq) const {
        f32x4 s = {0.f, 0.f, 0.f, 0.f};
#pragma unroll
        for (int ai = 0; ai < 2; ++ai)
#pragma unroll
            for (int bj = 0; bj < 2; ++bj)
#pragma unroll
                for (int m = 0; m < 4; ++m)
#pragma unroll
                    for (int n = 0; n < 2; ++n) s += acc[ai][bj][m][n];
        if (s[0] + s[1] + s[2] + s[3] == 1.2345e30f) *sink = 1.f;
    }
};

template <class Epi, class Sched, bool ALIGN_EPI = false, bool SP2 = false>
__device__ __forceinline__ void gemm_phase(PG8_LAS unsigned char* lds, const Gemm g, const Sched& S, const Epi& E) {
    const int tid = fresh_tid(), wid = __builtin_amdgcn_readfirstlane(tid >> 6), lane = tid & 63, wr = wid >> 2, wc = wid & 3, fr = lane & 15, fq = lane >> 4;
    const int K = g.K, nt = K / BK;
    unsigned voffA[2], voffB[2];
#pragma unroll
    for (int i = 0; i < 2; ++i) { int R, C; stage_rc(tid * 16 + i * 8192, R, C); const int Rb = Epi::PERM ? ((R & ~31) + perm32(R & 31)) : R;
        voffA[i] = (unsigned)(R * K + C) * 2u; voffB[i] = (unsigned)(Rb * K + C) * 2u; }
    const size_t kstep = (size_t)(BK * 2);
    const size_t hstep = (size_t)HALF * K * 2;
    const size_t tstep = 2 * hstep;
    const unsigned ldsw = (unsigned)wid * 1024u;
    const int aoff = lds_byte(wr * 64 + fr, fq * 8), boff = lds_byte(wc * 32 + fr, fq * 8);
#define PG8_SA(b, h) (((b) * 2 + (h)) * HTB)
#define PG8_SB(b, h) ((4 + (b) * 2 + (h)) * HTB)
#define PG8_STAGE(bufoff, gbase, voff) do { _Pragma("unroll") for (int _i = 0; _i < 2; ++_i) \
        __builtin_amdgcn_global_load_lds((const unsigned*)((const char*)(gbase) + (voff)[_i]), (PG8_LAS unsigned*)(lds + (bufoff) + ldsw + _i * 8192), 16, 0, 0); } while (0)
#define PG8_LDA(dst, b, h) do { _Pragma("unroll") for (int m = 0; m < 4; ++m) _Pragma("unroll") for (int k = 0; k < 2; ++k) dst[m][k] = *(const PG8_LAS bf16x8*)(lds + PG8_SA(b, h) + aoff + m * 2048 + k * 1024); } while (0)
#define PG8_LDB(dst, b, h) do { _Pragma("unroll") for (int n = 0; n < 2; ++n) _Pragma("unroll") for (int k = 0; k < 2; ++k) dst[n][k] = *(const PG8_LAS bf16x8*)(lds + PG8_SB(b, h) + boff + n * 2048 + k * 1024); } while (0)
#define PG8_MMA(ai, bj, At, Bt) do { __builtin_amdgcn_s_setprio(1); _Pragma("unroll") for (int m = 0; m < 4; ++m) _Pragma("unroll") for (int n = 0; n < 2; ++n) _Pragma("unroll") for (int k = 0; k < 2; ++k) \
        acc[ai][bj][m][n] = __builtin_amdgcn_mfma_f32_16x16x32_bf16(Bt[n][k], At[m][k], acc[ai][bj][m][n], 0, 0, 0); __builtin_amdgcn_s_setprio(0); } while (0)
#define PG8_WAIT_V(n) asm volatile("s_waitcnt vmcnt(" #n ")" ::: "memory")
#define PG8_WAIT_L(n) asm volatile("s_waitcnt lgkmcnt(" #n ")" ::: "memory")
#define PG8_BAR __builtin_amdgcn_s_barrier()
#define PG8_SCHED __builtin_amdgcn_sched_barrier(0)
    Unit cur, nxt; int ui = 0;
    if (!S.next(0, cur)) return;
    f32x4 acc[2][2][4][2];
#pragma unroll
    for (int a = 0; a < 2; ++a)
#pragma unroll
        for (int b = 0; b < 2; ++b)
#pragma unroll
            for (int m = 0; m < 4; ++m)
#pragma unroll
                for (int n = 0; n < 2; ++n) acc[a][b][m][n] = (f32x4){0.f, 0.f, 0.f, 0.f};
    bf16x8 At[4][2], B0[2][2], B1[2][2];
    const char* cA = (const char*)g.A + (size_t)cur.pm * tstep; const char* cB = (const char*)g.Bt + (size_t)cur.pn * tstep;
    S.a_ready(cur);
    if constexpr (SP2) {
        PG8_STAGE(PG8_SB(0, 0), cB, voffB); PG8_STAGE(PG8_SB(0, 1), cB + hstep, voffB); PG8_STAGE(PG8_SA(0, 0), cA, voffA); PG8_STAGE(PG8_SA(0, 1), cA + hstep, voffA);
        if (wr == 1) PG8_BAR;
        PG8_WAIT_V(2); PG8_BAR;
        PG8_STAGE(PG8_SB(1, 0), cB + kstep, voffB); PG8_STAGE(PG8_SA(1, 0), cA + kstep, voffA); PG8_STAGE(PG8_SB(1, 1), cB + hstep + kstep, voffB);
        PG8_WAIT_V(6); PG8_BAR;
    } else {
        PG8_STAGE(PG8_SB(0, 0), cB, voffB); PG8_STAGE(PG8_SA(0, 0), cA, voffA); PG8_STAGE(PG8_SB(0, 1), cB + hstep, voffB); PG8_STAGE(PG8_SA(0, 1), cA + hstep, voffA);
        if (wr == 1) PG8_BAR;
        PG8_WAIT_V(4); PG8_BAR;
        PG8_STAGE(PG8_SB(1, 0), cB + kstep, voffB); PG8_STAGE(PG8_SA(1, 0), cA + kstep, voffA); PG8_STAGE(PG8_SB(1, 1), cB + hstep + kstep, voffB);
        PG8_WAIT_V(6); PG8_BAR;
    }
    for (;;) {
        const bool has_next = S.next(ui + 1, nxt);
        const char* nA = has_next ? (const char*)g.A + (size_t)nxt.pm * tstep : cA; const char* nB = has_next ? (const char*)g.Bt + (size_t)nxt.pn * tstep : cB;
        for (int t = 0; t < nt; t += 2) {
            const bool last = (t == nt - 2);
            const char* a1 = cA + (size_t)(t + 1) * kstep;
            const char* a2 = last ? nA : cA + (size_t)(t + 2) * kstep; const char* b2 = last ? nB : cB + (size_t)(t + 2) * kstep;
            const char* a3 = a2 + kstep; const char* b3 = b2 + kstep;
            if (last && has_next) S.a_ready(nxt);
            if constexpr (SP2) {
            PG8_LDB(B0, 0, 0); PG8_LDB(B1, 0, 1); PG8_SCHED; PG8_LDA(At, 0, 0); PG8_STAGE(PG8_SA(1, 1), a1 + hstep, voffA);
            PG8_WAIT_V(8); PG8_WAIT_L(0); PG8_BAR; PG8_MMA(0, 0, At, B0); PG8_MMA(0, 1, At, B1); PG8_BAR; PG8_SCHED;
            PG8_LDA(At, 0, 1); PG8_STAGE(PG8_SB(0, 0), b2, voffB); PG8_STAGE(PG8_SB(0, 1), b2 + hstep, voffB); PG8_STAGE(PG8_SA(0, 0), a2, voffA);
            PG8_WAIT_V(8); PG8_WAIT_L(0); PG8_BAR; PG8_MMA(1, 0, At, B0); PG8_MMA(1, 1, At, B1); PG8_BAR; PG8_SCHED;
            PG8_LDB(B0, 1, 0); PG8_LDB(B1, 1, 1); PG8_SCHED; PG8_LDA(At, 1, 0); PG8_STAGE(PG8_SA(0, 1), a2 + hstep, voffA);
            PG8_WAIT_V(8); PG8_WAIT_L(0); PG8_BAR; PG8_MMA(0, 0, At, B0); PG8_MMA(0, 1, At, B1); PG8_BAR; PG8_SCHED;
            PG8_LDA(At, 1, 1); PG8_STAGE(PG8_SB(1, 0), b3, voffB); PG8_STAGE(PG8_SB(1, 1), b3 + hstep, voffB); PG8_STAGE(PG8_SA(1, 0), a3, voffA);
            PG8_WAIT_V(8); PG8_WAIT_L(0); PG8_BAR; PG8_MMA(1, 0, At, B0); PG8_MMA(1, 1, At, B1); PG8_BAR; PG8_SCHED;
            } else {
            PG8_LDB(B0, 0, 0); PG8_SCHED; PG8_LDA(At, 0, 0); PG8_STAGE(PG8_SA(1, 1), a1 + hstep, voffA);
            PG8_WAIT_L(8); PG8_BAR; PG8_WAIT_L(0); PG8_MMA(0, 0, At, B0); PG8_BAR; PG8_SCHED;
            PG8_LDB(B1, 0, 1); PG8_STAGE(PG8_SB(0, 0), b2, voffB);
            PG8_BAR; PG8_WAIT_L(0); PG8_MMA(0, 1, At, B1); PG8_BAR;
            PG8_LDA(At, 0, 1); PG8_STAGE(PG8_SA(0, 0), a2, voffA);
            PG8_BAR; PG8_WAIT_L(0); PG8_MMA(1, 0, At, B0); PG8_BAR; PG8_SCHED;
            PG8_STAGE(PG8_SB(0, 1), b2 + hstep, voffB);
            PG8_WAIT_V(6); PG8_BAR; PG8_MMA(1, 1, At, B1); PG8_BAR;
            PG8_LDB(B0, 1, 0); PG8_SCHED; PG8_LDA(At, 1, 0); PG8_STAGE(PG8_SA(0, 1), a2 + hstep, voffA);
            PG8_WAIT_L(8); PG8_BAR; PG8_WAIT_L(0); PG8_MMA(0, 0, At, B0); PG8_BAR; PG8_SCHED;
            PG8_LDB(B1, 1, 1); PG8_STAGE(PG8_SB(1, 0), b3, voffB);
            PG8_BAR; PG8_WAIT_L(0); PG8_MMA(0, 1, At, B1); PG8_BAR;
            PG8_LDA(At, 1, 1); PG8_STAGE(PG8_SA(1, 0), a3, voffA);
            PG8_BAR; PG8_WAIT_L(0); PG8_MMA(1, 0, At, B0); PG8_BAR; PG8_SCHED;
            PG8_STAGE(PG8_SB(1, 1), b3 + hstep, voffB);
            PG8_WAIT_V(6); PG8_BAR; PG8_MMA(1, 1, At, B1); PG8_BAR;
            }
        }
        if constexpr (ALIGN_EPI) { if (wr == 0) PG8_BAR; }
        if constexpr (!Epi::AFTER_DRAIN) { E(acc, cur, wr, wc, fr, fq); S.done(cur); }
        if (!has_next) break;
#pragma unroll
        for (int a = 0; a < 2; ++a)
#pragma unroll
            for (int b = 0; b < 2; ++b)
#pragma unroll
                for (int m = 0; m < 4; ++m)
#pragma unroll
                    for (int n = 0; n < 2; ++n) acc[a][b][m][n] = (f32x4){0.f, 0.f, 0.f, 0.f};
        cur = nxt; cA = nA; cB = nB; ++ui;
        if constexpr (ALIGN_EPI) { if (wr == 1) PG8_BAR; }
    }
    PG8_WAIT_V(0);
    if constexpr (!ALIGN_EPI) { if (wr == 0) PG8_BAR; }
    PG8_BAR;
    if constexpr (Epi::AFTER_DRAIN) { E.fused(acc, cur, wr, wc, fr, fq, lds, wid, lane); S.done(cur); }
#undef PG8_SA
#undef PG8_SB
#undef PG8_STAGE
#undef PG8_LDA
#undef PG8_LDB
#undef PG8_MMA
#undef PG8_WAIT_V
#undef PG8_WAIT_L
#undef PG8_BAR
#undef PG8_SCHED
}
}

namespace att {
using bf16 = __hip_bfloat16;
constexpr int D = 128, NW = 8, QBLK = 32, KVBLK = 64;
constexpr float SCALE = 1.0f;
constexpr float THR = 8.f;
constexpr int SDEPTH = 2;
constexpr int LDQ = 3072, LDK = 1280, LDO = 3072;
constexpr size_t SHM_V = KVBLK * D * 2, SHM_K = KVBLK * D * 2, SHM_ATTN = 2 * SHM_V + 2 * SHM_K + NW * 64 * 4;
typedef __bf16 abf16x2_t __attribute__((ext_vector_type(2))); typedef float af32x2_t __attribute__((ext_vector_type(2)));
__device__ __forceinline__ unsigned short bf1(float x) { const af32x2_t v = {x, x}; const abf16x2_t b = __builtin_convertvector(v, abf16x2_t); return (unsigned short)(__builtin_bit_cast(unsigned, b) & 0xffffu); }
using bf16x8 = __attribute__((ext_vector_type(8))) short;
using s16x4  = __attribute__((ext_vector_type(4))) short;
using f32x16 = __attribute__((ext_vector_type(16))) float;
using f32x8  = __attribute__((ext_vector_type(8))) float;
using u32x4  = __attribute__((ext_vector_type(4))) unsigned;
#define KSWZ(row, colB) ((row) * 256 + ((colB) ^ (((row) & 7) << 4)))
#define SBAR() __builtin_amdgcn_sched_barrier(0)
__device__ __forceinline__ int crow(int r, int hi) { return (r & 3) + 8 * (r >> 2) + 4 * hi; }
__device__ __forceinline__ unsigned cvtpk(float lo, float hi) {
  unsigned r; asm volatile("v_cvt_pk_bf16_f32 %0, %1, %2" : "=v"(r) : "v"(lo), "v"(hi)); return r;
}
template <typename TIn> struct Stage;
template <> struct Stage<bf16>  { using T = bf16x8;
  __device__ static __forceinline__ T ld8(const bf16* p) { return *reinterpret_cast<const bf16x8*>(p); }
  __device__ static __forceinline__ bf16x8 tobf(T x) { return x; } };
template <> struct Stage<float> { using T = f32x8;
  __device__ static __forceinline__ T ld8(const float* p) { return *reinterpret_cast<const f32x8*>(p); }
  __device__ static __forceinline__ bf16x8 tobf(T x) {
    u32x4 w = {cvtpk(x[0], x[1]), cvtpk(x[2], x[3]), cvtpk(x[4], x[5]), cvtpk(x[6], x[7])}; return *reinterpret_cast<bf16x8*>(&w); } };

__device__ __forceinline__ void partialSM(f32x16& p0, f32x16& p1, float& m_reg, float& mn, float& alpha) {
  constexpr float C = SCALE * 1.4426950408889634f;
  float pmax = p0[0]; for (int r = 1; r < 16; ++r) pmax = fmaxf(pmax, p0[r]); for (int r = 0; r < 16; ++r) pmax = fmaxf(pmax, p1[r]);
  { auto rr = __builtin_amdgcn_permlane32_swap(__float_as_uint(pmax), __float_as_uint(pmax), false, false);
    pmax = fmaxf(__uint_as_float(rr[0]), __uint_as_float(rr[1])); }
  if (__builtin_expect(__all(pmax - m_reg <= THR / SCALE), 1)) { mn = m_reg; alpha = 1.f; }
  else { mn = fmaxf(m_reg, pmax); alpha = __builtin_amdgcn_exp2f((m_reg - mn) * C); m_reg = mn; }
  float mnC = -mn * C;
  for (int r = 0; r < 16; ++r) p0[r] = fmaf(p0[r], C, mnC); for (int r = 0; r < 16; ++r) p1[r] = fmaf(p1[r], C, mnC);
  for (int r = 0; r < 16; ++r) p0[r] = __builtin_amdgcn_exp2f(p0[r]);
}
__device__ __forceinline__ void finishSM(f32x16& p0, f32x16& p1, float alpha, float& l_reg, bf16x8& pa0, bf16x8& pa1, bf16x8& pa2, bf16x8& pa3) {
  for (int r = 0; r < 16; ++r) p1[r] = __builtin_amdgcn_exp2f(p1[r]);
  float ps = 0; for (int r = 0; r < 16; ++r) ps += p0[r]; for (int r = 0; r < 16; ++r) ps += p1[r];
  { auto rr = __builtin_amdgcn_permlane32_swap(__float_as_uint(ps), __float_as_uint(ps), false, false);
    ps = __uint_as_float(rr[0]) + __uint_as_float(rr[1]); }
  l_reg = l_reg * alpha + ps;
#define PK4(P, BASE, OUT) do { unsigned a0 = cvtpk(P[BASE + 0], P[BASE + 1]), a1 = cvtpk(P[BASE + 2], P[BASE + 3]);   \
    unsigned b0 = cvtpk(P[BASE + 4], P[BASE + 5]), b1 = cvtpk(P[BASE + 6], P[BASE + 7]);                              \
    auto r0 = __builtin_amdgcn_permlane32_swap(a0, b0, false, false); auto r1 = __builtin_amdgcn_permlane32_swap(a1, b1, false, false); \
    u32x4 w = {r0[0], r1[0], r0[1], r1[1]}; OUT = *reinterpret_cast<bf16x8*>(&w); } while (0)
  PK4(p0, 0, pa0); PK4(p0, 8, pa1); PK4(p1, 0, pa2); PK4(p1, 8, pa3);
#undef PK4
}
__device__ __forceinline__ void qkt(f32x16& p0, f32x16& p1, const bf16* Ks, const bf16x8* qr, int r32, int hi) {
  p0 = f32x16{}; p1 = f32x16{};
  for (int d0 = 0; d0 < 8; ++d0) { int cb = (d0 * 16 + hi * 8) * 2;
    bf16x8 b0 = *reinterpret_cast<const bf16x8*>((const char*)Ks + KSWZ(r32, cb));
    bf16x8 b1 = *reinterpret_cast<const bf16x8*>((const char*)Ks + KSWZ(32 + r32, cb));
    p0 = __builtin_amdgcn_mfma_f32_32x32x16_bf16(b0, qr[d0], p0, 0, 0, 0);
    p1 = __builtin_amdgcn_mfma_f32_32x32x16_bf16(b1, qr[d0], p1, 0, 0, 0); }
}
__device__ __forceinline__ int v_st(int k, int c) { const int kk = (k & ~0xC) | ((k & 4) << 1) | ((k & 8) >> 1); return ((kk >> 3) * 4 + (c >> 5)) * 512 + ((kk & 7) * 32 + (c & 31)) * 2; }
__device__ __forceinline__ int v_rd_base(int lane) { return ((lane & 3) << 3) | (((lane >> 2) & 3) << 6) | (((lane >> 4) & 1) << 5) | (((lane >> 5) & 1) << 8); }
constexpr int v_rd_off(int d0, int ks, int half) { return d0 * 512 + ks * 4096 + half * 2048; }
template <int OFF> __device__ __forceinline__ s16x4 tr_read(int vb) {
  s16x4 r; asm volatile("ds_read_b64_tr_b16 %0, %1 offset:%2" : "=&v"(r) : "v"(vb), "i"(OFF) : "memory"); return r;
}
template <int D0> __device__ __forceinline__ void pv_one(f32x16& od, int vb, bf16x8 pa0, bf16x8 pa1, bf16x8 pa2, bf16x8 pa3) {
  const s16x4 l0 = tr_read<v_rd_off(D0, 0, 0)>(vb), h0 = tr_read<v_rd_off(D0, 0, 1)>(vb), l1 = tr_read<v_rd_off(D0, 1, 0)>(vb), h1 = tr_read<v_rd_off(D0, 1, 1)>(vb);
  const s16x4 l2 = tr_read<v_rd_off(D0, 2, 0)>(vb), h2 = tr_read<v_rd_off(D0, 2, 1)>(vb), l3 = tr_read<v_rd_off(D0, 3, 0)>(vb), h3 = tr_read<v_rd_off(D0, 3, 1)>(vb);
  asm volatile("s_waitcnt lgkmcnt(0)" ::: "memory"); SBAR();
#define PK(L, H) (bf16x8){L[0], L[1], L[2], L[3], H[0], H[1], H[2], H[3]}
  od = __builtin_amdgcn_mfma_f32_32x32x16_bf16(pa0, PK(l0, h0), od, 0, 0, 0);
  od = __builtin_amdgcn_mfma_f32_32x32x16_bf16(pa1, PK(l1, h1), od, 0, 0, 0);
  od = __builtin_amdgcn_mfma_f32_32x32x16_bf16(pa2, PK(l2, h2), od, 0, 0, 0);
  od = __builtin_amdgcn_mfma_f32_32x32x16_bf16(pa3, PK(l3, h3), od, 0, 0, 0);
#undef PK
}
__device__ __forceinline__ void pv_d0(f32x16* o, int vb, bf16x8 pa0, bf16x8 pa1, bf16x8 pa2, bf16x8 pa3) {
  pv_one<0>(o[0], vb, pa0, pa1, pa2, pa3); pv_one<1>(o[1], vb, pa0, pa1, pa2, pa3); pv_one<2>(o[2], vb, pa0, pa1, pa2, pa3); pv_one<3>(o[3], vb, pa0, pa1, pa2, pa3);
}

template <typename TQ>
__device__ __forceinline__ void attn_dense_body(const TQ* __restrict__ Qb, const bf16* __restrict__ Kh, const bf16* __restrict__ Vh,
                                                unsigned short* __restrict__ Ob, int seq, char* lds) {
  using St = Stage<bf16>; using SQ = Stage<TQ>;
  const int tid = fresh_tid(), wid = tid >> 6, lane = tid & 63, r32 = lane & 31, hi = lane >> 5;
  bf16* V_lds = (bf16*)lds; bf16* K_lds = (bf16*)(lds + 2 * SHM_V);
  float* ws = (float*)(lds + 2 * SHM_V + 2 * SHM_K) + wid * 64; float* li_l = ws; float* al_l = ws + 32;
  float m_reg = -1e30f, l_reg = 0; f32x16 o[4] = {}; bf16x8 qr[8];
  const TQ* Qw = Qb + (long)(wid * QBLK + r32) * LDQ + hi * 8;
#pragma unroll
  for (int d0 = 0; d0 < 8; ++d0) qr[d0] = SQ::tobf(SQ::ld8(Qw + d0 * 16));
  const int sr = tid >> 4, sc = (tid & 15) * 8, vst0 = v_st(sr, sc), vst1 = v_st(32 + sr, sc);
  const int vb0 = (int)(uintptr_t)V_lds + v_rd_base(lane);
  struct { typename St::T vs0, vs1, ks0, ks1; } sr_[SDEPTH];
#define SLOAD(i, k0) do { sr_[i].vs0 = St::ld8(&Vh[(long)((k0) + sr) * LDK + sc]); sr_[i].vs1 = St::ld8(&Vh[(long)((k0) + 32 + sr) * LDK + sc]); \
    sr_[i].ks0 = St::ld8(&Kh[(long)((k0) + sr) * LDK + sc]); sr_[i].ks1 = St::ld8(&Kh[(long)((k0) + 32 + sr) * LDK + sc]); } while (0)
#define SWRITE(b, i) do { *(bf16x8*)((char*)V_lds + (b) * SHM_V + vst0) = St::tobf(sr_[i].vs0);          \
    *(bf16x8*)((char*)V_lds + (b) * SHM_V + vst1) = St::tobf(sr_[i].vs1); int kc = sc * 2;               \
    *(bf16x8*)((char*)K_lds + (b) * SHM_K + KSWZ(sr, kc)) = St::tobf(sr_[i].ks0);                       \
    *(bf16x8*)((char*)K_lds + (b) * SHM_K + KSWZ(32 + sr, kc)) = St::tobf(sr_[i].ks1); } while (0)
#define SWAIT() do { if constexpr (SDEPTH == 2) asm volatile("s_waitcnt vmcnt(4)" ::: "memory"); else asm volatile("s_waitcnt vmcnt(0)" ::: "memory"); } while (0)
#define RESC(a) do { if (__any((a) < 1.f)) { if (hi == 0) al_l[r32] = (a); asm volatile("s_waitcnt lgkmcnt(0)" ::: "memory"); \
    for (int d = 0; d < 4; ++d) for (int r = 0; r < 16; ++r) o[d][r] *= al_l[crow(r, hi)]; } } while (0)
  f32x16 pA0, pA1, pB0, pB1; float mnA, mnB, alA, alB; bf16x8 pa0, pa1, pa2, pa3; const int NT = seq / KVBLK;
  constexpr int SE = 0, SO = SDEPTH - 1;
  SLOAD(SE, 0); asm volatile("s_waitcnt vmcnt(0)" ::: "memory"); SWRITE(0, SE); __syncthreads();
  qkt(pA0, pA1, K_lds, qr, r32, hi); partialSM(pA0, pA1, m_reg, mnA, alA);
  SLOAD(SO, KVBLK); if constexpr (SDEPTH == 2) { if (2 < NT) SLOAD(SE, 2 * KVBLK); }
  SWAIT(); SWRITE(1, SO); __syncthreads();
  for (int j = 1; j + 1 < NT; j += 2) {
    SBAR(); qkt(pB0, pB1, (bf16*)((char*)K_lds + SHM_K), qr, r32, hi);
    finishSM(pA0, pA1, alA, l_reg, pa0, pa1, pa2, pa3); SBAR();
    SLOAD(SO, (j + SDEPTH) * KVBLK); SBAR();
    pv_d0(o, vb0, pa0, pa1, pa2, pa3); partialSM(pB0, pB1, m_reg, mnB, alB);
    __syncthreads(); SWAIT(); SWRITE(0, SE);
    RESC(alB); __syncthreads();
    SBAR(); qkt(pA0, pA1, K_lds, qr, r32, hi);
    finishSM(pB0, pB1, alB, l_reg, pa0, pa1, pa2, pa3); SBAR();
    if (SDEPTH == 1 || j + 3 < NT) SLOAD(SE, (j + 1 + SDEPTH) * KVBLK); SBAR();
    pv_d0(o, vb0 + (int)SHM_V, pa0, pa1, pa2, pa3); partialSM(pA0, pA1, m_reg, mnA, alA);
    __syncthreads(); SWAIT(); SWRITE(1, SO);
    RESC(alA); __syncthreads();
  }
  SBAR(); qkt(pB0, pB1, (bf16*)((char*)K_lds + SHM_K), qr, r32, hi);
  finishSM(pA0, pA1, alA, l_reg, pa0, pa1, pa2, pa3); SBAR();
  pv_d0(o, vb0, pa0, pa1, pa2, pa3); partialSM(pB0, pB1, m_reg, mnB, alB);
  __syncthreads(); RESC(alB);
  finishSM(pB0, pB1, alB, l_reg, pa0, pa1, pa2, pa3); SBAR();
  pv_d0(o, vb0 + (int)SHM_V, pa0, pa1, pa2, pa3);
  if (hi == 0) li_l[r32] = l_reg; asm volatile("s_waitcnt lgkmcnt(0)" ::: "memory");
  float rli[16];
#pragma unroll
  for (int r = 0; r < 16; ++r) rli[r] = __builtin_amdgcn_rcpf(li_l[crow(r, hi)]);
  unsigned short* Ow = Ob + (long)(wid * QBLK) * LDO;
#pragma unroll
  for (int r = 0; r < 16; ++r) { int orow = crow(r, hi);
    for (int d0 = 0; d0 < 4; ++d0) Ow[(long)orow * LDO + d0 * 32 + r32] = bf1(o[d0][r] * rli[r]); }
#undef SLOAD
#undef SWRITE
#undef SWAIT
#undef RESC
}
}

constexpr int DM = 2048, NTOK = 6144, NPROMPT = 4096, INW = 15872;
constexpr int C_HQ = 0, C_HF = 1024, C_HI = 3072, C_HG = 4096, C_DQ = 5120, C_DK = 6144, C_DV = 7168, C_GQ = 8192, C_GK = 9216, C_GV = 9472, C_GATE = 9728;
constexpr int KROWS = 4096 + 2 * 1280;
constexpr int KVW = 1280;
constexpr float EPS = 1e-6f;
constexpr int NPH = 23;

constexpr size_t MiB = 1u << 20;
constexpr size_t WS_CTL = 0, CTL_ZERO_BYTES = 1 * MiB;
constexpr size_t WS_MOD = 1 * MiB, WS_ROPE = 2 * MiB, WS_WIN = 3 * MiB, WS_WBR = 127 * MiB, WS_WOUT = 151 * MiB, WS_WPQ = 167 * MiB, WS_PU = 183 * MiB, WS_PV = 311 * MiB;
constexpr size_t WS_H = 439 * MiB, WS_Z = 463 * MiB, WS_QA = 649 * MiB, WS_KA = 685 * MiB, WS_VA = 702 * MiB, WS_OA = 719 * MiB, WS_OH = 791 * MiB, WS_BR = 839 * MiB, WS_MG = 875 * MiB;
constexpr size_t WS_XM = 899 * MiB, WS_X1 = 947 * MiB, WS_PE = 995 * MiB, WS_PG = 998 * MiB, WS_END = 1001 * MiB;
constexpr size_t WS_UV8 = WS_PU, WS_SC = WS_PV;
constexpr size_t WS_QP = WS_OA;
constexpr size_t WS_MGP = WS_OH;
static_assert(WS_WIN + (size_t)2 * INW * DM * 2 <= WS_WBR && WS_Z + (size_t)NTOK * INW * 2 <= WS_QA && WS_KA + (size_t)KROWS * KVW * 2 <= WS_VA && WS_VA + (size_t)KROWS * KVW * 2 <= WS_OA, "d_ws map");
static_assert(WS_OA + (size_t)NTOK * 3072 * 4 <= WS_OH && WS_OH + (size_t)2 * NTOK * 1024 * 4 <= WS_BR && WS_BR + (size_t)3 * NTOK * 1024 * 2 <= WS_MG, "d_ws map 2");
constexpr int CW_BAR = 4096;

constexpr int LDS_BYTES = 163840, RING_OFF = 1024;

#define GAS __attribute__((address_space(1)))
#define LAS __attribute__((address_space(3)))
typedef unsigned short bf16;
typedef unsigned v4u __attribute__((ext_vector_type(4)));
typedef unsigned v2u __attribute__((ext_vector_type(2)));
typedef float f32x4 __attribute__((ext_vector_type(4)));
typedef float f32x2 __attribute__((ext_vector_type(2)));
typedef __bf16 bf16x2_t __attribute__((ext_vector_type(2)));
__device__ __forceinline__ unsigned pk2(float lo, float hi) { const f32x2 v = {lo, hi}; const bf16x2_t b = __builtin_convertvector(v, bf16x2_t); return __builtin_bit_cast(unsigned, b); }
__device__ __forceinline__ unsigned f2bf(float f) { return pk2(f, f) & 0xffffu; }
__device__ __forceinline__ float bflo(unsigned w) { return __uint_as_float(w << 16); }
__device__ __forceinline__ float bfhi(unsigned w) { return __uint_as_float(w & 0xffff0000u); }
__device__ __forceinline__ float wave_sum(float v) {
#pragma unroll
    for (int o = 1; o < 64; o <<= 1) v += __shfl_xor(v, o);
    return v;
}
__device__ __forceinline__ void ld16bf(const bf16* p, float (&v)[16]) {
    const v4u a = *(const v4u*)p, b = *(const v4u*)(p + 8);
    v[0] = bflo(a.x); v[1] = bfhi(a.x); v[2] = bflo(a.y); v[3] = bfhi(a.y); v[4] = bflo(a.z); v[5] = bfhi(a.z); v[6] = bflo(a.w); v[7] = bfhi(a.w);
    v[8] = bflo(b.x); v[9] = bfhi(b.x); v[10] = bflo(b.y); v[11] = bfhi(b.y); v[12] = bflo(b.z); v[13] = bfhi(b.z); v[14] = bflo(b.w); v[15] = bfhi(b.w);
}
__device__ __forceinline__ void ld16f(const float* p, float (&v)[16]) {
#pragma unroll
    for (int i = 0; i < 4; ++i) { const f32x4 x = *(const f32x4*)(p + 4 * i); v[4 * i] = x[0]; v[4 * i + 1] = x[1]; v[4 * i + 2] = x[2]; v[4 * i + 3] = x[3]; }
}
__device__ __forceinline__ void st16bf(bf16* p, const float (&v)[16]) {
    v4u a, b; a.x = pk2(v[0], v[1]); a.y = pk2(v[2], v[3]); a.z = pk2(v[4], v[5]); a.w = pk2(v[6], v[7]); b.x = pk2(v[8], v[9]); b.y = pk2(v[10], v[11]); b.z = pk2(v[12], v[13]); b.w = pk2(v[14], v[15]);
    *(v4u*)p = a; *(v4u*)(p + 8) = b;
}
__device__ __forceinline__ void st16f(float* p, const float (&v)[16]) {
#pragma unroll
    for (int i = 0; i < 4; ++i) *(f32x4*)(p + 4 * i) = (f32x4){v[4 * i], v[4 * i + 1], v[4 * i + 2], v[4 * i + 3]};
}

#define XB_TMO      128
#define XB_XCNT(j)  (256  + 64 * (j))
#define XB_XSUB(j)  (1280 + 64 * (j))
#define XB_XGEN(j)  (2304 + 64 * (j))
#define XB_TOP      3328
#define XB_TOPGEN   3392
#define XCD_BAR_WORDS 3456
#define XB_SPIN_CAP (1u << 18)

__device__ __forceinline__ unsigned xb_ld(unsigned* p)              { return __hip_atomic_load(p, __ATOMIC_RELAXED, __HIP_MEMORY_SCOPE_AGENT); }
__device__ __forceinline__ unsigned xb_add(unsigned* p, unsigned v) { return __hip_atomic_fetch_add(p, v, __ATOMIC_RELAXED, __HIP_MEMORY_SCOPE_AGENT); }
__device__ __forceinline__ unsigned xb_xcc_id() { return (unsigned)__builtin_amdgcn_s_getreg((3 << 11) | 20) & 0xFu; }
#define XB_SPIN(cond, bar) do { unsigned _sp = 0; while (cond) { __builtin_amdgcn_s_sleep(1); \
    if ((++_sp & 255u) == 0u) { if (xb_ld(&(bar)[XB_TMO])) break; if (_sp > XB_SPIN_CAP) { atomicAdd(&(bar)[XB_TMO], 1u); break; } } } } while (0)

struct XcdBarrier {
    unsigned* bar; unsigned x;
    volatile LAS unsigned* st;
};

__device__ __forceinline__ XcdBarrier xcd_barrier_post(unsigned* bar, volatile LAS unsigned* st) {
    XcdBarrier b; b.bar = bar; b.x = xb_xcc_id(); b.st = st;
    if (threadIdx.x == 0) (void)xb_add(&bar[XB_XCNT(b.x)], 1u);
    return b;
}
__device__ __forceinline__ void xcd_barrier_complete(unsigned* bar, unsigned x, unsigned& nloc, unsigned& nx) {
    const unsigned G = gridDim.x * gridDim.y * gridDim.z;
    unsigned sum, cnt, mine, sp = 0u;
    for (;;) {
        sum = 0u; cnt = 0u; mine = 0u;
#pragma unroll
        for (unsigned j = 0; j < 16; ++j) { const unsigned c = xb_ld(&bar[XB_XCNT(j)]); sum += c; cnt += (c > 0u) ? 1u : 0u; mine = (j == x) ? c : mine; }
        if (sum == G) break;
        __builtin_amdgcn_s_sleep(1);
        if ((++sp & 255u) == 0u) { if (xb_ld(&bar[XB_TMO])) break; if (sp > XB_SPIN_CAP) { atomicAdd(&bar[XB_TMO], 1u); break; } }
    }
    nloc = mine > 0u ? mine : 1u; nx = cnt > 0u ? cnt : 1u;
}

__device__ __forceinline__ void xcd_barrier(const XcdBarrier& b) {
    asm volatile("s_waitcnt vmcnt(0)" ::: "memory");
    __syncthreads();
    if (threadIdx.x == 0) {
        unsigned* bar = b.bar;
        __builtin_amdgcn_s_waitcnt(0);
        unsigned nloc = b.st[0], nx = b.st[1];
        if (nloc == 0u) { xcd_barrier_complete(bar, b.x, nloc, nx); b.st[0] = nloc; b.st[1] = nx; }
        const unsigned old = xb_add(&bar[XB_XSUB(b.x)], 1u);
        const unsigned gen = old / nloc;
        if (old + 1u == (gen + 1u) * nloc) {
            __builtin_amdgcn_fence(__ATOMIC_RELEASE, "agent");
            asm volatile("s_waitcnt vmcnt(0)" ::: "memory");
            const unsigned og = xb_add(&bar[XB_TOP], 1u);
            const unsigned tg = og / nx;
            if (og + 1u == (tg + 1u) * nx) xb_add(&bar[XB_TOPGEN], 1u);
            else XB_SPIN(xb_ld(&bar[XB_TOPGEN]) == tg, bar);
            __builtin_amdgcn_fence(__ATOMIC_ACQUIRE, "agent");
            xb_add(&bar[XB_XGEN(b.x)], 1u);
            asm volatile("s_waitcnt vmcnt(0)" ::: "memory");
        } else {
            XB_SPIN(xb_ld(&bar[XB_XGEN(b.x)]) == gen, bar);
            __builtin_amdgcn_fence(__ATOMIC_ACQUIRE, "agent");
            asm volatile("s_waitcnt vmcnt(0)" ::: "memory");
        }
    }
    __syncthreads();
}
struct Args { const float* in[26]; float* out; unsigned char* ws; int ph_lo, ph_hi; };
constexpr size_t OUT_YP = 0, OUT_DK = 12582912, OUT_DV = 20971520, OUT_GK = 29360128, OUT_GV = 31457280, OUT_ST = 33554432, OUT_TOTAL = 41943040;
#define LDS_WAIT() asm volatile("s_waitcnt lgkmcnt(0)" ::: "memory")

constexpr int TI_IN = (DM / 64) * (INW / 32), TI_BR = (1024 / 64) * (DM / 32), TI_SQ = (DM / 64) * (DM / 32), TI_LAYER = TI_IN + 3 * TI_BR + 2 * TI_SQ;
struct TItem { const float* src; bf16* dst; int N, K; };
__device__ __forceinline__ TItem p0_titem(const Args& a, unsigned char* ws, int l, int r) {
    const float* W; bf16* WT; int K, N, item;
    if (r < TI_IN) { W = a.in[13] + (size_t)l * DM * INW; K = DM; N = INW; WT = (bf16*)(ws + WS_WIN) + (size_t)l * INW * DM; item = r; }
    else if ((r -= TI_IN) < 3 * TI_BR) { const int lc = l * 3 + r / TI_BR; W = a.in[20] + (size_t)lc * 1024 * DM; K = 1024; N = DM; WT = (bf16*)(ws + WS_WBR) + (size_t)lc * DM * 1024; item = r % TI_BR; }
    else if ((r -= 3 * TI_BR) < TI_SQ) { W = a.in[21] + (size_t)l * DM * DM; K = DM; N = DM; WT = (bf16*)(ws + WS_WOUT) + (size_t)l * DM * DM; item = r; }
    else { r -= TI_SQ; W = a.in[22] + (size_t)l * DM * DM; K = DM; N = DM; WT = (bf16*)(ws + WS_WPQ) + (size_t)l * DM * DM; item = r; }
    const int nblk = N / 32, kb = item / nblk, nb = item % nblk, k0 = 64 * kb, n0 = 32 * nb;
    TItem t; t.src = W + (size_t)k0 * N + n0; t.dst = WT + (size_t)n0 * K + k0; t.N = N; t.K = K; return t;
}
__device__ __forceinline__ void p0_tload(const TItem& t, int lane, f32x4 (&tv)[8]) {
#pragma unroll
    for (int i = 0; i < 8; ++i) tv[i] = *(const f32x4*)(t.src + (size_t)((lane >> 3) + 8 * i) * t.N + 4 * (lane & 7));
}
__device__ __forceinline__ void p0_tfinish(const TItem& t, LAS float* scr, int lane, const f32x4 (&tv)[8]) {
#pragma unroll
    for (int i = 0; i < 8; ++i) { LAS float* d = scr + ((lane >> 3) + 8 * i) * 33 + 4 * (lane & 7); d[0] = tv[i][0]; d[1] = tv[i][1]; d[2] = tv[i][2]; d[3] = tv[i][3]; }
    LDS_WAIT(); asm volatile("" ::: "memory");
    const int c = lane & 7;
#pragma unroll
    for (int j = 0; j < 4; ++j) { const int n = (lane >> 3) + 8 * j; const LAS float* s = scr + (8 * c) * 33 + n;
        v4u o; o.x = pk2(s[0 * 33], s[1 * 33]); o.y = pk2(s[2 * 33], s[3 * 33]); o.z = pk2(s[4 * 33], s[5 * 33]); o.w = pk2(s[6 * 33], s[7 * 33]);
        *(v4u*)(t.dst + (size_t)n * t.K + 8 * c) = o; }
    LDS_WAIT(); asm volatile("" ::: "memory");
}
__device__ __forceinline__ void p0_transposes(const Args& a, unsigned char* ws, LAS float* scr, int lane, int l, int r0, int r1, int st) {
    if (r0 >= r1) return;
    f32x4 ta[8], tb[8]; TItem ca = p0_titem(a, ws, l, r0), cb;
    p0_tload(ca, lane, ta);
    for (int r = r0; r < r1; r += 2 * st) {
        const int i2 = r + st < r1 ? r + st : r1 - 1, i3 = r + 2 * st < r1 ? r + 2 * st : r1 - 1;
        cb = p0_titem(a, ws, l, i2); p0_tload(cb, lane, tb); __builtin_amdgcn_sched_barrier(0);
        p0_tfinish(ca, scr, lane, ta); __builtin_amdgcn_sched_barrier(0);
        ca = p0_titem(a, ws, l, i3); p0_tload(ca, lane, ta); __builtin_amdgcn_sched_barrier(0);
        p0_tfinish(cb, scr, lane, tb); __builtin_amdgcn_sched_barrier(0);
    }
}
__device__ __forceinline__ void fp8_row_load(const Args& a, int t, int le, int lane, f32x4 (&x)[8]) {
    const float* src = a.in[24 + t] + (size_t)le * 2048;
#pragma unroll
    for (int j = 0; j < 8; ++j) x[j] = *(const f32x4*)(src + j * 256 + lane * 4);
}
__device__ __forceinline__ void fp8_row_finish(unsigned char* ws, int t, int le, int lane, const f32x4 (&x)[8]) {
    unsigned char* UV8 = ws + WS_UV8; float* SC = (float*)(ws + WS_SC);
    float mx = 0.f;
#pragma unroll
    for (int j = 0; j < 8; ++j) mx = fmaxf(fmaxf(mx, fmaxf(fabsf(x[j][0]), fabsf(x[j][1]))), fmaxf(fabsf(x[j][2]), fabsf(x[j][3])));
#pragma unroll
    for (int o = 1; o < 64; o <<= 1) mx = fmaxf(mx, __shfl_xor(mx, o));
    const float qmax = t == 0 ? 127.0f : 448.0f;
    const float sc = mx > 0.f ? mx / qmax : 1.0f, inv = mx > 0.f ? qmax / mx : 0.f;
    unsigned w[8];
    if (t == 0) {
#pragma unroll
        for (int j = 0; j < 8; ++j) { const int q0 = (int)rintf(x[j][0] * inv), q1 = (int)rintf(x[j][1] * inv), q2 = (int)rintf(x[j][2] * inv), q3 = (int)rintf(x[j][3] * inv);
            w[j] = (unsigned)(q0 & 0xff) | ((unsigned)(q1 & 0xff) << 8) | ((unsigned)(q2 & 0xff) << 16) | ((unsigned)q3 << 24); }
    } else {
#pragma unroll
        for (int j = 0; j < 8; ++j) { int q = __builtin_amdgcn_cvt_pk_fp8_f32(x[j][0] * inv, x[j][1] * inv, 0, false); q = __builtin_amdgcn_cvt_pk_fp8_f32(x[j][2] * inv, x[j][3] * inv, q, true); w[j] = (unsigned)q; }
    }
    unsigned char* dst = UV8 + (size_t)le * 4096 + t * 2048 + lane * 32;
    *(v4u*)dst = (v4u){w[0], w[1], w[2], w[3]}; *(v4u*)(dst + 16) = (v4u){w[4], w[5], w[6], w[7]};
    if (lane == 0) SC[le * 2 + t] = sc;
}
__device__ __forceinline__ void fp8_rows(const Args& a, unsigned char* ws, int i0, int i1, int st, int lebase, int lane) {
    f32x4 xa[8], xb[8];
    if (i0 < i1) fp8_row_load(a, i0 >> 14, lebase + (i0 & 16383), lane, xa);
    for (int i = i0; i < i1; i += 2 * st) {
        const int i2 = i + st, i3 = i + 2 * st;
        if (i2 < i1) fp8_row_load(a, i2 >> 14, lebase + (i2 & 16383), lane, xb);
        fp8_row_finish(ws, i >> 14, lebase + (i & 16383), lane, xa);
        if (i3 < i1) fp8_row_load(a, i3 >> 14, lebase + (i3 & 16383), lane, xa);
        if (i2 < i1) fp8_row_finish(ws, i2 >> 14, lebase + (i2 & 16383), lane, xb);
    }
}
constexpr int SLOT_ROWS = 6144;
constexpr int TAIL_ROWS = 7680;
__device__ __forceinline__ void p0_prologue(const Args& a, unsigned char* ws, LAS unsigned char* lds, int G, bool defer_l1) {
    ws = fresh_ws(ws); const int tid = fresh_tid(), lane = tid & 63, wave = __builtin_amdgcn_readfirstlane(tid >> 6);
    const int bx = blockIdx.x;
    __syncthreads();
    {
        LAS float* sil = (LAS float*)(lds + RING_OFF); LAS float* red = sil + 3 * 2048;
        const float* c_ctx = a.in[8]; const float* cc = a.in[2];
        for (int i = tid; i < 3 * 2048; i += 512) { const int r = i >> 11, k = i & 2047; const float c = r == 0 ? c_ctx[k] : cc[(r - 1) * 2048 + k]; sil[i] = c / (1.0f + expf(-c)); }
        __syncthreads();
        const float* mod_w = a.in[9]; const float* mod_b = a.in[10]; float* MOD = (float*)(ws + WS_MOD);
        const int cg = tid % 24, kg = tid / 24;
        for (int task = bx; task < 256; task += G) {
            const int l = task >> 7, col0 = (task & 127) * 96;
            if (kg < 21) {
                float acc[3][4];
#pragma unroll
                for (int r = 0; r < 3; ++r)
#pragma unroll
                    for (int j = 0; j < 4; ++j) acc[r][j] = 0.f;
                const float* wp = mod_w + ((size_t)l * 2048) * 12288 + col0 + cg * 4;
#pragma unroll 4
                for (int k = kg; k < 2048; k += 21) { const f32x4 w = *(const f32x4*)(wp + (size_t)k * 12288); const float s0 = sil[k], s1 = sil[2048 + k], s2 = sil[4096 + k];
#pragma unroll
                    for (int j = 0; j < 4; ++j) { acc[0][j] += s0 * w[j]; acc[1][j] += s1 * w[j]; acc[2][j] += s2 * w[j]; } }
#pragma unroll
                for (int r = 0; r < 3; ++r)
#pragma unroll
                    for (int j = 0; j < 4; ++j) red[(kg * 24 + cg) * 12 + r * 4 + j] = acc[r][j];
            }
            __syncthreads();
            if (tid < 288) { const int r = tid / 96, c = tid % 96, g4 = c >> 2, j = c & 3; float s = 0.f;
                for (int q = 0; q < 21; ++q) s += red[(q * 24 + g4) * 12 + r * 4 + j];
                MOD[(size_t)(l * 3 + r) * 12288 + col0 + c] = s + mod_b[l * 12288 + col0 + c]; }
            __syncthreads();
        }
    }
    {
        f32x2* R64 = (f32x2*)(ws + WS_ROPE); f32x2* R128 = R64 + 64 * 16;
        const int gt = bx * 512 + tid;
        if (gt < 64 * 16) { const int pos = gt >> 4, i = gt & 15; const float inv = exp2f(-13.287712379549449f * (float)i / 16.0f); const float ang = (float)pos * inv; R64[gt] = (f32x2){cosf(ang), sinf(ang)}; }
        else if (gt < 64 * 16 + 64 * 32) { const int g2 = gt - 64 * 16, pos = g2 >> 5, i = g2 & 31; const float inv = exp2f(-13.287712379549449f * (float)i / 32.0f); const float ang = (float)pos * inv; R128[g2] = (f32x2){cosf(ang), sinf(ang)}; }
    }
    {
        LAS float* scr = (LAS float*)(lds + RING_OFF + wave * 16384);
        const int gw = bx * 8 + wave, NGW = G * 8;
        p0_transposes(a, ws, scr, lane, 0, gw, TI_LAYER, NGW);
        if (!defer_l1) p0_transposes(a, ws, scr, lane, 1, gw, TI_LAYER, NGW);
    }
    {
        const int gw = bx * 8 + wave, NGW = G * 8;
        fp8_rows(a, ws, (defer_l1 ? TAIL_ROWS + SLOT_ROWS : 0) + gw, 32768, NGW, 0, lane);
        if (!defer_l1) fp8_rows(a, ws, gw, 32768, NGW, 16384, lane);
    }
}
__device__ __forceinline__ void work_gemm1_tail(const Args& a, unsigned char* ws, int l) {
    ws = fresh_ws(ws); const int tid = fresh_tid(), lane = tid & 63, wave = __builtin_amdgcn_readfirstlane(tid >> 6);
    fp8_rows(a, ws, ((int)blockIdx.x - 208) * 8 + wave, TAIL_ROWS, 384, l * 16384, lane);
}
__device__ __forceinline__ void work_deferred(const Args& a, unsigned char* ws, LAS unsigned char* lds, int slot) {
    ws = fresh_ws(ws); const int tid = fresh_tid(), lane = tid & 63, wave = __builtin_amdgcn_readfirstlane(tid >> 6);
    const int gw = ((int)blockIdx.x - 192) * 8 + wave;
    if (slot < 3) {
        const int lo_ = slot == 0 ? 0 : slot == 1 ? 9216 : 16128, hi_ = slot == 0 ? 9216 : slot == 1 ? 16128 : TI_LAYER;
        p0_transposes(a, ws, (LAS float*)(lds + RING_OFF + wave * 16384), lane, 1, lo_ + gw, hi_, 512);
        { const int r0 = TAIL_ROWS + (slot == 0 ? 0 : slot == 1 ? 2458 : 4301), r1 = TAIL_ROWS + (slot == 0 ? 2458 : slot == 1 ? 4301 : SLOT_ROWS); fp8_rows(a, ws, r0 + gw, r1, 512, 0, lane); }
    } else {
        const int lo_ = slot == 3 ? TAIL_ROWS : slot == 4 ? 17715 : 25242, hi_ = slot == 3 ? 17715 : slot == 4 ? 25242 : 32768;
        fp8_rows(a, ws, lo_ + gw, hi_, 512, 16384, lane);
    }
}

__device__ __forceinline__ void norm_phase(const float* xp, const float* xs, const float* gain, const float* modl, int ch_sh, int ch_sc, bf16* H, int G) {
    const int tid = fresh_tid(), lane = tid & 63, gw = blockIdx.x * 8 + __builtin_amdgcn_readfirstlane(tid >> 6), NGW = G * 8;
    for (int row = gw; row < NTOK; row += NGW) {
        const float* xr = row < NPROMPT ? xp + (size_t)row * DM : xs + (size_t)(row - NPROMPT) * DM;
        const int r = row < NPROMPT ? 0 : 1 + ((row - NPROMPT) >> 10);
        const float* sh = modl + (size_t)r * 12288 + ch_sh * DM; const float* sc = modl + (size_t)r * 12288 + ch_sc * DM;
        f32x4 v[8]; float ss = 0.f;
#pragma unroll
        for (int j = 0; j < 8; ++j) { v[j] = *(const f32x4*)(xr + j * 256 + lane * 4); ss += (v[j][0] * v[j][0] + v[j][1] * v[j][1]) + (v[j][2] * v[j][2] + v[j][3] * v[j][3]); }
        const float rstd = 1.0f / sqrtf(wave_sum(ss) * (1.0f / DM) + EPS);
#pragma unroll
        for (int j = 0; j < 8; ++j) { const int c = j * 256 + lane * 4; const f32x4 g = *(const f32x4*)(gain + c), s1 = *(const f32x4*)(sc + c), s0 = *(const f32x4*)(sh + c);
            const f32x4 o = v[j] * rstd * g * (s1 + 1.0f) + s0; v2u w; w.x = pk2(o[0], o[1]); w.y = pk2(o[2], o[3]); *(v2u*)(H + (size_t)row * DM + c) = w; }
    }
}

__device__ __forceinline__ void rope_pair(float (&v)[16], const f32x2* tab, int fi0, bool first, int xm) {
#pragma unroll
    for (int e = 0; e < 16; ++e) { const float p = __shfl_xor(v[e], xm); const f32x2 cs = tab[fi0 + e]; v[e] = first ? v[e] * cs.x - p * cs.y : v[e] * cs.x + p * cs.y; }
}
__device__ __forceinline__ void prep_phase(const Args& a, unsigned char* ws, int l, int wg0, int nwg) {
    ws = fresh_ws(ws); const int tid = fresh_tid(), lane = tid & 63, gw = ((int)blockIdx.x - wg0) * 8 + __builtin_amdgcn_readfirstlane(tid >> 6), NGW = nwg * 8;
    const bf16* Z = (const bf16*)(ws + WS_Z); bf16* QA = (bf16*)(ws + WS_QA); bf16* KA = (bf16*)(ws + WS_KA); bf16* VA = (bf16*)(ws + WS_VA);
    const f32x2* R64 = (const f32x2*)(ws + WS_ROPE); const f32x2* R128 = R64 + 64 * 16;
    const float* dqk = a.in[16] + (size_t)l * 2 * 64; const float* gqk = a.in[19] + (size_t)l * 2 * 128;
    float* out = a.out;
    for (int task = gw; task < NTOK + 512; task += NGW) {
        if (task >= NTOK) {
            const int i = task - NTOK, b = i >> 8, p = i & 255; const size_t krow = (size_t)NPROMPT + b * 1280 + 1024 + p;
            float v[16];
            ld16f(a.in[3] + ((size_t)(b * 2 + l) * 256 + p) * 1024 + lane * 16, v); st16bf(KA + krow * KVW + lane * 16, v);
            ld16f(a.in[4] + ((size_t)(b * 2 + l) * 256 + p) * 1024 + lane * 16, v); st16bf(VA + krow * KVW + lane * 16, v);
            if (lane < 16) { ld16f(a.in[5] + ((size_t)(b * 2 + l) * 256 + p) * 256 + lane * 16, v); st16bf(KA + krow * KVW + 1024 + lane * 16, v);
                             ld16f(a.in[6] + ((size_t)(b * 2 + l) * 256 + p) * 256 + lane * 16, v); st16bf(VA + krow * KVW + 1024 + lane * 16, v); }
            continue;
        }
        const int row = task; const bool latent = row >= NPROMPT;
        int b, t; size_t krow;
        if (!latent) { b = row >> 8; t = row & 255; krow = row; } else { b = (row - NPROMPT) >> 10; t = (row - NPROMPT) & 1023; krow = (size_t)NPROMPT + b * 1280 + t; }
        const int prow = t >> 6, pcol = t & 63;
        const bf16* z = Z + (size_t)row * INW;
        const size_t co = ((size_t)(b * 2 + l) * 256 + t);
        float v[16];
        {
            ld16bf(z + C_DQ + lane * 16, v); float ss = 0.f;
#pragma unroll
            for (int e = 0; e < 16; ++e) ss += v[e] * v[e];
            ss += __shfl_xor(ss, 1); ss += __shfl_xor(ss, 2);
            const float rstd = 1.0f / sqrtf(ss * (1.0f / 64.0f) + EPS); const int sub = lane & 3; const float* gn = dqk + sub * 16;
#pragma unroll
            for (int e = 0; e < 16; ++e) v[e] = v[e] * rstd * gn[e];
            if (latent) rope_pair(v, R64 + (sub < 2 ? prow : pcol) * 16, 0, (sub & 1) == 0, 1);
#pragma unroll
            for (int e = 0; e < 16; ++e) v[e] *= 0.125f;
            const int he = lane >> 2, half = he & 1; bf16* q = QA + (size_t)row * 3072 + he * 128;
            st16bf(q + half * 64 + sub * 16, v);
            *(v4u*)(q + (1 - half) * 64 + sub * 16) = (v4u){0u, 0u, 0u, 0u}; *(v4u*)(q + (1 - half) * 64 + sub * 16 + 8) = (v4u){0u, 0u, 0u, 0u};
        }
        {
            ld16bf(z + C_DK + lane * 16, v); float ss = 0.f;
#pragma unroll
            for (int e = 0; e < 16; ++e) ss += v[e] * v[e];
            ss += __shfl_xor(ss, 1); ss += __shfl_xor(ss, 2);
            const float rstd = 1.0f / sqrtf(ss * (1.0f / 64.0f) + EPS); const int sub = lane & 3; const float* gn = dqk + 64 + sub * 16;
#pragma unroll
            for (int e = 0; e < 16; ++e) v[e] = v[e] * rstd * gn[e];
            if (latent) rope_pair(v, R64 + (sub < 2 ? prow : pcol) * 16, 0, (sub & 1) == 0, 1);
            else st16f(out + OUT_DK + co * 1024 + lane * 16, v);
            st16bf(KA + krow * KVW + lane * 16, v);
        }
        {
            ld16bf(z + C_DV + lane * 16, v);
            if (!latent) st16f(out + OUT_DV + co * 1024 + lane * 16, v);
            *(v4u*)(VA + krow * KVW + lane * 16) = *(const v4u*)(z + C_DV + lane * 16); *(v4u*)(VA + krow * KVW + lane * 16 + 8) = *(const v4u*)(z + C_DV + lane * 16 + 8);
        }
        {
            ld16bf(z + C_GQ + lane * 16, v); float ss = 0.f;
#pragma unroll
            for (int e = 0; e < 16; ++e) ss += v[e] * v[e];
            ss += __shfl_xor(ss, 1); ss += __shfl_xor(ss, 2); ss += __shfl_xor(ss, 4);
            const float rstd = 1.0f / sqrtf(ss * (1.0f / 128.0f) + EPS); const int sub = lane & 7; const float* gn = gqk + sub * 16;
#pragma unroll
            for (int e = 0; e < 16; ++e) v[e] = v[e] * rstd * gn[e];
            if (latent) rope_pair(v, R128 + (sub < 4 ? prow : pcol) * 32, (sub & 1) * 16, (sub & 2) == 0, 2);
#pragma unroll
            for (int e = 0; e < 16; ++e) v[e] *= 0.08838834764831845f;
            st16bf(QA + (size_t)row * 3072 + 2048 + lane * 16, v);
        }
        {
            const int ln = lane & 15;
            ld16bf(z + C_GK + ln * 16, v); float ss = 0.f;
#pragma unroll
            for (int e = 0; e < 16; ++e) ss += v[e] * v[e];
            ss += __shfl_xor(ss, 1); ss += __shfl_xor(ss, 2); ss += __shfl_xor(ss, 4);
            const float rstd = 1.0f / sqrtf(ss * (1.0f / 128.0f) + EPS); const int sub = lane & 7; const float* gn = gqk + 128 + sub * 16;
#pragma unroll
            for (int e = 0; e < 16; ++e) v[e] = v[e] * rstd * gn[e];
            if (latent) rope_pair(v, R128 + (sub < 4 ? prow : pcol) * 32, (sub & 1) * 16, (sub & 2) == 0, 2);
            if (lane < 16) { if (!latent) st16f(out + OUT_GK + co * 256 + lane * 16, v); st16bf(KA + krow * KVW + 1024 + lane * 16, v); }
            ld16bf(z + C_GV + ln * 16, v);
            if (lane < 16) { if (!latent) st16f(out + OUT_GV + co * 256 + lane * 16, v); st16bf(VA + krow * KVW + 1024 + lane * 16, v); }
        }
    }
}

typedef short bf16x4s __attribute__((ext_vector_type(4)));
typedef short bf16x8h __attribute__((ext_vector_type(8)));
constexpr int HG_QD = 0, HG_QR = 4352, HG_KR = 8704, HG_KDT = 13056, HG_VT = 17152, HG_DEC = 21248, HG_BUF = 22016, HG_TOTS = 2 * HG_BUF;
__device__ __forceinline__ void hgrn_item(const Args& a, unsigned char* ws, LAS unsigned char* lds, int l, int item, const XcdBarrier* barp = nullptr, int split = -1) {
    ws = fresh_ws(ws); const int tid = fresh_tid(), lane = tid & 63, wave = __builtin_amdgcn_readfirstlane(tid >> 6);
    const bf16* Z = (const bf16*)(ws + WS_Z);
    int b, h, dir, T, row0; const bool latent = item < 32;
    if (latent) { b = item >> 4; h = (item >> 1) & 7; dir = item & 1; T = 1024; row0 = NPROMPT + b * 1024; }
    else { const int it = item - 32; b = it >> 4; h = (it >> 1) & 7; dir = it & 1; T = 256; row0 = b * 256; }
    const bool stager = wave < 4;
    const int cl = lane & 15, gr = lane >> 4, kc = (wave & 3) * 16 + cl;
    const int fr = lane & 15, g = lane >> 4, vb = (wave & 3) * 32;
    const size_t sidx = ((((size_t)(b * 2 + l) * 2 + dir) * 8 + h) * 128) * 128;
    LAS unsigned char* base = lds + RING_OFF;
    const long ost = dir ? -1024 : 1024, zst = dir ? -(long)INW : (long)INW;
    const int nchunk = T >> 4;
#define HG_EXP(x) __builtin_amdgcn_exp2f(1.4426950408889634f * (x))
    if (stager) {
        float lb[2] = {0.f, 0.f};
        if (l == 1) { const float* hl = a.in[14];
#pragma unroll
            for (int ch = 0; ch < 2; ++ch) { const float a0 = hl[(dir * 2 + 0) * 1024 + h * 128 + 2 * kc + ch], a1 = hl[(dir * 2 + 1) * 1024 + h * 128 + 2 * kc + ch]; lb[ch] = 1.0f / (1.0f + expf(a0 - a1)); } }
        const bf16* const zb0 = Z + (size_t)(row0 + (dir ? T - 1 : 0)) * INW + h * 128 + 2 * kc + zst * (4 * gr);
        unsigned rqA[4], rzA[4], rvA[4], rqB[4], rzB[4], rvB[4];
#define HG_LOAD(rq, rz, rv, c) do { if ((c) < nchunk) { _Pragma("unroll") for (int i = 0; i < 4; ++i) { const bf16* zr = zb0 + zst * ((c) * 16 + i); \
            rq[i] = *(const unsigned*)(zr + C_HQ); rz[i] = *(const unsigned*)(zr + C_HF + dir * 1024); rv[i] = *(const unsigned*)(zr + C_HI); } } } while (0)
#define HG_STAGE(rq, rz, rv, pbuf) do { \
            float lf[2][4], kk[2][4]; \
            _Pragma("unroll") for (int i = 0; i < 4; ++i) _Pragma("unroll") for (int ch = 0; ch < 2; ++ch) { const float zf = ch ? bfhi(rz[i]) : bflo(rz[i]); const float e = HG_EXP(-fabsf(zf)), inv = __builtin_amdgcn_rcpf(1.0f + e); \
                const float sp = zf >= 0.f ? inv : e * inv, sn = zf >= 0.f ? e * inv : inv; kk[ch][i] = (1.0f - lb[ch]) * sn; lf[ch][i] = 0.6931471805599453f * __builtin_amdgcn_logf(lb[ch] + (1.0f - lb[ch]) * sp); } \
            float cs[2][4], pre[2], bm[2], b15[2]; \
            _Pragma("unroll") for (int ch = 0; ch < 2; ++ch) { cs[ch][0] = lf[ch][0]; cs[ch][1] = cs[ch][0] + lf[ch][1]; cs[ch][2] = cs[ch][1] + lf[ch][2]; cs[ch][3] = cs[ch][2] + lf[ch][3]; \
                float P = cs[ch][3]; float t_ = __shfl_up(P, 16); if (gr >= 1) P += t_; t_ = __shfl_up(P, 32); if (gr >= 2) P += t_;        \
                pre[ch] = P - cs[ch][3]; bm[ch] = __shfl(P, 16 + cl); b15[ch] = __shfl(P, 48 + cl); } \
            LAS unsigned char* pb_ = base + (pbuf) * HG_BUF; float kd[2][4]; \
            _Pragma("unroll") for (int i = 0; i < 4; ++i) { const int s = 4 * gr + i; float qd[2], qr[2], kr[2]; \
                _Pragma("unroll") for (int ch = 0; ch < 2; ++ch) { const float q = ch ? bfhi(rq[i]) : bflo(rq[i]); const float bb = pre[ch] + cs[ch][i]; \
                    const float er = HG_EXP(fminf(fmaxf(bb - bm[ch], -80.f), 80.f)); \
                    qd[ch] = q * HG_EXP(bb); qr[ch] = q * er; kr[ch] = kk[ch][i] * __builtin_amdgcn_rcpf(er); kd[ch][i] = kk[ch][i] * HG_EXP(b15[ch] - bb); } \
                *(LAS unsigned*)(pb_ + HG_QD + s * 272 + kc * 4) = pk2(qd[0], qd[1]); \
                *(LAS unsigned*)(pb_ + HG_QR + s * 272 + kc * 4) = pk2(qr[0], qr[1]); \
                *(LAS unsigned*)(pb_ + HG_KR + s * 272 + kc * 4) = pk2(kr[0], kr[1]); } \
            *(LAS v2u*)(pb_ + HG_KDT + (2 * kc) * 32 + gr * 8) = (v2u){pk2(kd[0][0], kd[0][1]), pk2(kd[0][2], kd[0][3])}; *(LAS v2u*)(pb_ + HG_KDT + (2 * kc + 1) * 32 + gr * 8) = (v2u){pk2(kd[1][0], kd[1][1]), pk2(kd[1][2], kd[1][3])}; \
            *(LAS v2u*)(pb_ + HG_VT + (2 * kc) * 32 + gr * 8) = (v2u){(rv[0] & 0xffffu) | (rv[1] << 16), (rv[2] & 0xffffu) | (rv[3] << 16)}; \
            *(LAS v2u*)(pb_ + HG_VT + (2 * kc + 1) * 32 + gr * 8) = (v2u){(rv[0] >> 16) | (rv[1] & 0xffff0000u), (rv[2] >> 16) | (rv[3] & 0xffff0000u)}; \
            if (gr == 0) *(LAS f32x2*)(pb_ + HG_DEC + kc * 8) = (f32x2){HG_EXP(b15[0]), HG_EXP(b15[1])}; \
        } while (0)
        HG_LOAD(rqA, rzA, rvA, 0); HG_LOAD(rqB, rzB, rvB, 1);
        HG_STAGE(rqA, rzA, rvA, 0);
        HG_LOAD(rqA, rzA, rvA, 2);
        __syncthreads();
        for (int c = 0; c < nchunk; c += 2) {
            if (c == split) xcd_barrier(*barp);
            HG_STAGE(rqB, rzB, rvB, 1); HG_LOAD(rqB, rzB, rvB, c + 3);
            __syncthreads();
            if (c + 2 < nchunk) { HG_STAGE(rqA, rzA, rvA, 0); HG_LOAD(rqA, rzA, rvA, c + 4); }
            __syncthreads();
        }
#undef HG_LOAD
#undef HG_STAGE
        __syncthreads();
    } else {
        bf16* OH = (bf16*)(ws + WS_OH) + (size_t)dir * NTOK * 1024;
        bf16* const ob0 = OH + (size_t)(row0 + (dir ? T - 1 : 0)) * 1024 + h * 128 + vb + fr + ost * (4 * g);
        f32x4 S0[8], S1[8];
        if (latent) { const float* st = a.in[7] + sidx;
#pragma unroll
            for (int kt = 0; kt < 8; ++kt)
#pragma unroll
                for (int r = 0; r < 4; ++r) { S0[kt][r] = st[(size_t)(16 * kt + 4 * g + r) * 128 + vb + fr]; S1[kt][r] = st[(size_t)(16 * kt + 4 * g + r) * 128 + vb + 16 + fr]; } }
        else {
#pragma unroll
            for (int kt = 0; kt < 8; ++kt) { S0[kt] = (f32x4){0.f, 0.f, 0.f, 0.f}; S1[kt] = (f32x4){0.f, 0.f, 0.f, 0.f}; } }
#define HG_OTILE(SS, nt_, c) do { f32x4 o = {0.f, 0.f, 0.f, 0.f}; \
            _Pragma("unroll") for (int ks = 0; ks < 4; ++ks) { \
                const v4u bs4 = {pk2(SS[2 * ks][0], SS[2 * ks][1]), pk2(SS[2 * ks][2], SS[2 * ks][3]), pk2(SS[2 * ks + 1][0], SS[2 * ks + 1][1]), pk2(SS[2 * ks + 1][2], SS[2 * ks + 1][3])}; \
                o = __builtin_amdgcn_mfma_f32_16x16x32_bf16(__builtin_bit_cast(bf16x8h, qa[ks]), __builtin_bit_cast(bf16x8h, bs4), o, 0, 0, 0); } \
            const v2u bv2 = *(const LAS v2u*)(pb_ + HG_VT + (vb + 16 * (nt_) + fr) * 32 + g * 8); const v4u bv4 = {bv2.x, bv2.y, 0u, 0u}; const bf16x8h bv = __builtin_bit_cast(bf16x8h, bv4); \
            o = __builtin_amdgcn_mfma_f32_16x16x32_bf16(pa, bv, o, 0, 0, 0); \
            _Pragma("unroll") for (int r = 0; r < 4; ++r) ob0[ost * ((c) * 16 + r) + 16 * (nt_)] = (bf16)f2bf(o[r]); \
            _Pragma("unroll") for (int kt = 0; kt < 8; ++kt) SS[kt] = __builtin_amdgcn_mfma_f32_16x16x32_bf16(__builtin_bit_cast(bf16x8h, ak[kt]), bv, SS[kt] * dd[kt], 0, 0, 0); } while (0)
#define HG_MFMA(c) do { \
            const LAS unsigned char* pb_ = base + ((c) & 1) * HG_BUF; \
            f32x4 at = {0.f, 0.f, 0.f, 0.f}; \
            _Pragma("unroll") for (int ks = 0; ks < 4; ++ks) { const bf16x8h ka = *(const LAS bf16x8h*)(pb_ + HG_KR + fr * 272 + (32 * ks + 8 * g) * 2), qb = *(const LAS bf16x8h*)(pb_ + HG_QR + fr * 272 + (32 * ks + 8 * g) * 2); \
                at = __builtin_amdgcn_mfma_f32_16x16x32_bf16(ka, qb, at, 0, 0, 0); }            \
            _Pragma("unroll") for (int r = 0; r < 4; ++r) if (4 * g + r > fr) at[r] = 0.f; \
            const v4u pa4 = {pk2(at[0], at[1]), pk2(at[2], at[3]), 0u, 0u}; const bf16x8h pa = __builtin_bit_cast(bf16x8h, pa4);     \
            v4u qa[4]; v4u ak[8]; f32x4 dd[8]; \
            _Pragma("unroll") for (int ks = 0; ks < 4; ++ks) { const v2u alo = *(const LAS v2u*)(pb_ + HG_QD + fr * 272 + (32 * ks + 4 * g) * 2), ahi = *(const LAS v2u*)(pb_ + HG_QD + fr * 272 + (32 * ks + 16 + 4 * g) * 2); qa[ks] = (v4u){alo.x, alo.y, ahi.x, ahi.y}; } \
            _Pragma("unroll") for (int kt = 0; kt < 8; ++kt) { dd[kt] = *(const LAS f32x4*)(pb_ + HG_DEC + (16 * kt + 4 * g) * 4); const v2u ak2 = *(const LAS v2u*)(pb_ + HG_KDT + (16 * kt + fr) * 32 + g * 8); ak[kt] = (v4u){ak2.x, ak2.y, 0u, 0u}; } \
            HG_OTILE(S0, 0, c); HG_OTILE(S1, 1, c); \
        } while (0)
        __syncthreads();
        for (int c = 0; c < nchunk; c += 2) {
            if (c == split) xcd_barrier(*barp);
            HG_MFMA(c);
            __syncthreads();
            HG_MFMA(c + 1);
            __syncthreads();
        }
#undef HG_MFMA
#undef HG_OTILE
        if (!latent) { float* st = a.out + OUT_ST + sidx;
#pragma unroll
            for (int kt = 0; kt < 8; ++kt)
#pragma unroll
                for (int r = 0; r < 4; ++r) { st[(size_t)(16 * kt + 4 * g + r) * 128 + vb + fr] = S0[kt][r]; st[(size_t)(16 * kt + 4 * g + r) * 128 + vb + 16 + fr] = S1[kt][r]; } }
        __syncthreads();
    }
#undef HG_EXP
}

__device__ __forceinline__ void attn_unit(unsigned char* ws, char* lds_generic, int u) {
    ws = fresh_ws(ws);
    int b, he, row0, key0, seq;
    if (u < 192) { b = u / 96; const int r = u % 96; he = r >> 2; const int qb = r & 3; row0 = NPROMPT + b * 1024 + qb * 256; key0 = NPROMPT + b * 1280; seq = 1280; }
    else { const int uu = u - 192; b = uu / 24; he = uu % 24; row0 = b * 256; key0 = b * 256; seq = 256; }
    const int kvh = he < 16 ? (he >> 1) : 8 + ((he - 16) >> 2);
    const att::bf16* Q = (const att::bf16*)(ws + WS_QA) + (size_t)row0 * 3072 + he * 128;
    const att::bf16* K = (const att::bf16*)(ws + WS_KA) + (size_t)key0 * KVW + kvh * 128;
    const att::bf16* V = (const att::bf16*)(ws + WS_VA) + (size_t)key0 * KVW + kvh * 128;
    unsigned short* O = (unsigned short*)(ws + WS_OA) + (size_t)row0 * 3072 + he * 128;
    att::attn_dense_body<att::bf16>(Q, K, V, O, seq, lds_generic + RING_OFF);
    __syncthreads();
}

__device__ __forceinline__ void post_phase(const Args& a, unsigned char* ws, int l, int G) {
    ws = fresh_ws(ws); const int tid = fresh_tid(), lane = tid & 63, gw = blockIdx.x * 8 + __builtin_amdgcn_readfirstlane(tid >> 6), NGW = G * 8;
    const bf16* Z = (const bf16*)(ws + WS_Z); const bf16* OA = (const bf16*)(ws + WS_OA); const bf16* OHf = (const bf16*)(ws + WS_OH); const bf16* OHb = OHf + (size_t)NTOK * 1024;
    bf16* BR = (bf16*)(ws + WS_BR);
    const float lam_init = 0.8f - 0.6f * expf(-0.3f * (float)l);
    const float* lp = a.in[17] + (size_t)l * 4 * 64;
    const float s01 = wave_sum(lp[lane] * lp[64 + lane]), s23 = wave_sum(lp[128 + lane] * lp[192 + lane]);
    const float lam = expf(s01) - expf(s23) + lam_init;
    const float* hn = a.in[15] + (size_t)l * 128; const float* sl = a.in[18] + (size_t)l * 128;
    const int sub = lane & 7;
    for (int row = gw; row < NTOK; row += NGW) {
        float v[16], w[16];
        {
            ld16bf(OHf + (size_t)row * 1024 + lane * 16, v); ld16bf(OHb + (size_t)row * 1024 + lane * 16, w); float ss = 0.f;
#pragma unroll
            for (int e = 0; e < 16; ++e) { v[e] += w[e]; ss += v[e] * v[e]; }
            ss += __shfl_xor(ss, 1); ss += __shfl_xor(ss, 2); ss += __shfl_xor(ss, 4);
            const float rstd = 1.0f / sqrtf(ss * (1.0f / 128.0f) + EPS);
            ld16bf(Z + (size_t)row * INW + C_HG + lane * 16, w);
#pragma unroll
            for (int e = 0; e < 16; ++e) { const float g = w[e]; v[e] = v[e] * rstd * hn[sub * 16 + e] * (g / (1.0f + expf(-g))); }
            st16bf(BR + (size_t)row * 1024 + lane * 16, v);
        }
        {
            const int h = lane >> 3; const bf16* o1 = OA + (size_t)row * 3072 + (2 * h) * 128 + sub * 16;
            ld16bf(o1, v); ld16bf(o1 + 128, w); float ss = 0.f;
#pragma unroll
            for (int e = 0; e < 16; ++e) { v[e] -= lam * w[e]; ss += v[e] * v[e]; }
            ss += __shfl_xor(ss, 1); ss += __shfl_xor(ss, 2); ss += __shfl_xor(ss, 4);
            const float rstd = 1.0f / sqrtf(ss * (1.0f / 128.0f) + EPS);
#pragma unroll
            for (int e = 0; e < 16; ++e) v[e] = v[e] * rstd * sl[sub * 16 + e] * (1.0f - lam_init);
            st16bf(BR + (size_t)NTOK * 1024 + (size_t)row * 1024 + lane * 16, v);
        }
        {
            *(v4u*)(BR + (size_t)2 * NTOK * 1024 + (size_t)row * 1024 + lane * 16) = *(const v4u*)(OA + (size_t)row * 3072 + 2048 + lane * 16); *(v4u*)(BR + (size_t)2 * NTOK * 1024 + (size_t)row * 1024 + lane * 16 + 8) = *(const v4u*)(OA + (size_t)row * 3072 + 2048 + lane * 16 + 8);
        }
    }
}

typedef short bf16x8s __attribute__((ext_vector_type(8)));
typedef float f32x16 __attribute__((ext_vector_type(16)));
__device__ __forceinline__ unsigned ford(float f) { const unsigned u = __float_as_uint(f); return u ^ ((u >> 31) ? 0xffffffffu : 0x80000000u); }
__device__ __forceinline__ float funord(unsigned k) { const unsigned u = (k & 0x80000000u) ? (k ^ 0x80000000u) : ~k; return __uint_as_float(u); }
__device__ __forceinline__ void ins16(unsigned (&L)[16], unsigned x) {
#pragma unroll
    for (int i = 0; i < 16; ++i) { const unsigned hi = L[i] > x ? L[i] : x; x = L[i] > x ? x : L[i]; L[i] = hi; }
}
__device__ __forceinline__ void ce_desc(unsigned& a_, unsigned& b_) { const unsigned hi = a_ > b_ ? a_ : b_, lo = a_ > b_ ? b_ : a_; a_ = hi; b_ = lo; }
__device__ __forceinline__ void sort16_desc(unsigned (&x)[16]) {
#pragma unroll
    for (int k = 2; k <= 16; k <<= 1)
#pragma unroll
        for (int j = k >> 1; j > 0; j >>= 1)
#pragma unroll
            for (int i = 0; i < 16; ++i) { const int l = i ^ j; if (l > i) { if ((i & k) == 0) ce_desc(x[i], x[l]); else ce_desc(x[l], x[i]); } }
}
__device__ __forceinline__ void merge16_desc(unsigned (&a_)[16], const unsigned (&b_)[16]) {
#pragma unroll
    for (int i = 0; i < 16; ++i) a_[i] = a_[i] > b_[15 - i] ? a_[i] : b_[15 - i];
#pragma unroll
    for (int j = 8; j > 0; j >>= 1)
#pragma unroll
        for (int i = 0; i < 16; ++i) { const int l = i ^ j; if (l > i) ce_desc(a_[i], a_[l]); }
}
__device__ __forceinline__ void peer_top16(unsigned (&L)[16], const LAS unsigned char* keysL, const bf16* qp, int c, int qrow, int hf) {
    f32x16 acc[4];
#pragma unroll
    for (int tl = 0; tl < 4; ++tl)
#pragma unroll
        for (int r = 0; r < 16; ++r) acc[tl][r] = 0.f;
    bf16x8s bq[8];
#pragma unroll
    for (int ks = 0; ks < 8; ++ks) bq[ks] = *(const bf16x8s*)(qp + c * 128 + ks * 16 + hf * 8);
#pragma unroll
    for (int ks = 0; ks < 8; ++ks)
#pragma unroll
        for (int tl = 0; tl < 4; ++tl) { const bf16x8s ka = *(const LAS bf16x8s*)(keysL + (c * 128 + tl * 32 + qrow) * 256 + (((ks * 2 + hf) ^ (qrow & 15)) << 4));
            acc[tl] = __builtin_amdgcn_mfma_f32_32x32x16_bf16(ka, bq[ks], acc[tl], 0, 0, 0); }
    unsigned K1[16], K2[16], K3[16];
#pragma unroll
    for (int r = 0; r < 16; ++r) { const unsigned kc = 127u - (unsigned)((r & 3) + 8 * (r >> 2)) - 4u * (unsigned)hf;
        L[r] = (ford(acc[0][r]) & 0xffffff80u) | kc; K1[r] = (ford(acc[1][r]) & 0xffffff80u) | (kc - 32u); K2[r] = (ford(acc[2][r]) & 0xffffff80u) | (kc - 64u); K3[r] = (ford(acc[3][r]) & 0xffffff80u) | (kc - 96u); }
    sort16_desc(L); sort16_desc(K1); sort16_desc(K2); sort16_desc(K3);
    merge16_desc(L, K1); merge16_desc(K2, K3); merge16_desc(L, K2);
    unsigned P[16];
#pragma unroll
    for (int i = 0; i < 16; ++i) P[i] = (unsigned)__shfl_xor((int)L[i], 32);
    merge16_desc(L, P);
}
__device__ __forceinline__ float gelu_erf(float x) { return 0.5f * x * (1.0f + erff(x * 0.70710678118654752f)); }
__device__ __forceinline__ void peer_topk_phase(const Args& a, unsigned char* ws, LAS unsigned char* lds, int l, int G) {
    ws = fresh_ws(ws); const int tid = fresh_tid(), lane = tid & 63, wave = __builtin_amdgcn_readfirstlane(tid >> 6);
    LAS unsigned char* keysL = lds + RING_OFF;
    LAS unsigned char* wtab = keysL + 65536 + wave * 2048;
    const float* pk = a.in[23] + (size_t)l * 2 * 128 * 128;
    for (int i = tid; i < 2 * 128 * 16; i += 512) { const int q = i & 15, rk = i >> 4, k = rk & 127;
        const f32x4 x0 = *(const f32x4*)(pk + (size_t)rk * 128 + q * 8), x1 = *(const f32x4*)(pk + (size_t)rk * 128 + q * 8 + 4);
        v4u o; o.x = pk2(x0[0], x0[1]); o.y = pk2(x0[2], x0[3]); o.z = pk2(x1[0], x1[1]); o.w = pk2(x1[2], x1[3]);
        *(LAS v4u*)(keysL + rk * 256 + ((q ^ (k & 15)) << 4)) = o; }
    __syncthreads();
    const bf16* QPb = (const bf16*)(ws + WS_QP); unsigned* PE = (unsigned*)(ws + WS_PE); unsigned* PG = (unsigned*)(ws + WS_PG);
    const int gw = blockIdx.x * 8 + wave, NGW = G * 8;
    const int hf = lane >> 5, qrow = lane & 31, tq = qrow >> 3, hq = qrow & 7;
    for (int tile = gw; tile < NTOK / 3; tile += NGW) {
        const int tok0 = tile * 3;
        const bf16* qp = QPb + (size_t)(tok0 + (tq < 3 ? tq : 2)) * DM + hq * 256;
        unsigned L0[16], L1[16];
        peer_top16(L0, keysL, qp, 0, qrow, hf);
        peer_top16(L1, keysL, qp, 1, qrow, hf);
        unsigned tw[8];
#pragma unroll
        for (int i = 0; i < 4; ++i) { tw[i] = (127u - (L0[4 * i] & 127u)) | ((127u - (L0[4 * i + 1] & 127u)) << 8) | ((127u - (L0[4 * i + 2] & 127u)) << 16) | ((127u - (L0[4 * i + 3] & 127u)) << 24);
                                      tw[4 + i] = (127u - (L1[4 * i] & 127u)) | ((127u - (L1[4 * i + 1] & 127u)) << 8) | ((127u - (L1[4 * i + 2] & 127u)) << 16) | ((127u - (L1[4 * i + 3] & 127u)) << 24); }
        *(LAS v4u*)(wtab + lane * 32) = (v4u){tw[0], tw[1], tw[2], tw[3]}; *(LAS v4u*)(wtab + lane * 32 + 16) = (v4u){tw[4], tw[5], tw[6], tw[7]};
        float v0[16], v1[16];
#pragma unroll
        for (int i = 0; i < 16; ++i) { v0[i] = funord(L0[i] & 0xffffff80u); v1[i] = funord(L1[i] & 0xffffff80u); }
        unsigned C[16], C1[16], C2[16], C3[16];
#pragma unroll
        for (int i = 0; i < 16; ++i) { C[i] = 0u; C1[i] = 0u; C2[i] = 0u; C3[i] = 0u; }
#pragma unroll
        for (int i = 0; i < 16; ++i)
#pragma unroll
            for (int j = 0; j < 16; ++j) if ((i + 1) * (j + 1) <= 16) {
                constexpr int PRE[16] = {0, 16, 24, 29, 33, 36, 38, 40, 42, 43, 44, 45, 46, 47, 48, 49};
                const int s = PRE[i] + j; const unsigned key = (ford(v0[i] + v1[j]) & 0xffffff00u) | (255u - (unsigned)(i * 16 + j));
                if (s < 16) C[s & 15] = key; else if (s < 32) C1[s & 15] = key; else if (s < 48) C2[s & 15] = key; else C3[s & 15] = key; }
        sort16_desc(C); sort16_desc(C1); sort16_desc(C2); sort16_desc(C3);
        merge16_desc(C, C1); merge16_desc(C2, C3); merge16_desc(C, C2);
        LDS_WAIT(); asm volatile("" ::: "memory");
        float ex[16]; float sum = 0.f; const float c0 = funord(C[0] & 0xffffff00u);
#pragma unroll
        for (int r = 0; r < 16; ++r) { ex[r] = expf(funord(C[r] & 0xffffff00u) - c0); sum += ex[r]; }
        const float rs = 1.0f / sum;
        if (tq < 3) { const size_t ob = (size_t)(tok0 + tq) * 128 + hq * 16;
            if (hf == 0) { unsigned ev[16];
#pragma unroll
                for (int r = 0; r < 16; ++r) { const unsigned ci = 255u - (C[r] & 255u); const unsigned k0 = wtab[lane * 32 + (ci >> 4)], k1 = wtab[lane * 32 + 16 + (ci & 15u)]; ev[r] = k0 * 128u + k1; }
#pragma unroll
                for (int r = 0; r < 16; r += 4) *(v4u*)(PE + ob + r) = (v4u){ev[r], ev[r + 1], ev[r + 2], ev[r + 3]}; }
            else {
#pragma unroll
                for (int r = 0; r < 16; r += 4) *(v4u*)(PG + ob + r) = (v4u){__float_as_uint(ex[r] * rs), __float_as_uint(ex[r + 1] * rs), __float_as_uint(ex[r + 2] * rs), __float_as_uint(ex[r + 3] * rs)}; }
        }
        LDS_WAIT(); asm volatile("" ::: "memory");
    }
    __syncthreads();
}
#define PEER_ACC(OUT) do { _Pragma("unroll") for (int j = 0; j < 8; ++j) { const int q = (int)w[t][j >> 2][j & 3]; \
        OUT[2 * j] = __builtin_elementwise_fma(__builtin_amdgcn_cvt_pk_f32_fp8(q, false), wg2, OUT[2 * j]); OUT[2 * j + 1] = __builtin_elementwise_fma(__builtin_amdgcn_cvt_pk_f32_fp8(q, true), wg2, OUT[2 * j + 1]); } } while (0)
__device__ __forceinline__ void fma_ip(float& o, float x, float w) { asm("v_fma_f32 %0, %1, %2, %0" : "+v"(o) : "v"(x), "v"(w)); }
__device__ __forceinline__ void peer_gather_phase(const Args& a, unsigned char* ws, LAS unsigned char* lds, int l, float* xout, int G, unsigned emask = 0xffffu, int skip = 0, bool n1fuse = false) {
    ws = fresh_ws(ws); const int tid = fresh_tid(), lane = tid & 63, wave = __builtin_amdgcn_readfirstlane(tid >> 6);
    LAS unsigned char* wb = lds + RING_OFF + wave * 16384;
    LAS v2u* list = (LAS v2u*)(wb + 12288); LAS unsigned* hist = (LAS unsigned*)(wb + 15360);
    const bf16* H = (const bf16*)(ws + WS_H); const unsigned* PE = (const unsigned*)(ws + WS_PE); const unsigned* PG = (const unsigned*)(ws + WS_PG);
    const unsigned char* UV8 = ws + WS_UV8 + (size_t)l * 16384 * 4096; const float* SC = (const float*)(ws + WS_SC) + (size_t)l * 16384 * 2;
    const float* XM = (const float*)(ws + WS_XM); const float* MOD = (const float*)(ws + WS_MOD) + (size_t)l * 3 * 12288;
    const int gw = blockIdx.x * 8 + wave, NGW = G * 8;
    for (int tile = gw; tile < NTOK / 3; tile += NGW) {
        const int tok0 = tile * 3;
        {
            unsigned e[6], gb[6], pos[6];
            hist[lane] = 0u; hist[64 + lane] = 0u; hist[128 + lane] = 0u;
#pragma unroll
            for (int m = 0; m < 6; ++m) { const size_t ix = (size_t)(tok0 + (m >> 1)) * 128 + ((lane + 64 * m) & 127); e[m] = PE[ix] & emask; gb[m] = PG[ix]; }
            LDS_WAIT(); asm volatile("" ::: "memory");
#pragma unroll
            for (int m = 0; m < 6; ++m) pos[m] = __hip_atomic_fetch_add(hist + (m >> 1) * 64 + (e[m] >> 8), 1u, __ATOMIC_RELAXED, __HIP_MEMORY_SCOPE_WORKGROUP);
            LDS_WAIT(); asm volatile("" ::: "memory");
            const unsigned cnt0 = hist[lane], cnt1 = hist[64 + lane], cnt2 = hist[128 + lane]; unsigned inc0 = cnt0, inc1 = cnt1, inc2 = cnt2;
#pragma unroll
            for (int o = 1; o < 64; o <<= 1) { const unsigned t0 = (unsigned)__shfl_up((int)inc0, o), t1 = (unsigned)__shfl_up((int)inc1, o), t2 = (unsigned)__shfl_up((int)inc2, o); if (lane >= o) { inc0 += t0; inc1 += t1; inc2 += t2; } }
            LDS_WAIT(); asm volatile("" ::: "memory");
            hist[lane] = inc0 - cnt0; hist[64 + lane] = 128u + inc1 - cnt1; hist[128 + lane] = 256u + inc2 - cnt2;
            LDS_WAIT(); asm volatile("" ::: "memory");
#pragma unroll
            for (int m = 0; m < 6; ++m) { const unsigned p_ = hist[(m >> 1) * 64 + (e[m] >> 8)] + pos[m]; list[p_] = (v2u){e[m], gb[m]}; }
            LDS_WAIT(); asm volatile("" ::: "memory");
        }
        if (!(skip & 1)) {
            unsigned hq[3][8]; float hs[3];
#pragma unroll
            for (int t = 0; t < 3; ++t) { float hv[8][4]; float mx = 0.f;
#pragma unroll
                for (int j = 0; j < 8; ++j) { const v2u a0 = *(const v2u*)(H + (size_t)(tok0 + t) * DM + j * 256 + lane * 4); hv[j][0] = bflo(a0.x); hv[j][1] = bfhi(a0.x); hv[j][2] = bflo(a0.y); hv[j][3] = bfhi(a0.y);
                    mx = fmaxf(fmaxf(mx, fmaxf(fabsf(hv[j][0]), fabsf(hv[j][1]))), fmaxf(fabsf(hv[j][2]), fabsf(hv[j][3]))); }
#pragma unroll
                for (int o = 1; o < 64; o <<= 1) mx = fmaxf(mx, __shfl_xor(mx, o));
                const float inv = mx > 0.f ? 127.0f / mx : 0.f; hs[t] = mx * (1.0f / 127.0f);
#pragma unroll
                for (int j = 0; j < 8; ++j) { const int q0 = (int)rintf(hv[j][0] * inv), q1 = (int)rintf(hv[j][1] * inv), q2 = (int)rintf(hv[j][2] * inv), q3 = (int)rintf(hv[j][3] * inv);
                    hq[t][j] = (unsigned)(q0 & 0xff) | ((unsigned)(q1 & 0xff) << 8) | ((unsigned)(q2 & 0xff) << 16) | ((unsigned)q3 << 24); } }
#define PU_LOAD(W, SCL, G_, kb_) do { _Pragma("unroll") for (int t = 0; t < 3; ++t) { const v2u r = list[t * 128 + (kb_)]; const int ee = __builtin_amdgcn_readfirstlane((int)r.x); G_[t] = __uint_as_float((unsigned)__builtin_amdgcn_readfirstlane((int)r.y)); \
            const unsigned char* base = UV8 + (size_t)ee * 4096 + lane * 32; W[t][0] = *(const v4u*)base; W[t][1] = *(const v4u*)(base + 16); SCL[t] = *(const f32x2*)(SC + (size_t)ee * 2); } } while (0)
#define PU_DOT(HV, Wt) ({ int s_ = 0; _Pragma("unroll") for (int j = 0; j < 8; ++j) s_ = __builtin_amdgcn_sdot4((int)Wt[j >> 2][j & 3], (int)HV[j], s_, false); s_; })
#define PU_RED(x_) do { x_ += __builtin_amdgcn_update_dpp(0, x_, 0xB1, 0xF, 0xF, false); x_ += __builtin_amdgcn_update_dpp(0, x_, 0x4E, 0xF, 0xF, false); \
            x_ += __builtin_amdgcn_update_dpp(0, x_, 0x141, 0xF, 0xF, false); x_ += __builtin_amdgcn_update_dpp(0, x_, 0x140, 0xF, 0xF, false); \
            x_ += __builtin_amdgcn_update_dpp(0, x_, 0x142, 0xA, 0xF, false); x_ += __builtin_amdgcn_update_dpp(0, x_, 0x143, 0xC, 0xF, false); } while (0)
#define PU_COMP(W, kb_) do { int d0 = PU_DOT(hq[0], W[0]), d1 = PU_DOT(hq[1], W[1]), d2 = PU_DOT(hq[2], W[2]); PU_RED(d0); PU_RED(d1); PU_RED(d2); \
            if (lane == 63) { dl[(kb_)] = d0; dl[128 + (kb_)] = d1; dl[256 + (kb_)] = d2; } } while (0)
            LAS int* dl = (LAS int*)wb;
            v4u wA[3][2], wB[3][2];
#define PU_LOAD2(W, kb_) do { _Pragma("unroll") for (int t = 0; t < 3; ++t) { const int ee = __builtin_amdgcn_readfirstlane((int)list[t * 128 + (kb_)].x); \
            const unsigned char* base = UV8 + (size_t)ee * 4096 + lane * 32; W[t][0] = *(const v4u*)base; W[t][1] = *(const v4u*)(base + 16); } } while (0)
            PU_LOAD2(wA, 0);
#pragma unroll 1
            for (int kb = 0; kb < 128; kb += 2) {
                PU_LOAD2(wB, kb + 1); PU_COMP(wA, kb);
                if (kb + 2 < 128) PU_LOAD2(wA, kb + 2);
                PU_COMP(wB, kb + 1);
            }
            LDS_WAIT(); asm volatile("" ::: "memory");
#pragma unroll
            for (int m = 0; m < 6; ++m) { const int li = lane + 64 * m; const v2u ent = list[li]; const f32x2 sc2 = *(const f32x2*)(SC + (size_t)ent.x * 2);
                ((LAS float*)list)[2 * li + 1] = __uint_as_float(ent.y) * gelu_erf((float)dl[li] * (sc2.x * hs[m >> 1])) * sc2.y; }
#undef PU_LOAD2
#undef PU_RED
#undef PU_LOAD
#undef PU_DOT
#undef PU_COMP
        }
        LDS_WAIT(); asm volatile("" ::: "memory");
        f32x2 out0[16], out1[16], out2[16];
#pragma unroll
        for (int i = 0; i < 16; ++i) { out0[i] = (f32x2){0.f, 0.f}; out1[i] = (f32x2){0.f, 0.f}; out2[i] = (f32x2){0.f, 0.f}; }
#define PV_LOAD(W, G_, kb_) do { _Pragma("unroll") for (int t = 0; t < 3; ++t) { const v2u r = list[t * 128 + (kb_)]; const int ee = __builtin_amdgcn_readfirstlane((int)r.x); G_[t] = __uint_as_float((unsigned)__builtin_amdgcn_readfirstlane((int)r.y)); \
            const unsigned char* base = UV8 + (size_t)ee * 4096 + 2048 + lane * 32; W[t][0] = *(const v4u*)base; W[t][1] = *(const v4u*)(base + 16); } } while (0)
#define PV_FMA(O, X, Wg) do { O.x = __builtin_fmaf(X.x, Wg, O.x); O.y = __builtin_fmaf(X.y, Wg, O.y); } while (0)
#define PV_COMP(W, G_) do { _Pragma("unroll") for (int t = 0; t < 3; ++t) { const float wg = G_[t]; \
            _Pragma("unroll") for (int j = 0; j < 8; ++j) { const int q = (int)W[t][j >> 2][j & 3]; const f32x2 lo = __builtin_amdgcn_cvt_pk_f32_fp8(q, false), hi = __builtin_amdgcn_cvt_pk_f32_fp8(q, true); \
                if (t == 0) { PV_FMA(out0[2 * j], lo, wg); PV_FMA(out0[2 * j + 1], hi, wg); } \
                else if (t == 1) { PV_FMA(out1[2 * j], lo, wg); PV_FMA(out1[2 * j + 1], hi, wg); } \
                else { PV_FMA(out2[2 * j], lo, wg); PV_FMA(out2[2 * j + 1], hi, wg); } } } } while (0)
        if (!(skip & 2)) {
            v4u wA[3][2], wB[3][2]; float gA[3], gB[3];
            PV_LOAD(wA, gA, 0);
#pragma unroll 1
            for (int kb = 0; kb < 128; kb += 2) {
                PV_LOAD(wB, gB, kb + 1); PV_COMP(wA, gA);
                if (kb + 2 < 128) PV_LOAD(wA, gA, kb + 2);
                PV_COMP(wB, gB);
            }
        }
#undef PV_LOAD
#undef PV_COMP
#pragma unroll
        for (int tt = 0; tt < 3; ++tt) {
            const int row = tok0 + tt; const int r = row < NPROMPT ? 0 : 1 + ((row - NPROMPT) >> 10);
            const float* g2 = MOD + (size_t)r * 12288 + 5 * DM;
            float ss = 0.f;
#pragma unroll
            for (int j = 0; j < 8; ++j) { const int c = j * 256 + lane * 4; const size_t off = (size_t)row * DM + c;
                const f32x4 x0 = *(const f32x4*)(XM + off), ga = *(const f32x4*)(g2 + c);
                const f32x2 oa = tt == 0 ? out0[2 * j] : (tt == 1 ? out1[2 * j] : out2[2 * j]), ob = tt == 0 ? out0[2 * j + 1] : (tt == 1 ? out1[2 * j + 1] : out2[2 * j + 1]);
                const f32x4 xo = x0 + ga * (f32x4){oa.x, oa.y, ob.x, ob.y}; *(f32x4*)(xout + off) = xo;
                ss += (xo[0] * xo[0] + xo[1] * xo[1]) + (xo[2] * xo[2] + xo[3] * xo[3]); }
            if (n1fuse) { const float* n1gain = a.in[11] + DM; const float* n1mod = (const float*)(ws + WS_MOD) + (size_t)3 * 12288;
                const float rstd = 1.0f / sqrtf(wave_sum(ss) * (1.0f / DM) + EPS); const float* sh = n1mod + (size_t)r * 12288; const float* sc = sh + DM; bf16* Hw = (bf16*)(ws + WS_H);
#pragma unroll
                for (int j = 0; j < 8; ++j) { const int c = j * 256 + lane * 4; const size_t off = (size_t)row * DM + c;
                    const f32x4 x0 = *(const f32x4*)(XM + off), ga = *(const f32x4*)(g2 + c);
                    const f32x2 oa = tt == 0 ? out0[2 * j] : (tt == 1 ? out1[2 * j] : out2[2 * j]), ob = tt == 0 ? out0[2 * j + 1] : (tt == 1 ? out1[2 * j + 1] : out2[2 * j + 1]);
                    const f32x4 xo = x0 + ga * (f32x4){oa.x, oa.y, ob.x, ob.y};
                    const f32x4 gn = *(const f32x4*)(n1gain + c), s1 = *(const f32x4*)(sc + c), s0 = *(const f32x4*)(sh + c);
                    const f32x4 o = xo * rstd * gn * (s1 + 1.0f) + s0; *(v2u*)(Hw + (size_t)row * DM + c) = (v2u){pk2(o[0], o[1]), pk2(o[2], o[3])}; }
            }
        }
        asm volatile("" ::: "memory");
    }
    __syncthreads();
}
#undef PEER_ACC

__device__ __forceinline__ unsigned dg_hash(unsigned x) { x ^= x >> 16; x *= 0x7feb352du; x ^= x >> 15; x *= 0x846ca68bu; x ^= x >> 16; return x; }
__device__ __forceinline__ void dummy_gather(unsigned char* ws, int mode, int G) {
    ws = fresh_ws(ws); const int tid = fresh_tid(), lane = tid & 63, wave = __builtin_amdgcn_readfirstlane(tid >> 6);
    const unsigned char* UV8 = ws + WS_UV8; const int gw = blockIdx.x * 8 + wave;
    f32x2 hv[16], out[16];
#pragma unroll
    for (int i = 0; i < 16; ++i) { hv[i] = (f32x2){(float)(lane + i) * 0.001f, (float)(lane - i) * 0.002f}; out[i] = (f32x2){0.f, 0.f}; }
    for (int jb = 0; jb < 384; jb += 4) {
        int e[4];
#pragma unroll
        for (int t = 0; t < 4; ++t) { const unsigned hsh = dg_hash((unsigned)(gw * 384 + jb + t) * 2654435761u + 12345u); e[t] = mode == 0 ? (int)(hsh & 16383u) : (int)((((unsigned)(jb + t) / 12u) << 9) | (hsh & 511u)); }
        v4u w[4][4];
#pragma unroll
        for (int t = 0; t < 4; ++t) { const unsigned char* base = UV8 + (size_t)e[t] * 4096 + lane * 32;
            w[t][0] = *(const v4u*)base; w[t][1] = *(const v4u*)(base + 16); w[t][2] = *(const v4u*)(base + 2048); w[t][3] = *(const v4u*)(base + 2048 + 16); }
        float d[4];
#pragma unroll
        for (int t = 0; t < 4; ++t) { f32x2 s = {0.f, 0.f};
#pragma unroll
            for (int j = 0; j < 8; ++j) { const int q = (int)w[t][j >> 2][j & 3];
                s = __builtin_elementwise_fma(__builtin_amdgcn_cvt_pk_f32_fp8(q, false), hv[2 * j], s); s = __builtin_elementwise_fma(__builtin_amdgcn_cvt_pk_f32_fp8(q, true), hv[2 * j + 1], s); }
            d[t] = s.x + s.y; }
#pragma unroll
        for (int o = 1; o < 64; o <<= 1) {
#pragma unroll
            for (int t = 0; t < 4; ++t) d[t] += __shfl_xor(d[t], o); }
#pragma unroll
        for (int t = 0; t < 4; ++t) { const float wg = d[t] * 1e-3f; const f32x2 wg2 = {wg, wg};
#pragma unroll
            for (int j = 0; j < 8; ++j) { const int q = (int)w[t][2 + (j >> 2)][j & 3];
                out[2 * j] = __builtin_elementwise_fma(__builtin_amdgcn_cvt_pk_f32_fp8(q, false), wg2, out[2 * j]); out[2 * j + 1] = __builtin_elementwise_fma(__builtin_amdgcn_cvt_pk_f32_fp8(q, true), wg2, out[2 * j + 1]); } }
    }
    float* scratch = (float*)(ws + WS_PE);
    float acc = 0.f;
#pragma unroll
    for (int i = 0; i < 16; ++i) acc += out[i].x + out[i].y;
    scratch[(size_t)gw * 64 + lane] = acc;
}
#ifdef PROBE_G1NS
struct ProbeOrder : pg8::StaticOrder {
    __device__ bool next(int i, pg8::Unit& u) const { const bool r = pg8::StaticOrder::next(i, u); if (PROBE_G1NS & 2) u.pn &= 1; if (PROBE_G1NS & 4) u.pm &= 1; return r; }
};
#endif
__global__ void __launch_bounds__(512, 2) mk_fwd(Args args) {
    extern __shared__ __attribute__((aligned(16))) unsigned char lds_raw[];
    LAS unsigned char* lds = (LAS unsigned char*)lds_raw;
    const int G = gridDim.x;
    unsigned char* ws = args.ws;
    unsigned* ctl = (unsigned*)(ws + WS_CTL);
    for (int u = threadIdx.x; u < RING_OFF / 4; u += 512) ((LAS unsigned*)lds)[u] = 0u;
    __syncthreads();
    const int lo = args.ph_lo, hi = args.ph_hi;
    XcdBarrier bar; bar.bar = ctl + CW_BAR; bar.x = 0; bar.st = (volatile LAS unsigned*)(lds + 32);
    if (hi - lo > 1) bar = xcd_barrier_post(ctl + CW_BAR, (volatile LAS unsigned*)(lds + 32));
#ifndef PH_EN
#define PH_EN 0xfff
#endif
#define PHEN(k) (((PH_EN) >> (k)) & 1)
#ifndef PROBE_DUP
#define PROBE_DUP 0
#endif
#define NREP(k) ((((PROBE_DUP) >> (k)) & 1) ? 2 : 1)
#define IN(k) (lo <= (k) && (k) < hi)
#define SEAM(k) do { if (IN(k) && IN((k) + 1)) xcd_barrier(bar); } while (0)

#ifndef PROBE_XBAR
#define PROBE_XBAR 0
#endif
    if (PHEN(0) && IN(0)) { for (int rep = 0; rep < NREP(0); ++rep) p0_prologue(args, ws, lds, G, lo == 0 && hi == NPH && G == 256); }
    SEAM(0);

    for (int l = 0; l < 2; ++l) {
        ws = fresh_ws(ws);
        const int pb = 1 + 11 * l;
#define MODall ((const float*)(ws + WS_MOD))
#define Hb ((bf16*)(ws + WS_H))
#define Zb ((bf16*)(ws + WS_Z))
        const float* xin_p = l == 0 ? args.in[0] : (const float*)(ws + WS_X1);
        const float* xin_s = l == 0 ? args.in[1] : (const float*)(ws + WS_X1) + (size_t)NPROMPT * DM;
        const float* modl = MODall + (size_t)l * 3 * 12288;
        for (int xb = 0; xb < PROBE_XBAR; ++xb) xcd_barrier(bar);
        const bool n1fused = lo == 0 && hi == NPH;
        const bool defer = lo == 0 && hi == NPH && G == 256 && (int)blockIdx.x >= 192;
        if (!(l == 1 && n1fused)) {
            if (PHEN(1) && IN(pb + 0)) for (int rep = 0; rep < NREP(1); ++rep) norm_phase(xin_p, xin_s, args.in[11] + (size_t)l * DM, modl, 0, 1, Hb, G);
            SEAM(pb + 0);
        }
#ifdef PROBE_G1NS
        { ws = fresh_ws(ws);
            pg8::Gemm g{Hb, (const bf16*)(ws + WS_WIN) + (size_t)l * INW * DM, NTOK, INW, DM}; ProbeOrder S; S.init(NTOK, INW, G, (int)blockIdx.x);
            pg8::EpiNull E{(float*)(ws + WS_QA)};
            pg8::gemm_phase<pg8::EpiNull, ProbeOrder, true, true>(lds + RING_OFF, g, S, E);
            xcd_barrier(bar);
        }
#endif
        if (PHEN(2) && IN(pb + 1)) for (int rep = 0; rep < NREP(2); ++rep) { ws = fresh_ws(ws);
            pg8::Gemm g{Hb, (const bf16*)(ws + WS_WIN) + (size_t)l * INW * DM, NTOK, INW, DM}; pg8::StaticOrder S; S.init(NTOK, INW, G, (int)blockIdx.x);
            pg8::EpiBf16<0> E{Zb, INW, nullptr, 0, 0, 1.f};
            pg8::gemm_phase<pg8::EpiBf16<0>, pg8::StaticOrder, true, true>(lds + RING_OFF, g, S, E);
            if (lo == 0 && hi == NPH && G == 256 && (int)blockIdx.x >= 208) work_gemm1_tail(args, ws, l);
        }
        SEAM(pb + 1);
        const bool early = IN(pb + 2) && IN(pb + 3) && G > 64;
        if (early && (int)blockIdx.x < 32) { hgrn_item(args, ws, lds, l, (int)blockIdx.x, &bar, 16); }
        else {
            if (PHEN(3) && IN(pb + 2)) for (int rep = 0; rep < NREP(3); ++rep) prep_phase(args, ws, l, early ? 32 : 0, early ? G - 32 : G);
            SEAM(pb + 2);
            if (PHEN(4) && IN(pb + 3)) for (int rep = 0; rep < NREP(4); ++rep) {
                const int bx = blockIdx.x;
                if (G > 64 && bx < 32) { for (int rp = 0; rp < NREP(12); ++rp) hgrn_item(args, ws, lds, l, bx); }
                else {
                    const int u0 = G > 64 ? bx - 32 : bx, us = G > 64 ? G - 32 : G;
                    if (G <= 64) for (int u = bx; u < 32; u += G) hgrn_item(args, ws, lds, l, u);
                    for (int rp = 0; rp < NREP(12); ++rp)
                    for (int u = u0; u < 832; u += us) if (u >= 192 && u < 448) hgrn_item(args, ws, lds, l, 32 + (u - 192));
                    for (int rp = 0; rp < NREP(13); ++rp)
                    for (int u = u0; u < 832; u += us) if (u < 192 || u >= 448) attn_unit(ws, (char*)lds_raw, u < 192 ? u : 192 + (u - 448));
                }
            }
        }
        SEAM(pb + 3);
        if (PHEN(5) && IN(pb + 4)) for (int rep = 0; rep < NREP(5); ++rep) post_phase(args, ws, l, G);
        SEAM(pb + 4);
        if (PHEN(6) && IN(pb + 5)) for (int rep = 0; rep < NREP(6); ++rep) { ws = fresh_ws(ws);
            pg8::StaticOrder S; S.init(NTOK, DM, G, (int)blockIdx.x);
            for (int c = 0; c < 3; ++c) {
                pg8::Gemm g{(const bf16*)(ws + WS_BR) + (size_t)c * NTOK * 1024, (const bf16*)(ws + WS_WBR) + (size_t)(l * 3 + c) * DM * 1024, NTOK, DM, 1024};
                pg8::EpiGate E{Zb, INW, C_GATE + c * DM, (bf16*)(ws + WS_MGP), (bf16*)(ws + WS_MG), DM, c};
                pg8::gemm_phase<pg8::EpiGate, pg8::StaticOrder, true, true>(lds + RING_OFF, g, S, E);
            }
            if (defer) work_deferred(args, ws, lds, 3 * l + 0);
        }
        SEAM(pb + 5);
        if (PHEN(7) && IN(pb + 6)) for (int rep = 0; rep < NREP(7); ++rep) { ws = fresh_ws(ws);
            pg8::Gemm g{(const bf16*)(ws + WS_MG), (const bf16*)(ws + WS_WOUT) + (size_t)l * DM * DM, NTOK, DM, DM}; pg8::StaticOrder S; S.init(NTOK, DM, G, (int)blockIdx.x);
            pg8::EpiResid E{xin_p, xin_s, modl + 2 * DM, (float*)(ws + WS_XM)};
            pg8::gemm_phase<pg8::EpiResid, pg8::StaticOrder, true, true>(lds + RING_OFF, g, S, E);
            if (defer) work_deferred(args, ws, lds, 3 * l + 1);
        }
        SEAM(pb + 6);
        if (PHEN(8) && IN(pb + 7)) for (int rep = 0; rep < NREP(8); ++rep) norm_phase((const float*)(ws + WS_XM), (const float*)(ws + WS_XM) + (size_t)NPROMPT * DM, args.in[12] + (size_t)l * DM, modl, 3, 4, Hb, G);
        SEAM(pb + 7);
        if (PHEN(9) && IN(pb + 8)) for (int rep = 0; rep < NREP(9); ++rep) { ws = fresh_ws(ws);
            pg8::Gemm g{Hb, (const bf16*)(ws + WS_WPQ) + (size_t)l * DM * DM, NTOK, DM, DM}; pg8::StaticOrder S; S.init(NTOK, DM, G, (int)blockIdx.x);
            pg8::EpiBf16<0> E{(bf16*)(ws + WS_QP), DM, nullptr, 0, 0, 1.f};
            pg8::gemm_phase<pg8::EpiBf16<0>, pg8::StaticOrder, true, true>(lds + RING_OFF, g, S, E);
            if (defer) work_deferred(args, ws, lds, 3 * l + 2);
        }
        SEAM(pb + 8);
#ifdef PROBE_DG
        dummy_gather(ws, PROBE_DG, G);
#endif
        if (PHEN(10) && IN(pb + 9)) for (int rep = 0; rep < NREP(10); ++rep) peer_topk_phase(args, ws, lds, l, G);
        SEAM(pb + 9);
        if (PHEN(11) && IN(pb + 10)) for (int rep = 0; rep < NREP(11); ++rep) peer_gather_phase(args, ws, lds, l, l == 0 ? (float*)(ws + WS_X1) : args.out, G, 0xffffu, 0, l == 0 && n1fused);
#ifdef PROBE_GS
        peer_gather_phase(args, ws, lds, l, (float*)(ws + WS_QA), G, 0xffffu, PROBE_GS);
#endif
#ifdef PROBE_GM
        peer_gather_phase(args, ws, lds, l, (float*)(ws + WS_QA), G, PROBE_GM, PROBE_GSK);
#endif
        if (l == 0) SEAM(pb + 10);
    }
#undef MODall
#undef Hb
#undef Zb
#undef IN
#undef SEAM
}

extern "C" void kernel_launch(void* const* d_in, const int* in_sizes, int n_in, void* d_out, int out_size, void* d_ws, size_t ws_size, hipStream_t stream) {
    static int grid = 0;
    if (grid == 0) {
        if (n_in != 26 || (size_t)out_size != OUT_TOTAL || ws_size < WS_END) { fprintf(stderr, "kernel_launch: shape mismatch: n_in %d out %d ws %zu (need %zu)\n", n_in, out_size, ws_size, (size_t)WS_END); grid = -1; return; }
        int dev = 0, cus = 0, per_cu = 0;
        if (hipGetDevice(&dev) != hipSuccess || hipDeviceGetAttribute(&cus, hipDeviceAttributeMultiprocessorCount, dev) != hipSuccess) { grid = -1; return; }
        if (hipFuncSetAttribute((const void*)mk_fwd, hipFuncAttributeMaxDynamicSharedMemorySize, LDS_BYTES) != hipSuccess) { fprintf(stderr, "kernel_launch: hipFuncSetAttribute failed\n"); grid = -1; return; }
        if (hipOccupancyMaxActiveBlocksPerMultiprocessor(&per_cu, (const void*)mk_fwd, 512, LDS_BYTES) != hipSuccess || per_cu < 1) { fprintf(stderr, "kernel_launch: occupancy query says %d\n", per_cu); per_cu = 1; }
        (void)hipGetLastError();
        grid = cus;
    }
    if (grid < 0) return;
    (void)hipMemsetAsync((char*)d_ws + WS_CTL, 0, CTL_ZERO_BYTES, stream);
    Args a{};
    for (int i = 0; i < 26; ++i) a.in[i] = (const float*)d_in[i];
    a.out = (float*)d_out; a.ws = (unsigned char*)d_ws;
#if N_LAUNCH_MODE == 0
    a.ph_lo = 0; a.ph_hi = NPH;
    hipLaunchKernelGGL(mk_fwd, dim3(grid), dim3(512), LDS_BYTES, stream, a);
#else
    for (int p = 0; p < NPH; ++p) { a.ph_lo = p; a.ph_hi = p + 1; hipLaunchKernelGGL(mk_fwd, dim3(grid), dim3(512), LDS_BYTES, stream, a); }
#endif
    const hipError_t le = hipPeekAtLastError();
    if (le != hipSuccess) fprintf(stderr, "kernel_launch: launch failed: %s\n", hipGetErrorName(le));
}
```

```cpp
#include <hip/hip_runtime.h>
#include <hip/hip_bf16.h>
#include <cstdio>
#include <cstdint>
#include <cmath>
#define PROBE_DUP 0
#define HG_PROBE 0
#define PROBE_XBAR 0

#ifndef N_LAUNCH_MODE
#define N_LAUNCH_MODE 0
#endif
__device__ __forceinline__ int fresh_tid() { int t = (int)threadIdx.x; asm volatile("" : "+v"(t)); return t; }
__device__ __forceinline__ unsigned char* fresh_ws(unsigned char* p) { __attribute__((address_space(1))) unsigned char* g = (__attribute__((address_space(1))) unsigned char*)p; asm volatile("" : "+s"(g)); return (unsigned char*)g; }
namespace pg8 {
#define PG8_LAS __attribute__((address_space(3)))
typedef unsigned short bf16_t;
typedef short bf16x8 __attribute__((ext_vector_type(8)));
typedef float f32x4 __attribute__((ext_vector_type(4)));
typedef unsigned u32x4 __attribute__((ext_vector_type(4)));
constexpr int BM = 256, BK = 64, HALF = 128, HTB = HALF * BK * 2  , STAGE_BYTES = 8 * HTB, NXCD = 8, WGM = 8;

__host__ __device__ __forceinline__ int lds_byte(int r, int c) { const int st = (r >> 4) * 2 + (c >> 5), rr = r & 15, cc = c & 31, ob = rr * 64 + cc * 2; return st * 1024 + (ob ^ (((ob >> 9) & 1) << 5)); }
__host__ __device__ __forceinline__ void stage_rc(int b, int& R, int& C) { const int st = b / 1024, sb = b % 1024, swz = sb ^ (((sb >> 9) & 1) << 5); R = (st >> 1) * 16 + swz / 64; C = (st & 1) * 32 + (swz % 64) / 2; }
__host__ __device__ __forceinline__ int perm32(int rho) { const int n = rho >> 4, i = rho & 15; return 8 * (i >> 2) + 4 * n + (i & 3); }

struct Unit { int pm, pn; };
struct Gemm { const bf16_t* A; const bf16_t* Bt; int M, N, K; };

struct StaticOrder {
    int nM, nN, nwg, G, c;
    __host__ __device__ void init(int M, int N, int G_, int c_) { nM = M / BM; nN = N / BM; nwg = nM * nN; G = G_; c = c_; }
    __host__ __device__ bool next(int i, Unit& u) const {
        const long L = (long)i * G + c; if (L >= nwg) return false;
        int wgid = (int)L; { const int q = nwg / NXCD, r = nwg % NXCD, xcd = wgid % NXCD, off = wgid / NXCD; wgid = (xcd < r ? xcd * (q + 1) : r * (q + 1) + (xcd - r) * q) + off; }
        const int nig = WGM * nN, gid = wgid / nig, fm = gid * WGM, gsz = (nM - fm) < WGM ? (nM - fm) : WGM;
        u.pm = fm + ((wgid % nig) % gsz); u.pn = (wgid % nig) / gsz; return true;
    }
    __device__ __forceinline__ void a_ready(const Unit&) const {}
    __device__ __forceinline__ void done(const Unit&) const {}
};

__device__ __forceinline__ unsigned cvt_pk_bf16(float lo, float hi) { unsigned r; asm volatile("v_cvt_pk_bf16_f32 %0, %1, %2" : "=v"(r) : "v"(lo), "v"(hi)); return r; }
typedef float f32x2 __attribute__((ext_vector_type(2)));
__device__ __forceinline__ f32x2 gelu_pk(f32x2 v) {
    const f32x2 av = __builtin_elementwise_abs(v), d = av * 0.2316418882f + 1.0f;
    f32x2 t; t.x = __builtin_amdgcn_rcpf(d.x); t.y = __builtin_amdgcn_rcpf(d.y);
    f32x2 q = t * 0.5307027145f + (-0.7265760135f); q = q * t + 0.7107068705f; q = q * t + (-0.142248368f); q = q * t + 0.127414796f; q = q * t;
    const f32x2 s = (v * v) * (-0.72134752044f);
    f32x2 e; e.x = __builtin_amdgcn_exp2f(s.x); e.y = __builtin_amdgcn_exp2f(s.y);
    const f32x2 m = v * (q * e), r = v - m;
    f32x2 o; o.x = v.x < 0.f ? m.x : r.x; o.y = v.y < 0.f ? m.y : r.y; return o;
}

template <int ACT  > struct EpiBf16 {
    static constexpr bool PERM = true, AFTER_DRAIN = false; static_assert(ACT == 0 || ACT == 1, "EpiBf16: ACT is 0 (none) or 1 (gelu_pk)");
    bf16_t* O; int ldc; const float* bias; int split_cols; size_t split_stride; float scale0;
    __device__ __forceinline__ void operator()(const f32x4 (&acc)[2][2][4][2], const Unit& u, int wr, int wc, int fr, int fq) const {
        const int row0 = u.pm * BM + wr * 64 + fr; int colt = u.pn * BM; bf16_t* base = O;
        float sc = 1.f; if (split_cols) { const int t = colt / split_cols; base += (size_t)t * split_stride; colt -= t * split_cols; if (t == 0) sc = scale0; }
        const int col0 = colt + wc * 32 + 8 * fq, bcol0 = u.pn * BM + wc * 32 + 8 * fq;
        f32x4 bv[2][2];
#pragma unroll
        for (int bj = 0; bj < 2; ++bj)
#pragma unroll
            for (int n = 0; n < 2; ++n) bv[bj][n] = bias ? *(const f32x4*)(bias + bcol0 + bj * HALF + 4 * n) : (f32x4){0.f, 0.f, 0.f, 0.f};
#pragma unroll
        for (int ai = 0; ai < 2; ++ai)
#pragma unroll
            for (int m = 0; m < 4; ++m) { bf16_t* rowp = base + (size_t)(row0 + ai * HALF + m * 16) * ldc + col0;
#pragma unroll
                for (int bj = 0; bj < 2; ++bj) { f32x4 v0 = acc[ai][bj][m][0] + bv[bj][0], v1 = acc[ai][bj][m][1] + bv[bj][1];
                    if (ACT == 1) { f32x2 a = gelu_pk((f32x2){v0[0], v0[1]}), b = gelu_pk((f32x2){v0[2], v0[3]}), c = gelu_pk((f32x2){v1[0], v1[1]}), d = gelu_pk((f32x2){v1[2], v1[3]});
                        v0 = (f32x4){a.x, a.y, b.x, b.y}; v1 = (f32x4){c.x, c.y, d.x, d.y}; }
                    v0 = v0 * sc; v1 = v1 * sc; u32x4 w; w.x = cvt_pk_bf16(v0[0], v0[1]); w.y = cvt_pk_bf16(v0[2], v0[3]); w.z = cvt_pk_bf16(v1[0], v1[1]); w.w = cvt_pk_bf16(v1[2], v1[3]);
                    *(u32x4*)(rowp + bj * HALF) = w; } }
    }
};

struct EpiF32 {
    static constexpr bool PERM = false, AFTER_DRAIN = false;
    float* C; int ldc;
    __device__ __forceinline__ void operator()(const f32x4 (&acc)[2][2][4][2], const Unit& u, int wr, int wc, int fr, int fq) const {
        const int row0 = u.pm * BM + wr * 64 + fr, col0 = u.pn * BM + wc * 32 + 4 * fq;
#pragma unroll
        for (int ai = 0; ai < 2; ++ai)
#pragma unroll
            for (int m = 0; m < 4; ++m) { float* rowp = C + (size_t)(row0 + ai * HALF + m * 16) * ldc + col0;
#pragma unroll
                for (int bj = 0; bj < 2; ++bj)
#pragma unroll
                    for (int n = 0; n < 2; ++n) *(f32x4*)(rowp + bj * HALF + n * 16) = acc[ai][bj][m][n]; }
    }
};
__device__ __forceinline__ float sigmoid_f(float x) { return __builtin_amdgcn_rcpf(1.0f + __builtin_amdgcn_exp2f(-1.4426950408889634f * x)); }
struct EpiGate {
    static constexpr bool PERM = true, AFTER_DRAIN = false;
    const bf16_t* Z; int ldz; int gcol0; bf16_t* P; bf16_t* O; int ldc; int MODE;
    __device__ __forceinline__ void operator()(const f32x4 (&acc)[2][2][4][2], const Unit& u, int wr, int wc, int fr, int fq) const {
        const int row0 = u.pm * BM + wr * 64 + fr, col0 = u.pn * BM + wc * 32 + 8 * fq;
#pragma unroll
        for (int ai = 0; ai < 2; ++ai)
#pragma unroll
            for (int m = 0; m < 4; ++m) { const int row = row0 + ai * HALF + m * 16;
#pragma unroll
                for (int bj = 0; bj < 2; ++bj) { const int col = col0 + bj * HALF;
                    const u32x4 gz = *(const u32x4*)(Z + (size_t)row * ldz + gcol0 + col);
                    f32x4 s0, s1;
                    s0[0] = sigmoid_f(__uint_as_float(gz[0] << 16)); s0[1] = sigmoid_f(__uint_as_float(gz[0] & 0xffff0000u));
                    s0[2] = sigmoid_f(__uint_as_float(gz[1] << 16)); s0[3] = sigmoid_f(__uint_as_float(gz[1] & 0xffff0000u));
                    s1[0] = sigmoid_f(__uint_as_float(gz[2] << 16)); s1[1] = sigmoid_f(__uint_as_float(gz[2] & 0xffff0000u));
                    s1[2] = sigmoid_f(__uint_as_float(gz[3] << 16)); s1[3] = sigmoid_f(__uint_as_float(gz[3] & 0xffff0000u));
                    f32x4 v0 = acc[ai][bj][m][0] * s0, v1 = acc[ai][bj][m][1] * s1;
                    bf16_t* pp = P + (size_t)row * ldc + col;
                    if (MODE >= 1) { const u32x4 pw = *(const u32x4*)pp;
                        v0[0] += __uint_as_float(pw[0] << 16); v0[1] += __uint_as_float(pw[0] & 0xffff0000u); v0[2] += __uint_as_float(pw[1] << 16); v0[3] += __uint_as_float(pw[1] & 0xffff0000u);
                        v1[0] += __uint_as_float(pw[2] << 16); v1[1] += __uint_as_float(pw[2] & 0xffff0000u); v1[2] += __uint_as_float(pw[3] << 16); v1[3] += __uint_as_float(pw[3] & 0xffff0000u); }
                    u32x4 w; w.x = cvt_pk_bf16(v0[0], v0[1]); w.y = cvt_pk_bf16(v0[2], v0[3]); w.z = cvt_pk_bf16(v1[0], v1[1]); w.w = cvt_pk_bf16(v1[2], v1[3]);
                    *(u32x4*)((MODE <= 1 ? pp : O + (size_t)row * ldc + col)) = w; } }
    }
};
struct EpiResid {
    static constexpr bool PERM = false, AFTER_DRAIN = false;
    const float* xp; const float* xs; const float* gate; float* out;
    __device__ __forceinline__ void operator()(const f32x4 (&acc)[2][2][4][2], const Unit& u, int wr, int wc, int fr, int fq) const {
        const int row0 = u.pm * BM + wr * 64 + fr, col0 = u.pn * BM + wc * 32 + 4 * fq;
        const bool samp = u.pm >= 16; const int r = samp ? 1 + ((u.pm - 16) >> 2) : 0;
        const float* xb = samp ? xs - (size_t)4096 * 2048 : xp;
        f32x4 gv[2][2];
#pragma unroll
        for (int bj = 0; bj < 2; ++bj)
#pragma unroll
            for (int n = 0; n < 2; ++n) gv[bj][n] = *(const f32x4*)(gate + (size_t)r * 12288 + col0 + bj * HALF + n * 16);
#pragma unroll
        for (int ai = 0; ai < 2; ++ai)
#pragma unroll
            for (int m = 0; m < 4; ++m) { const size_t off = (size_t)(row0 + ai * HALF + m * 16) * 2048 + col0;
#pragma unroll
                for (int bj = 0; bj < 2; ++bj)
#pragma unroll
                    for (int n = 0; n < 2; ++n) { const f32x4 x = *(const f32x4*)(xb + off + bj * HALF + n * 16);
                        *(f32x4*)(out + off + bj * HALF + n * 16) = x + gv[bj][n] * acc[ai][bj][m][n]; } }
    }
};
struct EpiNull {
    static constexpr bool PERM = true, AFTER_DRAIN = false;
    float* sink;
    __device__ __forceinline__ void operator()(const f32x4 (&acc)[2][2][4][2], const Unit& u, int wr, int wc, int fr, int fq) const {
        f32x4 s = {0.f, 0.f, 0.f, 0.f};
#pragma unroll
        for (int ai = 0; ai < 2; ++ai)
#pragma unroll
            for (int bj = 0; bj < 2; ++bj)
#pragma unroll
                for (int m = 0; m < 4; ++m)
#pragma unroll
                    for (int n = 0; n < 2; ++n) s += acc[ai][bj][m][n];
        if (s[0] + s[1] + s[2] + s[3] == 1.2345e30f) *sink = 1.f;
    }
};

template <class Epi, class Sched, bool ALIGN_EPI = false, bool SP2 = false>
__device__ __forceinline__ void gemm_phase(PG8_LAS unsigned char* lds, const Gemm g, const Sched& S, const Epi& E) {
    const int tid = fresh_tid(), wid = __builtin_amdgcn_readfirstlane(tid >> 6), lane = tid & 63, wr = wid >> 2, wc = wid & 3, fr = lane & 15, fq = lane >> 4;
    const int K = g.K, nt = K / BK;
    unsigned voffA[2], voffB[2];
#pragma unroll
    for (int i = 0; i < 2; ++i) { int R, C; stage_rc(tid * 16 + i * 8192, R, C); const int Rb = Epi::PERM ? ((R & ~31) + perm32(R & 31)) : R;
        voffA[i] = (unsigned)(R * K + C) * 2u; voffB[i] = (unsigned)(Rb * K + C) * 2u; }
    const size_t kstep = (size_t)(BK * 2);
    const size_t hstep = (size_t)HALF * K * 2;
    const size_t tstep = 2 * hstep;
    const unsigned ldsw = (unsigned)wid * 1024u;
    const int aoff = lds_byte(wr * 64 + fr, fq * 8), boff = lds_byte(wc * 32 + fr, fq * 8);
#define PG8_SA(b, h) (((b) * 2 + (h)) * HTB)
#define PG8_SB(b, h) ((4 + (b) * 2 + (h)) * HTB)
#define PG8_STAGE(bufoff, gbase, voff) do { _Pragma("unroll") for (int _i = 0; _i < 2; ++_i) \
        __builtin_amdgcn_global_load_lds((const unsigned*)((const char*)(gbase) + (voff)[_i]), (PG8_LAS unsigned*)(lds + (bufoff) + ldsw + _i * 8192), 16, 0, 0); } while (0)
#define PG8_LDA(dst, b, h) do { _Pragma("unroll") for (int m = 0; m < 4; ++m) _Pragma("unroll") for (int k = 0; k < 2; ++k) dst[m][k] = *(const PG8_LAS bf16x8*)(lds + PG8_SA(b, h) + aoff + m * 2048 + k * 1024); } while (0)
#define PG8_LDB(dst, b, h) do { _Pragma("unroll") for (int n = 0; n < 2; ++n) _Pragma("unroll") for (int k = 0; k < 2; ++k) dst[n][k] = *(const PG8_LAS bf16x8*)(lds + PG8_SB(b, h) + boff + n * 2048 + k * 1024); } while (0)
#define PG8_MMA(ai, bj, At, Bt) do { __builtin_amdgcn_s_setprio(1); _Pragma("unroll") for (int m = 0; m < 4; ++m) _Pragma("unroll") for (int n = 0; n < 2; ++n) _Pragma("unroll") for (int k = 0; k < 2; ++k) \
        acc[ai][bj][m][n] = __builtin_amdgcn_mfma_f32_16x16x32_bf16(Bt[n][k], At[m][k], acc[ai][bj][m][n], 0, 0, 0); __builtin_amdgcn_s_setprio(0); } while (0)
#define PG8_WAIT_V(n) asm volatile("s_waitcnt vmcnt(" #n ")" ::: "memory")
#define PG8_WAIT_L(n) asm volatile("s_waitcnt lgkmcnt(" #n ")" ::: "memory")
#define PG8_BAR __builtin_amdgcn_s_barrier()
#define PG8_SCHED __builtin_amdgcn_sched_barrier(0)
    Unit cur, nxt; int ui = 0;
    if (!S.next(0, cur)) return;
    f32x4 acc[2][2][4][2];
#pragma unroll
    for (int a = 0; a < 2; ++a)
#pragma unroll
        for (int b = 0; b < 2; ++b)
#pragma unroll
            for (int m = 0; m < 4; ++m)
#pragma unroll
                for (int n = 0; n < 2; ++n) acc[a][b][m][n] = (f32x4){0.f, 0.f, 0.f, 0.f};
    bf16x8 At[4][2], B0[2][2], B1[2][2];
    const char* cA = (const char*)g.A + (size_t)cur.pm * tstep; const char* cB = (const char*)g.Bt + (size_t)cur.pn * tstep;
    S.a_ready(cur);
    if constexpr (SP2) {
        PG8_STAGE(PG8_SB(0, 0), cB, voffB); PG8_STAGE(PG8_SB(0, 1), cB + hstep, voffB); PG8_STAGE(PG8_SA(0, 0), cA, voffA); PG8_STAGE(PG8_SA(0, 1), cA + hstep, voffA);
        if (wr == 1) PG8_BAR;
        PG8_WAIT_V(2); PG8_BAR;
        PG8_STAGE(PG8_SB(1, 0), cB + kstep, voffB); PG8_STAGE(PG8_SA(1, 0), cA + kstep, voffA); PG8_STAGE(PG8_SB(1, 1), cB + hstep + kstep, voffB);
        PG8_WAIT_V(6); PG8_BAR;
    } else {
        PG8_STAGE(PG8_SB(0, 0), cB, voffB); PG8_STAGE(PG8_SA(0, 0), cA, voffA); PG8_STAGE(PG8_SB(0, 1), cB + hstep, voffB); PG8_STAGE(PG8_SA(0, 1), cA + hstep, voffA);
        if (wr == 1) PG8_BAR;
        PG8_WAIT_V(4); PG8_BAR;
        PG8_STAGE(PG8_SB(1, 0), cB + kstep, voffB); PG8_STAGE(PG8_SA(1, 0), cA + kstep, voffA); PG8_STAGE(PG8_SB(1, 1), cB + hstep + kstep, voffB);
        PG8_WAIT_V(6); PG8_BAR;
    }
    for (;;) {
        const bool has_next = S.next(ui + 1, nxt);
        const char* nA = has_next ? (const char*)g.A + (size_t)nxt.pm * tstep : cA; const char* nB = has_next ? (const char*)g.Bt + (size_t)nxt.pn * tstep : cB;
        for (int t = 0; t < nt; t += 2) {
            const bool last = (t == nt - 2);
            const char* a1 = cA + (size_t)(t + 1) * kstep;
            const char* a2 = last ? nA : cA + (size_t)(t + 2) * kstep; const char* b2 = last ? nB : cB + (size_t)(t + 2) * kstep;
            const char* a3 = a2 + kstep; const char* b3 = b2 + kstep;
            if (last && has_next) S.a_ready(nxt);
            if constexpr (SP2) {
            PG8_LDB(B0, 0, 0); PG8_LDB(B1, 0, 1); PG8_SCHED; PG8_LDA(At, 0, 0); PG8_STAGE(PG8_SA(1, 1), a1 + hstep, voffA);
            PG8_WAIT_V(8); PG8_WAIT_L(0); PG8_BAR; PG8_MMA(0, 0, At, B0); PG8_MMA(0, 1, At, B1); PG8_BAR; PG8_SCHED;
            PG8_LDA(At, 0, 1); PG8_STAGE(PG8_SB(0, 0), b2, voffB); PG8_STAGE(PG8_SB(0, 1), b2 + hstep, voffB); PG8_STAGE(PG8_SA(0, 0), a2, voffA);
            PG8_WAIT_V(8); PG8_WAIT_L(0); PG8_BAR; PG8_MMA(1, 0, At, B0); PG8_MMA(1, 1, At, B1); PG8_BAR; PG8_SCHED;
            PG8_LDB(B0, 1, 0); PG8_LDB(B1, 1, 1); PG8_SCHED; PG8_LDA(At, 1, 0); PG8_STAGE(PG8_SA(0, 1), a2 + hstep, voffA);
            PG8_WAIT_V(8); PG8_WAIT_L(0); PG8_BAR; PG8_MMA(0, 0, At, B0); PG8_MMA(0, 1, At, B1); PG8_BAR; PG8_SCHED;
            PG8_LDA(At, 1, 1); PG8_STAGE(PG8_SB(1, 0), b3, voffB); PG8_STAGE(PG8_SB(1, 1), b3 + hstep, voffB); PG8_STAGE(PG8_SA(1, 0), a3, voffA);
            PG8_WAIT_V(8); PG8_WAIT_L(0); PG8_BAR; PG8_MMA(1, 0, At, B0); PG8_MMA(1, 1, At, B1); PG8_BAR; PG8_SCHED;
            } else {
            PG8_LDB(B0, 0, 0); PG8_SCHED; PG8_LDA(At, 0, 0); PG8_STAGE(PG8_SA(1, 1), a1 + hstep, voffA);
            PG8_WAIT_L(8); PG8_BAR; PG8_WAIT_L(0); PG8_MMA(0, 0, At, B0); PG8_BAR; PG8_SCHED;
            PG8_LDB(B1, 0, 1); PG8_STAGE(PG8_SB(0, 0), b2, voffB);
            PG8_BAR; PG8_WAIT_L(0); PG8_MMA(0, 1, At, B1); PG8_BAR;
            PG8_LDA(At, 0, 1); PG8_STAGE(PG8_SA(0, 0), a2, voffA);
            PG8_BAR; PG8_WAIT_L(0); PG8_MMA(1, 0, At, B0); PG8_BAR; PG8_SCHED;
            PG8_STAGE(PG8_SB(0, 1), b2 + hstep, voffB);
            PG8_WAIT_V(6); PG8_BAR; PG8_MMA(1, 1, At, B1); PG8_BAR;
            PG8_LDB(B0, 1, 0); PG8_SCHED; PG8_LDA(At, 1, 0); PG8_STAGE(PG8_SA(0, 1), a2 + hstep, voffA);
            PG8_WAIT_L(8); PG8_BAR; PG8_WAIT_L(0); PG8_MMA(0, 0, At, B0); PG8_BAR; PG8_SCHED;
            PG8_LDB(B1, 1, 1); PG8_STAGE(PG8_SB(1, 0), b3, voffB);
            PG8_BAR; PG8_WAIT_L(0); PG8_MMA(0, 1, At, B1); PG8_BAR;
            PG8_LDA(At, 1, 1); PG8_STAGE(PG8_SA(1, 0), a3, voffA);
            PG8_BAR; PG8_WAIT_L(0); PG8_MMA(1, 0, At, B0); PG8_BAR; PG8_SCHED;
            PG8_STAGE(PG8_SB(1, 1), b3 + hstep, voffB);
            PG8_WAIT_V(6); PG8_BAR; PG8_MMA(1, 1, At, B1); PG8_BAR;
            }
        }
        if constexpr (ALIGN_EPI) { if (wr == 0) PG8_BAR; }
        if constexpr (!Epi::AFTER_DRAIN) { E(acc, cur, wr, wc, fr, fq); S.done(cur); }
        if (!has_next) break;
#pragma unroll
        for (int a = 0; a < 2; ++a)
#pragma unroll
            for (int b = 0; b < 2; ++b)
#pragma unroll
                for (int m = 0; m < 4; ++m)
#pragma unroll
                    for (int n = 0; n < 2; ++n) acc[a][b][m][n] = (f32x4){0.f, 0.f, 0.f, 0.f};
        cur = nxt; cA = nA; cB = nB; ++ui;
        if constexpr (ALIGN_EPI) { if (wr == 1) PG8_BAR; }
    }
    PG8_WAIT_V(0);
    if constexpr (!ALIGN_EPI) { if (wr == 0) PG8_BAR; }
    PG8_BAR;
    if constexpr (Epi::AFTER_DRAIN) { E.fused(acc, cur, wr, wc, fr, fq, lds, wid, lane); S.done(cur); }
#undef PG8_SA
#undef PG8_SB
#undef PG8_STAGE
#undef PG8_LDA
#undef PG8_LDB
#undef PG8_MMA
#undef PG8_WAIT_V
#undef PG8_WAIT_L
#undef PG8_BAR
#undef PG8_SCHED
}
}

namespace att {
using bf16 = __hip_bfloat16;
constexpr int D = 128, NW = 8, QBLK = 32, KVBLK = 64;
constexpr float SCALE = 1.0f;
constexpr float THR = 8.f;
constexpr int SDEPTH = 2;
constexpr int LDQ = 3072, LDK = 1280, LDO = 3072;
constexpr size_t SHM_V = KVBLK * D * 2, SHM_K = KVBLK * D * 2, SHM_ATTN = 2 * SHM_V + 2 * SHM_K + NW * 64 * 4;
typedef __bf16 abf16x2_t __attribute__((ext_vector_type(2))); typedef float af32x2_t __attribute__((ext_vector_type(2)));
__device__ __forceinline__ unsigned short bf1(float x) { const af32x2_t v = {x, x}; const abf16x2_t b = __builtin_convertvector(v, abf16x2_t); return (unsigned short)(__builtin_bit_cast(unsigned, b) & 0xffffu); }
using bf16x8 = __attribute__((ext_vector_type(8))) short;
using s16x4  = __attribute__((ext_vector_type(4))) short;
using f32x16 = __attribute__((ext_vector_type(16))) float;
using f32x8  = __attribute__((ext_vector_type(8))) float;
using u32x4  = __attribute__((ext_vector_type(4))) unsigned;
#define KSWZ(row, colB) ((row) * 256 + ((colB) ^ (((row) & 7) << 4)))
#define SBAR() __builtin_amdgcn_sched_barrier(0)
__device__ __forceinline__ int crow(int r, int hi) { return (r & 3) + 8 * (r >> 2) + 4 * hi; }
__device__ __forceinline__ unsigned cvtpk(float lo, float hi) {
  unsigned r; asm volatile("v_cvt_pk_bf16_f32 %0, %1, %2" : "=v"(r) : "v"(lo), "v"(hi)); return r;
}
template <typename TIn> struct Stage;
template <> struct Stage<bf16>  { using T = bf16x8;
  __device__ static __forceinline__ T ld8(const bf16* p) { return *reinterpret_cast<const bf16x8*>(p); }
  __device__ static __forceinline__ bf16x8 tobf(T x) { return x; } };
template <> struct Stage<float> { using T = f32x8;
  __device__ static __forceinline__ T ld8(const float* p) { return *reinterpret_cast<const f32x8*>(p); }
  __device__ static __forceinline__ bf16x8 tobf(T x) {
    u32x4 w = {cvtpk(x[0], x[1]), cvtpk(x[2], x[3]), cvtpk(x[4], x[5]), cvtpk(x[6], x[7])}; return *reinterpret_cast<bf16x8*>(&w); } };

__device__ __forceinline__ void partialSM(f32x16& p0, f32x16& p1, float& m_reg, float& mn, float& alpha) {
  constexpr float C = SCALE * 1.4426950408889634f;
  float pmax = p0[0]; for (int r = 1; r < 16; ++r) pmax = fmaxf(pmax, p0[r]); for (int r = 0; r < 16; ++r) pmax = fmaxf(pmax, p1[r]);
  { auto rr = __builtin_amdgcn_permlane32_swap(__float_as_uint(pmax), __float_as_uint(pmax), false, false);
    pmax = fmaxf(__uint_as_float(rr[0]), __uint_as_float(rr[1])); }
  if (__builtin_expect(__all(pmax - m_reg <= THR / SCALE), 1)) { mn = m_reg; alpha = 1.f; }
  else { mn = fmaxf(m_reg, pmax); alpha = __builtin_amdgcn_exp2f((m_reg - mn) * C); m_reg = mn; }
  float mnC = -mn * C;
  for (int r = 0; r < 16; ++r) p0[r] = fmaf(p0[r], C, mnC); for (int r = 0; r < 16; ++r) p1[r] = fmaf(p1[r], C, mnC);
  for (int r = 0; r < 16; ++r) p0[r] = __builtin_amdgcn_exp2f(p0[r]);
}
__device__ __forceinline__ void finishSM(f32x16& p0, f32x16& p1, float alpha, float& l_reg, bf16x8& pa0, bf16x8& pa1, bf16x8& pa2, bf16x8& pa3) {
  for (int r = 0; r < 16; ++r) p1[r] = __builtin_amdgcn_exp2f(p1[r]);
  float ps = 0; for (int r = 0; r < 16; ++r) ps += p0[r]; for (int r = 0; r < 16; ++r) ps += p1[r];
  { auto rr = __builtin_amdgcn_permlane32_swap(__float_as_uint(ps), __float_as_uint(ps), false, false);
    ps = __uint_as_float(rr[0]) + __uint_as_float(rr[1]); }
  l_reg = l_reg * alpha + ps;
#define PK4(P, BASE, OUT) do { unsigned a0 = cvtpk(P[BASE + 0], P[BASE + 1]), a1 = cvtpk(P[BASE + 2], P[BASE + 3]);   \
    unsigned b0 = cvtpk(P[BASE + 4], P[BASE + 5]), b1 = cvtpk(P[BASE + 6], P[BASE + 7]);                              \
    auto r0 = __builtin_amdgcn_permlane32_swap(a0, b0, false, false); auto r1 = __builtin_amdgcn_permlane32_swap(a1, b1, false, false); \
    u32x4 w = {r0[0], r1[0], r0[1], r1[1]}; OUT = *reinterpret_cast<bf16x8*>(&w); } while (0)
  PK4(p0, 0, pa0); PK4(p0, 8, pa1); PK4(p1, 0, pa2); PK4(p1, 8, pa3);
#undef PK4
}
__device__ __forceinline__ void qkt(f32x16& p0, f32x16& p1, const bf16* Ks, const bf16x8* qr, int r32, int hi) {
  p0 = f32x16{}; p1 = f32x16{};
  for (int d0 = 0; d0 < 8; ++d0) { int cb = (d0 * 16 + hi * 8) * 2;
    bf16x8 b0 = *reinterpret_cast<const bf16x8*>((const char*)Ks + KSWZ(r32, cb));
    bf16x8 b1 = *reinterpret_cast<const bf16x8*>((const char*)Ks + KSWZ(32 + r32, cb));
    p0 = __builtin_amdgcn_mfma_f32_32x32x16_bf16(b0, qr[d0], p0, 0, 0, 0);
    p1 = __builtin_amdgcn_mfma_f32_32x32x16_bf16(b1, qr[d0], p1, 0, 0, 0); }
}
__device__ __forceinline__ int v_st(int k, int c) { const int kk = (k & ~0xC) | ((k & 4) << 1) | ((k & 8) >> 1); return ((kk >> 3) * 4 + (c >> 5)) * 512 + ((kk & 7) * 32 + (c & 31)) * 2; }
__device__ __forceinline__ int v_rd_base(int lane) { return ((lane & 3) << 3) | (((lane >> 2) & 3) << 6) | (((lane >> 4) & 1) << 5) | (((lane >> 5) & 1) << 8); }
constexpr int v_rd_off(int d0, int ks, int half) { return d0 * 512 + ks * 4096 + half * 2048; }
template <int OFF> __device__ __forceinline__ s16x4 tr_read(int vb) {
  s16x4 r; asm volatile("ds_read_b64_tr_b16 %0, %1 offset:%2" : "=&v"(r) : "v"(vb), "i"(OFF) : "memory"); return r;
}
template <int D0> __device__ __forceinline__ void pv_one(f32x16& od, int vb, bf16x8 pa0, bf16x8 pa1, bf16x8 pa2, bf16x8 pa3) {
  const s16x4 l0 = tr_read<v_rd_off(D0, 0, 0)>(vb), h0 = tr_read<v_rd_off(D0, 0, 1)>(vb), l1 = tr_read<v_rd_off(D0, 1, 0)>(vb), h1 = tr_read<v_rd_off(D0, 1, 1)>(vb);
  const s16x4 l2 = tr_read<v_rd_off(D0, 2, 0)>(vb), h2 = tr_read<v_rd_off(D0, 2, 1)>(vb), l3 = tr_read<v_rd_off(D0, 3, 0)>(vb), h3 = tr_read<v_rd_off(D0, 3, 1)>(vb);
  asm volatile("s_waitcnt lgkmcnt(0)" ::: "memory"); SBAR();
#define PK(L, H) (bf16x8){L[0], L[1], L[2], L[3], H[0], H[1], H[2], H[3]}
  od = __builtin_amdgcn_mfma_f32_32x32x16_bf16(pa0, PK(l0, h0), od, 0, 0, 0);
  od = __builtin_amdgcn_mfma_f32_32x32x16_bf16(pa1, PK(l1, h1), od, 0, 0, 0);
  od = __builtin_amdgcn_mfma_f32_32x32x16_bf16(pa2, PK(l2, h2), od, 0, 0, 0);
  od = __builtin_amdgcn_mfma_f32_32x32x16_bf16(pa3, PK(l3, h3), od, 0, 0, 0);
#undef PK
}
__device__ __forceinline__ void pv_d0(f32x16* o, int vb, bf16x8 pa0, bf16x8 pa1, bf16x8 pa2, bf16x8 pa3) {
  pv_one<0>(o[0], vb, pa0, pa1, pa2, pa3); pv_one<1>(o[1], vb, pa0, pa1, pa2, pa3); pv_one<2>(o[2], vb, pa0, pa1, pa2, pa3); pv_one<3>(o[3], vb, pa0, pa1, pa2, pa3);
}

template <typename TQ>
__device__ __forceinline__ void attn_dense_body(const TQ* __restrict__ Qb, const bf16* __restrict__ Kh, const bf16* __restrict__ Vh,
                                                unsigned short* __restrict__ Ob, int seq, char* lds) {
  using St = Stage<bf16>; using SQ = Stage<TQ>;
  const int tid = fresh_tid(), wid = tid >> 6, lane = tid & 63, r32 = lane & 31, hi = lane >> 5;
  bf16* V_lds = (bf16*)lds; bf16* K_lds = (bf16*)(lds + 2 * SHM_V);
  float* ws = (float*)(lds + 2 * SHM_V + 2 * SHM_K) + wid * 64; float* li_l = ws; float* al_l = ws + 32;
  float m_reg = -1e30f, l_reg = 0; f32x16 o[4] = {}; bf16x8 qr[8];
  const TQ* Qw = Qb + (long)(wid * QBLK + r32) * LDQ + hi * 8;
#pragma unroll
  for (int d0 = 0; d0 < 8; ++d0) qr[d0] = SQ::tobf(SQ::ld8(Qw + d0 * 16));
  const int sr = tid >> 4, sc = (tid & 15) * 8, vst0 = v_st(sr, sc), vst1 = v_st(32 + sr, sc);
  const int vb0 = (int)(uintptr_t)V_lds + v_rd_base(lane);
  struct { typename St::T vs0, vs1, ks0, ks1; } sr_[SDEPTH];
#define SLOAD(i, k0) do { sr_[i].vs0 = St::ld8(&Vh[(long)((k0) + sr) * LDK + sc]); sr_[i].vs1 = St::ld8(&Vh[(long)((k0) + 32 + sr) * LDK + sc]); \
    sr_[i].ks0 = St::ld8(&Kh[(long)((k0) + sr) * LDK + sc]); sr_[i].ks1 = St::ld8(&Kh[(long)((k0) + 32 + sr) * LDK + sc]); } while (0)
#define SWRITE(b, i) do { *(bf16x8*)((char*)V_lds + (b) * SHM_V + vst0) = St::tobf(sr_[i].vs0);          \
    *(bf16x8*)((char*)V_lds + (b) * SHM_V + vst1) = St::tobf(sr_[i].vs1); int kc = sc * 2;               \
    *(bf16x8*)((char*)K_lds + (b) * SHM_K + KSWZ(sr, kc)) = St::tobf(sr_[i].ks0);                       \
    *(bf16x8*)((char*)K_lds + (b) * SHM_K + KSWZ(32 + sr, kc)) = St::tobf(sr_[i].ks1); } while (0)
#define SWAIT() do { if constexpr (SDEPTH == 2) asm volatile("s_waitcnt vmcnt(4)" ::: "memory"); else asm volatile("s_waitcnt vmcnt(0)" ::: "memory"); } while (0)
#define RESC(a) do { if (__any((a) < 1.f)) { if (hi == 0) al_l[r32] = (a); asm volatile("s_waitcnt lgkmcnt(0)" ::: "memory"); \
    for (int d = 0; d < 4; ++d) for (int r = 0; r < 16; ++r) o[d][r] *= al_l[crow(r, hi)]; } } while (0)
  f32x16 pA0, pA1, pB0, pB1; float mnA, mnB, alA, alB; bf16x8 pa0, pa1, pa2, pa3; const int NT = seq / KVBLK;
  constexpr int SE = 0, SO = SDEPTH - 1;
  SLOAD(SE, 0); asm volatile("s_waitcnt vmcnt(0)" ::: "memory"); SWRITE(0, SE); __syncthreads();
  qkt(pA0, pA1, K_lds, qr, r32, hi); partialSM(pA0, pA1, m_reg, mnA, alA);
  SLOAD(SO, KVBLK); if constexpr (SDEPTH == 2) { if (2 < NT) SLOAD(SE, 2 * KVBLK); }
  SWAIT(); SWRITE(1, SO); __syncthreads();
  for (int j = 1; j + 1 < NT; j += 2) {
    SBAR(); qkt(pB0, pB1, (bf16*)((char*)K_lds + SHM_K), qr, r32, hi);
    finishSM(pA0, pA1, alA, l_reg, pa0, pa1, pa2, pa3); SBAR();
    SLOAD(SO, (j + SDEPTH) * KVBLK); SBAR();
    pv_d0(o, vb0, pa0, pa1, pa2, pa3); partialSM(pB0, pB1, m_reg, mnB, alB);
    __syncthreads(); SWAIT(); SWRITE(0, SE);
    RESC(alB); __syncthreads();
    SBAR(); qkt(pA0, pA1, K_lds, qr, r32, hi);
    finishSM(pB0, pB1, alB, l_reg, pa0, pa1, pa2, pa3); SBAR();
    if (SDEPTH == 1 || j + 3 < NT) SLOAD(SE, (j + 1 + SDEPTH) * KVBLK); SBAR();
    pv_d0(o, vb0 + (int)SHM_V, pa0, pa1, pa2, pa3); partialSM(pA0, pA1, m_reg, mnA, alA);
    __syncthreads(); SWAIT(); SWRITE(1, SO);
    RESC(alA); __syncthreads();
  }
  SBAR(); qkt(pB0, pB1, (bf16*)((char*)K_lds + SHM_K), qr, r32, hi);
  finishSM(pA0, pA1, alA, l_reg, pa0, pa1, pa2, pa3); SBAR();
  pv_d0(o, vb0, pa0, pa1, pa2, pa3); partialSM(pB0, pB1, m_reg, mnB, alB);
  __syncthreads(); RESC(alB);
  finishSM(pB0, pB1, alB, l_reg, pa0, pa1, pa2, pa3); SBAR();
  pv_d0(o, vb0 + (int)SHM_V, pa0, pa1, pa2, pa3);
  if (hi == 0) li_l[r32] = l_reg; asm volatile("s_waitcnt lgkmcnt(0)" ::: "memory");
  float rli[16];
#pragma unroll
  for (int r = 0; r < 16; ++r) rli[r] = __builtin_amdgcn_rcpf(li_l[crow(r, hi)]);
  unsigned short* Ow = Ob + (long)(wid * QBLK) * LDO;
#pragma unroll
  for (int r = 0; r < 16; ++r) { int orow = crow(r, hi);
    for (int d0 = 0; d0 < 4; ++d0) Ow[(long)orow * LDO + d0 * 32 + r32] = bf1(o[d0][r] * rli[r]); }
#undef SLOAD
#undef SWRITE
#undef SWAIT
#undef RESC
}
}

constexpr int DM = 2048, NTOK = 6144, NPROMPT = 4096, INW = 15872;
constexpr int C_HQ = 0, C_HF = 1024, C_HI = 3072, C_HG = 4096, C_DQ = 5120, C_DK = 6144, C_DV = 7168, C_GQ = 8192, C_GK = 9216, C_GV = 9472, C_GATE = 9728;
constexpr int KROWS = 4096 + 2 * 1280;
constexpr int KVW = 1280;
constexpr float EPS = 1e-6f;
constexpr int NPH = 23;

constexpr size_t MiB = 1u << 20;
constexpr size_t WS_CTL = 0, CTL_ZERO_BYTES = 1 * MiB;
constexpr size_t WS_MOD = 1 * MiB, WS_ROPE = 2 * MiB, WS_WIN = 3 * MiB, WS_WBR = 127 * MiB, WS_WOUT = 151 * MiB, WS_WPQ = 167 * MiB, WS_PU = 183 * MiB, WS_PV = 311 * MiB;
constexpr size_t WS_H = 439 * MiB, WS_Z = 463 * MiB, WS_QA = 649 * MiB, WS_KA = 685 * MiB, WS_VA = 702 * MiB, WS_OA = 719 * MiB, WS_OH = 791 * MiB, WS_BR = 839 * MiB, WS_MG = 875 * MiB;
constexpr size_t WS_XM = 899 * MiB, WS_X1 = 947 * MiB, WS_PE = 995 * MiB, WS_PG = 998 * MiB, WS_END = 1001 * MiB;
constexpr size_t WS_UV8 = WS_PU, WS_SC = WS_PV;
constexpr size_t WS_QP = WS_OA;
constexpr size_t WS_MGP = WS_OH;
static_assert(WS_WIN + (size_t)2 * INW * DM * 2 <= WS_WBR && WS_Z + (size_t)NTOK * INW * 2 <= WS_QA && WS_KA + (size_t)KROWS * KVW * 2 <= WS_VA && WS_VA + (size_t)KROWS * KVW * 2 <= WS_OA, "d_ws map");
static_assert(WS_OA + (size_t)NTOK * 3072 * 4 <= WS_OH && WS_OH + (size_t)2 * NTOK * 1024 * 4 <= WS_BR && WS_BR + (size_t)3 * NTOK * 1024 * 2 <= WS_MG, "d_ws map 2");
constexpr int CW_BAR = 4096;

constexpr int LDS_BYTES = 163840, RING_OFF = 1024;

#define GAS __attribute__((address_space(1)))
#define LAS __attribute__((address_space(3)))
typedef unsigned short bf16;
typedef unsigned v4u __attribute__((ext_vector_type(4)));
typedef unsigned v2u __attribute__((ext_vector_type(2)));
typedef float f32x4 __attribute__((ext_vector_type(4)));
typedef float f32x2 __attribute__((ext_vector_type(2)));
typedef __bf16 bf16x2_t __attribute__((ext_vector_type(2)));
__device__ __forceinline__ unsigned pk2(float lo, float hi) { const f32x2 v = {lo, hi}; const bf16x2_t b = __builtin_convertvector(v, bf16x2_t); return __builtin_bit_cast(unsigned, b); }
__device__ __forceinline__ unsigned f2bf(float f) { return pk2(f, f) & 0xffffu; }
__device__ __forceinline__ float bflo(unsigned w) { return __uint_as_float(w << 16); }
__device__ __forceinline__ float bfhi(unsigned w) { return __uint_as_float(w & 0xffff0000u); }
__device__ __forceinline__ float wave_sum(float v) {
#pragma unroll
    for (int o = 1; o < 64; o <<= 1) v += __shfl_xor(v, o);
    return v;
}
__device__ __forceinline__ void ld16bf(const bf16* p, float (&v)[16]) {
    const v4u a = *(const v4u*)p, b = *(const v4u*)(p + 8);
    v[0] = bflo(a.x); v[1] = bfhi(a.x); v[2] = bflo(a.y); v[3] = bfhi(a.y); v[4] = bflo(a.z); v[5] = bfhi(a.z); v[6] = bflo(a.w); v[7] = bfhi(a.w);
    v[8] = bflo(b.x); v[9] = bfhi(b.x); v[10] = bflo(b.y); v[11] = bfhi(b.y); v[12] = bflo(b.z); v[13] = bfhi(b.z); v[14] = bflo(b.w); v[15] = bfhi(b.w);
}
__device__ __forceinline__ void ld16f(const float* p, float (&v)[16]) {
#pragma unroll
    for (int i = 0; i < 4; ++i) { const f32x4 x = *(const f32x4*)(p + 4 * i); v[4 * i] = x[0]; v[4 * i + 1] = x[1]; v[4 * i + 2] = x[2]; v[4 * i + 3] = x[3]; }
}
__device__ __forceinline__ void st16bf(bf16* p, const float (&v)[16]) {
    v4u a, b; a.x = pk2(v[0], v[1]); a.y = pk2(v[2], v[3]); a.z = pk2(v[4], v[5]); a.w = pk2(v[6], v[7]); b.x = pk2(v[8], v[9]); b.y = pk2(v[10], v[11]); b.z = pk2(v[12], v[13]); b.w = pk2(v[14], v[15]);
    *(v4u*)p = a; *(v4u*)(p + 8) = b;
}
__device__ __forceinline__ void st16f(float* p, const float (&v)[16]) {
#pragma unroll
    for (int i = 0; i < 4; ++i) *(f32x4*)(p + 4 * i) = (f32x4){v[4 * i], v[4 * i + 1], v[4 * i + 2], v[4 * i + 3]};
}

#define XB_TMO      128
#define XB_XCNT(j)  (256  + 64 * (j))
#define XB_XSUB(j)  (1280 + 64 * (j))
#define XB_XGEN(j)  (2304 + 64 * (j))
#define XB_TOP      3328
#define XB_TOPGEN   3392
#define XCD_BAR_WORDS 3456
#define XB_SPIN_CAP (1u << 18)

__device__ __forceinline__ unsigned xb_ld(unsigned* p)              { return __hip_atomic_load(p, __ATOMIC_RELAXED, __HIP_MEMORY_SCOPE_AGENT); }
__device__ __forceinline__ unsigned xb_add(unsigned* p, unsigned v) { return __hip_atomic_fetch_add(p, v, __ATOMIC_RELAXED, __HIP_MEMORY_SCOPE_AGENT); }
__device__ __forceinline__ unsigned xb_xcc_id() { return (unsigned)__builtin_amdgcn_s_getreg((3 << 11) | 20) & 0xFu; }
#define XB_SPIN(cond, bar) do { unsigned _sp = 0; while (cond) { __builtin_amdgcn_s_sleep(1); \
    if ((++_sp & 255u) == 0u) { if (xb_ld(&(bar)[XB_TMO])) break; if (_sp > XB_SPIN_CAP) { atomicAdd(&(bar)[XB_TMO], 1u); break; } } } } while (0)

struct XcdBarrier {
    unsigned* bar; unsigned x;
    volatile LAS unsigned* st;
};

__device__ __forceinline__ XcdBarrier xcd_barrier_post(unsigned* bar, volatile LAS unsigned* st) {
    XcdBarrier b; b.bar = bar; b.x = xb_xcc_id(); b.st = st;
    if (threadIdx.x == 0) (void)xb_add(&bar[XB_XCNT(b.x)], 1u);
    return b;
}
__device__ __forceinline__ void xcd_barrier_complete(unsigned* bar, unsigned x, unsigned& nloc, unsigned& nx) {
    const unsigned G = gridDim.x * gridDim.y * gridDim.z;
    unsigned sum, cnt, mine, sp = 0u;
    for (;;) {
        sum = 0u; cnt = 0u; mine = 0u;
#pragma unroll
        for (unsigned j = 0; j < 16; ++j) { const unsigned c = xb_ld(&bar[XB_XCNT(j)]); sum += c; cnt += (c > 0u) ? 1u : 0u; mine = (j == x) ? c : mine; }
        if (sum == G) break;
        __builtin_amdgcn_s_sleep(1);
        if ((++sp & 255u) == 0u) { if (xb_ld(&bar[XB_TMO])) break; if (sp > XB_SPIN_CAP) { atomicAdd(&bar[XB_TMO], 1u); break; } }
    }
    nloc = mine > 0u ? mine : 1u; nx = cnt > 0u ? cnt : 1u;
}

__device__ __forceinline__ void xcd_barrier(const XcdBarrier& b) {
    asm volatile("s_waitcnt vmcnt(0)" ::: "memory");
    __syncthreads();
    if (threadIdx.x == 0) {
        unsigned* bar = b.bar;
        __builtin_amdgcn_s_waitcnt(0);
        unsigned nloc = b.st[0], nx = b.st[1];
        if (nloc == 0u) { xcd_barrier_complete(bar, b.x, nloc, nx); b.st[0] = nloc; b.st[1] = nx; }
        const unsigned old = xb_add(&bar[XB_XSUB(b.x)], 1u);
        const unsigned gen = old / nloc;
        if (old + 1u == (gen + 1u) * nloc) {
            __builtin_amdgcn_fence(__ATOMIC_RELEASE, "agent");
            asm volatile("s_waitcnt vmcnt(0)" ::: "memory");
            const unsigned og = xb_add(&bar[XB_TOP], 1u);
            const unsigned tg = og / nx;
            if (og + 1u == (tg + 1u) * nx) xb_add(&bar[XB_TOPGEN], 1u);
            else XB_SPIN(xb_ld(&bar[XB_TOPGEN]) == tg, bar);
            __builtin_amdgcn_fence(__ATOMIC_ACQUIRE, "agent");
            xb_add(&bar[XB_XGEN(b.x)], 1u);
            asm volatile("s_waitcnt vmcnt(0)" ::: "memory");
        } else {
            XB_SPIN(xb_ld(&bar[XB_XGEN(b.x)]) == gen, bar);
            __builtin_amdgcn_fence(__ATOMIC_ACQUIRE, "agent");
            asm volatile("s_waitcnt vmcnt(0)" ::: "memory");
        }
    }
    __syncthreads();
}
struct Args { const float* in[26]; float* out; unsigned char* ws; int ph_lo, ph_hi; };
constexpr size_t OUT_YP = 0, OUT_DK = 12582912, OUT_DV = 20971520, OUT_GK = 29360128, OUT_GV = 31457280, OUT_ST = 33554432, OUT_TOTAL = 41943040;
#define LDS_WAIT() asm volatile("s_waitcnt lgkmcnt(0)" ::: "memory")

constexpr int TI_IN = (DM / 64) * (INW / 32), TI_BR = (1024 / 64) * (DM / 32), TI_SQ = (DM / 64) * (DM / 32), TI_LAYER = TI_IN + 3 * TI_BR + 2 * TI_SQ;
struct TItem { const float* src; bf16* dst; int N, K; };
__device__ __forceinline__ TItem p0_titem(const Args& a, unsigned char* ws, int l, int r) {
    const float* W; bf16* WT; int K, N, item;
    if (r < TI_IN) { W = a.in[13] + (size_t)l * DM * INW; K = DM; N = INW; WT = (bf16*)(ws + WS_WIN) + (size_t)l * INW * DM; item = r; }
    else if ((r -= TI_IN) < 3 * TI_BR) { const int lc = l * 3 + r / TI_BR; W = a.in[20] + (size_t)lc * 1024 * DM; K = 1024; N = DM; WT = (bf16*)(ws + WS_WBR) + (size_t)lc * DM * 1024; item = r % TI_BR; }
    else if ((r -= 3 * TI_BR) < TI_SQ) { W = a.in[21] + (size_t)l * DM * DM; K = DM; N = DM; WT = (bf16*)(ws + WS_WOUT) + (size_t)l * DM * DM; item = r; }
    else { r -= TI_SQ; W = a.in[22] + (size_t)l * DM * DM; K = DM; N = DM; WT = (bf16*)(ws + WS_WPQ) + (size_t)l * DM * DM; item = r; }
    const int nblk = N / 32, kb = item / nblk, nb = item % nblk, k0 = 64 * kb, n0 = 32 * nb;
    TItem t; t.src = W + (size_t)k0 * N + n0; t.dst = WT + (size_t)n0 * K + k0; t.N = N; t.K = K; return t;
}
__device__ __forceinline__ void p0_tload(const TItem& t, int lane, f32x4 (&tv)[8]) {
#pragma unroll
    for (int i = 0; i < 8; ++i) tv[i] = *(const f32x4*)(t.src + (size_t)((lane >> 3) + 8 * i) * t.N + 4 * (lane & 7));
}
__device__ __forceinline__ void p0_tfinish(const TItem& t, LAS float* scr, int lane, const f32x4 (&tv)[8]) {
#pragma unroll
    for (int i = 0; i < 8; ++i) { LAS float* d = scr + ((lane >> 3) + 8 * i) * 33 + 4 * (lane & 7); d[0] = tv[i][0]; d[1] = tv[i][1]; d[2] = tv[i][2]; d[3] = tv[i][3]; }
    LDS_WAIT(); asm volatile("" ::: "memory");
    const int c = lane & 7;
#pragma unroll
    for (int j = 0; j < 4; ++j) { const int n = (lane >> 3) + 8 * j; const LAS float* s = scr + (8 * c) * 33 + n;
        v4u o; o.x = pk2(s[0 * 33], s[1 * 33]); o.y = pk2(s[2 * 33], s[3 * 33]); o.z = pk2(s[4 * 33], s[5 * 33]); o.w = pk2(s[6 * 33], s[7 * 33]);
        *(v4u*)(t.dst + (size_t)n * t.K + 8 * c) = o; }
    LDS_WAIT(); asm volatile("" ::: "memory");
}
__device__ __forceinline__ void p0_transposes(const Args& a, unsigned char* ws, LAS float* scr, int lane, int l, int r0, int r1, int st) {
    if (r0 >= r1) return;
    f32x4 ta[8], tb[8]; TItem ca = p0_titem(a, ws, l, r0), cb;
    p0_tload(ca, lane, ta);
    for (int r = r0; r < r1; r += 2 * st) {
        const int i2 = r + st < r1 ? r + st : r1 - 1, i3 = r + 2 * st < r1 ? r + 2 * st : r1 - 1;
        cb = p0_titem(a, ws, l, i2); p0_tload(cb, lane, tb); __builtin_amdgcn_sched_barrier(0);
        p0_tfinish(ca, scr, lane, ta); __builtin_amdgcn_sched_barrier(0);
        ca = p0_titem(a, ws, l, i3); p0_tload(ca, lane, ta); __builtin_amdgcn_sched_barrier(0);
        p0_tfinish(cb, scr, lane, tb); __builtin_amdgcn_sched_barrier(0);
    }
}
__device__ __forceinline__ void fp8_row_load(const Args& a, int t, int le, int lane, f32x4 (&x)[8]) {
    const float* src = a.in[24 + t] + (size_t)le * 2048;
#pragma unroll
    for (int j = 0; j < 8; ++j) x[j] = *(const f32x4*)(src + j * 256 + lane * 4);
}
__device__ __forceinline__ void fp8_row_finish(unsigned char* ws, int t, int le, int lane, const f32x4 (&x)[8]) {
    unsigned char* UV8 = ws + WS_UV8; float* SC = (float*)(ws + WS_SC);
    float mx = 0.f;
#pragma unroll
    for (int j = 0; j < 8; ++j) mx = fmaxf(fmaxf(mx, fmaxf(fabsf(x[j][0]), fabsf(x[j][1]))), fmaxf(fabsf(x[j][2]), fabsf(x[j][3])));
#pragma unroll
    for (int o = 1; o < 64; o <<= 1) mx = fmaxf(mx, __shfl_xor(mx, o));
    const float qmax = t == 0 ? 127.0f : 448.0f;
    const float sc = mx > 0.f ? mx / qmax : 1.0f, inv = mx > 0.f ? qmax / mx : 0.f;
    unsigned w[8];
    if (t == 0) {
#pragma unroll
        for (int j = 0; j < 8; ++j) { const int q0 = (int)rintf(x[j][0] * inv), q1 = (int)rintf(x[j][1] * inv), q2 = (int)rintf(x[j][2] * inv), q3 = (int)rintf(x[j][3] * inv);
            w[j] = (unsigned)(q0 & 0xff) | ((unsigned)(q1 & 0xff) << 8) | ((unsigned)(q2 & 0xff) << 16) | ((unsigned)q3 << 24); }
    } else {
#pragma unroll
        for (int j = 0; j < 8; ++j) { int q = __builtin_amdgcn_cvt_pk_fp8_f32(x[j][0] * inv, x[j][1] * inv, 0, false); q = __builtin_amdgcn_cvt_pk_fp8_f32(x[j][2] * inv, x[j][3] * inv, q, true); w[j] = (unsigned)q; }
    }
    unsigned char* dst = UV8 + (size_t)le * 4096 + t * 2048 + lane * 32;
    *(v4u*)dst = (v4u){w[0], w[1], w[2], w[3]}; *(v4u*)(dst + 16) = (v4u){w[4], w[5], w[6], w[7]};
    if (lane == 0) SC[le * 2 + t] = sc;
}
__device__ __forceinline__ void fp8_rows(const Args& a, unsigned char* ws, int i0, int i1, int st, int lebase, int lane) {
    f32x4 xa[8], xb[8];
    if (i0 < i1) fp8_row_load(a, i0 >> 14, lebase + (i0 & 16383), lane, xa);
    for (int i = i0; i < i1; i += 2 * st) {
        const int i2 = i + st, i3 = i + 2 * st;
        if (i2 < i1) fp8_row_load(a, i2 >> 14, lebase + (i2 & 16383), lane, xb);
        fp8_row_finish(ws, i >> 14, lebase + (i & 16383), lane, xa);
        if (i3 < i1) fp8_row_load(a, i3 >> 14, lebase + (i3 & 16383), lane, xa);
        if (i2 < i1) fp8_row_finish(ws, i2 >> 14, lebase + (i2 & 16383), lane, xb);
    }
}
constexpr int SCAN_ROWS = 3840;
constexpr int SLOT_ROWS = 6144;
constexpr int TAIL_ROWS = 7680;
__device__ __forceinline__ void p0_prologue(const Args& a, unsigned char* ws, LAS unsigned char* lds, int G, bool defer_l1) {
    ws = fresh_ws(ws); const int tid = fresh_tid(), lane = tid & 63, wave = __builtin_amdgcn_readfirstlane(tid >> 6);
    const int bx = blockIdx.x;
    __syncthreads();
    {
        LAS float* sil = (LAS float*)(lds + RING_OFF); LAS float* red = sil + 3 * 2048;
        const float* c_ctx = a.in[8]; const float* cc = a.in[2];
        for (int i = tid; i < 3 * 2048; i += 512) { const int r = i >> 11, k = i & 2047; const float c = r == 0 ? c_ctx[k] : cc[(r - 1) * 2048 + k]; sil[i] = c / (1.0f + expf(-c)); }
        __syncthreads();
        const float* mod_w = a.in[9]; const float* mod_b = a.in[10]; float* MOD = (float*)(ws + WS_MOD);
        const int cg = tid % 24, kg = tid / 24;
        for (int task = bx; task < 256; task += G) {
            const int l = task >> 7, col0 = (task & 127) * 96;
            if (kg < 21) {
                float acc[3][4];
#pragma unroll
                for (int r = 0; r < 3; ++r)
#pragma unroll
                    for (int j = 0; j < 4; ++j) acc[r][j] = 0.f;
                const float* wp = mod_w + ((size_t)l * 2048) * 12288 + col0 + cg * 4;
#pragma unroll 4
                for (int k = kg; k < 2048; k += 21) { const f32x4 w = *(const f32x4*)(wp + (size_t)k * 12288); const float s0 = sil[k], s1 = sil[2048 + k], s2 = sil[4096 + k];
#pragma unroll
                    for (int j = 0; j < 4; ++j) { acc[0][j] += s0 * w[j]; acc[1][j] += s1 * w[j]; acc[2][j] += s2 * w[j]; } }
#pragma unroll
                for (int r = 0; r < 3; ++r)
#pragma unroll
                    for (int j = 0; j < 4; ++j) red[(kg * 24 + cg) * 12 + r * 4 + j] = acc[r][j];
            }
            __syncthreads();
            if (tid < 288) { const int r = tid / 96, c = tid % 96, g4 = c >> 2, j = c & 3; float s = 0.f;
                for (int q = 0; q < 21; ++q) s += red[(q * 24 + g4) * 12 + r * 4 + j];
                MOD[(size_t)(l * 3 + r) * 12288 + col0 + c] = s + mod_b[l * 12288 + col0 + c]; }
            __syncthreads();
        }
    }
    {
        f32x2* R64 = (f32x2*)(ws + WS_ROPE); f32x2* R128 = R64 + 64 * 16;
        const int gt = bx * 512 + tid;
        if (gt < 64 * 16) { const int pos = gt >> 4, i = gt & 15; const float inv = exp2f(-13.287712379549449f * (float)i / 16.0f); const float ang = (float)pos * inv; R64[gt] = (f32x2){cosf(ang), sinf(ang)}; }
        else if (gt < 64 * 16 + 64 * 32) { const int g2 = gt - 64 * 16, pos = g2 >> 5, i = g2 & 31; const float inv = exp2f(-13.287712379549449f * (float)i / 32.0f); const float ang = (float)pos * inv; R128[g2] = (f32x2){cosf(ang), sinf(ang)}; }
    }
    {
        LAS float* scr = (LAS float*)(lds + RING_OFF + wave * 16384);
        const int gw = bx * 8 + wave, NGW = G * 8;
        p0_transposes(a, ws, scr, lane, 0, gw, TI_LAYER, NGW);
        if (!defer_l1) p0_transposes(a, ws, scr, lane, 1, gw, TI_LAYER, NGW);
    }
    {
        const int gw = bx * 8 + wave, NGW = G * 8;
        fp8_rows(a, ws, (defer_l1 ? TAIL_ROWS + SLOT_ROWS + SCAN_ROWS : 0) + gw, 32768, NGW, 0, lane);
        if (!defer_l1) fp8_rows(a, ws, gw, 32768, NGW, 16384, lane);
    }
}
__device__ __forceinline__ void work_gemm1_tail(const Args& a, unsigned char* ws, int l) {
    ws = fresh_ws(ws); const int tid = fresh_tid(), lane = tid & 63, wave = __builtin_amdgcn_readfirstlane(tid >> 6);
    fp8_rows(a, ws, ((int)blockIdx.x - 208) * 8 + wave, TAIL_ROWS, 384, l * 16384, lane);
}
__device__ __forceinline__ void work_scan_tail(const Args& a, unsigned char* ws) {
    ws = fresh_ws(ws); const int tid = fresh_tid(), lane = tid & 63, wave = __builtin_amdgcn_readfirstlane(tid >> 6);
    fp8_rows(a, ws, TAIL_ROWS + SLOT_ROWS + (int)blockIdx.x * 8 + wave, TAIL_ROWS + SLOT_ROWS + SCAN_ROWS, 256, 0, lane);
}
__device__ __forceinline__ void work_deferred(const Args& a, unsigned char* ws, LAS unsigned char* lds, int slot) {
    ws = fresh_ws(ws); const int tid = fresh_tid(), lane = tid & 63, wave = __builtin_amdgcn_readfirstlane(tid >> 6);
    const int gw = ((int)blockIdx.x - 192) * 8 + wave;
    if (slot < 3) {
        const int lo_ = slot == 0 ? 0 : slot == 1 ? 9216 : 16128, hi_ = slot == 0 ? 9216 : slot == 1 ? 16128 : TI_LAYER;
        p0_transposes(a, ws, (LAS float*)(lds + RING_OFF + wave * 16384), lane, 1, lo_ + gw, hi_, 512);
        { const int r0 = TAIL_ROWS + (slot == 0 ? 0 : slot == 1 ? 2458 : 4301), r1 = TAIL_ROWS + (slot == 0 ? 2458 : slot == 1 ? 4301 : SLOT_ROWS); fp8_rows(a, ws, r0 + gw, r1, 512, 0, lane); }
    } else {
        const int lo_ = slot == 3 ? TAIL_ROWS : slot == 4 ? 17715 : 25242, hi_ = slot == 3 ? 17715 : slot == 4 ? 25242 : 32768;
        fp8_rows(a, ws, lo_ + gw, hi_, 512, 16384, lane);
    }
}

__device__ __forceinline__ void norm_phase(const float* xp, const float* xs, const float* gain, const float* modl, int ch_sh, int ch_sc, bf16* H, int G) {
    const int tid = fresh_tid(), lane = tid & 63, gw = blockIdx.x * 8 + __builtin_amdgcn_readfirstlane(tid >> 6), NGW = G * 8;
    for (int row = gw; row < NTOK; row += NGW) {
        const float* xr = row < NPROMPT ? xp + (size_t)row * DM : xs + (size_t)(row - NPROMPT) * DM;
        const int r = row < NPROMPT ? 0 : 1 + ((row - NPROMPT) >> 10);
        const float* sh = modl + (size_t)r * 12288 + ch_sh * DM; const float* sc = modl + (size_t)r * 12288 + ch_sc * DM;
        f32x4 v[8]; float ss = 0.f;
#pragma unroll
        for (int j = 0; j < 8; ++j) { v[j] = *(const f32x4*)(xr + j * 256 + lane * 4); ss += (v[j][0] * v[j][0] + v[j][1] * v[j][1]) + (v[j][2] * v[j][2] + v[j][3] * v[j][3]); }
        const float rstd = 1.0f / sqrtf(wave_sum(ss) * (1.0f / DM) + EPS);
#pragma unroll
        for (int j = 0; j < 8; ++j) { const int c = j * 256 + lane * 4; const f32x4 g = *(const f32x4*)(gain + c), s1 = *(const f32x4*)(sc + c), s0 = *(const f32x4*)(sh + c);
            const f32x4 o = v[j] * rstd * g * (s1 + 1.0f) + s0; v2u w; w.x = pk2(o[0], o[1]); w.y = pk2(o[2], o[3]); *(v2u*)(H + (size_t)row * DM + c) = w; }
    }
}

__device__ __forceinline__ void rope_pair(float (&v)[16], const f32x2* tab, int fi0, bool first, int xm) {
#pragma unroll
    for (int e = 0; e < 16; ++e) { const float p = __shfl_xor(v[e], xm); const f32x2 cs = tab[fi0 + e]; v[e] = first ? v[e] * cs.x - p * cs.y : v[e] * cs.x + p * cs.y; }
}
__device__ __forceinline__ void prep_phase(const Args& a, unsigned char* ws, int l, int wg0, int nwg) {
    ws = fresh_ws(ws); const int tid = fresh_tid(), lane = tid & 63, gw = ((int)blockIdx.x - wg0) * 8 + __builtin_amdgcn_readfirstlane(tid >> 6), NGW = nwg * 8;
    const bf16* Z = (const bf16*)(ws + WS_Z); bf16* QA = (bf16*)(ws + WS_QA); bf16* KA = (bf16*)(ws + WS_KA); bf16* VA = (bf16*)(ws + WS_VA);
    const f32x2* R64 = (const f32x2*)(ws + WS_ROPE); const f32x2* R128 = R64 + 64 * 16;
    const float* dqk = a.in[16] + (size_t)l * 2 * 64; const float* gqk = a.in[19] + (size_t)l * 2 * 128;
    float* out = a.out;
    for (int task = gw; task < NTOK + 512; task += NGW) {
        if (task >= NTOK) {
            const int i = task - NTOK, b = i >> 8, p = i & 255; const size_t krow = (size_t)NPROMPT + b * 1280 + 1024 + p;
            float v[16];
            ld16f(a.in[3] + ((size_t)(b * 2 + l) * 256 + p) * 1024 + lane * 16, v); st16bf(KA + krow * KVW + lane * 16, v);
            ld16f(a.in[4] + ((size_t)(b * 2 + l) * 256 + p) * 1024 + lane * 16, v); st16bf(VA + krow * KVW + lane * 16, v);
            if (lane < 16) { ld16f(a.in[5] + ((size_t)(b * 2 + l) * 256 + p) * 256 + lane * 16, v); st16bf(KA + krow * KVW + 1024 + lane * 16, v);
                             ld16f(a.in[6] + ((size_t)(b * 2 + l) * 256 + p) * 256 + lane * 16, v); st16bf(VA + krow * KVW + 1024 + lane * 16, v); }
            continue;
        }
        const int row = task; const bool latent = row >= NPROMPT;
        int b, t; size_t krow;
        if (!latent) { b = row >> 8; t = row & 255; krow = row; } else { b = (row - NPROMPT) >> 10; t = (row - NPROMPT) & 1023; krow = (size_t)NPROMPT + b * 1280 + t; }
        const int prow = t >> 6, pcol = t & 63;
        const bf16* z = Z + (size_t)row * INW;
        const size_t co = ((size_t)(b * 2 + l) * 256 + t);
        float v[16];
        {
            ld16bf(z + C_DQ + lane * 16, v); float ss = 0.f;
#pragma unroll
            for (int e = 0; e < 16; ++e) ss += v[e] * v[e];
            ss += __shfl_xor(ss, 1); ss += __shfl_xor(ss, 2);
            const float rstd = 1.0f / sqrtf(ss * (1.0f / 64.0f) + EPS); const int sub = lane & 3; const float* gn = dqk + sub * 16;
#pragma unroll
            for (int e = 0; e < 16; ++e) v[e] = v[e] * rstd * gn[e];
            if (latent) rope_pair(v, R64 + (sub < 2 ? prow : pcol) * 16, 0, (sub & 1) == 0, 1);
#pragma unroll
            for (int e = 0; e < 16; ++e) v[e] *= 0.125f;
            const int he = lane >> 2, half = he & 1; bf16* q = QA + (size_t)row * 3072 + he * 128;
            st16bf(q + half * 64 + sub * 16, v);
            *(v4u*)(q + (1 - half) * 64 + sub * 16) = (v4u){0u, 0u, 0u, 0u}; *(v4u*)(q + (1 - half) * 64 + sub * 16 + 8) = (v4u){0u, 0u, 0u, 0u};
        }
        {
            ld16bf(z + C_DK + lane * 16, v); float ss = 0.f;
#pragma unroll
            for (int e = 0; e < 16; ++e) ss += v[e] * v[e];
            ss += __shfl_xor(ss, 1); ss += __shfl_xor(ss, 2);
            const float rstd = 1.0f / sqrtf(ss * (1.0f / 64.0f) + EPS); const int sub = lane & 3; const float* gn = dqk + 64 + sub * 16;
#pragma unroll
            for (int e = 0; e < 16; ++e) v[e] = v[e] * rstd * gn[e];
            if (latent) rope_pair(v, R64 + (sub < 2 ? prow : pcol) * 16, 0, (sub & 1) == 0, 1);
            else st16f(out + OUT_DK + co * 1024 + lane * 16, v);
            st16bf(KA + krow * KVW + lane * 16, v);
        }
        {
            ld16bf(z + C_DV + lane * 16, v);
            if (!latent) st16f(out + OUT_DV + co * 1024 + lane * 16, v);
            *(v4u*)(VA + krow * KVW + lane * 16) = *(const v4u*)(z + C_DV + lane * 16); *(v4u*)(VA + krow * KVW + lane * 16 + 8) = *(const v4u*)(z + C_DV + lane * 16 + 8);
        }
        {
            ld16bf(z + C_GQ + lane * 16, v); float ss = 0.f;
#pragma unroll
            for (int e = 0; e < 16; ++e) ss += v[e] * v[e];
            ss += __shfl_xor(ss, 1); ss += __shfl_xor(ss, 2); ss += __shfl_xor(ss, 4);
            const float rstd = 1.0f / sqrtf(ss * (1.0f / 128.0f) + EPS); const int sub = lane & 7; const float* gn = gqk + sub * 16;
#pragma unroll
            for (int e = 0; e < 16; ++e) v[e] = v[e] * rstd * gn[e];
            if (latent) rope_pair(v, R128 + (sub < 4 ? prow : pcol) * 32, (sub & 1) * 16, (sub & 2) == 0, 2);
#pragma unroll
            for (int e = 0; e < 16; ++e) v[e] *= 0.08838834764831845f;
            st16bf(QA + (size_t)row * 3072 + 2048 + lane * 16, v);
        }
        {
            const int ln = lane & 15;
            ld16bf(z + C_GK + ln * 16, v); float ss = 0.f;
#pragma unroll
            for (int e = 0; e < 16; ++e) ss += v[e] * v[e];
            ss += __shfl_xor(ss, 1); ss += __shfl_xor(ss, 2); ss += __shfl_xor(ss, 4);
            const float rstd = 1.0f / sqrtf(ss * (1.0f / 128.0f) + EPS); const int sub = lane & 7; const float* gn = gqk + 128 + sub * 16;
#pragma unroll
            for (int e = 0; e < 16; ++e) v[e] = v[e] * rstd * gn[e];
            if (latent) rope_pair(v, R128 + (sub < 4 ? prow : pcol) * 32, (sub & 1) * 16, (sub & 2) == 0, 2);
            if (lane < 16) { if (!latent) st16f(out + OUT_GK + co * 256 + lane * 16, v); st16bf(KA + krow * KVW + 1024 + lane * 16, v); }
            ld16bf(z + C_GV + ln * 16, v);
            if (lane < 16) { if (!latent) st16f(out + OUT_GV + co * 256 + lane * 16, v); st16bf(VA + krow * KVW + 1024 + lane * 16, v); }
        }
    }
}

typedef short bf16x4s __attribute__((ext_vector_type(4)));
typedef short bf16x8h __attribute__((ext_vector_type(8)));
constexpr int HG_QD = 0, HG_QR = 4352, HG_KR = 8704, HG_KDT = 13056, HG_VT = 17152, HG_DEC = 21248, HG_BUF = 22016, HG_TOTS = 2 * HG_BUF;
__device__ __forceinline__ void hgrn_item(const Args& a, unsigned char* ws, LAS unsigned char* lds, int l, int item, const XcdBarrier* barp = nullptr, int split = -1) {
    ws = fresh_ws(ws); const int tid = fresh_tid(), lane = tid & 63, wave = __builtin_amdgcn_readfirstlane(tid >> 6);
    const bf16* Z = (const bf16*)(ws + WS_Z);
    int b, h, dir, T, row0; const bool latent = item < 32;
    if (latent) { b = item >> 4; h = (item >> 1) & 7; dir = item & 1; T = 1024; row0 = NPROMPT + b * 1024; }
    else { const int it = item - 32; b = it >> 4; h = (it >> 1) & 7; dir = it & 1; T = 256; row0 = b * 256; }
    const bool stager = wave < 4;
    const int cl = lane & 15, gr = lane >> 4, kc = (wave & 3) * 16 + cl;
    const int fr = lane & 15, g = lane >> 4, vb = (wave & 3) * 32;
    const size_t sidx = ((((size_t)(b * 2 + l) * 2 + dir) * 8 + h) * 128) * 128;
    LAS unsigned char* base = lds + RING_OFF;
    const long ost = dir ? -1024 : 1024, zst = dir ? -(long)INW : (long)INW;
    const int nchunk = T >> 4;
#define HG_EXP(x) __builtin_amdgcn_exp2f(1.4426950408889634f * (x))
    if (stager) {
        float lb[2] = {0.f, 0.f};
        if (l == 1) { const float* hl = a.in[14];
#pragma unroll
            for (int ch = 0; ch < 2; ++ch) { const float a0 = hl[(dir * 2 + 0) * 1024 + h * 128 + 2 * kc + ch], a1 = hl[(dir * 2 + 1) * 1024 + h * 128 + 2 * kc + ch]; lb[ch] = 1.0f / (1.0f + expf(a0 - a1)); } }
        const bf16* const zb0 = Z + (size_t)(row0 + (dir ? T - 1 : 0)) * INW + h * 128 + 2 * kc + zst * (4 * gr);
        unsigned rqA[4], rzA[4], rvA[4], rqB[4], rzB[4], rvB[4];
#define HG_LOAD(rq, rz, rv, c) do { if ((c) < nchunk) { _Pragma("unroll") for (int i = 0; i < 4; ++i) { const bf16* zr = zb0 + zst * ((c) * 16 + i); \
            rq[i] = *(const unsigned*)(zr + C_HQ); rz[i] = *(const unsigned*)(zr + C_HF + dir * 1024); rv[i] = *(const unsigned*)(zr + C_HI); } } } while (0)
#define HG_STAGE(rq, rz, rv, pbuf) do { \
            float lf[2][4], kk[2][4]; \
            _Pragma("unroll") for (int i = 0; i < 4; ++i) _Pragma("unroll") for (int ch = 0; ch < 2; ++ch) { const float zf = ch ? bfhi(rz[i]) : bflo(rz[i]); const float e = HG_EXP(-fabsf(zf)), inv = __builtin_amdgcn_rcpf(1.0f + e); \
                const float sp = zf >= 0.f ? inv : e * inv, sn = zf >= 0.f ? e * inv : inv; kk[ch][i] = (1.0f - lb[ch]) * sn; lf[ch][i] = 0.6931471805599453f * __builtin_amdgcn_logf(lb[ch] + (1.0f - lb[ch]) * sp); } \
            float cs[2][4], pre[2], bm[2], b15[2]; \
            _Pragma("unroll") for (int ch = 0; ch < 2; ++ch) { cs[ch][0] = lf[ch][0]; cs[ch][1] = cs[ch][0] + lf[ch][1]; cs[ch][2] = cs[ch][1] + lf[ch][2]; cs[ch][3] = cs[ch][2] + lf[ch][3]; \
                float P = cs[ch][3]; float t_ = __shfl_up(P, 16); if (gr >= 1) P += t_; t_ = __shfl_up(P, 32); if (gr >= 2) P += t_;        \
                pre[ch] = P - cs[ch][3]; bm[ch] = __shfl(P, 16 + cl); b15[ch] = __shfl(P, 48 + cl); } \
            LAS unsigned char* pb_ = base + (pbuf) * HG_BUF; float kd[2][4]; \
            _Pragma("unroll") for (int i = 0; i < 4; ++i) { const int s = 4 * gr + i; float qd[2], qr[2], kr[2]; \
                _Pragma("unroll") for (int ch = 0; ch < 2; ++ch) { const float q = ch ? bfhi(rq[i]) : bflo(rq[i]); const float bb = pre[ch] + cs[ch][i]; \
                    const float er = HG_EXP(fminf(fmaxf(bb - bm[ch], -80.f), 80.f)); \
                    qd[ch] = q * HG_EXP(bb); qr[ch] = q * er; kr[ch] = kk[ch][i] * __builtin_amdgcn_rcpf(er); kd[ch][i] = kk[ch][i] * HG_EXP(b15[ch] - bb); } \
                *(LAS unsigned*)(pb_ + HG_QD + s * 272 + kc * 4) = pk2(qd[0], qd[1]); \
                *(LAS unsigned*)(pb_ + HG_QR + s * 272 + kc * 4) = pk2(qr[0], qr[1]); \
                *(LAS unsigned*)(pb_ + HG_KR + s * 272 + kc * 4) = pk2(kr[0], kr[1]); } \
            *(LAS v2u*)(pb_ + HG_KDT + (2 * kc) * 32 + gr * 8) = (v2u){pk2(kd[0][0], kd[0][1]), pk2(kd[0][2], kd[0][3])}; *(LAS v2u*)(pb_ + HG_KDT + (2 * kc + 1) * 32 + gr * 8) = (v2u){pk2(kd[1][0], kd[1][1]), pk2(kd[1][2], kd[1][3])}; \
            *(LAS v2u*)(pb_ + HG_VT + (2 * kc) * 32 + gr * 8) = (v2u){(rv[0] & 0xffffu) | (rv[1] << 16), (rv[2] & 0xffffu) | (rv[3] << 16)}; \
            *(LAS v2u*)(pb_ + HG_VT + (2 * kc + 1) * 32 + gr * 8) = (v2u){(rv[0] >> 16) | (rv[1] & 0xffff0000u), (rv[2] >> 16) | (rv[3] & 0xffff0000u)}; \
            if (gr == 0) *(LAS f32x2*)(pb_ + HG_DEC + kc * 8) = (f32x2){HG_EXP(b15[0]), HG_EXP(b15[1])}; \
        } while (0)
        HG_LOAD(rqA, rzA, rvA, 0); HG_LOAD(rqB, rzB, rvB, 1);
        HG_STAGE(rqA, rzA, rvA, 0);
        HG_LOAD(rqA, rzA, rvA, 2);
        __syncthreads();
        for (int c = 0; c < nchunk; c += 2) {
            if (c == split) xcd_barrier(*barp);
            HG_STAGE(rqB, rzB, rvB, 1); HG_LOAD(rqB, rzB, rvB, c + 3);
            __syncthreads();
            if (c + 2 < nchunk) { HG_STAGE(rqA, rzA, rvA, 0); HG_LOAD(rqA, rzA, rvA, c + 4); }
            __syncthreads();
        }
#undef HG_LOAD
#undef HG_STAGE
        __syncthreads();
    } else {
        bf16* OH = (bf16*)(ws + WS_OH) + (size_t)dir * NTOK * 1024;
        bf16* const ob0 = OH + (size_t)(row0 + (dir ? T - 1 : 0)) * 1024 + h * 128 + vb + fr + ost * (4 * g);
        f32x4 S0[8], S1[8];
        if (latent) { const float* st = a.in[7] + sidx;
#pragma unroll
            for (int kt = 0; kt < 8; ++kt)
#pragma unroll
                for (int r = 0; r < 4; ++r) { S0[kt][r] = st[(size_t)(16 * kt + 4 * g + r) * 128 + vb + fr]; S1[kt][r] = st[(size_t)(16 * kt + 4 * g + r) * 128 + vb + 16 + fr]; } }
        else {
#pragma unroll
            for (int kt = 0; kt < 8; ++kt) { S0[kt] = (f32x4){0.f, 0.f, 0.f, 0.f}; S1[kt] = (f32x4){0.f, 0.f, 0.f, 0.f}; } }
#define HG_OTILE(SS, nt_, c) do { f32x4 o = {0.f, 0.f, 0.f, 0.f}; \
            _Pragma("unroll") for (int ks = 0; ks < 4; ++ks) { \
                const v4u bs4 = {pk2(SS[2 * ks][0], SS[2 * ks][1]), pk2(SS[2 * ks][2], SS[2 * ks][3]), pk2(SS[2 * ks + 1][0], SS[2 * ks + 1][1]), pk2(SS[2 * ks + 1][2], SS[2 * ks + 1][3])}; \
                o = __builtin_amdgcn_mfma_f32_16x16x32_bf16(__builtin_bit_cast(bf16x8h, qa[ks]), __builtin_bit_cast(bf16x8h, bs4), o, 0, 0, 0); } \
            const v2u bv2 = *(const LAS v2u*)(pb_ + HG_VT + (vb + 16 * (nt_) + fr) * 32 + g * 8); const v4u bv4 = {bv2.x, bv2.y, 0u, 0u}; const bf16x8h bv = __builtin_bit_cast(bf16x8h, bv4); \
            o = __builtin_amdgcn_mfma_f32_16x16x32_bf16(pa, bv, o, 0, 0, 0); \
            _Pragma("unroll") for (int r = 0; r < 4; ++r) ob0[ost * ((c) * 16 + r) + 16 * (nt_)] = (bf16)f2bf(o[r]); \
            _Pragma("unroll") for (int kt = 0; kt < 8; ++kt) SS[kt] = __builtin_amdgcn_mfma_f32_16x16x32_bf16(__builtin_bit_cast(bf16x8h, ak[kt]), bv, SS[kt] * dd[kt], 0, 0, 0); } while (0)
#define HG_MFMA(c) do { \
            const LAS unsigned char* pb_ = base + ((c) & 1) * HG_BUF; \
            f32x4 at = {0.f, 0.f, 0.f, 0.f}; \
            _Pragma("unroll") for (int ks = 0; ks < 4; ++ks) { const bf16x8h ka = *(const LAS bf16x8h*)(pb_ + HG_KR + fr * 272 + (32 * ks + 8 * g) * 2), qb = *(const LAS bf16x8h*)(pb_ + HG_QR + fr * 272 + (32 * ks + 8 * g) * 2); \
                at = __builtin_amdgcn_mfma_f32_16x16x32_bf16(ka, qb, at, 0, 0, 0); }            \
            _Pragma("unroll") for (int r = 0; r < 4; ++r) if (4 * g + r > fr) at[r] = 0.f; \
            const v4u pa4 = {pk2(at[0], at[1]), pk2(at[2], at[3]), 0u, 0u}; const bf16x8h pa = __builtin_bit_cast(bf16x8h, pa4);     \
            v4u qa[4]; v4u ak[8]; f32x4 dd[8]; \
            _Pragma("unroll") for (int ks = 0; ks < 4; ++ks) { const v2u alo = *(const LAS v2u*)(pb_ + HG_QD + fr * 272 + (32 * ks + 4 * g) * 2), ahi = *(const LAS v2u*)(pb_ + HG_QD + fr * 272 + (32 * ks + 16 + 4 * g) * 2); qa[ks] = (v4u){alo.x, alo.y, ahi.x, ahi.y}; } \
            _Pragma("unroll") for (int kt = 0; kt < 8; ++kt) { dd[kt] = *(const LAS f32x4*)(pb_ + HG_DEC + (16 * kt + 4 * g) * 4); const v2u ak2 = *(const LAS v2u*)(pb_ + HG_KDT + (16 * kt + fr) * 32 + g * 8); ak[kt] = (v4u){ak2.x, ak2.y, 0u, 0u}; } \
            HG_OTILE(S0, 0, c); HG_OTILE(S1, 1, c); \
        } while (0)
        __syncthreads();
        for (int c = 0; c < nchunk; c += 2) {
            if (c == split) xcd_barrier(*barp);
            HG_MFMA(c);
            __syncthreads();
            HG_MFMA(c + 1);
            __syncthreads();
        }
#undef HG_MFMA
#undef HG_OTILE
        if (!latent) { float* st = a.out + OUT_ST + sidx;
#pragma unroll
            for (int kt = 0; kt < 8; ++kt)
#pragma unroll
                for (int r = 0; r < 4; ++r) { st[(size_t)(16 * kt + 4 * g + r) * 128 + vb + fr] = S0[kt][r]; st[(size_t)(16 * kt + 4 * g + r) * 128 + vb + 16 + fr] = S1[kt][r]; } }
        __syncthreads();
    }
#undef HG_EXP
}

__device__ __forceinline__ void attn_unit(unsigned char* ws, char* lds_generic, int u) {
    ws = fresh_ws(ws);
    int b, he, row0, key0, seq;
    if (u < 192) { b = u / 96; const int r = u % 96; he = r >> 2; const int qb = r & 3; row0 = NPROMPT + b * 1024 + qb * 256; key0 = NPROMPT + b * 1280; seq = 1280; }
    else { const int uu = u - 192; b = uu / 24; he = uu % 24; row0 = b * 256; key0 = b * 256; seq = 256; }
    const int kvh = he < 16 ? (he >> 1) : 8 + ((he - 16) >> 2);
    const att::bf16* Q = (const att::bf16*)(ws + WS_QA) + (size_t)row0 * 3072 + he * 128;
    const att::bf16* K = (const att::bf16*)(ws + WS_KA) + (size_t)key0 * KVW + kvh * 128;
    const att::bf16* V = (const att::bf16*)(ws + WS_VA) + (size_t)key0 * KVW + kvh * 128;
    unsigned short* O = (unsigned short*)(ws + WS_OA) + (size_t)row0 * 3072 + he * 128;
    att::attn_dense_body<att::bf16>(Q, K, V, O, seq, lds_generic + RING_OFF);
    __syncthreads();
}

__device__ __forceinline__ void post_phase(const Args& a, unsigned char* ws, int l, int G) {
    ws = fresh_ws(ws); const int tid = fresh_tid(), lane = tid & 63, gw = blockIdx.x * 8 + __builtin_amdgcn_readfirstlane(tid >> 6), NGW = G * 8;
    const bf16* Z = (const bf16*)(ws + WS_Z); const bf16* OA = (const bf16*)(ws + WS_OA); const bf16* OHf = (const bf16*)(ws + WS_OH); const bf16* OHb = OHf + (size_t)NTOK * 1024;
    bf16* BR = (bf16*)(ws + WS_BR);
    const float lam_init = 0.8f - 0.6f * expf(-0.3f * (float)l);
    const float* lp = a.in[17] + (size_t)l * 4 * 64;
    const float s01 = wave_sum(lp[lane] * lp[64 + lane]), s23 = wave_sum(lp[128 + lane] * lp[192 + lane]);
    const float lam = expf(s01) - expf(s23) + lam_init;
    const float* hn = a.in[15] + (size_t)l * 128; const float* sl = a.in[18] + (size_t)l * 128;
    const int sub = lane & 7;
    for (int row = gw; row < NTOK; row += NGW) {
        float v[16], w[16];
        {
            ld16bf(OHf + (size_t)row * 1024 + lane * 16, v); ld16bf(OHb + (size_t)row * 1024 + lane * 16, w); float ss = 0.f;
#pragma unroll
            for (int e = 0; e < 16; ++e) { v[e] += w[e]; ss += v[e] * v[e]; }
            ss += __shfl_xor(ss, 1); ss += __shfl_xor(ss, 2); ss += __shfl_xor(ss, 4);
            const float rstd = 1.0f / sqrtf(ss * (1.0f / 128.0f) + EPS);
            ld16bf(Z + (size_t)row * INW + C_HG + lane * 16, w);
#pragma unroll
            for (int e = 0; e < 16; ++e) { const float g = w[e]; v[e] = v[e] * rstd * hn[sub * 16 + e] * (g / (1.0f + expf(-g))); }
            st16bf(BR + (size_t)row * 1024 + lane * 16, v);
        }
        {
            const int h = lane >> 3; const bf16* o1 = OA + (size_t)row * 3072 + (2 * h) * 128 + sub * 16;
            ld16bf(o1, v); ld16bf(o1 + 128, w); float ss = 0.f;
#pragma unroll
            for (int e = 0; e < 16; ++e) { v[e] -= lam * w[e]; ss += v[e] * v[e]; }
            ss += __shfl_xor(ss, 1); ss += __shfl_xor(ss, 2); ss += __shfl_xor(ss, 4);
            const float rstd = 1.0f / sqrtf(ss * (1.0f / 128.0f) + EPS);
#pragma unroll
            for (int e = 0; e < 16; ++e) v[e] = v[e] * rstd * sl[sub * 16 + e] * (1.0f - lam_init);
            st16bf(BR + (size_t)NTOK * 1024 + (size_t)row * 1024 + lane * 16, v);
        }
        {
            *(v4u*)(BR + (size_t)2 * NTOK * 1024 + (size_t)row * 1024 + lane * 16) = *(const v4u*)(OA + (size_t)row * 3072 + 2048 + lane * 16); *(v4u*)(BR + (size_t)2 * NTOK * 1024 + (size_t)row * 1024 + lane * 16 + 8) = *(const v4u*)(OA + (size_t)row * 3072 + 2048 + lane * 16 + 8);
        }
    }
}

typedef short bf16x8s __attribute__((ext_vector_type(8)));
typedef float f32x16 __attribute__((ext_vector_type(16)));
__device__ __forceinline__ unsigned ford(float f) { const unsigned u = __float_as_uint(f); return u ^ ((u >> 31) ? 0xffffffffu : 0x80000000u); }
__device__ __forceinline__ float funord(unsigned k) { const unsigned u = (k & 0x80000000u) ? (k ^ 0x80000000u) : ~k; return __uint_as_float(u); }
__device__ __forceinline__ void ins16(unsigned (&L)[16], unsigned x) {
#pragma unroll
    for (int i = 0; i < 16; ++i) { const unsigned hi = L[i] > x ? L[i] : x; x = L[i] > x ? x : L[i]; L[i] = hi; }
}
__device__ __forceinline__ void ce_desc(unsigned& a_, unsigned& b_) { const unsigned hi = a_ > b_ ? a_ : b_, lo = a_ > b_ ? b_ : a_; a_ = hi; b_ = lo; }
__device__ __forceinline__ void sort16_desc(unsigned (&x)[16]) {
#pragma unroll
    for (int k = 2; k <= 16; k <<= 1)
#pragma unroll
        for (int j = k >> 1; j > 0; j >>= 1)
#pragma unroll
            for (int i = 0; i < 16; ++i) { const int l = i ^ j; if (l > i) { if ((i & k) == 0) ce_desc(x[i], x[l]); else ce_desc(x[l], x[i]); } }
}
__device__ __forceinline__ void merge16_desc(unsigned (&a_)[16], const unsigned (&b_)[16]) {
#pragma unroll
    for (int i = 0; i < 16; ++i) a_[i] = a_[i] > b_[15 - i] ? a_[i] : b_[15 - i];
#pragma unroll
    for (int j = 8; j > 0; j >>= 1)
#pragma unroll
        for (int i = 0; i < 16; ++i) { const int l = i ^ j; if (l > i) ce_desc(a_[i], a_[l]); }
}
__device__ __forceinline__ void peer_top16(unsigned (&L)[16], const LAS unsigned char* keysL, const bf16* qp, int c, int qrow, int hf) {
    f32x16 acc[4];
#pragma unroll
    for (int tl = 0; tl < 4; ++tl)
#pragma unroll
        for (int r = 0; r < 16; ++r) acc[tl][r] = 0.f;
    bf16x8s bq[8];
#pragma unroll
    for (int ks = 0; ks < 8; ++ks) bq[ks] = *(const bf16x8s*)(qp + c * 128 + ks * 16 + hf * 8);
#pragma unroll
    for (int ks = 0; ks < 8; ++ks)
#pragma unroll
        for (int tl = 0; tl < 4; ++tl) { const bf16x8s ka = *(const LAS bf16x8s*)(keysL + (c * 128 + tl * 32 + qrow) * 256 + (((ks * 2 + hf) ^ (qrow & 15)) << 4));
            acc[tl] = __builtin_amdgcn_mfma_f32_32x32x16_bf16(ka, bq[ks], acc[tl], 0, 0, 0); }
    unsigned K1[16], K2[16], K3[16];
#pragma unroll
    for (int r = 0; r < 16; ++r) { const unsigned kc = 127u - (unsigned)((r & 3) + 8 * (r >> 2)) - 4u * (unsigned)hf;
        L[r] = (ford(acc[0][r]) & 0xffffff80u) | kc; K1[r] = (ford(acc[1][r]) & 0xffffff80u) | (kc - 32u); K2[r] = (ford(acc[2][r]) & 0xffffff80u) | (kc - 64u); K3[r] = (ford(acc[3][r]) & 0xffffff80u) | (kc - 96u); }
    sort16_desc(L); sort16_desc(K1); sort16_desc(K2); sort16_desc(K3);
    merge16_desc(L, K1); merge16_desc(K2, K3); merge16_desc(L, K2);
    unsigned P[16];
#pragma unroll
    for (int i = 0; i < 16; ++i) P[i] = (unsigned)__shfl_xor((int)L[i], 32);
    merge16_desc(L, P);
}
__device__ __forceinline__ float gelu_erf(float x) { return 0.5f * x * (1.0f + erff(x * 0.70710678118654752f)); }
__device__ __forceinline__ void peer_topk_phase(const Args& a, unsigned char* ws, LAS unsigned char* lds, int l, int G) {
    ws = fresh_ws(ws); const int tid = fresh_tid(), lane = tid & 63, wave = __builtin_amdgcn_readfirstlane(tid >> 6);
    LAS unsigned char* keysL = lds + RING_OFF;
    LAS unsigned char* wtab = keysL + 65536 + wave * 2048;
    const float* pk = a.in[23] + (size_t)l * 2 * 128 * 128;
    for (int i = tid; i < 2 * 128 * 16; i += 512) { const int q = i & 15, rk = i >> 4, k = rk & 127;
        const f32x4 x0 = *(const f32x4*)(pk + (size_t)rk * 128 + q * 8), x1 = *(const f32x4*)(pk + (size_t)rk * 128 + q * 8 + 4);
        v4u o; o.x = pk2(x0[0], x0[1]); o.y = pk2(x0[2], x0[3]); o.z = pk2(x1[0], x1[1]); o.w = pk2(x1[2], x1[3]);
        *(LAS v4u*)(keysL + rk * 256 + ((q ^ (k & 15)) << 4)) = o; }
    __syncthreads();
    const bf16* QPb = (const bf16*)(ws + WS_QP); unsigned* PE = (unsigned*)(ws + WS_PE); unsigned* PG = (unsigned*)(ws + WS_PG);
    const int gw = blockIdx.x * 8 + wave, NGW = G * 8;
    const int hf = lane >> 5, qrow = lane & 31, tq = qrow >> 3, hq = qrow & 7;
    for (int tile = gw; tile < NTOK / 3; tile += NGW) {
        const int tok0 = tile * 3;
        const bf16* qp = QPb + (size_t)(tok0 + (tq < 3 ? tq : 2)) * DM + hq * 256;
        unsigned L0[16], L1[16];
        peer_top16(L0, keysL, qp, 0, qrow, hf);
        peer_top16(L1, keysL, qp, 1, qrow, hf);
        unsigned tw[8];
#pragma unroll
        for (int i = 0; i < 4; ++i) { tw[i] = (127u - (L0[4 * i] & 127u)) | ((127u - (L0[4 * i + 1] & 127u)) << 8) | ((127u - (L0[4 * i + 2] & 127u)) << 16) | ((127u - (L0[4 * i + 3] & 127u)) << 24);
                                      tw[4 + i] = (127u - (L1[4 * i] & 127u)) | ((127u - (L1[4 * i + 1] & 127u)) << 8) | ((127u - (L1[4 * i + 2] & 127u)) << 16) | ((127u - (L1[4 * i + 3] & 127u)) << 24); }
        *(LAS v4u*)(wtab + lane * 32) = (v4u){tw[0], tw[1], tw[2], tw[3]}; *(LAS v4u*)(wtab + lane * 32 + 16) = (v4u){tw[4], tw[5], tw[6], tw[7]};
        float v0[16], v1[16];
#pragma unroll
        for (int i = 0; i < 16; ++i) { v0[i] = funord(L0[i] & 0xffffff80u); v1[i] = funord(L1[i] & 0xffffff80u); }
        unsigned C[16], C1[16], C2[16], C3[16];
#pragma unroll
        for (int i = 0; i < 16; ++i) { C[i] = 0u; C1[i] = 0u; C2[i] = 0u; C3[i] = 0u; }
#pragma unroll
        for (int i = 0; i < 16; ++i)
#pragma unroll
            for (int j = 0; j < 16; ++j) if ((i + 1) * (j + 1) <= 16) {
                constexpr int PRE[16] = {0, 16, 24, 29, 33, 36, 38, 40, 42, 43, 44, 45, 46, 47, 48, 49};
                const int s = PRE[i] + j; const unsigned key = (ford(v0[i] + v1[j]) & 0xffffff00u) | (255u - (unsigned)(i * 16 + j));
                if (s < 16) C[s & 15] = key; else if (s < 32) C1[s & 15] = key; else if (s < 48) C2[s & 15] = key; else C3[s & 15] = key; }
        sort16_desc(C); sort16_desc(C1); sort16_desc(C2); sort16_desc(C3);
        merge16_desc(C, C1); merge16_desc(C2, C3); merge16_desc(C, C2);
        LDS_WAIT(); asm volatile("" ::: "memory");
        float ex[16]; float sum = 0.f; const float c0 = funord(C[0] & 0xffffff00u);
#pragma unroll
        for (int r = 0; r < 16; ++r) { ex[r] = expf(funord(C[r] & 0xffffff00u) - c0); sum += ex[r]; }
        const float rs = 1.0f / sum;
        if (tq < 3) { const size_t ob = (size_t)(tok0 + tq) * 128 + hq * 16;
            if (hf == 0) { unsigned ev[16];
#pragma unroll
                for (int r = 0; r < 16; ++r) { const unsigned ci = 255u - (C[r] & 255u); const unsigned k0 = wtab[lane * 32 + (ci >> 4)], k1 = wtab[lane * 32 + 16 + (ci & 15u)]; ev[r] = k0 * 128u + k1; }
#pragma unroll
                for (int r = 0; r < 16; r += 4) *(v4u*)(PE + ob + r) = (v4u){ev[r], ev[r + 1], ev[r + 2], ev[r + 3]}; }
            else {
#pragma unroll
                for (int r = 0; r < 16; r += 4) *(v4u*)(PG + ob + r) = (v4u){__float_as_uint(ex[r] * rs), __float_as_uint(ex[r + 1] * rs), __float_as_uint(ex[r + 2] * rs), __float_as_uint(ex[r + 3] * rs)}; }
        }
        LDS_WAIT(); asm volatile("" ::: "memory");
    }
    __syncthreads();
}
#define PEER_ACC(OUT) do { _Pragma("unroll") for (int j = 0; j < 8; ++j) { const int q = (int)w[t][j >> 2][j & 3]; \
        OUT[2 * j] = __builtin_elementwise_fma(__builtin_amdgcn_cvt_pk_f32_fp8(q, false), wg2, OUT[2 * j]); OUT[2 * j + 1] = __builtin_elementwise_fma(__builtin_amdgcn_cvt_pk_f32_fp8(q, true), wg2, OUT[2 * j + 1]); } } while (0)
__device__ __forceinline__ void fma_ip(float& o, float x, float w) { asm("v_fma_f32 %0, %1, %2, %0" : "+v"(o) : "v"(x), "v"(w)); }
__device__ __forceinline__ void peer_gather_phase(const Args& a, unsigned char* ws, LAS unsigned char* lds, int l, float* xout, int G, unsigned emask = 0xffffu, int skip = 0, bool n1fuse = false) {
    ws = fresh_ws(ws); const int tid = fresh_tid(), lane = tid & 63, wave = __builtin_amdgcn_readfirstlane(tid >> 6);
    LAS unsigned char* wb = lds + RING_OFF + wave * 16384;
    LAS v2u* list = (LAS v2u*)(wb + 12288); LAS unsigned* hist = (LAS unsigned*)(wb + 15360);
    const bf16* H = (const bf16*)(ws + WS_H); const unsigned* PE = (const unsigned*)(ws + WS_PE); const unsigned* PG = (const unsigned*)(ws + WS_PG);
    const unsigned char* UV8 = ws + WS_UV8 + (size_t)l * 16384 * 4096; const float* SC = (const float*)(ws + WS_SC) + (size_t)l * 16384 * 2;
    const float* XM = (const float*)(ws + WS_XM); const float* MOD = (const float*)(ws + WS_MOD) + (size_t)l * 3 * 12288;
    const int gw = blockIdx.x * 8 + wave, NGW = G * 8;
    for (int tile = gw; tile < NTOK / 3; tile += NGW) {
        const int tok0 = tile * 3;
        {
            unsigned e[6], gb[6], pos[6];
            hist[lane] = 0u; hist[64 + lane] = 0u; hist[128 + lane] = 0u;
#pragma unroll
            for (int m = 0; m < 6; ++m) { const size_t ix = (size_t)(tok0 + (m >> 1)) * 128 + ((lane + 64 * m) & 127); e[m] = PE[ix] & emask; gb[m] = PG[ix]; }
            LDS_WAIT(); asm volatile("" ::: "memory");
#pragma unroll
            for (int m = 0; m < 6; ++m) pos[m] = __hip_atomic_fetch_add(hist + (m >> 1) * 64 + (e[m] >> 8), 1u, __ATOMIC_RELAXED, __HIP_MEMORY_SCOPE_WORKGROUP);
            LDS_WAIT(); asm volatile("" ::: "memory");
            const unsigned cnt0 = hist[lane], cnt1 = hist[64 + lane], cnt2 = hist[128 + lane]; unsigned inc0 = cnt0, inc1 = cnt1, inc2 = cnt2;
#pragma unroll
            for (int o = 1; o < 64; o <<= 1) { const unsigned t0 = (unsigned)__shfl_up((int)inc0, o), t1 = (unsigned)__shfl_up((int)inc1, o), t2 = (unsigned)__shfl_up((int)inc2, o); if (lane >= o) { inc0 += t0; inc1 += t1; inc2 += t2; } }
            LDS_WAIT(); asm volatile("" ::: "memory");
            hist[lane] = inc0 - cnt0; hist[64 + lane] = 128u + inc1 - cnt1; hist[128 + lane] = 256u + inc2 - cnt2;
            LDS_WAIT(); asm volatile("" ::: "memory");
#pragma unroll
            for (int m = 0; m < 6; ++m) { const unsigned p_ = hist[(m >> 1) * 64 + (e[m] >> 8)] + pos[m]; list[p_] = (v2u){e[m], gb[m]}; }
            LDS_WAIT(); asm volatile("" ::: "memory");
        }
        if (!(skip & 1)) {
            unsigned hq[3][8]; float hs[3];
#pragma unroll
            for (int t = 0; t < 3; ++t) { float hv[8][4]; float mx = 0.f;
#pragma unroll
                for (int j = 0; j < 8; ++j) { const v2u a0 = *(const v2u*)(H + (size_t)(tok0 + t) * DM + j * 256 + lane * 4); hv[j][0] = bflo(a0.x); hv[j][1] = bfhi(a0.x); hv[j][2] = bflo(a0.y); hv[j][3] = bfhi(a0.y);
                    mx = fmaxf(fmaxf(mx, fmaxf(fabsf(hv[j][0]), fabsf(hv[j][1]))), fmaxf(fabsf(hv[j][2]), fabsf(hv[j][3]))); }
#pragma unroll
                for (int o = 1; o < 64; o <<= 1) mx = fmaxf(mx, __shfl_xor(mx, o));
                const float inv = mx > 0.f ? 127.0f / mx : 0.f; hs[t] = mx * (1.0f / 127.0f);
#pragma unroll
                for (int j = 0; j < 8; ++j) { const int q0 = (int)rintf(hv[j][0] * inv), q1 = (int)rintf(hv[j][1] * inv), q2 = (int)rintf(hv[j][2] * inv), q3 = (int)rintf(hv[j][3] * inv);
                    hq[t][j] = (unsigned)(q0 & 0xff) | ((unsigned)(q1 & 0xff) << 8) | ((unsigned)(q2 & 0xff) << 16) | ((unsigned)q3 << 24); } }
#define PU_LOAD(W, SCL, G_, kb_) do { _Pragma("unroll") for (int t = 0; t < 3; ++t) { const v2u r = list[t * 128 + (kb_)]; const int ee = __builtin_amdgcn_readfirstlane((int)r.x); G_[t] = __uint_as_float((unsigned)__builtin_amdgcn_readfirstlane((int)r.y)); \
            const unsigned char* base = UV8 + (size_t)ee * 4096 + lane * 32; W[t][0] = *(const v4u*)base; W[t][1] = *(const v4u*)(base + 16); SCL[t] = *(const f32x2*)(SC + (size_t)ee * 2); } } while (0)
#define PU_DOT(HV, Wt) ({ int s_ = 0; _Pragma("unroll") for (int j = 0; j < 8; ++j) s_ = __builtin_amdgcn_sdot4((int)Wt[j >> 2][j & 3], (int)HV[j], s_, false); s_; })
#define PU_RED(x_) do { x_ += __builtin_amdgcn_update_dpp(0, x_, 0xB1, 0xF, 0xF, false); x_ += __builtin_amdgcn_update_dpp(0, x_, 0x4E, 0xF, 0xF, false); \
            x_ += __builtin_amdgcn_update_dpp(0, x_, 0x141, 0xF, 0xF, false); x_ += __builtin_amdgcn_update_dpp(0, x_, 0x140, 0xF, 0xF, false); \
            x_ += __builtin_amdgcn_update_dpp(0, x_, 0x142, 0xA, 0xF, false); x_ += __builtin_amdgcn_update_dpp(0, x_, 0x143, 0xC, 0xF, false); } while (0)
#define PU_COMP(W, kb_) do { int d0 = PU_DOT(hq[0], W[0]), d1 = PU_DOT(hq[1], W[1]), d2 = PU_DOT(hq[2], W[2]); PU_RED(d0); PU_RED(d1); PU_RED(d2); \
            if (lane == 63) { dl[(kb_)] = d0; dl[128 + (kb_)] = d1; dl[256 + (kb_)] = d2; } } while (0)
            LAS int* dl = (LAS int*)wb;
            v4u wA[3][2], wB[3][2];
#define PU_LOAD2(W, kb_) do { _Pragma("unroll") for (int t = 0; t < 3; ++t) { const int ee = __builtin_amdgcn_readfirstlane((int)list[t * 128 + (kb_)].x); \
            const unsigned char* base = UV8 + (size_t)ee * 4096 + lane * 32; W[t][0] = *(const v4u*)base; W[t][1] = *(const v4u*)(base + 16); } } while (0)
            PU_LOAD2(wA, 0);
#pragma unroll 1
            for (int kb = 0; kb < 128; kb += 2) {
                PU_LOAD2(wB, kb + 1); PU_COMP(wA, kb);
                if (kb + 2 < 128) PU_LOAD2(wA, kb + 2);
                PU_COMP(wB, kb + 1);
            }
            LDS_WAIT(); asm volatile("" ::: "memory");
#pragma unroll
            for (int m = 0; m < 6; ++m) { const int li = lane + 64 * m; const v2u ent = list[li]; const f32x2 sc2 = *(const f32x2*)(SC + (size_t)ent.x * 2);
                ((LAS float*)list)[2 * li + 1] = __uint_as_float(ent.y) * gelu_erf((float)dl[li] * (sc2.x * hs[m >> 1])) * sc2.y; }
#undef PU_LOAD2
#undef PU_RED
#undef PU_LOAD
#undef PU_DOT
#undef PU_COMP
        }
        LDS_WAIT(); asm volatile("" ::: "memory");
        f32x2 out0[16], out1[16], out2[16];
#pragma unroll
        for (int i = 0; i < 16; ++i) { out0[i] = (f32x2){0.f, 0.f}; out1[i] = (f32x2){0.f, 0.f}; out2[i] = (f32x2){0.f, 0.f}; }
#define PV_LOAD(W, G_, kb_) do { _Pragma("unroll") for (int t = 0; t < 3; ++t) { const v2u r = list[t * 128 + (kb_)]; const int ee = __builtin_amdgcn_readfirstlane((int)r.x); G_[t] = __uint_as_float((unsigned)__builtin_amdgcn_readfirstlane((int)r.y)); \
            const unsigned char* base = UV8 + (size_t)ee * 4096 + 2048 + lane * 32; W[t][0] = *(const v4u*)base; W[t][1] = *(const v4u*)(base + 16); } } while (0)
#define PV_FMA(O, X, Wg) do { O.x = __builtin_fmaf(X.x, Wg, O.x); O.y = __builtin_fmaf(X.y, Wg, O.y); } while (0)
#define PV_COMP(W, G_) do { _Pragma("unroll") for (int t = 0; t < 3; ++t) { const float wg = G_[t]; \
            _Pragma("unroll") for (int j = 0; j < 8; ++j) { const int q = (int)W[t][j >> 2][j & 3]; const f32x2 lo = __builtin_amdgcn_cvt_pk_f32_fp8(q, false), hi = __builtin_amdgcn_cvt_pk_f32_fp8(q, true); \
                if (t == 0) { PV_FMA(out0[2 * j], lo, wg); PV_FMA(out0[2 * j + 1], hi, wg); } \
                else if (t == 1) { PV_FMA(out1[2 * j], lo, wg); PV_FMA(out1[2 * j + 1], hi, wg); } \
                else { PV_FMA(out2[2 * j], lo, wg); PV_FMA(out2[2 * j + 1], hi, wg); } } } } while (0)
        if (!(skip & 2)) {
            v4u wA[3][2], wB[3][2]; float gA[3], gB[3];
            PV_LOAD(wA, gA, 0);
#pragma unroll 1
            for (int kb = 0; kb < 128; kb += 2) {
                PV_LOAD(wB, gB, kb + 1); PV_COMP(wA, gA);
                if (kb + 2 < 128) PV_LOAD(wA, gA, kb + 2);
                PV_COMP(wB, gB);
            }
        }
#undef PV_LOAD
#undef PV_COMP
#pragma unroll
        for (int tt = 0; tt < 3; ++tt) {
            const int row = tok0 + tt; const int r = row < NPROMPT ? 0 : 1 + ((row - NPROMPT) >> 10);
            const float* g2 = MOD + (size_t)r * 12288 + 5 * DM;
            float ss = 0.f;
#pragma unroll
            for (int j = 0; j < 8; ++j) { const int c = j * 256 + lane * 4; const size_t off = (size_t)row * DM + c;
                const f32x4 x0 = *(const f32x4*)(XM + off), ga = *(const f32x4*)(g2 + c);
                const f32x2 oa = tt == 0 ? out0[2 * j] : (tt == 1 ? out1[2 * j] : out2[2 * j]), ob = tt == 0 ? out0[2 * j + 1] : (tt == 1 ? out1[2 * j + 1] : out2[2 * j + 1]);
                const f32x4 xo = x0 + ga * (f32x4){oa.x, oa.y, ob.x, ob.y}; *(f32x4*)(xout + off) = xo;
                ss += (xo[0] * xo[0] + xo[1] * xo[1]) + (xo[2] * xo[2] + xo[3] * xo[3]); }
            if (n1fuse) { const float* n1gain = a.in[11] + DM; const float* n1mod = (const float*)(ws + WS_MOD) + (size_t)3 * 12288;
                const float rstd = 1.0f / sqrtf(wave_sum(ss) * (1.0f / DM) + EPS); const float* sh = n1mod + (size_t)r * 12288; const float* sc = sh + DM; bf16* Hw = (bf16*)(ws + WS_H);
#pragma unroll
                for (int j = 0; j < 8; ++j) { const int c = j * 256 + lane * 4; const size_t off = (size_t)row * DM + c;
                    const f32x4 x0 = *(const f32x4*)(XM + off), ga = *(const f32x4*)(g2 + c);
                    const f32x2 oa = tt == 0 ? out0[2 * j] : (tt == 1 ? out1[2 * j] : out2[2 * j]), ob = tt == 0 ? out0[2 * j + 1] : (tt == 1 ? out1[2 * j + 1] : out2[2 * j + 1]);
                    const f32x4 xo = x0 + ga * (f32x4){oa.x, oa.y, ob.x, ob.y};
                    const f32x4 gn = *(const f32x4*)(n1gain + c), s1 = *(const f32x4*)(sc + c), s0 = *(const f32x4*)(sh + c);
                    const f32x4 o = xo * rstd * gn * (s1 + 1.0f) + s0; *(v2u*)(Hw + (size_t)row * DM + c) = (v2u){pk2(o[0], o[1]), pk2(o[2], o[3])}; }
            }
        }
        asm volatile("" ::: "memory");
    }
    __syncthreads();
}
#undef PEER_ACC

__device__ __forceinline__ unsigned dg_hash(unsigned x) { x ^= x >> 16; x *= 0x7feb352du; x ^= x >> 15; x *= 0x846ca68bu; x ^= x >> 16; return x; }
__device__ __forceinline__ void dummy_gather(unsigned char* ws, int mode, int G) {
    ws = fresh_ws(ws); const int tid = fresh_tid(), lane = tid & 63, wave = __builtin_amdgcn_readfirstlane(tid >> 6);
    const unsigned char* UV8 = ws + WS_UV8; const int gw = blockIdx.x * 8 + wave;
    f32x2 hv[16], out[16];
#pragma unroll
    for (int i = 0; i < 16; ++i) { hv[i] = (f32x2){(float)(lane + i) * 0.001f, (float)(lane - i) * 0.002f}; out[i] = (f32x2){0.f, 0.f}; }
    for (int jb = 0; jb < 384; jb += 4) {
        int e[4];
#pragma unroll
        for (int t = 0; t < 4; ++t) { const unsigned hsh = dg_hash((unsigned)(gw * 384 + jb + t) * 2654435761u + 12345u); e[t] = mode == 0 ? (int)(hsh & 16383u) : (int)((((unsigned)(jb + t) / 12u) << 9) | (hsh & 511u)); }
        v4u w[4][4];
#pragma unroll
        for (int t = 0; t < 4; ++t) { const unsigned char* base = UV8 + (size_t)e[t] * 4096 + lane * 32;
            w[t][0] = *(const v4u*)base; w[t][1] = *(const v4u*)(base + 16); w[t][2] = *(const v4u*)(base + 2048); w[t][3] = *(const v4u*)(base + 2048 + 16); }
        float d[4];
#pragma unroll
        for (int t = 0; t < 4; ++t) { f32x2 s = {0.f, 0.f};
#pragma unroll
            for (int j = 0; j < 8; ++j) { const int q = (int)w[t][j >> 2][j & 3];
                s = __builtin_elementwise_fma(__builtin_amdgcn_cvt_pk_f32_fp8(q, false), hv[2 * j], s); s = __builtin_elementwise_fma(__builtin_amdgcn_cvt_pk_f32_fp8(q, true), hv[2 * j + 1], s); }
            d[t] = s.x + s.y; }
#pragma unroll
        for (int o = 1; o < 64; o <<= 1) {
#pragma unroll
            for (int t = 0; t < 4; ++t) d[t] += __shfl_xor(d[t], o); }
#pragma unroll
        for (int t = 0; t < 4; ++t) { const float wg = d[t] * 1e-3f; const f32x2 wg2 = {wg, wg};
#pragma unroll
            for (int j = 0; j < 8; ++j) { const int q = (int)w[t][2 + (j >> 2)][j & 3];
                out[2 * j] = __builtin_elementwise_fma(__builtin_amdgcn_cvt_pk_f32_fp8(q, false), wg2, out[2 * j]); out[2 * j + 1] = __builtin_elementwise_fma(__builtin_amdgcn_cvt_pk_f32_fp8(q, true), wg2, out[2 * j + 1]); } }
    }
    float* scratch = (float*)(ws + WS_PE);
    float acc = 0.f;
#pragma unroll
    for (int i = 0; i < 16; ++i) acc += out[i].x + out[i].y;
    scratch[(size_t)gw * 64 + lane] = acc;
}
#ifdef PROBE_G1NS
struct ProbeOrder : pg8::StaticOrder {
    __device__ bool next(int i, pg8::Unit& u) const { const bool r = pg8::StaticOrder::next(i, u); if (PROBE_G1NS & 2) u.pn &= 1; if (PROBE_G1NS & 4) u.pm &= 1; return r; }
};
#endif
__global__ void __launch_bounds__(512, 2) mk_fwd(Args args) {
    extern __shared__ __attribute__((aligned(16))) unsigned char lds_raw[];
    LAS unsigned char* lds = (LAS unsigned char*)lds_raw;
    const int G = gridDim.x;
    unsigned char* ws = args.ws;
    unsigned* ctl = (unsigned*)(ws + WS_CTL);
    for (int u = threadIdx.x; u < RING_OFF / 4; u += 512) ((LAS unsigned*)lds)[u] = 0u;
    __syncthreads();
    const int lo = args.ph_lo, hi = args.ph_hi;
    XcdBarrier bar; bar.bar = ctl + CW_BAR; bar.x = 0; bar.st = (volatile LAS unsigned*)(lds + 32);
    if (hi - lo > 1) bar = xcd_barrier_post(ctl + CW_BAR, (volatile LAS unsigned*)(lds + 32));
#ifndef PH_EN
#define PH_EN 0xfff
#endif
#define PHEN(k) (((PH_EN) >> (k)) & 1)
#ifndef PROBE_DUP
#define PROBE_DUP 0
#endif
#define NREP(k) ((((PROBE_DUP) >> (k)) & 1) ? 2 : 1)
#define IN(k) (lo <= (k) && (k) < hi)
#define SEAM(k) do { if (IN(k) && IN((k) + 1)) xcd_barrier(bar); } while (0)

#ifndef PROBE_XBAR
#define PROBE_XBAR 0
#endif
    if (PHEN(0) && IN(0)) { for (int rep = 0; rep < NREP(0); ++rep) p0_prologue(args, ws, lds, G, lo == 0 && hi == NPH && G == 256); }
    SEAM(0);

    for (int l = 0; l < 2; ++l) {
        ws = fresh_ws(ws);
        const int pb = 1 + 11 * l;
#define MODall ((const float*)(ws + WS_MOD))
#define Hb ((bf16*)(ws + WS_H))
#define Zb ((bf16*)(ws + WS_Z))
        const float* xin_p = l == 0 ? args.in[0] : (const float*)(ws + WS_X1);
        const float* xin_s = l == 0 ? args.in[1] : (const float*)(ws + WS_X1) + (size_t)NPROMPT * DM;
        const float* modl = MODall + (size_t)l * 3 * 12288;
        for (int xb = 0; xb < PROBE_XBAR; ++xb) xcd_barrier(bar);
        const bool n1fused = lo == 0 && hi == NPH;
        const bool defer = lo == 0 && hi == NPH && G == 256 && (int)blockIdx.x >= 192;
        if (!(l == 1 && n1fused)) {
            if (PHEN(1) && IN(pb + 0)) for (int rep = 0; rep < NREP(1); ++rep) norm_phase(xin_p, xin_s, args.in[11] + (size_t)l * DM, modl, 0, 1, Hb, G);
            SEAM(pb + 0);
        }
#ifdef PROBE_G1NS
        { ws = fresh_ws(ws);
            pg8::Gemm g{Hb, (const bf16*)(ws + WS_WIN) + (size_t)l * INW * DM, NTOK, INW, DM}; ProbeOrder S; S.init(NTOK, INW, G, (int)blockIdx.x);
            pg8::EpiNull E{(float*)(ws + WS_QA)};
            pg8::gemm_phase<pg8::EpiNull, ProbeOrder, true, true>(lds + RING_OFF, g, S, E);
            xcd_barrier(bar);
        }
#endif
        if (PHEN(2) && IN(pb + 1)) for (int rep = 0; rep < NREP(2); ++rep) { ws = fresh_ws(ws);
            pg8::Gemm g{Hb, (const bf16*)(ws + WS_WIN) + (size_t)l * INW * DM, NTOK, INW, DM}; pg8::StaticOrder S; S.init(NTOK, INW, G, (int)blockIdx.x);
            pg8::EpiBf16<0> E{Zb, INW, nullptr, 0, 0, 1.f};
            pg8::gemm_phase<pg8::EpiBf16<0>, pg8::StaticOrder, true, true>(lds + RING_OFF, g, S, E);
            if (lo == 0 && hi == NPH && G == 256 && (int)blockIdx.x >= 208) work_gemm1_tail(args, ws, l);
        }
        SEAM(pb + 1);
        const bool early = IN(pb + 2) && IN(pb + 3) && G > 64;
        if (early && (int)blockIdx.x < 32) { hgrn_item(args, ws, lds, l, (int)blockIdx.x, &bar, 28); if (l == 0 && lo == 0 && hi == NPH && G == 256) work_scan_tail(args, ws); }
        else {
            if (PHEN(3) && IN(pb + 2)) for (int rep = 0; rep < NREP(3); ++rep) prep_phase(args, ws, l, early ? 32 : 0, early ? G - 32 : G);
            SEAM(pb + 2);
            if (PHEN(4) && IN(pb + 3)) for (int rep = 0; rep < NREP(4); ++rep) {
                const int bx = blockIdx.x;
                if (G > 64 && bx < 32) { for (int rp = 0; rp < NREP(12); ++rp) hgrn_item(args, ws, lds, l, bx); }
                else {
                    const int u0 = G > 64 ? bx - 32 : bx, us = G > 64 ? G - 32 : G;
                    if (G <= 64) for (int u = bx; u < 32; u += G) hgrn_item(args, ws, lds, l, u);
                    for (int rp = 0; rp < NREP(12); ++rp)
                    for (int u = u0; u < 832; u += us) if (u >= 192 && u < 448) hgrn_item(args, ws, lds, l, 32 + (u - 192));
                    for (int rp = 0; rp < NREP(13); ++rp)
                    for (int u = u0; u < 832; u += us) if (u < 192 || u >= 448) attn_unit(ws, (char*)lds_raw, u < 192 ? u : 192 + (u - 448));
                }
            }
        }
        SEAM(pb + 3);
        if (PHEN(5) && IN(pb + 4)) for (int rep = 0; rep < NREP(5); ++rep) post_phase(args, ws, l, G);
        SEAM(pb + 4);
        if (PHEN(6) && IN(pb + 5)) for (int rep = 0; rep < NREP(6); ++rep) { ws = fresh_ws(ws);
            pg8::StaticOrder S; S.init(NTOK, DM, G, (int)blockIdx.x);
            for (int c = 0; c < 3; ++c) {
                pg8::Gemm g{(const bf16*)(ws + WS_BR) + (size_t)c * NTOK * 1024, (const bf16*)(ws + WS_WBR) + (size_t)(l * 3 + c) * DM * 1024, NTOK, DM, 1024};
                pg8::EpiGate E{Zb, INW, C_GATE + c * DM, (bf16*)(ws + WS_MGP), (bf16*)(ws + WS_MG), DM, c};
                pg8::gemm_phase<pg8::EpiGate, pg8::StaticOrder, true, true>(lds + RING_OFF, g, S, E);
            }
            if (defer) work_deferred(args, ws, lds, 3 * l + 0);
        }
        SEAM(pb + 5);
        if (PHEN(7) && IN(pb + 6)) for (int rep = 0; rep < NREP(7); ++rep) { ws = fresh_ws(ws);
            pg8::Gemm g{(const bf16*)(ws + WS_MG), (const bf16*)(ws + WS_WOUT) + (size_t)l * DM * DM, NTOK, DM, DM}; pg8::StaticOrder S; S.init(NTOK, DM, G, (int)blockIdx.x);
            pg8::EpiResid E{xin_p, xin_s, modl + 2 * DM, (float*)(ws + WS_XM)};
            pg8::gemm_phase<pg8::EpiResid, pg8::StaticOrder, true, true>(lds + RING_OFF, g, S, E);
            if (defer) work_deferred(args, ws, lds, 3 * l + 1);
        }
        SEAM(pb + 6);
        if (PHEN(8) && IN(pb + 7)) for (int rep = 0; rep < NREP(8); ++rep) norm_phase((const float*)(ws + WS_XM), (const float*)(ws + WS_XM) + (size_t)NPROMPT * DM, args.in[12] + (size_t)l * DM, modl, 3, 4, Hb, G);
        SEAM(pb + 7);
        if (PHEN(9) && IN(pb + 8)) for (int rep = 0; rep < NREP(9); ++rep) { ws = fresh_ws(ws);
            pg8::Gemm g{Hb, (const bf16*)(ws + WS_WPQ) + (size_t)l * DM * DM, NTOK, DM, DM}; pg8::StaticOrder S; S.init(NTOK, DM, G, (int)blockIdx.x);
            pg8::EpiBf16<0> E{(bf16*)(ws + WS_QP), DM, nullptr, 0, 0, 1.f};
            pg8::gemm_phase<pg8::EpiBf16<0>, pg8::StaticOrder, true, true>(lds + RING_OFF, g, S, E);
            if (defer) work_deferred(args, ws, lds, 3 * l + 2);
        }
        SEAM(pb + 8);
#ifdef PROBE_DG
        dummy_gather(ws, PROBE_DG, G);
#endif
        if (PHEN(10) && IN(pb + 9)) for (int rep = 0; rep < NREP(10); ++rep) peer_topk_phase(args, ws, lds, l, G);
        SEAM(pb + 9);
        if (PHEN(11) && IN(pb + 10)) for (int rep = 0; rep < NREP(11); ++rep) peer_gather_phase(args, ws, lds, l, l == 0 ? (float*)(ws + WS_X1) : args.out, G, 0xffffu, 0, l == 0 && n1fused);
#ifdef PROBE_GS
        peer_gather_phase(args, ws, lds, l, (float*)(ws + WS_QA), G, 0xffffu, PROBE_GS);
#endif
#ifdef PROBE_GM
        peer_gather_phase(args, ws, lds, l, (float*)(ws + WS_QA), G, PROBE_GM, PROBE_GSK);
#endif
        if (l == 0) SEAM(pb + 10);
    }
#undef MODall
#undef Hb
#undef Zb
#undef IN
#undef SEAM
}

extern "C" void kernel_launch(void* const* d_in, const int* in_sizes, int n_in, void* d_out, int out_size, void* d_ws, size_t ws_size, hipStream_t stream) {
    static int grid = 0;
    if (grid == 0) {
        if (n_in != 26 || (size_t)out_size != OUT_TOTAL || ws_size < WS_END) { fprintf(stderr, "kernel_launch: shape mismatch: n_in %d out %d ws %zu (need %zu)\n", n_in, out_size, ws_size, (size_t)WS_END); grid = -1; return; }
        int dev = 0, cus = 0, per_cu = 0;
        if (hipGetDevice(&dev) != hipSuccess || hipDeviceGetAttribute(&cus, hipDeviceAttributeMultiprocessorCount, dev) != hipSuccess) { grid = -1; return; }
        if (hipFuncSetAttribute((const void*)mk_fwd, hipFuncAttributeMaxDynamicSharedMemorySize, LDS_BYTES) != hipSuccess) { fprintf(stderr, "kernel_launch: hipFuncSetAttribute failed\n"); grid = -1; return; }
        if (hipOccupancyMaxActiveBlocksPerMultiprocessor(&per_cu, (const void*)mk_fwd, 512, LDS_BYTES) != hipSuccess || per_cu < 1) { fprintf(stderr, "kernel_launch: occupancy query says %d\n", per_cu); per_cu = 1; }
        (void)hipGetLastError();
        grid = cus;
    }
    if (grid < 0) return;
    (void)hipMemsetAsync((char*)d_ws + WS_CTL, 0, CTL_ZERO_BYTES, stream);
    Args a{};
    for (int i = 0; i < 26; ++i) a.in[i] = (const float*)d_in[i];
    a.out = (float*)d_out; a.ws = (unsigned char*)d_ws;
#if N_LAUNCH_MODE == 0
    a.ph_lo = 0; a.ph_hi = NPH;
    hipLaunchKernelGGL(mk_fwd, dim3(grid), dim3(512), LDS_BYTES, stream, a);
#else
    for (int p = 0; p < NPH; ++p) { a.ph_lo = p; a.ph_hi = p + 1; hipLaunchKernelGGL(mk_fwd, dim3(grid), dim3(512), LDS_BYTES, stream, a); }
#endif
    const hipError_t le = hipPeekAtLastError();
    if (le != hipSuccess) fprintf(stderr, "kernel_launch: launch failed: %s\n", hipGetErrorName(le));
}
```
